# Optimizing an MI355X kernel written in HIP

```python
import math
import jax, jax.numpy as jnp
from jax import lax
import numpy as np

D_MODEL = 1024
BATCH = 8
SEQ = 2048
DEPTH = 2

N_MEM = 256
D_MIX = D_MODEL
D_ATTN = D_MIX // 2
D_CONV = D_MIX - D_ATTN
HEAD_DIM = 64
N_ATTN_HEADS = D_ATTN // HEAD_DIM
CONV_WIDTH = 31
Q_BLOCK = 128
N_XATTN_HEADS = 4
XATTN_HEAD_DIM = D_MODEL // N_XATTN_HEADS
D_FF = 2816
D_IN = 3 * D_ATTN + N_ATTN_HEADS + 2 * D_CONV
EPS = 1e-6
NEG_INF = -1e30

kernel_name = "fox_conformer_macaron_hybrid"


def rmsnorm(x, g):
    xf = x.astype(jnp.float32)
    y = xf * lax.rsqrt(jnp.mean(xf * xf, axis=-1, keepdims=True) + EPS)
    return (y * g.astype(jnp.float32)).astype(x.dtype)


def layernorm(x, g, b):
    xf = x.astype(jnp.float32)
    mu = jnp.mean(xf, axis=-1, keepdims=True)
    xc = xf - mu
    y = xc * lax.rsqrt(jnp.mean(xc * xc, axis=-1, keepdims=True) + EPS)
    return (y * g.astype(jnp.float32) + b.astype(jnp.float32)).astype(x.dtype)


def swiglu(h, w_gate, w_up, w_down):
    return (jax.nn.silu(h @ w_gate) * (h @ w_up)) @ w_down


def fox_attention(q, k, v, logf):
    B, S, H, Dh = q.shape
    scale = 1.0 / math.sqrt(Dh)
    c = jnp.transpose(jnp.cumsum(logf, axis=1), (0, 2, 1))
    outs = []
    for i in range(S // Q_BLOCK):
        q0, q1 = i * Q_BLOCK, (i + 1) * Q_BLOCK
        qb = q[:, q0:q1]
        kb = k[:, :q1]
        vb = v[:, :q1]
        s = jnp.einsum('bqhd,bkhd->bhqk', qb, kb).astype(jnp.float32) * scale
        s = s + c[:, :, q0:q1, None] - c[:, :, None, :q1]
        mask = (q0 + jnp.arange(Q_BLOCK))[:, None] >= jnp.arange(q1)[None, :]
        s = jnp.where(mask[None, None], s, NEG_INF)
        p = jax.nn.softmax(s, axis=-1).astype(v.dtype)
        outs.append(jnp.einsum('bhqk,bkhd->bqhd', p, vb))
    return jnp.concatenate(outs, axis=1)


def causal_depthwise_conv(u, w, b):
    C = u.shape[-1]
    kern = w.astype(u.dtype)[:, None, :]
    y = lax.conv_general_dilated(
        u, kern, window_strides=(1,), padding=[(CONV_WIDTH - 1, 0)],
        dimension_numbers=('NWC', 'WIO', 'NWC'), feature_group_count=C)
    return y + b.astype(u.dtype)


def hybrid_mix(h, w_in, b_f, conv_w, conv_b, ln_g, ln_b, attn_g, conv_g, w_out):
    B, S, _ = h.shape
    proj = h @ w_in
    splits = [D_ATTN, 2 * D_ATTN, 3 * D_ATTN, 3 * D_ATTN + N_ATTN_HEADS,
              3 * D_ATTN + N_ATTN_HEADS + D_CONV]
    q, k, v, f_logit, a, g = jnp.split(proj, splits, axis=-1)
    q = q.reshape(B, S, N_ATTN_HEADS, HEAD_DIM)
    k = k.reshape(B, S, N_ATTN_HEADS, HEAD_DIM)
    v = v.reshape(B, S, N_ATTN_HEADS, HEAD_DIM)
    logf = jax.nn.log_sigmoid((f_logit + b_f).astype(jnp.float32))
    attn = fox_attention(q, k, v, logf).reshape(B, S, D_ATTN)
    u = a * jax.nn.sigmoid(g)
    u = causal_depthwise_conv(u, conv_w, conv_b)
    u = jax.nn.silu(layernorm(u, ln_g, ln_b))
    y = jnp.concatenate([rmsnorm(attn, attn_g), rmsnorm(u, conv_g)], axis=-1)
    return y @ w_out


def memory_cross_attention(h, mem_n, w_q, w_kv, w_o):
    B, S, _ = h.shape
    q = (h @ w_q).reshape(B, S, N_XATTN_HEADS, XATTN_HEAD_DIM)
    kv = mem_n @ w_kv
    k, v = jnp.split(kv, 2, axis=-1)
    k = k.reshape(B, -1, N_XATTN_HEADS, XATTN_HEAD_DIM)
    v = v.reshape(B, -1, N_XATTN_HEADS, XATTN_HEAD_DIM)
    s = jnp.einsum('bqhd,bmhd->bhqm', q, k).astype(jnp.float32) / math.sqrt(XATTN_HEAD_DIM)
    p = jax.nn.softmax(s, axis=-1).astype(v.dtype)
    o = jnp.einsum('bhqm,bmhd->bqhd', p, v).reshape(B, S, D_MODEL)
    return o @ w_o


def setup_inputs(seed: int = 0) -> dict:
    key = jax.random.key(seed)
    ks = iter(jax.random.split(key, 32))
    L = DEPTH

    def w(shape, fan_in):
        return jax.random.normal(next(ks), shape, jnp.float32) * (fan_in ** -0.5)

    def gain(shape):
        return 1.0 + 0.02 * jax.random.normal(next(ks), shape, jnp.float32)

    def bias(shape):
        return 0.02 * jax.random.normal(next(ks), shape, jnp.float32)

    return {
        "x": jax.random.normal(next(ks), (BATCH, SEQ, D_MODEL), jnp.float32),
        "mem": jax.random.normal(next(ks), (BATCH, N_MEM, D_MODEL), jnp.float32),
        "ffn1_norm_g": gain((L, D_MODEL)),
        "ffn1_w_gate": w((L, D_MODEL, D_FF), D_MODEL),
        "ffn1_w_up": w((L, D_MODEL, D_FF), D_MODEL),
        "ffn1_w_down": w((L, D_FF, D_MODEL), D_FF),
        "mix_norm_g": gain((L, D_MODEL)),
        "w_in": w((L, D_MODEL, D_IN), D_MODEL),
        "b_f": jax.random.uniform(next(ks), (L, N_ATTN_HEADS), jnp.float32, 1.0, 6.0),
        "conv_w": w((L, CONV_WIDTH, D_CONV), CONV_WIDTH),
        "conv_b": bias((L, D_CONV)),
        "conv_ln_g": gain((L, D_CONV)),
        "conv_ln_b": bias((L, D_CONV)),
        "attn_out_g": gain((L, D_ATTN)),
        "conv_out_g": gain((L, D_CONV)),
        "w_out": w((L, D_MIX, D_MODEL), D_MIX),
        "xattn_norm_g": gain((L, D_MODEL)),
        "mem_norm_g": gain((L, D_MODEL)),
        "xattn_w_q": w((L, D_MODEL, D_MODEL), D_MODEL),
        "xattn_w_kv": w((L, D_MODEL, 2 * D_MODEL), D_MODEL),
        "xattn_w_o": w((L, D_MODEL, D_MODEL), D_MODEL),
        "ffn2_norm_g": gain((L, D_MODEL)),
        "ffn2_w_gate": w((L, D_MODEL, D_FF), D_MODEL),
        "ffn2_w_up": w((L, D_MODEL, D_FF), D_MODEL),
        "ffn2_w_down": w((L, D_FF, D_MODEL), D_FF),
        "final_norm_g": gain((D_MODEL,)),
    }


def reference(x, mem, ffn1_norm_g, ffn1_w_gate, ffn1_w_up, ffn1_w_down, mix_norm_g, w_in, b_f,
              conv_w, conv_b, conv_ln_g, conv_ln_b, attn_out_g, conv_out_g, w_out,
              xattn_norm_g, mem_norm_g, xattn_w_q, xattn_w_kv, xattn_w_o,
              ffn2_norm_g, ffn2_w_gate, ffn2_w_up, ffn2_w_down, final_norm_g):
    for l in range(DEPTH):
        x = x + 0.5 * swiglu(rmsnorm(x, ffn1_norm_g[l]), ffn1_w_gate[l], ffn1_w_up[l], ffn1_w_down[l])
        x = x + hybrid_mix(rmsnorm(x, mix_norm_g[l]), w_in[l], b_f[l], conv_w[l], conv_b[l],
                           conv_ln_g[l], conv_ln_b[l], attn_out_g[l], conv_out_g[l], w_out[l])
        x = x + memory_cross_attention(rmsnorm(x, xattn_norm_g[l]), rmsnorm(mem, mem_norm_g[l]),
                                       xattn_w_q[l], xattn_w_kv[l], xattn_w_o[l])
        x = x + 0.5 * swiglu(rmsnorm(x, ffn2_norm_g[l]), ffn2_w_gate[l], ffn2_w_up[l], ffn2_w_down[l])
    return rmsnorm(x, final_norm_g)
```

```cpp
#include <hip/hip_runtime.h>
#include <cstdio>
#include <cstdint>
namespace nv {
constexpr int D = 1024, DFF = 2816, DIN = 2568, DATT = 512, DCONV = 512, NH = 8, HD = 64, CW = 31, NMEM = 256, XH = 4, XHD = 256, SEQ = 2048;
constexpr float EPS = 1e-6f;

__device__ __forceinline__ float wsum(float v) {
#pragma unroll
    for (int o = 1; o < 64; o <<= 1) v += __shfl_xor(v, o);
    return v;
}
__device__ __forceinline__ float wmax(float v) {
#pragma unroll
    for (int o = 1; o < 64; o <<= 1) v = fmaxf(v, __shfl_xor(v, o));
    return v;
}
__global__ void rmsnorm_k(const float* in, int ldi, const float* g, float* out, int ldo, int rows, int dim) {
    const int r = blockIdx.x * 4 + (threadIdx.x >> 6), lane = threadIdx.x & 63;
    if (r >= rows) return;
    const float* x = in + (size_t)r * ldi;
    float s = 0.f;
    for (int i = lane; i < dim; i += 64) s += x[i] * x[i];
    s = wsum(s);
    const float rs = rsqrtf(s / (float)dim + EPS);
    for (int i = lane; i < dim; i += 64) out[(size_t)r * ldo + i] = x[i] * rs * g[i];
}
__global__ void copy_k(const float* in, float* out, size_t n) {
    for (size_t i = (size_t)blockIdx.x * blockDim.x + threadIdx.x; i < n; i += (size_t)gridDim.x * blockDim.x) out[i] = in[i];
}
template <int MODE>
__global__ void gemm_k(const float* A, int lda, const float* W, const float* W2, int ldw, float* C, int ldc, const float* Res, float alpha, int R, int N, int K) {
    __shared__ float As[16][65];
    __shared__ float Bs[16][64];
    __shared__ float B2s[16][64];
    const int tx = threadIdx.x & 15, ty = threadIdx.x >> 4;
    const int m0 = blockIdx.y * 64, n0 = blockIdx.x * 64;
    float acc[4][4], acc2[4][4];
#pragma unroll
    for (int i = 0; i < 4; ++i)
#pragma unroll
        for (int j = 0; j < 4; ++j) { acc[i][j] = 0.f; acc2[i][j] = 0.f; }
    for (int k0 = 0; k0 < K; k0 += 16) {
#pragma unroll
        for (int i = 0; i < 4; ++i) {
            const int idx = threadIdx.x + i * 256;
            { const int m = idx >> 4, k = idx & 15; As[k][m] = A[(size_t)(m0 + m) * lda + k0 + k]; }
            { const int k = idx >> 6, n = idx & 63; const bool ok = (n0 + n) < N;
              Bs[k][n] = ok ? W[(size_t)(k0 + k) * ldw + n0 + n] : 0.f;
              if (MODE == 1) B2s[k][n] = ok ? W2[(size_t)(k0 + k) * ldw + n0 + n] : 0.f; }
        }
        __syncthreads();
#pragma unroll
        for (int k = 0; k < 16; ++k) {
            float a[4], b[4], b2[4];
#pragma unroll
            for (int i = 0; i < 4; ++i) a[i] = As[k][ty * 4 + i];
#pragma unroll
            for (int j = 0; j < 4; ++j) { b[j] = Bs[k][tx * 4 + j]; if (MODE == 1) b2[j] = B2s[k][tx * 4 + j]; }
#pragma unroll
            for (int i = 0; i < 4; ++i)
#pragma unroll
                for (int j = 0; j < 4; ++j) { acc[i][j] += a[i] * b[j]; if (MODE == 1) acc2[i][j] += a[i] * b2[j]; }
        }
        __syncthreads();
    }
#pragma unroll
    for (int i = 0; i < 4; ++i)
#pragma unroll
        for (int j = 0; j < 4; ++j) {
            const int m = m0 + ty * 4 + i, n = n0 + tx * 4 + j;
            if (n < N) {
                float v = acc[i][j];
                if (MODE == 1) { v = v / (1.f + expf(-v)) * acc2[i][j]; }
                if (MODE == 2) { v = Res[(size_t)m * ldc + n] + alpha * v; }
                C[(size_t)m * ldc + n] = v;
            }
        }
}
__device__ __forceinline__ float log_sigmoid(float z) { return fminf(z, 0.f) - log1pf(expf(-fabsf(z))); }
__global__ void cumsum_k(const float* P, const float* bf, float* Cc, int NS) {
    const int h = threadIdx.x; if (h >= NH) return;
    float c = 0.f;
    for (int t = 0; t < NS; ++t) { c += log_sigmoid(P[(size_t)t * DIN + 1536 + h] + bf[h]); Cc[h * NS + t] = c; }
}
__global__ void fox_k(const float* P, const float* Cc, float* ATT, int NS) {
    const int t = blockIdx.x, h = blockIdx.y, lane = threadIdx.x;
    __shared__ float qs[64];
    qs[lane] = P[(size_t)t * DIN + h * 64 + lane];
    __syncthreads();
    const float ct = Cc[h * NS + t];
    float m = -3.0e38f, l = 0.f, o = 0.f;
    for (int s0 = 0; s0 <= t; s0 += 64) {
        const int s = s0 + lane;
        float sc = -1e30f;
        if (s <= t) {
            const float* kr = P + (size_t)s * DIN + 512 + h * 64;
            float dot = 0.f;
            for (int d = 0; d < 64; ++d) dot += qs[d] * kr[d];
            sc = dot * 0.125f + (ct - Cc[h * NS + s]);
        }
        const float mn = fmaxf(m, wmax(sc));
        const float p = expf(sc - mn);
        const float corr = expf(m - mn);
        l = l * corr + wsum(p);
        o *= corr;
        for (int j = 0; j < 64; ++j) {
            const float pj = __shfl(p, j);
            if (s0 + j <= t) o += pj * P[(size_t)(s0 + j) * DIN + 1024 + h * 64 + lane];
        }
        m = mn;
    }
    ATT[(size_t)t * DATT + h * 64 + lane] = o / l;
}
__device__ __forceinline__ float bsum512(float v, float* red) {
    v = wsum(v);
    __syncthreads();
    if ((threadIdx.x & 63) == 0) red[threadIdx.x >> 6] = v;
    __syncthreads();
    float s = 0.f;
#pragma unroll
    for (int i = 0; i < 8; ++i) s += red[i];
    return s;
}
__global__ void conv_k(const float* P, const float* cw, const float* cb, const float* lg, const float* lb, const float* cg, float* Y, int NS) {
    __shared__ float red[8];
    const int t = blockIdx.x, c = threadIdx.x;
    float acc = 0.f;
    for (int j = 0; j < CW; ++j) {
        const int tt = t - (CW - 1) + j;
        if (tt >= 0) {
            const float a = P[(size_t)tt * DIN + 1544 + c], g = P[(size_t)tt * DIN + 2056 + c];
            acc += cw[j * DCONV + c] * (a / (1.f + expf(-g)));
        }
    }
    acc += cb[c];
    const float mu = bsum512(acc, red) * (1.f / DCONV);
    const float xc = acc - mu;
    const float var = bsum512(xc * xc, red) * (1.f / DCONV);
    float y = xc * rsqrtf(var + EPS) * lg[c] + lb[c];
    y = y / (1.f + expf(-y));
    const float ss = bsum512(y * y, red) * (1.f / DCONV);
    Y[(size_t)t * D + DATT + c] = y * rsqrtf(ss + EPS) * cg[c];
}
__global__ void xattn_k(const float* Qx, const float* KV, float* XO) {
    const int t = blockIdx.x, h = blockIdx.y, lane = threadIdx.x;
    __shared__ float qs[XHD];
    for (int i = lane; i < XHD; i += 64) qs[i] = Qx[(size_t)t * D + h * XHD + i];
    __syncthreads();
    float sc[4]; float m = -3.0e38f;
#pragma unroll
    for (int ch = 0; ch < 4; ++ch) {
        const float* kr = KV + (size_t)(ch * 64 + lane) * (2 * D) + h * XHD;
        float dot = 0.f;
        for (int d = 0; d < XHD; ++d) dot += qs[d] * kr[d];
        sc[ch] = dot * (1.f / 16.f);
        m = fmaxf(m, sc[ch]);
    }
    m = wmax(m);
    float l = 0.f;
#pragma unroll
    for (int ch = 0; ch < 4; ++ch) { sc[ch] = expf(sc[ch] - m); l += sc[ch]; }
    l = wsum(l);
    float o[4] = {0.f, 0.f, 0.f, 0.f};
#pragma unroll
    for (int ch = 0; ch < 4; ++ch)
        for (int j = 0; j < 64; ++j) {
            const float pj = __shfl(sc[ch], j);
            const float* vr = KV + (size_t)(ch * 64 + j) * (2 * D) + D + h * XHD;
#pragma unroll
            for (int i = 0; i < 4; ++i) o[i] += pj * vr[lane + 64 * i];
        }
#pragma unroll
    for (int i = 0; i < 4; ++i) XO[(size_t)t * D + h * XHD + lane + 64 * i] = o[i] / l;
}

struct Bufs { float *X, *HN, *P, *H, *Cc, *ATT, *Y, *QX, *MEMN, *KV, *XO; };
constexpr size_t NV_WS_BYTES = (size_t)100 << 20;
inline Bufs carve(unsigned char* base) {
    Bufs b; size_t o = 0;
    auto take = [&](size_t nfloat) { float* p = (float*)(base + o); o += ((nfloat * 4 + 255) / 256) * 256; return p; };
    b.X = take((size_t)2048 * D); b.HN = take((size_t)2048 * D); b.P = take((size_t)2048 * DIN); b.H = take((size_t)2048 * DFF);
    b.Cc = take((size_t)NH * 2048); b.ATT = take((size_t)2048 * DATT); b.Y = take((size_t)2048 * D); b.QX = take((size_t)2048 * D);
    b.MEMN = take((size_t)NMEM * D); b.KV = take((size_t)NMEM * 2 * D); b.XO = take((size_t)2048 * D);
    return b;
}
template <int MODE>
inline void gemm(hipStream_t st, const float* A, int lda, const float* W, const float* W2, int ldw, float* C, int ldc, const float* Res, float alpha, int R, int N, int K) {
    dim3 grid((N + 63) / 64, R / 64);
    hipLaunchKernelGGL(gemm_k<MODE>, grid, dim3(256), 0, st, A, lda, W, W2, ldw, C, ldc, Res, alpha, R, N, K);
}
inline void rmsnorm(hipStream_t st, const float* in, int ldi, const float* g, float* out, int ldo, int rows, int dim) {
    hipLaunchKernelGGL(rmsnorm_k, dim3((rows + 3) / 4), dim3(256), 0, st, in, ldi, g, out, ldo, rows, dim);
}
inline void forward(hipStream_t st, void* const* d_in, int b, int NS, float* out, unsigned char* wsbase) {
    Bufs B = carve(wsbase);
    auto in = [&](int i) { return (const float*)d_in[i]; };
    hipLaunchKernelGGL(copy_k, dim3(1024), dim3(256), 0, st, in(0) + (size_t)b * SEQ * D, B.X, (size_t)NS * D);
    for (int l = 0; l < 2; ++l) {
        rmsnorm(st, B.X, D, in(2) + l * D, B.HN, D, NS, D);
        gemm<1>(st, B.HN, D, in(3) + (size_t)l * D * DFF, in(4) + (size_t)l * D * DFF, DFF, B.H, DFF, nullptr, 0.f, NS, DFF, D);
        gemm<2>(st, B.H, DFF, in(5) + (size_t)l * DFF * D, nullptr, D, B.X, D, B.X, 0.5f, NS, D, DFF);
        rmsnorm(st, B.X, D, in(6) + l * D, B.HN, D, NS, D);
        gemm<0>(st, B.HN, D, in(7) + (size_t)l * D * DIN, nullptr, DIN, B.P, DIN, nullptr, 0.f, NS, DIN, D);
        hipLaunchKernelGGL(cumsum_k, dim3(1), dim3(64), 0, st, B.P, in(8) + l * NH, B.Cc, NS);
        hipLaunchKernelGGL(fox_k, dim3(NS, NH), dim3(64), 0, st, B.P, B.Cc, B.ATT, NS);
        rmsnorm(st, B.ATT, DATT, in(13) + l * DATT, B.Y, D, NS, DATT);
        hipLaunchKernelGGL(conv_k, dim3(NS), dim3(512), 0, st, B.P, in(9) + (size_t)l * CW * DCONV, in(10) + l * DCONV, in(11) + l * DCONV, in(12) + l * DCONV, in(14) + l * DCONV, B.Y, NS);
        gemm<2>(st, B.Y, D, in(15) + (size_t)l * D * D, nullptr, D, B.X, D, B.X, 1.0f, NS, D, D);
        rmsnorm(st, B.X, D, in(16) + l * D, B.HN, D, NS, D);
        gemm<0>(st, B.HN, D, in(18) + (size_t)l * D * D, nullptr, D, B.QX, D, nullptr, 0.f, NS, D, D);
        rmsnorm(st, in(1) + (size_t)b * NMEM * D, D, in(17) + l * D, B.MEMN, D, NMEM, D);
        gemm<0>(st, B.MEMN, D, in(19) + (size_t)l * D * 2 * D, nullptr, 2 * D, B.KV, 2 * D, nullptr, 0.f, NMEM, 2 * D, D);
        hipLaunchKernelGGL(xattn_k, dim3(NS, XH), dim3(64), 0, st, B.QX, B.KV, B.XO);
        gemm<2>(st, B.XO, D, in(20) + (size_t)l * D * D, nullptr, D, B.X, D, B.X, 1.0f, NS, D, D);
        rmsnorm(st, B.X, D, in(21) + l * D, B.HN, D, NS, D);
        gemm<1>(st, B.HN, D, in(22) + (size_t)l * D * DFF, in(23) + (size_t)l * D * DFF, DFF, B.H, DFF, nullptr, 0.f, NS, DFF, D);
        gemm<2>(st, B.H, DFF, in(24) + (size_t)l * DFF * D, nullptr, D, B.X, D, B.X, 0.5f, NS, D, DFF);
    }
    rmsnorm(st, B.X, D, in(25), out, D, NS, D);
}
}
extern "C" void kernel_launch(void* const* d_in, const int* in_sizes, int n_in, void* d_out, int out_size, void* d_ws, size_t ws_size, hipStream_t stream) {
    for (int b = 0; b < 8; ++b) nv::forward(stream, d_in, b, 2048, (float*)d_out + (size_t)b * 2048 * 1024, (unsigned char*)d_ws);
}
```

```cpp
#include <hip/hip_runtime.h>
#include <cstdio>
#include <cstdint>
template <int X> __device__ __forceinline__ float swz_xor(float v) { return __int_as_float(__builtin_amdgcn_ds_swizzle(__float_as_int(v), (X << 10) | 0x1f)); }
__device__ __forceinline__ float sum_x32(float v) { auto rr = __builtin_amdgcn_permlane32_swap(__float_as_uint(v), __float_as_uint(v), false, false); return __uint_as_float(rr[0]) + __uint_as_float(rr[1]); }
__device__ __forceinline__ float max_x32(float v) { auto rr = __builtin_amdgcn_permlane32_swap(__float_as_uint(v), __float_as_uint(v), false, false); return fmaxf(__uint_as_float(rr[0]), __uint_as_float(rr[1])); }
__device__ __forceinline__ float wave_sum64(float v) { v += swz_xor<1>(v); v += swz_xor<2>(v); v += swz_xor<4>(v); v += swz_xor<8>(v); v += swz_xor<16>(v); return sum_x32(v); }
namespace pg8 {
#define PG8_LAS __attribute__((address_space(3)))
typedef unsigned short bf16_t;
typedef short bf16x8 __attribute__((ext_vector_type(8)));
typedef float f32x4 __attribute__((ext_vector_type(4)));
typedef float f32x2 __attribute__((ext_vector_type(2)));
typedef unsigned u32x4 __attribute__((ext_vector_type(4)));
constexpr int BM = 256, BK = 64, HALF = 128, HTB = HALF * BK * 2  , STAGE_BYTES = 8 * HTB, NXCD = 8, WGM = 8;

__host__ __device__ __forceinline__ int lds_byte(int r, int c) { const int st = (r >> 4) * 2 + (c >> 5), rr = r & 15, cc = c & 31, ob = rr * 64 + cc * 2; return st * 1024 + (ob ^ (((ob >> 9) & 1) << 5)); }
__host__ __device__ __forceinline__ void stage_rc(int b, int& R, int& C) { const int st = b / 1024, sb = b % 1024, swz = sb ^ (((sb >> 9) & 1) << 5); R = (st >> 1) * 16 + swz / 64; C = (st & 1) * 32 + (swz % 64) / 2; }
__host__ __device__ __forceinline__ int perm32(int rho) { const int n = rho >> 4, i = rho & 15; return 8 * (i >> 2) + 4 * n + (i & 3); }

struct Unit { int pm, pn; const char* a; const char* b; int aux; };
template <int LDA, int LDB, int K_> struct Gemm { static constexpr int lda = LDA, ldb = LDB, K = K_; };

__device__ __forceinline__ unsigned cvt_pk_bf16(float lo, float hi) { unsigned r; asm volatile("v_cvt_pk_bf16_f32 %0, %1, %2" : "=v"(r) : "v"(lo), "v"(hi)); return r; }


template <class Epi, class Sched, class Gemm, bool ALIGN_EPI = true, bool SP2 = true>
__device__ __forceinline__ void gemm_phase(PG8_LAS unsigned char* lds, const Gemm g, const Sched& S, const Epi& E, const int tid) {
    const int wid = __builtin_amdgcn_readfirstlane(tid >> 6), lane = tid & 63, wr = wid >> 2, wc = wid & 3, fr = lane & 15, fq = lane >> 4;
    constexpr int K = Gemm::K, nt = K / BK;
    unsigned voffA[2], voffB[2];
#pragma unroll
    for (int i = 0; i < 2; ++i) { int R, C; stage_rc(tid * 16 + i * 8192, R, C); const int Rb = Epi::PERM ? ((R & ~31) + perm32(R & 31)) : R;
        voffA[i] = (unsigned)(R * Gemm::lda + C) * 2u; voffB[i] = (unsigned)(Rb * Gemm::ldb + C) * 2u; }
    constexpr size_t kstep = (size_t)(BK * 2);
    constexpr size_t hstepA = (size_t)HALF * Gemm::lda * 2, hstepB = (size_t)HALF * Gemm::ldb * 2;
    const unsigned ldsw = (unsigned)wid * 1024u;
    const int aoff = lds_byte(wr * 64 + fr, fq * 8), boff = lds_byte(wc * 32 + fr, fq * 8);
#define PG8_SA(b, h) (((b) * 2 + (h)) * HTB)
#define PG8_SB(b, h) ((4 + (b) * 2 + (h)) * HTB)
#define PG8_STAGE(bufoff, gbase, voff) do { _Pragma("unroll") for (int _i = 0; _i < 2; ++_i) \
        __builtin_amdgcn_global_load_lds((const unsigned*)((const char*)(gbase) + (voff)[_i]), (PG8_LAS unsigned*)(lds + (bufoff) + ldsw + _i * 8192), 16, 0, 0); } while (0)
#define PG8_LDA(dst, b, h) do { _Pragma("unroll") for (int m = 0; m < 4; ++m) _Pragma("unroll") for (int k = 0; k < 2; ++k) dst[m][k] = *(const PG8_LAS bf16x8*)(lds + PG8_SA(b, h) + aoff + m * 2048 + k * 1024); } while (0)
#define PG8_LDB(dst, b, h) do { _Pragma("unroll") for (int n = 0; n < 2; ++n) _Pragma("unroll") for (int k = 0; k < 2; ++k) dst[n][k] = *(const PG8_LAS bf16x8*)(lds + PG8_SB(b, h) + boff + n * 2048 + k * 1024); } while (0)
#define PG8_MMA(ai, bj, At, Bt) do { __builtin_amdgcn_s_setprio(1); _Pragma("unroll") for (int m = 0; m < 4; ++m) _Pragma("unroll") for (int n = 0; n < 2; ++n) _Pragma("unroll") for (int k = 0; k < 2; ++k) \
        acc[ai][bj][m][n] = __builtin_amdgcn_mfma_f32_16x16x32_bf16(Bt[n][k], At[m][k], acc[ai][bj][m][n], 0, 0, 0); __builtin_amdgcn_s_setprio(0); } while (0)
#define PG8_WAIT_V(n) asm volatile("s_waitcnt vmcnt(" #n ")" ::: "memory")
#define PG8_WAIT_L(n) asm volatile("s_waitcnt lgkmcnt(" #n ")" ::: "memory")
#define PG8_BAR __builtin_amdgcn_s_barrier()
#define PG8_SCHED __builtin_amdgcn_sched_barrier(0)
    Unit cur, nxt; int ui = 0;
    if (!S.next(0, cur)) return;
    f32x4 acc[2][2][4][2];
#pragma unroll
    for (int a = 0; a < 2; ++a)
#pragma unroll
        for (int b = 0; b < 2; ++b)
#pragma unroll
            for (int m = 0; m < 4; ++m)
#pragma unroll
                for (int n = 0; n < 2; ++n) acc[a][b][m][n] = (f32x4){0.f, 0.f, 0.f, 0.f};
    bf16x8 At[4][2], B0[2][2], B1[2][2];
    const char* cA = cur.a; const char* cB = cur.b;
    if constexpr (SP2) {
        PG8_STAGE(PG8_SB(0, 0), cB, voffB); PG8_STAGE(PG8_SB(0, 1), cB + hstepB, voffB); PG8_STAGE(PG8_SA(0, 0), cA, voffA); PG8_STAGE(PG8_SA(0, 1), cA + hstepA, voffA);
        if (wr == 1) PG8_BAR;
        PG8_WAIT_V(2); PG8_BAR;
        PG8_STAGE(PG8_SB(1, 0), cB + kstep, voffB); PG8_STAGE(PG8_SA(1, 0), cA + kstep, voffA); PG8_STAGE(PG8_SB(1, 1), cB + hstepB + kstep, voffB);
        PG8_WAIT_V(6); PG8_BAR;
    } else {
        PG8_STAGE(PG8_SB(0, 0), cB, voffB); PG8_STAGE(PG8_SA(0, 0), cA, voffA); PG8_STAGE(PG8_SB(0, 1), cB + hstepB, voffB); PG8_STAGE(PG8_SA(0, 1), cA + hstepA, voffA);
        if (wr == 1) PG8_BAR;
        PG8_WAIT_V(4); PG8_BAR;
        PG8_STAGE(PG8_SB(1, 0), cB + kstep, voffB); PG8_STAGE(PG8_SA(1, 0), cA + kstep, voffA); PG8_STAGE(PG8_SB(1, 1), cB + hstepB + kstep, voffB);
        PG8_WAIT_V(6); PG8_BAR;
    }
    for (;;) {
        const bool has_next = S.next(ui + 1, nxt);
        const char* nA = has_next ? nxt.a : cA; const char* nB = has_next ? nxt.b : cB;
#pragma unroll 1
        for (int t = 0; t < nt; t += 2) {
            const bool last = (t == nt - 2);
            const char* a1 = cA + (size_t)(t + 1) * kstep;
            const char* a2 = last ? nA : cA + (size_t)(t + 2) * kstep; const char* b2 = last ? nB : cB + (size_t)(t + 2) * kstep;
            const char* a3 = a2 + kstep; const char* b3 = b2 + kstep;
            if constexpr (Epi::MIDK > 0) { if (t == Epi::MIDK) E.midk(acc, cur, wr, wc, fr, fq); }
            if constexpr (SP2) {
            PG8_LDB(B0, 0, 0); PG8_LDB(B1, 0, 1); PG8_SCHED; PG8_LDA(At, 0, 0); PG8_STAGE(PG8_SA(1, 1), a1 + hstepA, voffA);
            PG8_WAIT_V(8); PG8_WAIT_L(0); PG8_BAR; PG8_MMA(0, 0, At, B0); PG8_MMA(0, 1, At, B1); PG8_BAR; PG8_SCHED;
            PG8_LDA(At, 0, 1); PG8_STAGE(PG8_SB(0, 0), b2, voffB); PG8_STAGE(PG8_SB(0, 1), b2 + hstepB, voffB); PG8_STAGE(PG8_SA(0, 0), a2, voffA);
            PG8_WAIT_V(8); PG8_WAIT_L(0); PG8_BAR; PG8_MMA(1, 0, At, B0); PG8_MMA(1, 1, At, B1); PG8_BAR; PG8_SCHED;
            PG8_LDB(B0, 1, 0); PG8_LDB(B1, 1, 1); PG8_SCHED; PG8_LDA(At, 1, 0); PG8_STAGE(PG8_SA(0, 1), a2 + hstepA, voffA);
            PG8_WAIT_V(8); PG8_WAIT_L(0); PG8_BAR; PG8_MMA(0, 0, At, B0); PG8_MMA(0, 1, At, B1); PG8_BAR; PG8_SCHED;
            PG8_LDA(At, 1, 1); PG8_STAGE(PG8_SB(1, 0), b3, voffB); PG8_STAGE(PG8_SB(1, 1), b3 + hstepB, voffB); PG8_STAGE(PG8_SA(1, 0), a3, voffA);
            PG8_WAIT_V(8); PG8_WAIT_L(0); PG8_BAR; PG8_MMA(1, 0, At, B0); PG8_MMA(1, 1, At, B1); PG8_BAR; PG8_SCHED;
            } else {
            PG8_LDB(B0, 0, 0); PG8_SCHED; PG8_LDA(At, 0, 0); PG8_STAGE(PG8_SA(1, 1), a1 + hstepA, voffA);
            PG8_WAIT_L(8); PG8_BAR; PG8_WAIT_L(0); PG8_MMA(0, 0, At, B0); PG8_BAR; PG8_SCHED;
            PG8_LDB(B1, 0, 1); PG8_STAGE(PG8_SB(0, 0), b2, voffB);
            PG8_BAR; PG8_WAIT_L(0); PG8_MMA(0, 1, At, B1); PG8_BAR;
            PG8_LDA(At, 0, 1); PG8_STAGE(PG8_SA(0, 0), a2, voffA);
            PG8_BAR; PG8_WAIT_L(0); PG8_MMA(1, 0, At, B0); PG8_BAR; PG8_SCHED;
            PG8_STAGE(PG8_SB(0, 1), b2 + hstepB, voffB);
            PG8_WAIT_V(6); PG8_BAR; PG8_MMA(1, 1, At, B1); PG8_BAR;
            PG8_LDB(B0, 1, 0); PG8_SCHED; PG8_LDA(At, 1, 0); PG8_STAGE(PG8_SA(0, 1), a2 + hstepA, voffA);
            PG8_WAIT_L(8); PG8_BAR; PG8_WAIT_L(0); PG8_MMA(0, 0, At, B0); PG8_BAR; PG8_SCHED;
            PG8_LDB(B1, 1, 1); PG8_STAGE(PG8_SB(1, 0), b3, voffB);
            PG8_BAR; PG8_WAIT_L(0); PG8_MMA(0, 1, At, B1); PG8_BAR;
            PG8_LDA(At, 1, 1); PG8_STAGE(PG8_SA(1, 0), a3, voffA);
            PG8_BAR; PG8_WAIT_L(0); PG8_MMA(1, 0, At, B0); PG8_BAR; PG8_SCHED;
            PG8_STAGE(PG8_SB(1, 1), b3 + hstepB, voffB);
            PG8_WAIT_V(6); PG8_BAR; PG8_MMA(1, 1, At, B1); PG8_BAR;
            }
        }
        if constexpr (ALIGN_EPI) { if (wr == 0) PG8_BAR; }
        E(acc, cur, wr, wc, fr, fq);
        if (!has_next) break;
#pragma unroll
        for (int a = 0; a < 2; ++a)
#pragma unroll
            for (int b = 0; b < 2; ++b)
#pragma unroll
                for (int m = 0; m < 4; ++m)
#pragma unroll
                    for (int n = 0; n < 2; ++n) acc[a][b][m][n] = (f32x4){0.f, 0.f, 0.f, 0.f};
        cur = nxt; cA = nA; cB = nB; ++ui;
        if constexpr (ALIGN_EPI) { if (wr == 1) PG8_BAR; }
    }
    PG8_WAIT_V(0);
    if constexpr (!ALIGN_EPI) { if (wr == 0) PG8_BAR; }
    PG8_BAR;
#undef PG8_SA
#undef PG8_SB
#undef PG8_STAGE
#undef PG8_LDA
#undef PG8_LDB
#undef PG8_MMA
#undef PG8_WAIT_V
#undef PG8_WAIT_L
#undef PG8_BAR
#undef PG8_SCHED
}
}
namespace pg8 {
constexpr float LOG2E = 1.4426950408889634f;
constexpr float RMS_EPS = 1e-6f;

template <int kind, int nM, int nN, size_t sA, size_t sB, size_t batchB = 0>
struct SchedT {
    static constexpr int nwg = nM * nN, G = 256;
    int c; const char* A; const char* B;
    __device__ __forceinline__ void init(int c_, const void* A_, const void* B_) { c = c_; A = (const char*)A_; B = (const char*)B_; }
    __device__ __forceinline__ bool next(int i, Unit& u) const {
        const int L = i * G + c; if (L >= nwg) return false;
        if constexpr (kind <= 1) {
            int wgid = L; { constexpr int q = nwg / NXCD, r = nwg % NXCD; const int xcd = wgid % NXCD, off = wgid / NXCD; wgid = (xcd < r ? xcd * (q + 1) : r * (q + 1) + (xcd - r) * q) + off; }
            constexpr int nig = WGM * nN; const int gid = wgid / nig, fm = gid * WGM, gsz = (nM - fm) < WGM ? (nM - fm) : WGM;
            u.pm = fm + ((wgid % nig) % gsz); u.pn = (wgid % nig) / gsz;
            u.a = A + (size_t)u.pm * sA; u.b = B + (size_t)u.pn * sB + (kind == 1 ? (size_t)(u.pm >> 3) * batchB : (size_t)0); u.aux = 0;
        } else if constexpr (kind == 2) {
            const int b_ = L >> 4, h = (L >> 2) & 3, t4 = L & 3;
            u.pm = b_ * 4 + h; u.pn = t4;
            u.a = A + ((size_t)b_ * 256 * 2048 + (size_t)h * 256) * 2; u.b = B + ((size_t)t4 * 256 * 1024 + (size_t)h * 256) * 2;
            u.aux = b_ * 1048576 + (h * 256) * 1024 + t4 * 256;
        } else {
            const int b_ = L >> 4, h = (L >> 2) & 3, t4 = L & 3;
            u.pm = t4; u.pn = b_ * 4 + h;
            u.a = A + ((size_t)t4 * 256 * 1024 + (size_t)h * 256) * 2; u.b = B + ((size_t)b_ * 256 * 2048 + 1024 + (size_t)h * 256) * 2;
            u.aux = b_ * 1048576 + (t4 * 256) * 1024 + h * 256;
        }
        return true;
    }
};

__device__ __forceinline__ void store8(bf16_t* p, const f32x4 v0, const f32x4 v1) {
    u32x4 w; w.x = cvt_pk_bf16(v0[0], v0[1]); w.y = cvt_pk_bf16(v0[2], v0[3]); w.z = cvt_pk_bf16(v1[0], v1[1]); w.w = cvt_pk_bf16(v1[2], v1[3]); *(u32x4*)p = w;
}
__device__ __forceinline__ float sigmoidf_fast(float z) { return __builtin_amdgcn_rcpf(1.0f + __builtin_amdgcn_exp2f(-z * LOG2E)); }
__device__ __forceinline__ f32x4 sig4(f32x4 z) { f32x4 r; r[0] = sigmoidf_fast(z[0]); r[1] = sigmoidf_fast(z[1]); r[2] = sigmoidf_fast(z[2]); r[3] = sigmoidf_fast(z[3]); return r; }

struct EpiSwiGLU {
    static constexpr bool PERM = true; static constexpr int MIDK = 0;
    bf16_t* H; const float* ss; static constexpr int ldh = 2816;
    __device__ __forceinline__ void midk(f32x4 (&)[2][2][4][2], const Unit&, int, int, int, int) const {}
    __device__ __forceinline__ void operator()(f32x4 (&acc)[2][2][4][2], const Unit& u, int wr, int wc, int fr, int fq) const {
        const int row0 = u.pm * BM + wr * 64 + fr, col0 = u.pn * HALF + wc * 32 + 8 * fq;
#pragma unroll
        for (int ai = 0; ai < 2; ++ai)
#pragma unroll
            for (int m = 0; m < 4; ++m) {
                const int row = row0 + ai * HALF + m * 16;
                const float rs = __builtin_amdgcn_rsqf(ss[row] * (1.0f / 1024.0f) + RMS_EPS);
                const f32x4 g0 = acc[ai][0][m][0] * rs, g1 = acc[ai][0][m][1] * rs, u0 = acc[ai][1][m][0] * rs, u1 = acc[ai][1][m][1] * rs;
                store8(H + (size_t)row * ldh + col0, g0 * sig4(g0) * u0, g1 * sig4(g1) * u1);
            }
    }
};

template <int MIDK_>
struct EpiResid {
    static constexpr bool PERM = true; static constexpr int MIDK = MIDK_;
    const float* xin; float* xout; bf16_t* xb; float* ssn; const float* ssa; float alpha;
    __device__ __forceinline__ void midk(f32x4 (&acc)[2][2][4][2], const Unit& u, int wr, int wc, int fr, int fq) const {
        const int row0 = u.pm * BM + wr * 64 + fr;
#pragma unroll
        for (int ai = 0; ai < 2; ++ai)
#pragma unroll
            for (int m = 0; m < 4; ++m) {
                const float rs = __builtin_amdgcn_rsqf(ssa[row0 + ai * HALF + m * 16] * (1.0f / 512.0f) + RMS_EPS);
#pragma unroll
                for (int bj = 0; bj < 2; ++bj)
#pragma unroll
                    for (int n = 0; n < 2; ++n) acc[ai][bj][m][n] *= rs;
            }
    }
    __device__ __forceinline__ void operator()(f32x4 (&acc)[2][2][4][2], const Unit& u, int wr, int wc, int fr, int fq) const {
        const int row0 = u.pm * BM + wr * 64 + fr, col0 = u.pn * BM + wc * 32 + 8 * fq;
#pragma unroll
        for (int ai = 0; ai < 2; ++ai)
#pragma unroll
            for (int m = 0; m < 4; ++m) {
                const int row = row0 + ai * HALF + m * 16; float q = 0.f;
#pragma unroll
                for (int bj = 0; bj < 2; ++bj) {
                    const size_t off = (size_t)row * 1024 + col0 + bj * HALF;
                    const f32x4 r0 = *(const f32x4*)(xin + off), r1 = *(const f32x4*)(xin + off + 4);
                    const f32x4 v0 = r0 + acc[ai][bj][m][0] * alpha, v1 = r1 + acc[ai][bj][m][1] * alpha;
                    *(f32x4*)(xout + off) = v0; *(f32x4*)(xout + off + 4) = v1;
                    store8(xb + off, v0, v1);
                    q += (v0[0] * v0[0] + v0[1] * v0[1]) + (v0[2] * v0[2] + v0[3] * v0[3]) + (v1[0] * v1[0] + v1[1] * v1[1]) + (v1[2] * v1[2] + v1[3] * v1[3]);
                }
                q += swz_xor<16>(q); q = sum_x32(q);
                if (fq == 0) atomicAdd(ssn + row, q);
            }
    }
};

struct EpiWin {
    static constexpr bool PERM = true; static constexpr int MIDK = 0;
    bf16_t *Y, *KB, *VB, *UB; float* LOGFT; const float* ss; const float* bfp; float qscale;
    __device__ __forceinline__ void midk(f32x4 (&)[2][2][4][2], const Unit&, int, int, int, int) const {}
    __device__ __forceinline__ void operator()(f32x4 (&acc)[2][2][4][2], const Unit& u, int wr, int wc, int fr, int fq) const {
        const int row0 = u.pm * BM + wr * 64 + fr, cw = wc * 32 + 8 * fq; const int pn = u.pn;
#pragma unroll
        for (int ai = 0; ai < 2; ++ai)
#pragma unroll
            for (int m = 0; m < 4; ++m) {
                const int row = row0 + ai * HALF + m * 16;
                const float rs = __builtin_amdgcn_rsqf(ss[row] * (1.0f / 1024.0f) + RMS_EPS);
                if (pn < 6) {
                    bf16_t* base; int ld; float sc = rs;
                    if (pn < 2) { base = Y + pn * BM; ld = 1024; sc = rs * qscale; } else if (pn < 4) { base = KB + (pn - 2) * BM; ld = 512; } else { base = VB + (pn - 4) * BM; ld = 512; }
#pragma unroll
                    for (int bj = 0; bj < 2; ++bj) store8(base + (size_t)row * ld + bj * HALF + cw, acc[ai][bj][m][0] * sc, acc[ai][bj][m][1] * sc);
                } else if (pn < 10) {
                    const f32x4 a0 = acc[ai][0][m][0] * rs, a1 = acc[ai][0][m][1] * rs, g0 = acc[ai][1][m][0] * rs, g1 = acc[ai][1][m][1] * rs;
                    store8(UB + (size_t)row * 512 + (pn - 6) * HALF + cw, a0 * sig4(g0), a1 * sig4(g1));
                } else {
                    if (wc == 0 && fq == 0) {
                        const int b = row >> 11, t = row & 2047;
#pragma unroll
                        for (int n = 0; n < 2; ++n)
#pragma unroll
                            for (int e = 0; e < 4; ++e) {
                                const int h = 4 * n + e; const float z = acc[ai][0][m][n][e] * rs + bfp[h];
                                LOGFT[(size_t)(b * 8 + h) * 2048 + t] = fminf(z, 0.f) - log1pf(expf(-fabsf(z)));
                            }
                    }
                }
            }
    }
};

struct EpiRowScale {
    static constexpr bool PERM = true; static constexpr int MIDK = 0;
    bf16_t* O; const float* ssr; float scale; static constexpr int ldc = 2048;
    __device__ __forceinline__ void midk(f32x4 (&)[2][2][4][2], const Unit&, int, int, int, int) const {}
    __device__ __forceinline__ void operator()(f32x4 (&acc)[2][2][4][2], const Unit& u, int wr, int wc, int fr, int fq) const {
        const int row0 = u.pm * BM + wr * 64 + fr, col0 = u.pn * BM + wc * 32 + 8 * fq;
#pragma unroll
        for (int ai = 0; ai < 2; ++ai)
#pragma unroll
            for (int m = 0; m < 4; ++m) {
                const int row = row0 + ai * HALF + m * 16;
                const float rs = (ssr ? __builtin_amdgcn_rsqf(ssr[row] * (1.0f / 1024.0f) + RMS_EPS) : 1.0f) * scale;
#pragma unroll
                for (int bj = 0; bj < 2; ++bj) store8(O + (size_t)row * ldc + col0 + bj * HALF, acc[ai][bj][m][0] * rs, acc[ai][bj][m][1] * rs);
            }
    }
};

struct EpiAux {
    static constexpr bool PERM = true; static constexpr int MIDK = 0;
    bf16_t* O; float scale; static constexpr int ldc = 1024;
    __device__ __forceinline__ void midk(f32x4 (&)[2][2][4][2], const Unit&, int, int, int, int) const {}
    __device__ __forceinline__ void operator()(f32x4 (&acc)[2][2][4][2], const Unit& u, int wr, int wc, int fr, int fq) const {
        bf16_t* base = O + u.aux + (size_t)(wr * 64 + fr) * ldc + wc * 32 + 8 * fq;
#pragma unroll
        for (int ai = 0; ai < 2; ++ai)
#pragma unroll
            for (int m = 0; m < 4; ++m)
#pragma unroll
                for (int bj = 0; bj < 2; ++bj) store8(base + (size_t)(ai * HALF + m * 16) * ldc + bj * HALF, acc[ai][bj][m][0] * scale, acc[ai][bj][m][1] * scale);
    }
};

struct EpiSoftmax {
    static constexpr bool PERM = true; static constexpr int MIDK = 0;
    bf16_t* XP; const float* ss; PG8_LAS float* scr;
    __device__ __forceinline__ void midk(f32x4 (&)[2][2][4][2], const Unit&, int, int, int, int) const {}
    __device__ __forceinline__ void operator()(f32x4 (&acc)[2][2][4][2], const Unit& u, int wr, int wc, int fr, int fq) const {
        const int row0 = u.pm * BM + wr * 64 + fr, col0 = u.pn * BM + wc * 32 + 8 * fq;
        PG8_LAS float* TM = scr; PG8_LAS float* TS = scr + 1024;
        float rs[2][4];
#pragma unroll
        for (int ai = 0; ai < 2; ++ai)
#pragma unroll
            for (int m = 0; m < 4; ++m) {
                const int rl = ai * HALF + wr * 64 + m * 16 + fr;
                rs[ai][m] = __builtin_amdgcn_rsqf(ss[u.pm * BM + rl] * (1.0f / 1024.0f) + RMS_EPS);
                float v = -3.0e38f;
#pragma unroll
                for (int bj = 0; bj < 2; ++bj)
#pragma unroll
                    for (int n = 0; n < 2; ++n) { const f32x4 x = acc[ai][bj][m][n]; v = fmaxf(v, fmaxf(fmaxf(x[0], x[1]), fmaxf(x[2], x[3]))); }
                v = fmaxf(v, swz_xor<16>(v)); v = max_x32(v);
                if (fq == 0) TM[rl * 4 + wc] = v * rs[ai][m];
            }
        asm volatile("s_waitcnt lgkmcnt(0)" ::: "memory"); __builtin_amdgcn_s_barrier(); asm volatile("" ::: "memory");
#pragma unroll
        for (int ai = 0; ai < 2; ++ai)
#pragma unroll
            for (int m = 0; m < 4; ++m) {
                const int rl = ai * HALF + wr * 64 + m * 16 + fr;
                const f32x4 t = *(const PG8_LAS f32x4*)(TM + rl * 4);
                const float mrow = fmaxf(fmaxf(t[0], t[1]), fmaxf(t[2], t[3]));
                float s = 0.f;
#pragma unroll
                for (int bj = 0; bj < 2; ++bj)
#pragma unroll
                    for (int n = 0; n < 2; ++n) { f32x4 x = acc[ai][bj][m][n] * rs[ai][m] - mrow;
                        x[0] = __builtin_amdgcn_exp2f(x[0]); x[1] = __builtin_amdgcn_exp2f(x[1]); x[2] = __builtin_amdgcn_exp2f(x[2]); x[3] = __builtin_amdgcn_exp2f(x[3]);
                        acc[ai][bj][m][n] = x; s += (x[0] + x[1]) + (x[2] + x[3]); }
                s += swz_xor<16>(s); s = sum_x32(s);
                if (fq == 0) TS[rl * 4 + wc] = s;
            }
        asm volatile("s_waitcnt lgkmcnt(0)" ::: "memory"); __builtin_amdgcn_s_barrier(); asm volatile("" ::: "memory");
#pragma unroll
        for (int ai = 0; ai < 2; ++ai)
#pragma unroll
            for (int m = 0; m < 4; ++m) {
                const int rl = ai * HALF + wr * 64 + m * 16 + fr;
                const f32x4 t = *(const PG8_LAS f32x4*)(TS + rl * 4);
                const float inv = __builtin_amdgcn_rcpf((t[0] + t[1]) + (t[2] + t[3]));
#pragma unroll
                for (int bj = 0; bj < 2; ++bj) store8(XP + (size_t)(u.pm * BM + rl) * 1024 + col0 + bj * HALF, acc[ai][bj][m][0] * inv, acc[ai][bj][m][1] * inv);
            }
    }
};
}
#include <hip/hip_bf16.h>
namespace attn_body {
using bf16=__hip_bfloat16;
using bf16x8=__attribute__((ext_vector_type(8)))short;
using s16x4=__attribute__((ext_vector_type(4)))short;
using f32x16=__attribute__((ext_vector_type(16)))float;
using f32x4_t=__attribute__((ext_vector_type(4)))float;
using u32x4=__attribute__((ext_vector_type(4)))unsigned;
#define ATT_LAS __attribute__((address_space(3)))
constexpr int BATCH=8,NHEAD=8,SEQ=2048,D=64,QP=1024,KP=512;
constexpr int NW=8,QBLK=32,QB=QBLK*NW,KVBLK=64,NQB=SEQ/QB;
__device__ __forceinline__ int crow(int r,int hi){return (r&3)+8*(r>>2)+4*hi;}
#define SBAR() __builtin_amdgcn_sched_barrier(0)
__device__ __forceinline__ void cmask(f32x16&p0,f32x16&p1,int jb,int qrel,int hi){
  const float NEG=-INFINITY; int kb=64*jb+4*hi;
  #pragma unroll
  for(int r=0;r<16;++r){int kv=kb+(r&3)+8*(r>>2); if(kv>qrel)p0[r]=NEG; if(kv+32>qrel)p1[r]=NEG;}
}
constexpr int NSLOT=3, SLOTB=8192;
constexpr int LDS_K=0, LDS_V=NSLOT*SLOTB, LDS_WS=2*NSLOT*SLOTB, LDS_OST=LDS_WS+NW*64*4, LDS_CB=LDS_OST+NW*4096  , LDS_WT=LDS_CB+SEQ*4, LDS_BYTES=LDS_WT+64;
__device__ __forceinline__ void glds16(const void*gsrc,unsigned lds_dst){unsigned keep;
  asm volatile("s_mov_b32 %0, m0\n\ts_mov_b32 m0, %2\n\ts_nop 0\n\tglobal_load_lds_dwordx4 %1, off\n\ts_mov_b32 m0, %0":"=&s"(keep):"v"(gsrc),"s"(lds_dst):"memory");}
__device__ __forceinline__ float max3f(float a,float b,float c){float r;asm("v_max3_f32 %0, %1, %2, %3":"=v"(r):"v"(a),"v"(b),"v"(c));return r;}
__device__ __forceinline__ float max2f(float a,float b){float r;asm("v_max_f32_e32 %0, %1, %2":"=v"(r):"v"(a),"v"(b));return r;}
__device__ __forceinline__ float fadd_s(float a,float b){float r;asm("v_add_f32_e32 %0, %1, %2":"=v"(r):"v"(a),"v"(b));return r;}
__device__ __forceinline__ float fsub_s(float a,float b){float r;asm("v_sub_f32_e32 %0, %1, %2":"=v"(r):"v"(a),"v"(b));return r;}
typedef float f32x2_t __attribute__((ext_vector_type(2))); typedef __bf16 bf16x2_t __attribute__((ext_vector_type(2)));
__device__ __forceinline__ unsigned cvtpk_s(float lo,float hi){f32x2_t v={lo,hi};bf16x2_t b=__builtin_convertvector(v,bf16x2_t);return __builtin_bit_cast(unsigned,b);}
#define WAIT_BAR(N) asm volatile("s_waitcnt vmcnt(" #N ") lgkmcnt(0)\n\ts_barrier":::"memory")

__device__ __forceinline__ void qkt(f32x16&p0,f32x16&p1,const char*Kslot,const bf16x8*qr,const f32x16&negm,int r32,int hi){
  const char*kb=Kslot+hi*1024+r32*16;
  #pragma unroll
  for(int d0=0;d0<4;++d0){
    const bf16x8 b0=*reinterpret_cast<const bf16x8*>(kb+d0*2048);
    const bf16x8 b1=*reinterpret_cast<const bf16x8*>(kb+d0*2048+512);
    if(d0==0){p0=__builtin_amdgcn_mfma_f32_32x32x16_bf16(b0,qr[0],negm,0,0,0);p1=__builtin_amdgcn_mfma_f32_32x32x16_bf16(b1,qr[0],negm,0,0,0);}
    else{p0=__builtin_amdgcn_mfma_f32_32x32x16_bf16(b0,qr[d0],p0,0,0,0);p1=__builtin_amdgcn_mfma_f32_32x32x16_bf16(b1,qr[d0],p1,0,0,0);}}
}
typedef ATT_LAS const char* lds_cptr;
typedef short v4i16_t __attribute__((ext_vector_type(4)));
__device__ __forceinline__ void kload8(bf16x8*kf,lds_cptr kp){
  kf[0]=*(const ATT_LAS bf16x8*)(kp);      kf[1]=*(const ATT_LAS bf16x8*)(kp+512);
  kf[2]=*(const ATT_LAS bf16x8*)(kp+2048); kf[3]=*(const ATT_LAS bf16x8*)(kp+2560);
  kf[4]=*(const ATT_LAS bf16x8*)(kp+4096); kf[5]=*(const ATT_LAS bf16x8*)(kp+4608);
  kf[6]=*(const ATT_LAS bf16x8*)(kp+6144); kf[7]=*(const ATT_LAS bf16x8*)(kp+6656);
}
__device__ __forceinline__ void kload2(bf16x8*kf,lds_cptr kp,int j){ kf[2*j]=*(const ATT_LAS bf16x8*)(kp+j*2048); kf[2*j+1]=*(const ATT_LAS bf16x8*)(kp+j*2048+512); }
__device__ __forceinline__ s16x4 vtr(lds_cptr p){ return __builtin_bit_cast(s16x4,__builtin_amdgcn_ds_read_tr16_b64_v4i16((ATT_LAS v4i16_t*)p)); }
__device__ __forceinline__ float rowmax(const f32x16&p0,const f32x16&p1){
  float a=max3f(p0[0],p0[1],p1[0]),b=max3f(p0[2],p0[3],p1[1]);a=max3f(a,p1[2],p1[3]);
  #pragma unroll
  for(int r=4;r<16;r+=4){a=max3f(a,p0[r],p0[r+1]);b=max3f(b,p0[r+2],p0[r+3]);a=max3f(a,p1[r],p1[r+1]);b=max3f(b,p1[r+2],p1[r+3]);}
  const float m=max2f(a,b);
  auto rr=__builtin_amdgcn_permlane32_swap(__float_as_uint(m),__float_as_uint(m),false,false);
  return max2f(__uint_as_float(rr[0]),__uint_as_float(rr[1]));
}
__device__ __forceinline__ void pv(f32x16*o,int vb,bf16x8 pa0,bf16x8 pa1,bf16x8 pa2,bf16x8 pa3){
  #pragma unroll
  for(int d0=0;d0<2;++d0){s16x4 lo[4],hi[4];
    #pragma unroll
    for(int ks=0;ks<4;++ks){
      asm volatile("ds_read_b64_tr_b16 %0,%1 offset:%c2":"=&v"(lo[ks]):"v"(vb),"i"(d0*4096+ks*1024):"memory");
      asm volatile("ds_read_b64_tr_b16 %0,%1 offset:%c2":"=&v"(hi[ks]):"v"(vb),"i"(d0*4096+ks*1024+512):"memory");}
    asm volatile("s_waitcnt lgkmcnt(0)":::"memory");SBAR();
    #define PK(k) (bf16x8){lo[k][0],lo[k][1],lo[k][2],lo[k][3],hi[k][0],hi[k][1],hi[k][2],hi[k][3]}
    o[d0]=__builtin_amdgcn_mfma_f32_32x32x16_bf16(pa0,PK(0),o[d0],0,0,0);
    o[d0]=__builtin_amdgcn_mfma_f32_32x32x16_bf16(pa1,PK(1),o[d0],0,0,0);
    o[d0]=__builtin_amdgcn_mfma_f32_32x32x16_bf16(pa2,PK(2),o[d0],0,0,0);
    o[d0]=__builtin_amdgcn_mfma_f32_32x32x16_bf16(pa3,PK(3),o[d0],0,0,0);
    #undef PK
  }
}
__device__ __forceinline__ void scan_bias(const float*LOGFT,int bh,char*shm,const int tid){
  const int lane=tid&63,wid=tid>>6;
  ATT_LAS float*cb=(ATT_LAS float*)(shm+LDS_CB); ATT_LAS float*wt=(ATT_LAS float*)(shm+LDS_WT);
  const f32x4_t v=*(const f32x4_t*)(LOGFT+(size_t)bh*SEQ+4*tid);
  const float s0=v[0],s1=s0+v[1],s2=s1+v[2],s3=s2+v[3];
  float incl=s3;
  #pragma unroll
  for(int o=1;o<64;o<<=1){const float n=__int_as_float(__builtin_amdgcn_ds_bpermute((lane-o)<<2,__float_as_int(incl))); if(lane>=o)incl+=n;}
  if(lane==63)wt[wid]=incl;
  asm volatile("s_waitcnt lgkmcnt(0)\n\ts_barrier":::"memory");
  float woff=0.f;
  #pragma unroll
  for(int w=0;w<8;++w){const float x=wt[w]; if(w<wid)woff+=x;}
  const float ex=woff+incl-s3; const float L2E=-1.4426950408889634f;
  f32x4_t o4; o4[0]=(ex+s0)*L2E;o4[1]=(ex+s1)*L2E;o4[2]=(ex+s2)*L2E;o4[3]=(ex+s3)*L2E;
  *(ATT_LAS f32x4_t*)(cb+4*tid)=o4;
  asm volatile("s_waitcnt lgkmcnt(0)\n\ts_barrier":::"memory");
}
template<int THRL> __device__ __forceinline__ void attn_unit(int b,int h,int qb,const bf16*Q,const bf16*K,const bf16*V,bf16*O,float*ssa,char*shm,const int tid){
  const int lane=tid&63,r32=lane&31,hi=lane>>5; const int wid=__builtin_amdgcn_readfirstlane(tid>>6);
  const long rowbase=(long)b*SEQ; const int q0=qb*QB;
  const bf16*Qw=Q+(rowbase+q0+wid*QBLK)*QP+h*D;
  const bf16*Kh=K+rowbase*KP+h*D,*Vh=V+rowbase*KP+h*D;
  const unsigned lds0=(unsigned)(uintptr_t)shm;
  float*wsf=(float*)(shm+LDS_WS)+wid*64;
  const ATT_LAS float*cbh=(const ATT_LAS float*)(shm+LDS_CB)+4*hi;
  const bf16*ksrc=Kh+(long)lane*KP+wid*8;
  const bf16*vsrc=Vh+(long)(16*(wid&3)+(lane>>2))*KP+(wid>>2)*32+(lane&3)*8;
  const unsigned kdst=lds0+LDS_K+wid*1024, vdst=lds0+LDS_V+wid*1024;
  #define DMA_K(t,slot) glds16(ksrc+(long)(t)*KVBLK*KP,(unsigned)__builtin_amdgcn_readfirstlane(kdst+(slot)))
  #define DMA_V(t,slot) glds16(vsrc+(long)(t)*KVBLK*KP,(unsigned)__builtin_amdgcn_readfirstlane(vdst+(slot)))
  const int vb0=(int)(lds0+LDS_V)+((lane>>4)&1)*32+(lane&3)*8+(4*hi+((lane&15)>>2))*64;
  const char*Kbase=shm+LDS_K; bf16x8 kf[8];
  const lds_cptr shm3=(lds_cptr)shm; const lds_cptr kp0=shm3+LDS_K+hi*1024+r32*16; const lds_cptr vp0=shm3+LDS_V+((lane>>4)&1)*32+(lane&3)*8+(4*hi+((lane&15)>>2))*64;
  const int NT=(q0+QB)/KVBLK;
  DMA_K(0,0);DMA_V(0,0);DMA_K(1,SLOTB);
  bf16x8 qr[4];
  #pragma unroll
  for(int d0=0;d0<4;++d0)qr[d0]=*reinterpret_cast<const bf16x8*>(&Qw[(long)r32*QP+d0*16+hi*8]);
  float mhat=0.f,l_reg=0.f;f32x16 o[2];o[0]=f32x16{};o[1]=f32x16{};f32x16 negm=f32x16{};asm volatile("":"+v"(negm));
  const int qrel=wid*QBLK+r32;
  #define CMASK(P0,P1,t) do{int jb_=(t)-(NT-4); if(jb_>=0)cmask(P0,P1,jb_,qrel,hi);}while(0)
  #define ADDB(P0,P1,t) do{ const ATT_LAS float*cbt_=cbh+64*(t); \
    _Pragma("unroll") for(int j_=0;j_<4;++j_){ const f32x4_t b0_=*(const ATT_LAS f32x4_t*)(cbt_+8*j_), b1_=*(const ATT_LAS f32x4_t*)(cbt_+32+8*j_); \
      _Pragma("unroll") for(int i_=0;i_<4;++i_){P0[4*j_+i_]+=b0_[i_];P1[4*j_+i_]+=b1_[i_];} } }while(0)
  bool resc=false;
  #define START(P0,P1) do{ const float rm=rowmax(P0,P1); resc=false; \
    { const float dl=rm; mhat=fadd_s(mhat,dl); \
      _Pragma("unroll") for(int r=0;r<16;++r){P0[r]=fsub_s(P0[r],dl);P1[r]=fsub_s(P1[r],dl);} \
      _Pragma("unroll") for(int r=0;r<16;++r)negm[r]=-mhat; asm volatile("":"+v"(negm)); } \
    _Pragma("unroll") for(int r=0;r<16;++r)P0[r]=__builtin_amdgcn_exp2f(P0[r]); }while(0)
  #define RESC() do{ if(resc){ asm volatile("s_waitcnt lgkmcnt(0)":::"memory"); \
      _Pragma("unroll") for(int d_=0;d_<2;++d_) _Pragma("unroll") for(int r=0;r<16;++r)o[d_][r]*=wsf[crow(r,hi)]; } }while(0)
  f32x16 pA0,pA1,pB0,pB1;
  int sl_prev=0,sl_cur=0,sl_next=SLOTB;
  #define ROT() do{sl_prev=sl_cur;sl_cur=sl_next;sl_next=(sl_next==(NSLOT-1)*SLOTB)?0:sl_next+SLOTB;}while(0)
  DMA_K(2,2*SLOTB);
  WAIT_BAR(3);
  qkt(pA0,pA1,Kbase,qr,negm,r32,hi);asm volatile("s_nop 15\n\ts_nop 7":"+v"(pA0),"+v"(pA1));ADDB(pA0,pA1,0);asm volatile("s_nop 3":"+v"(pA0),"+v"(pA1));CMASK(pA0,pA1,0);
  START(pA0,pA1);
  _Pragma("unroll") for(int r=0;r<16;++r)pA1[r]=__builtin_amdgcn_exp2f(pA1[r]);
  WAIT_BAR(0);
  DMA_K(3,0);DMA_V(1,SLOTB);
  ROT();
  kload8(kf,kp0+sl_cur);
  WAIT_BAR(2);
  s16x4 vlo[8],vhi[8]; u32x4 pw0,pw1,pw2,pw3;
  #define PKW(P,B) cvtpk_s(P[B],P[B+1])
  #define PAF(k) __builtin_bit_cast(bf16x8,pw##k)
  #define VFR(i) (bf16x8){vlo[i][0],vlo[i][1],vlo[i][2],vlo[i][3],vhi[i][0],vhi[i][1],vhi[i][2],vhi[i][3]}
  #define PIN(x) asm volatile("":"+v"(x))
  #define MX3(a,b,c) __builtin_fmaxf(__builtin_fmaxf((a),(b)),(c))
  #define GAPA(MF,A0,A1,A2,A3,W0,W1,PW) do{ MF; sacc+=A0; sacc+=A1; sacc+=A2; sacc+=A3; PIN(sacc); W0; W1; PIN(PW); SBAR(); }while(0)
  #define EX(v) __builtin_amdgcn_exp2f(v)
  #define GAPB(MF,X,B) do{ MF; X[B]=EX(X[B]); X[B+1]=EX(X[B+1]); X[B+2]=EX(X[B+2]); X[B+3]=EX(X[B+3]); PIN(X); SBAR(); }while(0)
  #define VRD(i) do{ vlo[i]=vtr(vp_+(((i)>>2)*4096+((i)&3)*1024)); vhi[i]=vtr(vp_+(((i)>>2)*4096+((i)&3)*1024+512)); }while(0)
  #define KRD(G,j) do{ if(G){ kload2(kf,kp0+sl_next,j); SBAR(); } }while(0)
  #define STEP(C0,C1,P0,P1,t,GK,GV,GL) do{ SBAR(); \
    const lds_cptr vp_=vp0+sl_prev; \
    VRD(0); SBAR(); float sacc=(P0[0]+P0[1]); \
    GAPA(C0=__builtin_amdgcn_mfma_f32_32x32x16_bf16(kf[0],qr[0],negm,0,0,0), P0[2],P0[3],P0[4],P0[5],     pw0[0]=PKW(P0,0), pw0[1]=PKW(P0,2), pw0); \
    VRD(4); SBAR(); GAPA(C1=__builtin_amdgcn_mfma_f32_32x32x16_bf16(kf[1],qr[0],negm,0,0,0), P0[6],P0[7],P0[8],P0[9],     pw0[2]=PKW(P0,4), pw0[3]=PKW(P0,6), pw0); \
    VRD(1); SBAR(); GAPA(C0=__builtin_amdgcn_mfma_f32_32x32x16_bf16(kf[2],qr[1],C0,0,0,0),   P0[10],P0[11],P0[12],P0[13], pw1[0]=PKW(P0,8), pw1[1]=PKW(P0,10), pw1); \
    VRD(5); SBAR(); GAPA(C1=__builtin_amdgcn_mfma_f32_32x32x16_bf16(kf[3],qr[1],C1,0,0,0),   P0[14],P0[15],P1[0],P1[1],   pw1[2]=PKW(P0,12),pw1[3]=PKW(P0,14), pw1); \
    VRD(2); SBAR(); GAPA(C0=__builtin_amdgcn_mfma_f32_32x32x16_bf16(kf[4],qr[2],C0,0,0,0),   P1[2],P1[3],P1[4],P1[5],     pw2[0]=PKW(P1,0), pw2[1]=PKW(P1,2), pw2); \
    VRD(6); SBAR(); GAPA(C1=__builtin_amdgcn_mfma_f32_32x32x16_bf16(kf[5],qr[2],C1,0,0,0),   P1[6],P1[7],P1[8],P1[9],     pw2[2]=PKW(P1,4), pw2[3]=PKW(P1,6), pw2); \
    VRD(3); SBAR(); GAPA(C0=__builtin_amdgcn_mfma_f32_32x32x16_bf16(kf[6],qr[3],C0,0,0,0),   P1[10],P1[11],P1[12],P1[13], pw3[0]=PKW(P1,8), pw3[1]=PKW(P1,10), pw3); \
    VRD(7); SBAR(); GAPA(C1=__builtin_amdgcn_mfma_f32_32x32x16_bf16(kf[7],qr[3],C1,0,0,0),   P1[14],P1[15],0.f,0.f,       pw3[2]=PKW(P1,12),pw3[3]=PKW(P1,14), pw3); \
    l_reg+=sacc; \
    if(GK){DMA_K((t)+3,sl_cur);} if(GV){DMA_V((t)+1,sl_next);} \
    ADDB(C0,C1,t); \
    CMASK(C0,C1,t); \
    { float a=MX3(C0[0],C0[1],C1[0]),b=MX3(C0[2],C0[3],C1[1]); a=MX3(a,C1[2],C1[3]); \
      _Pragma("unroll") for(int r=4;r<16;r+=4){a=MX3(a,C0[r],C0[r+1]);b=MX3(b,C0[r+2],C0[r+3]);a=MX3(a,C1[r],C1[r+1]);b=MX3(b,C1[r+2],C1[r+3]);} \
      float rm=__builtin_fmaxf(a,b); { auto rr=__builtin_amdgcn_permlane32_swap(__float_as_uint(rm),__float_as_uint(rm),false,false); rm=__builtin_fmaxf(__uint_as_float(rr[0]),__uint_as_float(rr[1])); } \
      resc=false; \
      if(__builtin_expect(__any(rm>(float)THRL),0)){ const float dl=__builtin_fmaxf(rm,0.f); mhat+=dl; \
        _Pragma("unroll") for(int r=0;r<16;++r){C0[r]-=dl;C1[r]-=dl;} \
        _Pragma("unroll") for(int r=0;r<16;++r)negm[r]=-mhat; asm volatile("":"+v"(negm)); \
        const float f=__builtin_amdgcn_exp2f(-dl); l_reg*=f; if(hi==0)wsf[r32]=f; resc=true; } } \
    SBAR(); \
    GAPB(o[0]=__builtin_amdgcn_mfma_f32_32x32x16_bf16(PAF(0),VFR(0),o[0],0,0,0), C0,0); \
    GAPB(o[1]=__builtin_amdgcn_mfma_f32_32x32x16_bf16(PAF(0),VFR(4),o[1],0,0,0), C0,4); \
    KRD(GL,0); GAPB(o[0]=__builtin_amdgcn_mfma_f32_32x32x16_bf16(PAF(1),VFR(1),o[0],0,0,0), C0,8); \
    KRD(GL,1); GAPB(o[1]=__builtin_amdgcn_mfma_f32_32x32x16_bf16(PAF(1),VFR(5),o[1],0,0,0), C0,12); \
    KRD(GL,2); GAPB(o[0]=__builtin_amdgcn_mfma_f32_32x32x16_bf16(PAF(2),VFR(2),o[0],0,0,0), C1,0); \
    KRD(GL,3); GAPB(o[1]=__builtin_amdgcn_mfma_f32_32x32x16_bf16(PAF(2),VFR(6),o[1],0,0,0), C1,4); \
    GAPB(o[0]=__builtin_amdgcn_mfma_f32_32x32x16_bf16(PAF(3),VFR(3),o[0],0,0,0), C1,8); \
    GAPB(o[1]=__builtin_amdgcn_mfma_f32_32x32x16_bf16(PAF(3),VFR(7),o[1],0,0,0), C1,12); \
    }while(0)
  int t=1;
  #undef CMASK
  #define CMASK(P0,P1,t) do{}while(0)
  for(;t+5<NT;t+=2){
    STEP(pB0,pB1,pA0,pA1,t,true,true,true);     WAIT_BAR(2); RESC(); ROT();
    STEP(pA0,pA1,pB0,pB1,t+1,true,true,true);   WAIT_BAR(2); RESC(); ROT();
  }
  #undef CMASK
  #define CMASK(P0,P1,t) do{int jb_=(t)-(NT-4); if(jb_>=0)cmask(P0,P1,jb_,qrel,hi);}while(0)
  #define ENDW(tt) do{ if((tt)+3<NT){WAIT_BAR(2);} else if((tt)+2<NT){WAIT_BAR(1);} else {WAIT_BAR(0);} }while(0)
  for(;t+1<NT;t+=2){
    STEP(pB0,pB1,pA0,pA1,t,(t+3<NT),(t+1<NT),(t+1<NT));       ENDW(t);   RESC(); ROT();
    STEP(pA0,pA1,pB0,pB1,t+1,(t+4<NT),(t+2<NT),(t+2<NT));     ENDW(t+1); RESC(); ROT();
  }
  STEP(pB0,pB1,pA0,pA1,NT-1,false,false,false); RESC();
  { float sacc=pB0[0]+pB0[1]; _Pragma("unroll") for(int r=2;r<16;++r)sacc+=pB0[r]; _Pragma("unroll") for(int r=0;r<16;++r)sacc+=pB1[r]; l_reg+=sacc;
    pw0=(u32x4){PKW(pB0,0),PKW(pB0,2),PKW(pB0,4),PKW(pB0,6)};pw1=(u32x4){PKW(pB0,8),PKW(pB0,10),PKW(pB0,12),PKW(pB0,14)};pw2=(u32x4){PKW(pB1,0),PKW(pB1,2),PKW(pB1,4),PKW(pB1,6)};pw3=(u32x4){PKW(pB1,8),PKW(pB1,10),PKW(pB1,12),PKW(pB1,14)};
    SBAR(); pv(o,vb0+sl_cur,PAF(0),PAF(1),PAF(2),PAF(3)); }
  #undef PKW
  #undef PAF
  #undef VFR
  #undef PIN
  #undef MX3
  #undef GAPA
  #undef GAPB
  #undef EX
  #undef VRD
  #undef KRD
  #undef STEP
  #undef ENDW
  {auto rr=__builtin_amdgcn_permlane32_swap(__float_as_uint(l_reg),__float_as_uint(l_reg),false,false);l_reg=__uint_as_float(rr[0])+__uint_as_float(rr[1]);}
  if(hi==0)wsf[32+r32]=l_reg;asm volatile("s_waitcnt lgkmcnt(0)":::"memory");
  float rli[16];
  #pragma unroll
  for(int r=0;r<16;++r)rli[r]=__builtin_amdgcn_rcpf(wsf[32+crow(r,hi)]);
  bf16*Ow=O+(rowbase+q0+wid*QBLK)*QP+h*D;
  float*ssw=ssa+rowbase+q0+wid*QBLK;
  { bf16*stg=(bf16*)(shm+LDS_OST)+wid*2048;
    #pragma unroll
    for(int r=0;r<16;++r){const int orow=crow(r,hi);
      #pragma unroll
      for(int d0=0;d0<2;++d0)stg[orow*64+d0*32+r32]=__float2bfloat16(o[d0][r]*rli[r]);}
    asm volatile("s_waitcnt lgkmcnt(0)":::"memory");
    #pragma unroll
    for(int i=0;i<4;++i){const int row=i*8+(lane>>3),ch=lane&7; const u32x4 v=*(const u32x4*)(stg+row*64+ch*8); *(u32x4*)(Ow+(long)row*QP+ch*8)=v;
      float q=0.f;
      #pragma unroll
      for(int e=0;e<4;++e){const float lo=__uint_as_float(v[e]<<16),hi2=__uint_as_float(v[e]&0xffff0000u); q+=lo*lo+hi2*hi2;}
      q+=swz_xor<1>(q);q+=swz_xor<2>(q);q+=swz_xor<4>(q);
      if(ch==0)atomicAdd(ssw+row,q);} }
  asm volatile("s_waitcnt lgkmcnt(0)\n\ts_barrier":::"memory");
  #undef DMA_K
  #undef DMA_V
  #undef CMASK
  #undef ADDB
  #undef START
  #undef RESC
  #undef ROT
}
#undef SBAR
#undef WAIT_BAR

constexpr int CONV_W=31, CONV_C=512, CONV_TOK=64, CONV_ROWS=CONV_TOK+CONV_W-1;
__device__ __forceinline__ float wsum64(float v){ return wave_sum64(v); }
__device__ __forceinline__ void conv_unit(int unit,const bf16*UB,const float*cw,const float*cbias,const float*lng,const float*lnb,bf16*Y,char*shm,const int tid){
  const int lane=tid&63,wid=tid>>6;
  const int b=unit>>5,t0=(unit&31)*CONV_TOK;
  ATT_LAS u32x4*L=(ATT_LAS u32x4*)shm;
  for(int idx=tid;idx<CONV_ROWS*64;idx+=512){
    const int row=idx>>6,ch=idx&63,t=t0-(CONV_W-1)+row;
    u32x4 v=(u32x4){0u,0u,0u,0u};
    if(t>=0)v=*(const u32x4*)(UB+((size_t)b*SEQ+t)*CONV_C+ch*8);
    L[idx]=v;
  }
  __syncthreads();
  float acc[8][8];
  { const f32x4_t b0=*(const f32x4_t*)(cbias+8*lane),b1=*(const f32x4_t*)(cbias+8*lane+4);
    #pragma unroll
    for(int tt=0;tt<8;++tt){acc[tt][0]=b0[0];acc[tt][1]=b0[1];acc[tt][2]=b0[2];acc[tt][3]=b0[3];acc[tt][4]=b1[0];acc[tt][5]=b1[1];acc[tt][6]=b1[2];acc[tt][7]=b1[3];} }
  #pragma unroll 1
  for(int j=0;j<CONV_W;++j){
    const f32x4_t w0=*(const f32x4_t*)(cw+j*CONV_C+8*lane),w1=*(const f32x4_t*)(cw+j*CONV_C+8*lane+4);
    #pragma unroll
    for(int tt=0;tt<8;++tt){
      const u32x4 u=L[(wid*8+tt+j)*64+lane];
      acc[tt][0]+=w0[0]*__uint_as_float(u[0]<<16); acc[tt][1]+=w0[1]*__uint_as_float(u[0]&0xffff0000u);
      acc[tt][2]+=w0[2]*__uint_as_float(u[1]<<16); acc[tt][3]+=w0[3]*__uint_as_float(u[1]&0xffff0000u);
      acc[tt][4]+=w1[0]*__uint_as_float(u[2]<<16); acc[tt][5]+=w1[1]*__uint_as_float(u[2]&0xffff0000u);
      acc[tt][6]+=w1[2]*__uint_as_float(u[3]<<16); acc[tt][7]+=w1[3]*__uint_as_float(u[3]&0xffff0000u);
    }
  }
  const f32x4_t g0=*(const f32x4_t*)(lng+8*lane),g1=*(const f32x4_t*)(lng+8*lane+4),e0=*(const f32x4_t*)(lnb+8*lane),e1=*(const f32x4_t*)(lnb+8*lane+4);
  const float gg[8]={g0[0],g0[1],g0[2],g0[3],g1[0],g1[1],g1[2],g1[3]},bb[8]={e0[0],e0[1],e0[2],e0[3],e1[0],e1[1],e1[2],e1[3]};
  #pragma unroll
  for(int tt=0;tt<8;++tt){
    float s=0.f;
    #pragma unroll
    for(int e=0;e<8;++e)s+=acc[tt][e];
    const float mu=wsum64(s)*(1.0f/CONV_C);
    float q=0.f;
    #pragma unroll
    for(int e=0;e<8;++e){acc[tt][e]-=mu;q+=acc[tt][e]*acc[tt][e];}
    const float rstd=__builtin_amdgcn_rsqf(wsum64(q)*(1.0f/CONV_C)+1e-6f);
    float q2=0.f;
    #pragma unroll
    for(int e=0;e<8;++e){float y=acc[tt][e]*rstd*gg[e]+bb[e]; y=y*__builtin_amdgcn_rcpf(1.0f+__builtin_amdgcn_exp2f(-y*1.4426950408889634f)); acc[tt][e]=y;q2+=y*y;}
    const float r2=__builtin_amdgcn_rsqf(wsum64(q2)*(1.0f/CONV_C)+1e-6f);
    u32x4 w;
    w[0]=cvtpk_s(acc[tt][0]*r2,acc[tt][1]*r2);w[1]=cvtpk_s(acc[tt][2]*r2,acc[tt][3]*r2);w[2]=cvtpk_s(acc[tt][4]*r2,acc[tt][5]*r2);w[3]=cvtpk_s(acc[tt][6]*r2,acc[tt][7]*r2);
    *(u32x4*)(Y+((size_t)b*SEQ+t0+wid*8+tt)*QP+CONV_C+8*lane)=w;
  }
  __syncthreads();
}
}
constexpr int NWAVES = 8;
constexpr int M = 16384, DM = 1024, DFF = 2816, SEQ = 2048, NBATCH = 8, NMEMROWS = 2048, NLAYER = 2;
constexpr size_t MiB = 1u << 20;
constexpr size_t WS_CTL = 0, CTL_ZERO_BYTES = 2 * MiB;
constexpr size_t WS_W = 2 * MiB;
constexpr size_t W_LAYER = 97 * MiB / 2;
constexpr size_t WO_1A = 0, WO_1B = 11 * MiB, WO_IN = WO_1B + 11 * MiB / 2, WO_OUT = WO_IN + 11 * MiB / 2, WO_XQ = WO_OUT + 2 * MiB, WO_XKV = WO_XQ + 2 * MiB, WO_XO = WO_XKV + 4 * MiB,
                 WO_2A = WO_XO + 2 * MiB, WO_2B = WO_2A + 11 * MiB;
static_assert(WO_2B + 11 * MiB / 2 == W_LAYER, "weight map");
constexpr size_t WS_XB = 100 * MiB;
constexpr size_t WS_MKV = 132 * MiB;
constexpr size_t WS_MEMB = 148 * MiB;
constexpr size_t WS_R1 = 152 * MiB;
constexpr size_t R1_H = 0;
constexpr size_t R1_Y = 0, R1_KB = 32 * MiB, R1_VB = 48 * MiB, R1_UB = 64 * MiB, R1_LOGF = 80 * MiB;
constexpr size_t R1_XP = 0, R1_WQK = 64 * MiB, R1_WVO = 80 * MiB;
constexpr size_t WS_END = 248 * MiB;
constexpr int CW_BAR = 4096;
constexpr size_t CTL_SS = 256 * 1024;
constexpr size_t CTL_SSA = CTL_SS + 9 * (size_t)M * 4, CTL_SSM = CTL_SSA + 2 * (size_t)M * 4;
static_assert(CTL_SSM + 2048 * 4 <= CTL_ZERO_BYTES, "ctl map");
constexpr int RING_OFF = 0, RING_BYTES = 131072;
constexpr int EPI_SCR_OFF = RING_BYTES;
constexpr int LDSCTL_OFF = RING_BYTES + 8192, MISC_OFF = LDSCTL_OFF + 320;
constexpr int LDS_BYTES = 147456;
static_assert(MISC_OFF + 128 <= LDS_BYTES, "LDS map");

#define GAS __attribute__((address_space(1)))
#define LAS __attribute__((address_space(3)))
typedef unsigned short bf16;
typedef unsigned v4u __attribute__((ext_vector_type(4)));
typedef float f32x4 __attribute__((ext_vector_type(4)));
typedef GAS unsigned gu32;
#define RLX_AGENT __ATOMIC_RELAXED, __HIP_MEMORY_SCOPE_AGENT
#define LDS_WAIT() asm volatile("s_waitcnt lgkmcnt(0)" ::: "memory")
__device__ __forceinline__ unsigned f2bf(float f) { unsigned u = __builtin_bit_cast(unsigned, f); return (u + 0x7fffu + ((u >> 16) & 1u)) >> 16; }
__device__ __forceinline__ unsigned pk2(float lo, float hi) { return f2bf(lo) | (f2bf(hi) << 16); }

#define XB_TMO      128
#define XB_XCNT(j)  (256  + 64 * (j))
#define XB_XSUB(j)  (1280 + 64 * (j))
#define XB_XGEN(j)  (2304 + 64 * (j))
#define XB_TOP      3328
#define XB_TOPGEN   3392
#define XCD_BAR_WORDS 3456
#define XB_SPIN_CAP (1u << 18)
__device__ __forceinline__ unsigned xb_ld(unsigned* p)              { return __hip_atomic_load(p, __ATOMIC_RELAXED, __HIP_MEMORY_SCOPE_AGENT); }
__device__ __forceinline__ unsigned xb_add(unsigned* p, unsigned v) { return __hip_atomic_fetch_add(p, v, __ATOMIC_RELAXED, __HIP_MEMORY_SCOPE_AGENT); }
__device__ __forceinline__ unsigned xb_xcc_id() { return (unsigned)__builtin_amdgcn_s_getreg((3 << 11) | 20) & 0xFu; }
#define XB_SPIN(cond, bar) do { unsigned _sp = 0; while (cond) { __builtin_amdgcn_s_sleep(1); \
    if ((++_sp & 255u) == 0u) { if (xb_ld(&(bar)[XB_TMO])) break; if (_sp > XB_SPIN_CAP) { atomicAdd(&(bar)[XB_TMO], 1u); break; } } } } while (0)
struct XcdBarrier { unsigned* bar; unsigned x; volatile LAS unsigned* st; };
__device__ __forceinline__ XcdBarrier xcd_barrier_post(unsigned* bar, volatile LAS unsigned* st) {
    XcdBarrier b; b.bar = bar; b.x = xb_xcc_id(); b.st = st;
    if (threadIdx.x == 0) (void)xb_add(&bar[XB_XCNT(b.x)], 1u);
    return b;
}
__device__ __forceinline__ void xcd_barrier_complete(unsigned* bar, unsigned x, unsigned& nloc, unsigned& nx) {
    const unsigned G = gridDim.x * gridDim.y * gridDim.z;
    unsigned sum, cnt, mine, sp = 0u;
    for (;;) {
        sum = 0u; cnt = 0u; mine = 0u;
#pragma unroll
        for (unsigned j = 0; j < 16; ++j) { const unsigned c = xb_ld(&bar[XB_XCNT(j)]); sum += c; cnt += (c > 0u) ? 1u : 0u; mine = (j == x) ? c : mine; }
        if (sum == G) break;
        __builtin_amdgcn_s_sleep(1);
        if ((++sp & 255u) == 0u) { if (xb_ld(&bar[XB_TMO])) break; if (sp > XB_SPIN_CAP) { atomicAdd(&bar[XB_TMO], 1u); break; } }
    }
    nloc = mine > 0u ? mine : 1u; nx = cnt > 0u ? cnt : 1u;
}
__device__ __forceinline__ void xcd_barrier(const XcdBarrier& b) {
    asm volatile("s_waitcnt vmcnt(0)" ::: "memory");
    __syncthreads();
    if (threadIdx.x == 0) {
        unsigned* bar = b.bar;
        __builtin_amdgcn_s_waitcnt(0);
        unsigned nloc = b.st[0], nx = b.st[1];
        if (nloc == 0u) { xcd_barrier_complete(bar, b.x, nloc, nx); b.st[0] = nloc; b.st[1] = nx; }
        const unsigned old = xb_add(&bar[XB_XSUB(b.x)], 1u);
        const unsigned gen = old / nloc;
        if (old + 1u == (gen + 1u) * nloc) {
            __builtin_amdgcn_fence(__ATOMIC_RELEASE, "agent");
            asm volatile("s_waitcnt vmcnt(0)" ::: "memory");
            const unsigned og = xb_add(&bar[XB_TOP], 1u);
            const unsigned tg = og / nx;
            if (og + 1u == (tg + 1u) * nx) xb_add(&bar[XB_TOPGEN], 1u);
            else XB_SPIN(xb_ld(&bar[XB_TOPGEN]) == tg, bar);
            __builtin_amdgcn_fence(__ATOMIC_ACQUIRE, "agent");
            xb_add(&bar[XB_XGEN(b.x)], 1u);
            asm volatile("s_waitcnt vmcnt(0)" ::: "memory");
        } else {
            XB_SPIN(xb_ld(&bar[XB_XGEN(b.x)]) == gen, bar);
            __builtin_amdgcn_fence(__ATOMIC_ACQUIRE, "agent");
            asm volatile("s_waitcnt vmcnt(0)" ::: "memory");
        }
    }
    __syncthreads();
}

__device__ __forceinline__ float wave_sum(float v) { return wave_sum64(v); }
__device__ __forceinline__ void tr_item(const float* W, int ldw, int col0, int nvalid, int k0, const float* gain, int gsplit, const float* gain2, bf16* WT, int ldt, int drow0, LAS float* scr, int lane) {
#pragma unroll 8
    for (int i = 0; i < 32; ++i) { const int kk = 2 * i + (lane >> 5), n = lane & 31, k = k0 + kk;
        float v = (n < nvalid) ? W[(size_t)k * ldw + col0 + n] : 0.f;
        if (gain) v *= (k < gsplit ? gain[k] : gain2[k - gsplit]);
        scr[kk * 33 + n] = v; }
    LDS_WAIT(); asm volatile("" ::: "memory");
    const int c = lane & 7;
#pragma unroll
    for (int j = 0; j < 4; ++j) { const int n = (lane >> 3) + 8 * j; const LAS float* s = scr + (8 * c) * 33 + n;
        v4u o; o.x = pk2(s[0 * 33], s[1 * 33]); o.y = pk2(s[2 * 33], s[3 * 33]); o.z = pk2(s[4 * 33], s[5 * 33]); o.w = pk2(s[6 * 33], s[7 * 33]);
        *(GAS v4u*)(WT + (size_t)(drow0 + n) * ldt + k0 + 8 * c) = o; }
    LDS_WAIT(); asm volatile("" ::: "memory");
}
__device__ __forceinline__ void row_to_bf16(const float* xrow, bf16* orow, float* ssp, int lane) {
    const GAS f32x4* xr = (const GAS f32x4*)xrow + lane;
    f32x4 v[4]; float s = 0.f;
#pragma unroll
    for (int j = 0; j < 4; ++j) { v[j] = xr[64 * j]; s += (v[j].x * v[j].x + v[j].y * v[j].y) + (v[j].z * v[j].z + v[j].w * v[j].w); }
    s = wave_sum(s);
    GAS unsigned long long* o8 = (GAS unsigned long long*)orow + lane;
#pragma unroll
    for (int j = 0; j < 4; ++j) o8[64 * j] = (unsigned long long)pk2(v[j].x, v[j].y) | ((unsigned long long)pk2(v[j].z, v[j].w) << 32);
    if (lane == 0) *ssp = s;
}

struct Args { const float* in[26]; float* out; unsigned char* ws; int ph_lo, ph_hi, li, pad; };

enum { PH_PRO = 0, PH_L0 = 1, PH_PER_LAYER = 9, PH_FINAL = PH_L0 + 2 * PH_PER_LAYER, PH_COUNT = PH_FINAL + 1 };

#define WSP() ({ unsigned char* w_ = args.ws; asm volatile("" : "+s"(w_)); w_; })
#define INP(i) ({ int i_ = (i); asm volatile("" : "+s"(i_)); args.in[i_]; })
#define XPTR() ({ float* x_ = args.out; asm volatile("" : "+s"(x_)); x_; })
#define TID() ({ int w_ = wid_s; asm volatile("" : "+s"(w_)); int t_ = (w_ << 6) | (int)__builtin_amdgcn_mbcnt_hi(~0u, __builtin_amdgcn_mbcnt_lo(~0u, 0u)); asm volatile("" : "+v"(t_)); t_; })

constexpr size_t T1K = (size_t)256 * 1024 * 2, TFF = (size_t)256 * 2816 * 2;
using G_1024 = pg8::Gemm<1024, 1024, 1024>; using G_down = pg8::Gemm<2816, 2816, 2816>; using G_qk = pg8::Gemm<2048, 1024, 256>; using G_vo = pg8::Gemm<1024, 2048, 256>;
using S_up = pg8::SchedT<0, 64, 22, T1K, T1K>; using S_mkv = pg8::SchedT<0, 8, 8, T1K, T1K>; using S_down = pg8::SchedT<0, 64, 4, TFF, TFF>; using S_win = pg8::SchedT<0, 64, 11, T1K, T1K>;
using S_sq = pg8::SchedT<0, 64, 4, T1K, T1K>; using S_xb = pg8::SchedT<1, 64, 4, T1K, T1K, (size_t)1024 * 1024 * 2>; using S_qk = pg8::SchedT<2, 128, 1, 0, 0>; using S_vo = pg8::SchedT<3, 128, 1, 0, 0>;

__global__ void __launch_bounds__(NWAVES * 64, 2) mega_fwd(Args args) {
    extern __shared__ __attribute__((aligned(16))) unsigned char lds[];
    LAS unsigned char* ldsp = (LAS unsigned char*)lds;
    volatile LAS unsigned* MISC = (volatile LAS unsigned*)(ldsp + MISC_OFF);
    constexpr int G = 256; const int bx = blockIdx.x;
    const int wid_s = __builtin_amdgcn_readfirstlane(threadIdx.x >> 6);
    for (int u = threadIdx.x; u < (LDS_BYTES - LDSCTL_OFF) / 4; u += NWAVES * 64) ((LAS unsigned*)(ldsp + LDSCTL_OFF))[u] = 0u;
    __syncthreads();
    (void)xcd_barrier_post((unsigned*)(args.ws + WS_CTL) + CW_BAR + args.li * XCD_BAR_WORDS, MISC + 8);
#define PHLO() ({ int i_ = 0; asm volatile("" : "+s"(i_)); (&args.ph_lo)[i_]; })
#define PHHI() ({ int i_ = 1; asm volatile("" : "+s"(i_)); (&args.ph_lo)[i_]; })
#define PHLI() ({ int i_ = 2; asm volatile("" : "+s"(i_)); (&args.ph_lo)[i_]; })
#define IN(k) (PHLO() <= (k) && (k) < PHHI())
#define SEAM(k) do { if (IN(k) && IN((k) + 1)) { XcdBarrier bar_; bar_.bar = (unsigned*)(WSP() + WS_CTL) + CW_BAR + PHLI() * XCD_BAR_WORDS; bar_.x = xb_xcc_id(); bar_.st = MISC + 8; xcd_barrier(bar_); } } while (0)
    constexpr float QSCALE = 0.125f * 1.4426950408889634f, XSCALE = 0.0625f * 1.4426950408889634f;

    if (IN(PH_PRO)) {
        unsigned char* ws = WSP(); const int tid = TID();
        const int lane = tid & 63, wave = __builtin_amdgcn_readfirstlane(tid >> 6);
        LAS float* scr = (LAS float*)(ldsp + RING_OFF + wave * 16384);
        const int gw = bx * NWAVES + wave, NGW = G * NWAVES;
        for (int l = 0; l < NLAYER; ++l) {
            unsigned char* wl = ws + WS_W + (size_t)l * W_LAYER;
            for (int f = 0; f < 2; ++f) {
                const float* wg = INP(f ? 22 : 3) + (size_t)l * DM * DFF; const float* wu = INP(f ? 23 : 4) + (size_t)l * DM * DFF; const float* wd = INP(f ? 24 : 5) + (size_t)l * DFF * DM;
                const float* gn = INP(f ? 21 : 2) + l * DM;
                bf16* WA = (bf16*)(wl + (f ? WO_2A : WO_1A)); bf16* WB = (bf16*)(wl + (f ? WO_2B : WO_1B));
                for (int it = gw; it < 2 * 16 * 88; it += NGW) { const int which = it / (16 * 88), r = it % (16 * 88), kb = r / 88, nb = r % 88; const int j0 = nb * 32;
                    tr_item(which ? wu : wg, DFF, j0, 32, kb * 64, gn, 1 << 30, gn, WA, DM, 256 * (j0 / 128) + which * 128 + (j0 % 128), scr, lane); }
                for (int it = gw; it < 44 * 32; it += NGW) { const int kb = it / 32, nb = it % 32;
                    tr_item(wd, DM, nb * 32, 32, kb * 64, nullptr, 0, nullptr, WB, DFF, nb * 32, scr, lane); }
            }
            { const float* w = INP(7) + (size_t)l * DM * 2568; const float* gn = INP(6) + l * DM; bf16* WI = (bf16*)(wl + WO_IN);
              for (int it = gw; it < 16 * 81; it += NGW) { const int kb = it / 81, nb = it % 81; int col0, nvalid = 32, drow0;
                  if (nb < 48) { col0 = nb * 32; drow0 = col0; }
                  else if (nb == 48) { col0 = 1536; nvalid = 8; drow0 = 2560; }
                  else if (nb < 65) { const int ch = (nb - 49) * 32; col0 = 1544 + ch; drow0 = 1536 + 256 * (ch / 128) + (ch % 128); }
                  else { const int ch = (nb - 65) * 32; col0 = 2056 + ch; drow0 = 1536 + 256 * (ch / 128) + 128 + (ch % 128); }
                  tr_item(w, 2568, col0, nvalid, kb * 64, gn, 1 << 30, gn, WI, DM, drow0, scr, lane); } }
            { const float* w = INP(15) + (size_t)l * DM * DM; const float* g1 = INP(13) + l * 512; const float* g2 = INP(14) + l * 512;
              for (int it = gw; it < 16 * 32; it += NGW) { const int kb = it / 32, nb = it % 32;
                  tr_item(w, DM, nb * 32, 32, kb * 64, g1, 512, g2, (bf16*)(wl + WO_OUT), DM, nb * 32, scr, lane); } }
            { const float* w = INP(19) + (size_t)l * DM * 2048; const float* gn = INP(17) + l * DM;
              for (int it = gw; it < 16 * 64; it += NGW) { const int kb = it / 64, nb = it % 64;
                  tr_item(w, 2048, nb * 32, 32, kb * 64, gn, 1 << 30, gn, (bf16*)(wl + WO_XKV), DM, nb * 32, scr, lane); } }
            { const float* w = INP(20) + (size_t)l * DM * DM;
              for (int it = gw; it < 16 * 32; it += NGW) { const int kb = it / 32, nb = it % 32;
                  tr_item(w, DM, nb * 32, 32, kb * 64, nullptr, 0, nullptr, (bf16*)(wl + WO_XO), DM, nb * 32, scr, lane); } }
            { const float* w = INP(18) + (size_t)l * DM * DM; const float* gn = INP(16) + l * DM; bf16* WQ = (bf16*)(wl + WO_XQ);
              for (int r = gw; r < DM; r += NGW) { const float g = gn[r] * XSCALE; const GAS f32x4* xr = (const GAS f32x4*)(w + (size_t)r * DM) + lane; GAS unsigned long long* o8 = (GAS unsigned long long*)(WQ + (size_t)r * DM) + lane;
#pragma unroll
                  for (int j = 0; j < 4; ++j) { const f32x4 v = xr[64 * j] * g; o8[64 * j] = (unsigned long long)pk2(v.x, v.y) | ((unsigned long long)pk2(v.z, v.w) << 32); } } }
        }
        { const float* xin = INP(0); bf16* XB = (bf16*)(ws + WS_XB); float* ssb = (float*)(ws + CTL_SS);
          for (int m = gw; m < M; m += NGW) row_to_bf16(xin + (size_t)m * DM, XB + (size_t)m * DM, ssb + m, lane); }
        { const float* mem = INP(1); bf16* MEMB = (bf16*)(ws + WS_MEMB); float* ssm = (float*)(ws + CTL_SSM);
          for (int m = gw; m < NMEMROWS; m += NGW) row_to_bf16(mem + (size_t)m * DM, MEMB + (size_t)m * DM, ssm + m, lane); }
    }
    SEAM(PH_PRO);

#pragma unroll 1
    for (int l = 0; l < NLAYER; ++l) {
        const int P = PH_L0 + l * PH_PER_LAYER;
#pragma unroll 1
        for (int f = 0; f < 2; ++f) {
            const int pu = P + (f ? 7 : 0), pd = pu + 1;
            if (IN(pu)) {
                unsigned char* ws = WSP(); unsigned char* wl = ws + WS_W + (size_t)l * W_LAYER;
                G_1024 g; S_up S; S.init(bx, ws + WS_XB, wl + (f ? WO_2A : WO_1A));
                pg8::EpiSwiGLU E{(bf16*)(ws + WS_R1 + R1_H), (float*)(ws + CTL_SS) + (size_t)(4 * l + (f ? 3 : 0)) * M};
                pg8::gemm_phase<pg8::EpiSwiGLU, decltype(S), decltype(g)>(ldsp + RING_OFF, g, S, E, TID());
                if (l == 0 && f == 0) {
#pragma unroll 1
                    for (int l2 = 0; l2 < NLAYER; ++l2) {
                        unsigned char* ws2 = WSP();
                        S_mkv S2; S2.init((bx + 128 - 64 * l2) % G, ws2 + WS_MEMB, ws2 + WS_W + (size_t)l2 * W_LAYER + WO_XKV);
                        pg8::EpiRowScale E2{(bf16*)(ws2 + WS_MKV) + (size_t)l2 * 2048 * 2048, (float*)(ws2 + CTL_SSM), 1.0f};
                        pg8::gemm_phase<pg8::EpiRowScale, decltype(S2), decltype(g)>(ldsp + RING_OFF, g, S2, E2, TID());
                    }
                }
            }
            SEAM(pu);
            if (IN(pd)) {
                unsigned char* ws = WSP(); unsigned char* wl = ws + WS_W + (size_t)l * W_LAYER; float* X = XPTR();
                G_down g; S_down S; S.init(bx, ws + WS_R1 + R1_H, wl + (f ? WO_2B : WO_1B));
                pg8::EpiResid<0> E{(l == 0 && f == 0) ? INP(0) : X, X, (bf16*)(ws + WS_XB), (float*)(ws + CTL_SS) + (size_t)(4 * l + (f ? 4 : 1)) * M, nullptr, 0.5f};
                pg8::gemm_phase<pg8::EpiResid<0>, decltype(S), decltype(g)>(ldsp + RING_OFF, g, S, E, TID());
            }
            SEAM(pd);
            if (f == 1) break;
            if (IN(P + 2)) {
                unsigned char* ws = WSP(); unsigned char* wl = ws + WS_W + (size_t)l * W_LAYER; unsigned char* R1 = ws + WS_R1;
                G_1024 g; S_win S; S.init(bx, ws + WS_XB, wl + WO_IN);
                pg8::EpiWin E{(bf16*)(R1 + R1_Y), (bf16*)(R1 + R1_KB), (bf16*)(R1 + R1_VB), (bf16*)(R1 + R1_UB), (float*)(R1 + R1_LOGF), (float*)(ws + CTL_SS) + (size_t)(4 * l + 1) * M, INP(8) + l * 8, QSCALE};
                pg8::gemm_phase<pg8::EpiWin, decltype(S), decltype(g)>(ldsp + RING_OFF, g, S, E, TID());
            }
            SEAM(P + 2);
            if (IN(P + 3)) {
                unsigned char* ws = WSP(); unsigned char* R1 = ws + WS_R1;
                char* shm = (char*)lds + RING_OFF;
                const int vcu = (G % 8 == 0) ? (bx % 8) * (G / 8) + bx / 8 : bx;
                const int bh = vcu >> 2, s4 = vcu & 3;
                attn_body::bf16* YB = (attn_body::bf16*)(R1 + R1_Y); const attn_body::bf16* KB = (const attn_body::bf16*)(R1 + R1_KB); const attn_body::bf16* VB = (const attn_body::bf16*)(R1 + R1_VB);
                float* ssa = (float*)(ws + CTL_SSA) + (size_t)l * M;
                attn_body::scan_bias((const float*)(R1 + R1_LOGF), bh, shm, TID());
#pragma unroll 1
                for (int iu = 0; iu < 2; ++iu) attn_body::attn_unit<8>(bh >> 3, bh & 7, iu ? 7 - s4 : s4, YB, KB, VB, YB, ssa, shm, TID());
                __syncthreads();
                attn_body::conv_unit(bx, (const attn_body::bf16*)(R1 + R1_UB), INP(9) + (size_t)l * 31 * 512, INP(10) + l * 512, INP(11) + l * 512, INP(12) + l * 512, YB, shm, TID());
            }
            SEAM(P + 3);
            if (IN(P + 4)) {
                { unsigned char* ws = WSP(); unsigned char* wl = ws + WS_W + (size_t)l * W_LAYER; float* X = XPTR();
                  G_1024 g; S_sq S; S.init(bx, ws + WS_R1 + R1_Y, wl + WO_OUT);
                  pg8::EpiResid<8> E{X, X, (bf16*)(ws + WS_XB), (float*)(ws + CTL_SS) + (size_t)(4 * l + 2) * M, (float*)(ws + CTL_SSA) + (size_t)l * M, 1.0f};
                  pg8::gemm_phase<pg8::EpiResid<8>, decltype(S), decltype(g)>(ldsp + RING_OFF, g, S, E, TID()); }
                { unsigned char* ws = WSP(); unsigned char* wl = ws + WS_W + (size_t)l * W_LAYER;
                  G_qk g; S_qk S; S.init(bx, (bf16*)(ws + WS_MKV) + (size_t)l * 2048 * 2048, wl + WO_XQ);
                  pg8::EpiAux E{(bf16*)(ws + WS_R1 + R1_WQK), 1.0f};
                  pg8::gemm_phase<pg8::EpiAux, decltype(S), decltype(g)>(ldsp + RING_OFF, g, S, E, TID()); }
                { unsigned char* ws = WSP(); unsigned char* wl = ws + WS_W + (size_t)l * W_LAYER;
                  G_vo g; S_vo S; S.init((bx + 128) % G, wl + WO_XO, (bf16*)(ws + WS_MKV) + (size_t)l * 2048 * 2048);
                  pg8::EpiAux E{(bf16*)(ws + WS_R1 + R1_WVO), 1.0f};
                  pg8::gemm_phase<pg8::EpiAux, decltype(S), decltype(g)>(ldsp + RING_OFF, g, S, E, TID()); }
            }
            SEAM(P + 4);
            if (IN(P + 5)) {
                unsigned char* ws = WSP();
                G_1024 g; S_xb S; S.init(bx, ws + WS_XB, ws + WS_R1 + R1_WQK);
                pg8::EpiSoftmax E{(bf16*)(ws + WS_R1 + R1_XP), (float*)(ws + CTL_SS) + (size_t)(4 * l + 2) * M, (LAS float*)(ldsp + EPI_SCR_OFF)};
                pg8::gemm_phase<pg8::EpiSoftmax, decltype(S), decltype(g)>(ldsp + RING_OFF, g, S, E, TID());
            }
            SEAM(P + 5);
            if (IN(P + 6)) {
                unsigned char* ws = WSP(); float* X = XPTR();
                G_1024 g; S_xb S; S.init(bx, ws + WS_R1 + R1_XP, ws + WS_R1 + R1_WVO);
                pg8::EpiResid<0> E{X, X, (bf16*)(ws + WS_XB), (float*)(ws + CTL_SS) + (size_t)(4 * l + 3) * M, nullptr, 1.0f};
                pg8::gemm_phase<pg8::EpiResid<0>, decltype(S), decltype(g)>(ldsp + RING_OFF, g, S, E, TID());
            }
            SEAM(P + 6);
        }
    }
    if (IN(PH_FINAL)) {
        unsigned char* ws = WSP(); float* X = XPTR(); const int tid = TID();
        const int lane = tid & 63, wave = __builtin_amdgcn_readfirstlane(tid >> 6);
        const int gw = bx * NWAVES + wave, NGW = G * NWAVES; const float* ssf = (float*)(ws + CTL_SS) + (size_t)8 * M; const float* gn = INP(25);
        f32x4 gv[4];
#pragma unroll
        for (int j = 0; j < 4; ++j) gv[j] = *((const GAS f32x4*)gn + lane + 64 * j);
        for (int m = gw; m < M; m += NGW) { GAS f32x4* xr = (GAS f32x4*)(X + (size_t)m * DM) + lane; const float rs = __builtin_amdgcn_rsqf(ssf[m] * (1.0f / 1024.0f) + 1e-6f);
#pragma unroll
            for (int j = 0; j < 4; ++j) xr[64 * j] = xr[64 * j] * rs * gv[j]; }
    }
#undef IN
#undef SEAM
}

static int g_grid = 0;
static bool mega_setup() {
    if (g_grid) return g_grid > 0;
    int dev = 0, cus = 0, per_cu = 0;
    if (hipGetDevice(&dev) != hipSuccess || hipDeviceGetAttribute(&cus, hipDeviceAttributeMultiprocessorCount, dev) != hipSuccess) { g_grid = -1; return false; }
    if (hipFuncSetAttribute((const void*)mega_fwd, hipFuncAttributeMaxDynamicSharedMemorySize, LDS_BYTES) != hipSuccess) { fprintf(stderr, "hipFuncSetAttribute failed\n"); g_grid = -1; return false; }
    if (hipOccupancyMaxActiveBlocksPerMultiprocessor(&per_cu, (const void*)mega_fwd, NWAVES * 64, LDS_BYTES) != hipSuccess || per_cu < 1) { fprintf(stderr, "occupancy query: %d blocks per CU\n", per_cu); (void)hipGetLastError(); g_grid = -1; return false; }
    g_grid = cus;
    if (g_grid != 256) fprintf(stderr, "warning: %d CUs; the phase program is laid out for 256\n", g_grid);
    return true;
}
static void mega_launch(void* const* d_in, void* d_out, void* d_ws, hipStream_t stream, int lo, int hi, int li) {
    Args a{};
    for (int i = 0; i < 26; ++i) a.in[i] = (const float*)d_in[i];
    a.out = (float*)d_out; a.ws = (unsigned char*)d_ws; a.ph_lo = lo; a.ph_hi = hi; a.li = li;
    hipLaunchKernelGGL(mega_fwd, dim3(g_grid), dim3(NWAVES * 64), LDS_BYTES, stream, a);
}
extern "C" void kernel_launch(void* const* d_in, const int* in_sizes, int n_in, void* d_out, int out_size, void* d_ws, size_t ws_size, hipStream_t stream) {
    if (!mega_setup()) return;
    if (ws_size < WS_END) { fprintf(stderr, "kernel_launch: workspace too small (%zu < %zu)\n", ws_size, (size_t)WS_END); return; }
    (void)hipMemsetAsync((char*)d_ws + WS_CTL, 0, CTL_ZERO_BYTES, stream);
    mega_launch(d_in, d_out, d_ws, stream, 0, PH_COUNT, 0);
}
```

```cpp
#include <hip/hip_runtime.h>
#include <cstdio>
#include <cstdint>
template <int X> __device__ __forceinline__ float swz_xor(float v) { return __int_as_float(__builtin_amdgcn_ds_swizzle(__float_as_int(v), (X << 10) | 0x1f)); }
__device__ __forceinline__ float sum_x32(float v) { auto rr = __builtin_amdgcn_permlane32_swap(__float_as_uint(v), __float_as_uint(v), false, false); return __uint_as_float(rr[0]) + __uint_as_float(rr[1]); }
__device__ __forceinline__ float max_x32(float v) { auto rr = __builtin_amdgcn_permlane32_swap(__float_as_uint(v), __float_as_uint(v), false, false); return fmaxf(__uint_as_float(rr[0]), __uint_as_float(rr[1])); }
__device__ __forceinline__ float wave_sum64(float v) { v += swz_xor<1>(v); v += swz_xor<2>(v); v += swz_xor<4>(v); v += swz_xor<8>(v); v += swz_xor<16>(v); return sum_x32(v); }
namespace pg8 {
#define PG8_LAS __attribute__((address_space(3)))
typedef unsigned short bf16_t;
typedef short bf16x8 __attribute__((ext_vector_type(8)));
typedef float f32x4 __attribute__((ext_vector_type(4)));
typedef float f32x2 __attribute__((ext_vector_type(2)));
typedef unsigned u32x4 __attribute__((ext_vector_type(4)));
constexpr int BM = 256, BK = 64, HALF = 128, HTB = HALF * BK * 2  , STAGE_BYTES = 8 * HTB, NXCD = 8, WGM = 8;

__host__ __device__ __forceinline__ int lds_byte(int r, int c) { const int st = (r >> 4) * 2 + (c >> 5), rr = r & 15, cc = c & 31, ob = rr * 64 + cc * 2; return st * 1024 + (ob ^ (((ob >> 9) & 1) << 5)); }
__host__ __device__ __forceinline__ void stage_rc(int b, int& R, int& C) { const int st = b / 1024, sb = b % 1024, swz = sb ^ (((sb >> 9) & 1) << 5); R = (st >> 1) * 16 + swz / 64; C = (st & 1) * 32 + (swz % 64) / 2; }
__host__ __device__ __forceinline__ int perm32(int rho) { const int n = rho >> 4, i = rho & 15; return 8 * (i >> 2) + 4 * n + (i & 3); }

struct Unit { int pm, pn; const char* a; const char* b; int aux; };
template <int LDA, int LDB, int K_> struct Gemm { static constexpr int lda = LDA, ldb = LDB, K = K_; };

__device__ __forceinline__ unsigned cvt_pk_bf16(float lo, float hi) { unsigned r; asm volatile("v_cvt_pk_bf16_f32 %0, %1, %2" : "=v"(r) : "v"(lo), "v"(hi)); return r; }


template <class Epi, class Sched, class Gemm, bool ALIGN_EPI = true, bool SP2 = true>
__device__ __forceinline__ void gemm_phase(PG8_LAS unsigned char* lds, const Gemm g, const Sched& S, const Epi& E, const int tid) {
    const int wid = __builtin_amdgcn_readfirstlane(tid >> 6), lane = tid & 63, wr = wid >> 2, wc = wid & 3, fr = lane & 15, fq = lane >> 4;
    constexpr int K = Gemm::K, nt = K / BK;
    unsigned voffA[2], voffB[2];
#pragma unroll
    for (int i = 0; i < 2; ++i) { int R, C; stage_rc(tid * 16 + i * 8192, R, C); const int Rb = Epi::PERM ? ((R & ~31) + perm32(R & 31)) : R;
        voffA[i] = (unsigned)(R * Gemm::lda + C) * 2u; voffB[i] = (unsigned)(Rb * Gemm::ldb + C) * 2u; }
    constexpr size_t kstep = (size_t)(BK * 2);
    constexpr size_t hstepA = (size_t)HALF * Gemm::lda * 2, hstepB = (size_t)HALF * Gemm::ldb * 2;
    const unsigned ldsw = (unsigned)wid * 1024u;
    const int aoff = lds_byte(wr * 64 + fr, fq * 8), boff = lds_byte(wc * 32 + fr, fq * 8);
#define PG8_SA(b, h) (((b) * 2 + (h)) * HTB)
#define PG8_SB(b, h) ((4 + (b) * 2 + (h)) * HTB)
#define PG8_STAGE(bufoff, gbase, voff) do { _Pragma("unroll") for (int _i = 0; _i < 2; ++_i) \
        __builtin_amdgcn_global_load_lds((const unsigned*)((const char*)(gbase) + (voff)[_i]), (PG8_LAS unsigned*)(lds + (bufoff) + ldsw + _i * 8192), 16, 0, 0); } while (0)
#define PG8_LDA(dst, b, h) do { _Pragma("unroll") for (int m = 0; m < 4; ++m) _Pragma("unroll") for (int k = 0; k < 2; ++k) dst[m][k] = *(const PG8_LAS bf16x8*)(lds + PG8_SA(b, h) + aoff + m * 2048 + k * 1024); } while (0)
#define PG8_LDB(dst, b, h) do { _Pragma("unroll") for (int n = 0; n < 2; ++n) _Pragma("unroll") for (int k = 0; k < 2; ++k) dst[n][k] = *(const PG8_LAS bf16x8*)(lds + PG8_SB(b, h) + boff + n * 2048 + k * 1024); } while (0)
#define PG8_MMA(ai, bj, At, Bt) do { __builtin_amdgcn_s_setprio(1); _Pragma("unroll") for (int m = 0; m < 4; ++m) _Pragma("unroll") for (int n = 0; n < 2; ++n) _Pragma("unroll") for (int k = 0; k < 2; ++k) \
        acc[ai][bj][m][n] = __builtin_amdgcn_mfma_f32_16x16x32_bf16(Bt[n][k], At[m][k], acc[ai][bj][m][n], 0, 0, 0); __builtin_amdgcn_s_setprio(0); } while (0)
#define PG8_WAIT_V(n) asm volatile("s_waitcnt vmcnt(" #n ")" ::: "memory")
#define PG8_WAIT_L(n) asm volatile("s_waitcnt lgkmcnt(" #n ")" ::: "memory")
#define PG8_BAR __builtin_amdgcn_s_barrier()
#define PG8_SCHED __builtin_amdgcn_sched_barrier(0)
    Unit cur, nxt; int ui = 0;
    if (!S.next(0, cur)) return;
    f32x4 acc[2][2][4][2];
#pragma unroll
    for (int a = 0; a < 2; ++a)
#pragma unroll
        for (int b = 0; b < 2; ++b)
#pragma unroll
            for (int m = 0; m < 4; ++m)
#pragma unroll
                for (int n = 0; n < 2; ++n) acc[a][b][m][n] = (f32x4){0.f, 0.f, 0.f, 0.f};
    bf16x8 At[4][2], B0[2][2], B1[2][2];
    const char* cA = cur.a; const char* cB = cur.b;
    if constexpr (SP2) {
        PG8_STAGE(PG8_SB(0, 0), cB, voffB); PG8_STAGE(PG8_SB(0, 1), cB + hstepB, voffB); PG8_STAGE(PG8_SA(0, 0), cA, voffA); PG8_STAGE(PG8_SA(0, 1), cA + hstepA, voffA);
        if (wr == 1) PG8_BAR;
        PG8_WAIT_V(2); PG8_BAR;
        PG8_STAGE(PG8_SB(1, 0), cB + kstep, voffB); PG8_STAGE(PG8_SA(1, 0), cA + kstep, voffA); PG8_STAGE(PG8_SB(1, 1), cB + hstepB + kstep, voffB);
        PG8_WAIT_V(6); PG8_BAR;
    } else {
        PG8_STAGE(PG8_SB(0, 0), cB, voffB); PG8_STAGE(PG8_SA(0, 0), cA, voffA); PG8_STAGE(PG8_SB(0, 1), cB + hstepB, voffB); PG8_STAGE(PG8_SA(0, 1), cA + hstepA, voffA);
        if (wr == 1) PG8_BAR;
        PG8_WAIT_V(4); PG8_BAR;
        PG8_STAGE(PG8_SB(1, 0), cB + kstep, voffB); PG8_STAGE(PG8_SA(1, 0), cA + kstep, voffA); PG8_STAGE(PG8_SB(1, 1), cB + hstepB + kstep, voffB);
        PG8_WAIT_V(6); PG8_BAR;
    }
    for (;;) {
        const bool has_next = S.next(ui + 1, nxt);
        const char* nA = has_next ? nxt.a : cA; const char* nB = has_next ? nxt.b : cB;
#pragma unroll 1
        for (int t = 0; t < nt; t += 2) {
            const bool last = (t == nt - 2);
            const char* a1 = cA + (size_t)(t + 1) * kstep;
            const char* a2 = last ? nA : cA + (size_t)(t + 2) * kstep; const char* b2 = last ? nB : cB + (size_t)(t + 2) * kstep;
            const char* a3 = a2 + kstep; const char* b3 = b2 + kstep;
            if constexpr (Epi::MIDK > 0) { if (t == Epi::MIDK) E.midk(acc, cur, wr, wc, fr, fq); }
            if constexpr (SP2) {
            PG8_LDB(B0, 0, 0); PG8_LDB(B1, 0, 1); PG8_SCHED; PG8_LDA(At, 0, 0); PG8_STAGE(PG8_SA(1, 1), a1 + hstepA, voffA);
            PG8_WAIT_V(8); PG8_WAIT_L(0); PG8_BAR; PG8_MMA(0, 0, At, B0); PG8_MMA(0, 1, At, B1); PG8_BAR; PG8_SCHED;
            PG8_LDA(At, 0, 1); PG8_STAGE(PG8_SB(0, 0), b2, voffB); PG8_STAGE(PG8_SB(0, 1), b2 + hstepB, voffB); PG8_STAGE(PG8_SA(0, 0), a2, voffA);
            PG8_WAIT_V(8); PG8_WAIT_L(0); PG8_BAR; PG8_MMA(1, 0, At, B0); PG8_MMA(1, 1, At, B1); PG8_BAR; PG8_SCHED;
            PG8_LDB(B0, 1, 0); PG8_LDB(B1, 1, 1); PG8_SCHED; PG8_LDA(At, 1, 0); PG8_STAGE(PG8_SA(0, 1), a2 + hstepA, voffA);
            PG8_WAIT_V(8); PG8_WAIT_L(0); PG8_BAR; PG8_MMA(0, 0, At, B0); PG8_MMA(0, 1, At, B1); PG8_BAR; PG8_SCHED;
            PG8_LDA(At, 1, 1); PG8_STAGE(PG8_SB(1, 0), b3, voffB); PG8_STAGE(PG8_SB(1, 1), b3 + hstepB, voffB); PG8_STAGE(PG8_SA(1, 0), a3, voffA);
            PG8_WAIT_V(8); PG8_WAIT_L(0); PG8_BAR; PG8_MMA(1, 0, At, B0); PG8_MMA(1, 1, At, B1); PG8_BAR; PG8_SCHED;
            } else {
            PG8_LDB(B0, 0, 0); PG8_SCHED; PG8_LDA(At, 0, 0); PG8_STAGE(PG8_SA(1, 1), a1 + hstepA, voffA);
            PG8_WAIT_L(8); PG8_BAR; PG8_WAIT_L(0); PG8_MMA(0, 0, At, B0); PG8_BAR; PG8_SCHED;
            PG8_LDB(B1, 0, 1); PG8_STAGE(PG8_SB(0, 0), b2, voffB);
            PG8_BAR; PG8_WAIT_L(0); PG8_MMA(0, 1, At, B1); PG8_BAR;
            PG8_LDA(At, 0, 1); PG8_STAGE(PG8_SA(0, 0), a2, voffA);
            PG8_BAR; PG8_WAIT_L(0); PG8_MMA(1, 0, At, B0); PG8_BAR; PG8_SCHED;
            PG8_STAGE(PG8_SB(0, 1), b2 + hstepB, voffB);
            PG8_WAIT_V(6); PG8_BAR; PG8_MMA(1, 1, At, B1); PG8_BAR;
            PG8_LDB(B0, 1, 0); PG8_SCHED; PG8_LDA(At, 1, 0); PG8_STAGE(PG8_SA(0, 1), a2 + hstepA, voffA);
            PG8_WAIT_L(8); PG8_BAR; PG8_WAIT_L(0); PG8_MMA(0, 0, At, B0); PG8_BAR; PG8_SCHED;
            PG8_LDB(B1, 1, 1); PG8_STAGE(PG8_SB(1, 0), b3, voffB);
            PG8_BAR; PG8_WAIT_L(0); PG8_MMA(0, 1, At, B1); PG8_BAR;
            PG8_LDA(At, 1, 1); PG8_STAGE(PG8_SA(1, 0), a3, voffA);
            PG8_BAR; PG8_WAIT_L(0); PG8_MMA(1, 0, At, B0); PG8_BAR; PG8_SCHED;
            PG8_STAGE(PG8_SB(1, 1), b3 + hstepB, voffB);
            PG8_WAIT_V(6); PG8_BAR; PG8_MMA(1, 1, At, B1); PG8_BAR;
            }
        }
        if constexpr (ALIGN_EPI) { if (wr == 0) PG8_BAR; }
        E(acc, cur, wr, wc, fr, fq);
        if (!has_next) break;
#pragma unroll
        for (int a = 0; a < 2; ++a)
#pragma unroll
            for (int b = 0; b < 2; ++b)
#pragma unroll
                for (int m = 0; m < 4; ++m)
#pragma unroll
                    for (int n = 0; n < 2; ++n) acc[a][b][m][n] = (f32x4){0.f, 0.f, 0.f, 0.f};
        cur = nxt; cA = nA; cB = nB; ++ui;
        if constexpr (ALIGN_EPI) { if (wr == 1) PG8_BAR; }
    }
    PG8_WAIT_V(0);
    if constexpr (!ALIGN_EPI) { if (wr == 0) PG8_BAR; }
    PG8_BAR;
#undef PG8_SA
#undef PG8_SB
#undef PG8_STAGE
#undef PG8_LDA
#undef PG8_LDB
#undef PG8_MMA
#undef PG8_WAIT_V
#undef PG8_WAIT_L
#undef PG8_BAR
#undef PG8_SCHED
}
}
namespace pg8 {
constexpr float LOG2E = 1.4426950408889634f;
constexpr float RMS_EPS = 1e-6f;

template <int kind, int nM, int nN, size_t sA, size_t sB, size_t batchB = 0>
struct SchedT {
    static constexpr int nwg = nM * nN, G = 256;
    int c; const char* A; const char* B;
    __device__ __forceinline__ void init(int c_, const void* A_, const void* B_) { c = c_; A = (const char*)A_; B = (const char*)B_; }
    __device__ __forceinline__ bool next(int i, Unit& u) const {
        const int L = i * G + c; if (L >= nwg) return false;
        if constexpr (kind <= 1) {
            int wgid = L; { constexpr int q = nwg / NXCD, r = nwg % NXCD; const int xcd = wgid % NXCD, off = wgid / NXCD; wgid = (xcd < r ? xcd * (q + 1) : r * (q + 1) + (xcd - r) * q) + off; }
            constexpr int nig = WGM * nN; const int gid = wgid / nig, fm = gid * WGM, gsz = (nM - fm) < WGM ? (nM - fm) : WGM;
            u.pm = fm + ((wgid % nig) % gsz); u.pn = (wgid % nig) / gsz;
            u.a = A + (size_t)u.pm * sA; u.b = B + (size_t)u.pn * sB + (kind == 1 ? (size_t)(u.pm >> 3) * batchB : (size_t)0); u.aux = 0;
        } else if constexpr (kind == 2) {
            const int b_ = L >> 4, h = (L >> 2) & 3, t4 = L & 3;
            u.pm = b_ * 4 + h; u.pn = t4;
            u.a = A + ((size_t)b_ * 256 * 2048 + (size_t)h * 256) * 2; u.b = B + ((size_t)t4 * 256 * 1024 + (size_t)h * 256) * 2;
            u.aux = b_ * 1048576 + (h * 256) * 1024 + t4 * 256;
        } else {
            const int b_ = L >> 4, h = (L >> 2) & 3, t4 = L & 3;
            u.pm = t4; u.pn = b_ * 4 + h;
            u.a = A + ((size_t)t4 * 256 * 1024 + (size_t)h * 256) * 2; u.b = B + ((size_t)b_ * 256 * 2048 + 1024 + (size_t)h * 256) * 2;
            u.aux = b_ * 1048576 + (t4 * 256) * 1024 + h * 256;
        }
        return true;
    }
};

__device__ __forceinline__ void store8(bf16_t* p, const f32x4 v0, const f32x4 v1) {
    u32x4 w; w.x = cvt_pk_bf16(v0[0], v0[1]); w.y = cvt_pk_bf16(v0[2], v0[3]); w.z = cvt_pk_bf16(v1[0], v1[1]); w.w = cvt_pk_bf16(v1[2], v1[3]); *(u32x4*)p = w;
}
__device__ __forceinline__ float sigmoidf_fast(float z) { return __builtin_amdgcn_rcpf(1.0f + __builtin_amdgcn_exp2f(-z * LOG2E)); }
__device__ __forceinline__ f32x4 sig4(f32x4 z) { f32x4 r; r[0] = sigmoidf_fast(z[0]); r[1] = sigmoidf_fast(z[1]); r[2] = sigmoidf_fast(z[2]); r[3] = sigmoidf_fast(z[3]); return r; }

struct EpiSwiGLU {
    static constexpr bool PERM = true; static constexpr int MIDK = 0;
    bf16_t* H; const float* ss; static constexpr int ldh = 2816;
    __device__ __forceinline__ void midk(f32x4 (&)[2][2][4][2], const Unit&, int, int, int, int) const {}
    __device__ __forceinline__ void operator()(f32x4 (&acc)[2][2][4][2], const Unit& u, int wr, int wc, int fr, int fq) const {
        const int row0 = u.pm * BM + wr * 64 + fr, col0 = u.pn * HALF + wc * 32 + 8 * fq;
#pragma unroll
        for (int ai = 0; ai < 2; ++ai)
#pragma unroll
            for (int m = 0; m < 4; ++m) {
                const int row = row0 + ai * HALF + m * 16;
                const float rs = __builtin_amdgcn_rsqf(ss[row] * (1.0f / 1024.0f) + RMS_EPS);
                const f32x4 g0 = acc[ai][0][m][0] * rs, g1 = acc[ai][0][m][1] * rs, u0 = acc[ai][1][m][0] * rs, u1 = acc[ai][1][m][1] * rs;
                store8(H + (size_t)row * ldh + col0, g0 * sig4(g0) * u0, g1 * sig4(g1) * u1);
            }
    }
};

template <int MIDK_>
struct EpiResid {
    static constexpr bool PERM = true; static constexpr int MIDK = MIDK_;
    const float* xin; float* xout; bf16_t* xb; float* ssn; const float* ssa; float alpha;
    __device__ __forceinline__ void midk(f32x4 (&acc)[2][2][4][2], const Unit& u, int wr, int wc, int fr, int fq) const {
        const int row0 = u.pm * BM + wr * 64 + fr;
#pragma unroll
        for (int ai = 0; ai < 2; ++ai)
#pragma unroll
            for (int m = 0; m < 4; ++m) {
                const float rs = __builtin_amdgcn_rsqf(ssa[row0 + ai * HALF + m * 16] * (1.0f / 512.0f) + RMS_EPS);
#pragma unroll
                for (int bj = 0; bj < 2; ++bj)
#pragma unroll
                    for (int n = 0; n < 2; ++n) acc[ai][bj][m][n] *= rs;
            }
    }
    __device__ __forceinline__ void operator()(f32x4 (&acc)[2][2][4][2], const Unit& u, int wr, int wc, int fr, int fq) const {
        const int row0 = u.pm * BM + wr * 64 + fr, col0 = u.pn * BM + wc * 32 + 8 * fq;
#pragma unroll
        for (int ai = 0; ai < 2; ++ai)
#pragma unroll
            for (int m = 0; m < 4; ++m) {
                const int row = row0 + ai * HALF + m * 16; float q = 0.f;
#pragma unroll
                for (int bj = 0; bj < 2; ++bj) {
                    const size_t off = (size_t)row * 1024 + col0 + bj * HALF;
                    const f32x4 r0 = *(const f32x4*)(xin + off), r1 = *(const f32x4*)(xin + off + 4);
                    const f32x4 v0 = r0 + acc[ai][bj][m][0] * alpha, v1 = r1 + acc[ai][bj][m][1] * alpha;
                    *(f32x4*)(xout + off) = v0; *(f32x4*)(xout + off + 4) = v1;
                    store8(xb + off, v0, v1);
                    q += (v0[0] * v0[0] + v0[1] * v0[1]) + (v0[2] * v0[2] + v0[3] * v0[3]) + (v1[0] * v1[0] + v1[1] * v1[1]) + (v1[2] * v1[2] + v1[3] * v1[3]);
                }
                q += swz_xor<16>(q); q = sum_x32(q);
                if (fq == 0) atomicAdd(ssn + row, q);
            }
    }
};

struct EpiWin {
    static constexpr bool PERM = true; static constexpr int MIDK = 0;
    bf16_t *Y, *KB, *VB, *UB; float* LOGFT; const float* ss; const float* bfp; float qscale;
    __device__ __forceinline__ void midk(f32x4 (&)[2][2][4][2], const Unit&, int, int, int, int) const {}
    __device__ __forceinline__ void operator()(f32x4 (&acc)[2][2][4][2], const Unit& u, int wr, int wc, int fr, int fq) const {
        const int row0 = u.pm * BM + wr * 64 + fr, cw = wc * 32 + 8 * fq; const int pn = u.pn;
#pragma unroll
        for (int ai = 0; ai < 2; ++ai)
#pragma unroll
            for (int m = 0; m < 4; ++m) {
                const int row = row0 + ai * HALF + m * 16;
                const float rs = __builtin_amdgcn_rsqf(ss[row] * (1.0f / 1024.0f) + RMS_EPS);
                if (pn < 6) {
                    bf16_t* base; int ld; float sc = rs;
                    if (pn < 2) { base = Y + pn * BM; ld = 1024; sc = rs * qscale; } else if (pn < 4) { base = KB + (pn - 2) * BM; ld = 512; } else { base = VB + (pn - 4) * BM; ld = 512; }
#pragma unroll
                    for (int bj = 0; bj < 2; ++bj) store8(base + (size_t)row * ld + bj * HALF + cw, acc[ai][bj][m][0] * sc, acc[ai][bj][m][1] * sc);
                } else if (pn < 10) {
                    const f32x4 a0 = acc[ai][0][m][0] * rs, a1 = acc[ai][0][m][1] * rs, g0 = acc[ai][1][m][0] * rs, g1 = acc[ai][1][m][1] * rs;
                    store8(UB + (size_t)row * 512 + (pn - 6) * HALF + cw, a0 * sig4(g0), a1 * sig4(g1));
                } else {
                    if (wc == 0 && fq == 0) {
                        const int b = row >> 11, t = row & 2047;
#pragma unroll
                        for (int n = 0; n < 2; ++n)
#pragma unroll
                            for (int e = 0; e < 4; ++e) {
                                const int h = 4 * n + e; const float z = acc[ai][0][m][n][e] * rs + bfp[h];
                                LOGFT[(size_t)(b * 8 + h) * 2048 + t] = fminf(z, 0.f) - log1pf(expf(-fabsf(z)));
                            }
                    }
                }
            }
    }
};

struct EpiRowScale {
    static constexpr bool PERM = true; static constexpr int MIDK = 0;
    bf16_t* O; const float* ssr; float scale; static constexpr int ldc = 2048;
    __device__ __forceinline__ void midk(f32x4 (&)[2][2][4][2], const Unit&, int, int, int, int) const {}
    __device__ __forceinline__ void operator()(f32x4 (&acc)[2][2][4][2], const Unit& u, int wr, int wc, int fr, int fq) const {
        const int row0 = u.pm * BM + wr * 64 + fr, col0 = u.pn * BM + wc * 32 + 8 * fq;
#pragma unroll
        for (int ai = 0; ai < 2; ++ai)
#pragma unroll
            for (int m = 0; m < 4; ++m) {
                const int row = row0 + ai * HALF + m * 16;
                const float rs = (ssr ? __builtin_amdgcn_rsqf(ssr[row] * (1.0f / 1024.0f) + RMS_EPS) : 1.0f) * scale;
#pragma unroll
                for (int bj = 0; bj < 2; ++bj) store8(O + (size_t)row * ldc + col0 + bj * HALF, acc[ai][bj][m][0] * rs, acc[ai][bj][m][1] * rs);
            }
    }
};

struct EpiAux {
    static constexpr bool PERM = true; static constexpr int MIDK = 0;
    bf16_t* O; float scale; static constexpr int ldc = 1024;
    __device__ __forceinline__ void midk(f32x4 (&)[2][2][4][2], const Unit&, int, int, int, int) const {}
    __device__ __forceinline__ void operator()(f32x4 (&acc)[2][2][4][2], const Unit& u, int wr, int wc, int fr, int fq) const {
        bf16_t* base = O + u.aux + (size_t)(wr * 64 + fr) * ldc + wc * 32 + 8 * fq;
#pragma unroll
        for (int ai = 0; ai < 2; ++ai)
#pragma unroll
            for (int m = 0; m < 4; ++m)
#pragma unroll
                for (int bj = 0; bj < 2; ++bj) store8(base + (size_t)(ai * HALF + m * 16) * ldc + bj * HALF, acc[ai][bj][m][0] * scale, acc[ai][bj][m][1] * scale);
    }
};

struct EpiSoftmax {
    static constexpr bool PERM = true; static constexpr int MIDK = 0;
    bf16_t* XP; const float* ss; PG8_LAS float* scr;
    __device__ __forceinline__ void midk(f32x4 (&)[2][2][4][2], const Unit&, int, int, int, int) const {}
    __device__ __forceinline__ void operator()(f32x4 (&acc)[2][2][4][2], const Unit& u, int wr, int wc, int fr, int fq) const {
        const int row0 = u.pm * BM + wr * 64 + fr, col0 = u.pn * BM + wc * 32 + 8 * fq;
        PG8_LAS float* TM = scr; PG8_LAS float* TS = scr + 1024;
        float rs[2][4];
#pragma unroll
        for (int ai = 0; ai < 2; ++ai)
#pragma unroll
            for (int m = 0; m < 4; ++m) {
                const int rl = ai * HALF + wr * 64 + m * 16 + fr;
                rs[ai][m] = __builtin_amdgcn_rsqf(ss[u.pm * BM + rl] * (1.0f / 1024.0f) + RMS_EPS);
                float v = -3.0e38f;
#pragma unroll
                for (int bj = 0; bj < 2; ++bj)
#pragma unroll
                    for (int n = 0; n < 2; ++n) { const f32x4 x = acc[ai][bj][m][n]; v = fmaxf(v, fmaxf(fmaxf(x[0], x[1]), fmaxf(x[2], x[3]))); }
                v = fmaxf(v, swz_xor<16>(v)); v = max_x32(v);
                if (fq == 0) TM[rl * 4 + wc] = v * rs[ai][m];
            }
        asm volatile("s_waitcnt lgkmcnt(0)" ::: "memory"); __builtin_amdgcn_s_barrier(); asm volatile("" ::: "memory");
#pragma unroll
        for (int ai = 0; ai < 2; ++ai)
#pragma unroll
            for (int m = 0; m < 4; ++m) {
                const int rl = ai * HALF + wr * 64 + m * 16 + fr;
                const f32x4 t = *(const PG8_LAS f32x4*)(TM + rl * 4);
                const float mrow = fmaxf(fmaxf(t[0], t[1]), fmaxf(t[2], t[3]));
                float s = 0.f;
#pragma unroll
                for (int bj = 0; bj < 2; ++bj)
#pragma unroll
                    for (int n = 0; n < 2; ++n) { f32x4 x = acc[ai][bj][m][n] * rs[ai][m] - mrow;
                        x[0] = __builtin_amdgcn_exp2f(x[0]); x[1] = __builtin_amdgcn_exp2f(x[1]); x[2] = __builtin_amdgcn_exp2f(x[2]); x[3] = __builtin_amdgcn_exp2f(x[3]);
                        acc[ai][bj][m][n] = x; s += (x[0] + x[1]) + (x[2] + x[3]); }
                s += swz_xor<16>(s); s = sum_x32(s);
                if (fq == 0) TS[rl * 4 + wc] = s;
            }
        asm volatile("s_waitcnt lgkmcnt(0)" ::: "memory"); __builtin_amdgcn_s_barrier(); asm volatile("" ::: "memory");
#pragma unroll
        for (int ai = 0; ai < 2; ++ai)
#pragma unroll
            for (int m = 0; m < 4; ++m) {
                const int rl = ai * HALF + wr * 64 + m * 16 + fr;
                const f32x4 t = *(const PG8_LAS f32x4*)(TS + rl * 4);
                const float inv = __builtin_amdgcn_rcpf((t[0] + t[1]) + (t[2] + t[3]));
#pragma unroll
                for (int bj = 0; bj < 2; ++bj) store8(XP + (size_t)(u.pm * BM + rl) * 1024 + col0 + bj * HALF, acc[ai][bj][m][0] * inv, acc[ai][bj][m][1] * inv);
            }
    }
};
}
#include <hip/hip_bf16.h>
namespace attn_body {
using bf16=__hip_bfloat16;
using bf16x8=__attribute__((ext_vector_type(8)))short;
using s16x4=__attribute__((ext_vector_type(4)))short;
using f32x16=__attribute__((ext_vector_type(16)))float;
using f32x4_t=__attribute__((ext_vector_type(4)))float;
using u32x4=__attribute__((ext_vector_type(4)))unsigned;
#define ATT_LAS __attribute__((address_space(3)))
constexpr int BATCH=8,NHEAD=8,SEQ=2048,D=64,QP=1024,KP=512;
constexpr int NW=8,QBLK=32,QB=QBLK*NW,KVBLK=64,NQB=SEQ/QB;
__device__ __forceinline__ int crow(int r,int hi){return (r&3)+8*(r>>2)+4*hi;}
#define SBAR() __builtin_amdgcn_sched_barrier(0)
__device__ __forceinline__ void cmask(f32x16&p0,f32x16&p1,int jb,int qrel,int hi){
  const float NEG=-INFINITY; int kb=64*jb+4*hi;
  #pragma unroll
  for(int r=0;r<16;++r){int kv=kb+(r&3)+8*(r>>2); if(kv>qrel)p0[r]=NEG; if(kv+32>qrel)p1[r]=NEG;}
}
constexpr int NSLOT=3, SLOTB=8192;
constexpr int LDS_K=0, LDS_V=NSLOT*SLOTB, LDS_WS=2*NSLOT*SLOTB, LDS_OST=LDS_WS+NW*64*4, LDS_CB=LDS_OST+NW*4096  , LDS_WT=LDS_CB+SEQ*4, LDS_BYTES=LDS_WT+64;
__device__ __forceinline__ void glds16(const void*gsrc,unsigned lds_dst){unsigned keep;
  asm volatile("s_mov_b32 %0, m0\n\ts_mov_b32 m0, %2\n\ts_nop 0\n\tglobal_load_lds_dwordx4 %1, off\n\ts_mov_b32 m0, %0":"=&s"(keep):"v"(gsrc),"s"(lds_dst):"memory");}
__device__ __forceinline__ float max3f(float a,float b,float c){float r;asm("v_max3_f32 %0, %1, %2, %3":"=v"(r):"v"(a),"v"(b),"v"(c));return r;}
__device__ __forceinline__ float max2f(float a,float b){float r;asm("v_max_f32_e32 %0, %1, %2":"=v"(r):"v"(a),"v"(b));return r;}
__device__ __forceinline__ float fadd_s(float a,float b){float r;asm("v_add_f32_e32 %0, %1, %2":"=v"(r):"v"(a),"v"(b));return r;}
__device__ __forceinline__ float fsub_s(float a,float b){float r;asm("v_sub_f32_e32 %0, %1, %2":"=v"(r):"v"(a),"v"(b));return r;}
typedef float f32x2_t __attribute__((ext_vector_type(2))); typedef __bf16 bf16x2_t __attribute__((ext_vector_type(2)));
__device__ __forceinline__ unsigned cvtpk_s(float lo,float hi){f32x2_t v={lo,hi};bf16x2_t b=__builtin_convertvector(v,bf16x2_t);return __builtin_bit_cast(unsigned,b);}
#define WAIT_BAR(N) asm volatile("s_waitcnt vmcnt(" #N ") lgkmcnt(0)\n\ts_barrier":::"memory")

__device__ __forceinline__ void qkt(f32x16&p0,f32x16&p1,const char*Kslot,const bf16x8*qr,const f32x16&negm,int r32,int hi){
  const char*kb=Kslot+hi*1024+r32*16;
  #pragma unroll
  for(int d0=0;d0<4;++d0){
    const bf16x8 b0=*reinterpret_cast<const bf16x8*>(kb+d0*2048);
    const bf16x8 b1=*reinterpret_cast<const bf16x8*>(kb+d0*2048+512);
    if(d0==0){p0=__builtin_amdgcn_mfma_f32_32x32x16_bf16(b0,qr[0],negm,0,0,0);p1=__builtin_amdgcn_mfma_f32_32x32x16_bf16(b1,qr[0],negm,0,0,0);}
    else{p0=__builtin_amdgcn_mfma_f32_32x32x16_bf16(b0,qr[d0],p0,0,0,0);p1=__builtin_amdgcn_mfma_f32_32x32x16_bf16(b1,qr[d0],p1,0,0,0);}}
}
typedef ATT_LAS const char* lds_cptr;
typedef short v4i16_t __attribute__((ext_vector_type(4)));
__device__ __forceinline__ void kload8(bf16x8*kf,lds_cptr kp){
  kf[0]=*(const ATT_LAS bf16x8*)(kp);      kf[1]=*(const ATT_LAS bf16x8*)(kp+512);
  kf[2]=*(const ATT_LAS bf16x8*)(kp+2048); kf[3]=*(const ATT_LAS bf16x8*)(kp+2560);
  kf[4]=*(const ATT_LAS bf16x8*)(kp+4096); kf[5]=*(const ATT_LAS bf16x8*)(kp+4608);
  kf[6]=*(const ATT_LAS bf16x8*)(kp+6144); kf[7]=*(const ATT_LAS bf16x8*)(kp+6656);
}
__device__ __forceinline__ void kload2(bf16x8*kf,lds_cptr kp,int j){ kf[2*j]=*(const ATT_LAS bf16x8*)(kp+j*2048); kf[2*j+1]=*(const ATT_LAS bf16x8*)(kp+j*2048+512); }
__device__ __forceinline__ s16x4 vtr(lds_cptr p){ return __builtin_bit_cast(s16x4,__builtin_amdgcn_ds_read_tr16_b64_v4i16((ATT_LAS v4i16_t*)p)); }
__device__ __forceinline__ float rowmax(const f32x16&p0,const f32x16&p1){
  float a=max3f(p0[0],p0[1],p1[0]),b=max3f(p0[2],p0[3],p1[1]);a=max3f(a,p1[2],p1[3]);
  #pragma unroll
  for(int r=4;r<16;r+=4){a=max3f(a,p0[r],p0[r+1]);b=max3f(b,p0[r+2],p0[r+3]);a=max3f(a,p1[r],p1[r+1]);b=max3f(b,p1[r+2],p1[r+3]);}
  const float m=max2f(a,b);
  auto rr=__builtin_amdgcn_permlane32_swap(__float_as_uint(m),__float_as_uint(m),false,false);
  return max2f(__uint_as_float(rr[0]),__uint_as_float(rr[1]));
}
__device__ __forceinline__ void pv(f32x16*o,int vb,bf16x8 pa0,bf16x8 pa1,bf16x8 pa2,bf16x8 pa3){
  #pragma unroll
  for(int d0=0;d0<2;++d0){s16x4 lo[4],hi[4];
    #pragma unroll
    for(int ks=0;ks<4;++ks){
      asm volatile("ds_read_b64_tr_b16 %0,%1 offset:%c2":"=&v"(lo[ks]):"v"(vb),"i"(d0*4096+ks*1024):"memory");
      asm volatile("ds_read_b64_tr_b16 %0,%1 offset:%c2":"=&v"(hi[ks]):"v"(vb),"i"(d0*4096+ks*1024+512):"memory");}
    asm volatile("s_waitcnt lgkmcnt(0)":::"memory");SBAR();
    #define PK(k) (bf16x8){lo[k][0],lo[k][1],lo[k][2],lo[k][3],hi[k][0],hi[k][1],hi[k][2],hi[k][3]}
    o[d0]=__builtin_amdgcn_mfma_f32_32x32x16_bf16(pa0,PK(0),o[d0],0,0,0);
    o[d0]=__builtin_amdgcn_mfma_f32_32x32x16_bf16(pa1,PK(1),o[d0],0,0,0);
    o[d0]=__builtin_amdgcn_mfma_f32_32x32x16_bf16(pa2,PK(2),o[d0],0,0,0);
    o[d0]=__builtin_amdgcn_mfma_f32_32x32x16_bf16(pa3,PK(3),o[d0],0,0,0);
    #undef PK
  }
}
__device__ __forceinline__ void scan_bias(const float*LOGFT,int bh,char*shm,const int tid){
  const int lane=tid&63,wid=tid>>6;
  ATT_LAS float*cb=(ATT_LAS float*)(shm+LDS_CB); ATT_LAS float*wt=(ATT_LAS float*)(shm+LDS_WT);
  const f32x4_t v=*(const f32x4_t*)(LOGFT+(size_t)bh*SEQ+4*tid);
  const float s0=v[0],s1=s0+v[1],s2=s1+v[2],s3=s2+v[3];
  float incl=s3;
  #pragma unroll
  for(int o=1;o<64;o<<=1){const float n=__int_as_float(__builtin_amdgcn_ds_bpermute((lane-o)<<2,__float_as_int(incl))); if(lane>=o)incl+=n;}
  if(lane==63)wt[wid]=incl;
  asm volatile("s_waitcnt lgkmcnt(0)\n\ts_barrier":::"memory");
  float woff=0.f;
  #pragma unroll
  for(int w=0;w<8;++w){const float x=wt[w]; if(w<wid)woff+=x;}
  const float ex=woff+incl-s3; const float L2E=-1.4426950408889634f;
  f32x4_t o4; o4[0]=(ex+s0)*L2E;o4[1]=(ex+s1)*L2E;o4[2]=(ex+s2)*L2E;o4[3]=(ex+s3)*L2E;
  *(ATT_LAS f32x4_t*)(cb+4*tid)=o4;
  asm volatile("s_waitcnt lgkmcnt(0)\n\ts_barrier":::"memory");
}
template<int THRL> __device__ __forceinline__ void attn_unit(int b,int h,int qb,const bf16*Q,const bf16*K,const bf16*V,bf16*O,float*ssa,char*shm,const int tid){
  const int lane=tid&63,r32=lane&31,hi=lane>>5; const int wid=__builtin_amdgcn_readfirstlane(tid>>6);
  const long rowbase=(long)b*SEQ; const int q0=qb*QB;
  const bf16*Qw=Q+(rowbase+q0+wid*QBLK)*QP+h*D;
  const bf16*Kh=K+rowbase*KP+h*D,*Vh=V+rowbase*KP+h*D;
  const unsigned lds0=(unsigned)(uintptr_t)shm;
  float*wsf=(float*)(shm+LDS_WS)+wid*64;
  const ATT_LAS float*cbh=(const ATT_LAS float*)(shm+LDS_CB)+4*hi;
  const bf16*ksrc=Kh+(long)lane*KP+wid*8;
  const bf16*vsrc=Vh+(long)(16*(wid&3)+(lane>>2))*KP+(wid>>2)*32+(lane&3)*8;
  const unsigned kdst=lds0+LDS_K+wid*1024, vdst=lds0+LDS_V+wid*1024;
  #define DMA_K(t,slot) glds16(ksrc+(long)(t)*KVBLK*KP,(unsigned)__builtin_amdgcn_readfirstlane(kdst+(slot)))
  #define DMA_V(t,slot) glds16(vsrc+(long)(t)*KVBLK*KP,(unsigned)__builtin_amdgcn_readfirstlane(vdst+(slot)))
  const int vb0=(int)(lds0+LDS_V)+((lane>>4)&1)*32+(lane&3)*8+(4*hi+((lane&15)>>2))*64;
  const char*Kbase=shm+LDS_K; bf16x8 kf[8];
  const lds_cptr shm3=(lds_cptr)shm; const lds_cptr kp0=shm3+LDS_K+hi*1024+r32*16; const lds_cptr vp0=shm3+LDS_V+((lane>>4)&1)*32+(lane&3)*8+(4*hi+((lane&15)>>2))*64;
  const int NT=(q0+QB)/KVBLK;
  DMA_K(0,0);DMA_V(0,0);DMA_K(1,SLOTB);
  bf16x8 qr[4];
  #pragma unroll
  for(int d0=0;d0<4;++d0)qr[d0]=*reinterpret_cast<const bf16x8*>(&Qw[(long)r32*QP+d0*16+hi*8]);
  float mhat=0.f,l_reg=0.f;f32x16 o[2];o[0]=f32x16{};o[1]=f32x16{};f32x16 negm=f32x16{};asm volatile("":"+v"(negm));
  const int qrel=wid*QBLK+r32;
  #define CMASK(P0,P1,t) do{int jb_=(t)-(NT-4); if(jb_>=0)cmask(P0,P1,jb_,qrel,hi);}while(0)
  #define ADDB(P0,P1,t) do{ const ATT_LAS float*cbt_=cbh+64*(t); \
    _Pragma("unroll") for(int j_=0;j_<4;++j_){ const f32x4_t b0_=*(const ATT_LAS f32x4_t*)(cbt_+8*j_), b1_=*(const ATT_LAS f32x4_t*)(cbt_+32+8*j_); \
      _Pragma("unroll") for(int i_=0;i_<4;++i_){P0[4*j_+i_]+=b0_[i_];P1[4*j_+i_]+=b1_[i_];} } }while(0)
  bool resc=false;
  #define START(P0,P1) do{ const float rm=rowmax(P0,P1); resc=false; \
    { const float dl=rm; mhat=fadd_s(mhat,dl); \
      _Pragma("unroll") for(int r=0;r<16;++r){P0[r]=fsub_s(P0[r],dl);P1[r]=fsub_s(P1[r],dl);} \
      _Pragma("unroll") for(int r=0;r<16;++r)negm[r]=-mhat; asm volatile("":"+v"(negm)); } \
    _Pragma("unroll") for(int r=0;r<16;++r)P0[r]=__builtin_amdgcn_exp2f(P0[r]); }while(0)
  #define RESC() do{ if(resc){ asm volatile("s_waitcnt lgkmcnt(0)":::"memory"); \
      _Pragma("unroll") for(int d_=0;d_<2;++d_) _Pragma("unroll") for(int r=0;r<16;++r)o[d_][r]*=wsf[crow(r,hi)]; } }while(0)
  f32x16 pA0,pA1,pB0,pB1;
  int sl_prev=0,sl_cur=0,sl_next=SLOTB;
  #define ROT() do{sl_prev=sl_cur;sl_cur=sl_next;sl_next=(sl_next==(NSLOT-1)*SLOTB)?0:sl_next+SLOTB;}while(0)
  DMA_K(2,2*SLOTB);
  WAIT_BAR(3);
  qkt(pA0,pA1,Kbase,qr,negm,r32,hi);asm volatile("s_nop 15\n\ts_nop 7":"+v"(pA0),"+v"(pA1));ADDB(pA0,pA1,0);asm volatile("s_nop 3":"+v"(pA0),"+v"(pA1));CMASK(pA0,pA1,0);
  START(pA0,pA1);
  _Pragma("unroll") for(int r=0;r<16;++r)pA1[r]=__builtin_amdgcn_exp2f(pA1[r]);
  WAIT_BAR(0);
  DMA_K(3,0);DMA_V(1,SLOTB);
  ROT();
  kload8(kf,kp0+sl_cur);
  WAIT_BAR(2);
  s16x4 vlo[8],vhi[8]; u32x4 pw0,pw1,pw2,pw3;
  #define PKW(P,B) cvtpk_s(P[B],P[B+1])
  #define PAF(k) __builtin_bit_cast(bf16x8,pw##k)
  #define VFR(i) (bf16x8){vlo[i][0],vlo[i][1],vlo[i][2],vlo[i][3],vhi[i][0],vhi[i][1],vhi[i][2],vhi[i][3]}
  #define PIN(x) asm volatile("":"+v"(x))
  #define MX3(a,b,c) __builtin_fmaxf(__builtin_fmaxf((a),(b)),(c))
  #define GAPA(MF,A0,A1,A2,A3,W0,W1,PW) do{ MF; sacc+=A0; sacc+=A1; sacc+=A2; sacc+=A3; PIN(sacc); W0; W1; PIN(PW); SBAR(); }while(0)
  #define EX(v) __builtin_amdgcn_exp2f(v)
  #define GAPB(MF,X,B) do{ MF; X[B]=EX(X[B]); X[B+1]=EX(X[B+1]); X[B+2]=EX(X[B+2]); X[B+3]=EX(X[B+3]); PIN(X); SBAR(); }while(0)
  #define VRD(i) do{ vlo[i]=vtr(vp_+(((i)>>2)*4096+((i)&3)*1024)); vhi[i]=vtr(vp_+(((i)>>2)*4096+((i)&3)*1024+512)); }while(0)
  #define KRD(G,j) do{ if(G){ kload2(kf,kp0+sl_next,j); SBAR(); } }while(0)
  #define STEP(C0,C1,P0,P1,t,GK,GV,GL) do{ SBAR(); \
    const lds_cptr vp_=vp0+sl_prev; \
    VRD(0); SBAR(); float sacc=(P0[0]+P0[1]); \
    GAPA(C0=__builtin_amdgcn_mfma_f32_32x32x16_bf16(kf[0],qr[0],negm,0,0,0), P0[2],P0[3],P0[4],P0[5],     pw0[0]=PKW(P0,0), pw0[1]=PKW(P0,2), pw0); \
    VRD(4); SBAR(); GAPA(C1=__builtin_amdgcn_mfma_f32_32x32x16_bf16(kf[1],qr[0],negm,0,0,0), P0[6],P0[7],P0[8],P0[9],     pw0[2]=PKW(P0,4), pw0[3]=PKW(P0,6), pw0); \
    VRD(1); SBAR(); GAPA(C0=__builtin_amdgcn_mfma_f32_32x32x16_bf16(kf[2],qr[1],C0,0,0,0),   P0[10],P0[11],P0[12],P0[13], pw1[0]=PKW(P0,8), pw1[1]=PKW(P0,10), pw1); \
    VRD(5); SBAR(); GAPA(C1=__builtin_amdgcn_mfma_f32_32x32x16_bf16(kf[3],qr[1],C1,0,0,0),   P0[14],P0[15],P1[0],P1[1],   pw1[2]=PKW(P0,12),pw1[3]=PKW(P0,14), pw1); \
    VRD(2); SBAR(); GAPA(C0=__builtin_amdgcn_mfma_f32_32x32x16_bf16(kf[4],qr[2],C0,0,0,0),   P1[2],P1[3],P1[4],P1[5],     pw2[0]=PKW(P1,0), pw2[1]=PKW(P1,2), pw2); \
    VRD(6); SBAR(); GAPA(C1=__builtin_amdgcn_mfma_f32_32x32x16_bf16(kf[5],qr[2],C1,0,0,0),   P1[6],P1[7],P1[8],P1[9],     pw2[2]=PKW(P1,4), pw2[3]=PKW(P1,6), pw2); \
    VRD(3); SBAR(); GAPA(C0=__builtin_amdgcn_mfma_f32_32x32x16_bf16(kf[6],qr[3],C0,0,0,0),   P1[10],P1[11],P1[12],P1[13], pw3[0]=PKW(P1,8), pw3[1]=PKW(P1,10), pw3); \
    VRD(7); SBAR(); GAPA(C1=__builtin_amdgcn_mfma_f32_32x32x16_bf16(kf[7],qr[3],C1,0,0,0),   P1[14],P1[15],0.f,0.f,       pw3[2]=PKW(P1,12),pw3[3]=PKW(P1,14), pw3); \
    l_reg+=sacc; \
    if(GK){DMA_K((t)+3,sl_cur);} if(GV){DMA_V((t)+1,sl_next);} \
    ADDB(C0,C1,t); \
    CMASK(C0,C1,t); \
    { float a=MX3(C0[0],C0[1],C1[0]),b=MX3(C0[2],C0[3],C1[1]); a=MX3(a,C1[2],C1[3]); \
      _Pragma("unroll") for(int r=4;r<16;r+=4){a=MX3(a,C0[r],C0[r+1]);b=MX3(b,C0[r+2],C0[r+3]);a=MX3(a,C1[r],C1[r+1]);b=MX3(b,C1[r+2],C1[r+3]);} \
      float rm=__builtin_fmaxf(a,b); { auto rr=__builtin_amdgcn_permlane32_swap(__float_as_uint(rm),__float_as_uint(rm),false,false); rm=__builtin_fmaxf(__uint_as_float(rr[0]),__uint_as_float(rr[1])); } \
      resc=false; \
      if(__builtin_expect(__any(rm>(float)THRL),0)){ const float dl=__builtin_fmaxf(rm,0.f); mhat+=dl; \
        _Pragma("unroll") for(int r=0;r<16;++r){C0[r]-=dl;C1[r]-=dl;} \
        _Pragma("unroll") for(int r=0;r<16;++r)negm[r]=-mhat; asm volatile("":"+v"(negm)); \
        const float f=__builtin_amdgcn_exp2f(-dl); l_reg*=f; if(hi==0)wsf[r32]=f; resc=true; } } \
    SBAR(); \
    GAPB(o[0]=__builtin_amdgcn_mfma_f32_32x32x16_bf16(PAF(0),VFR(0),o[0],0,0,0), C0,0); \
    GAPB(o[1]=__builtin_amdgcn_mfma_f32_32x32x16_bf16(PAF(0),VFR(4),o[1],0,0,0), C0,4); \
    KRD(GL,0); GAPB(o[0]=__builtin_amdgcn_mfma_f32_32x32x16_bf16(PAF(1),VFR(1),o[0],0,0,0), C0,8); \
    KRD(GL,1); GAPB(o[1]=__builtin_amdgcn_mfma_f32_32x32x16_bf16(PAF(1),VFR(5),o[1],0,0,0), C0,12); \
    KRD(GL,2); GAPB(o[0]=__builtin_amdgcn_mfma_f32_32x32x16_bf16(PAF(2),VFR(2),o[0],0,0,0), C1,0); \
    KRD(GL,3); GAPB(o[1]=__builtin_amdgcn_mfma_f32_32x32x16_bf16(PAF(2),VFR(6),o[1],0,0,0), C1,4); \
    GAPB(o[0]=__builtin_amdgcn_mfma_f32_32x32x16_bf16(PAF(3),VFR(3),o[0],0,0,0), C1,8); \
    GAPB(o[1]=__builtin_amdgcn_mfma_f32_32x32x16_bf16(PAF(3),VFR(7),o[1],0,0,0), C1,12); \
    }while(0)
  int t=1;
  #undef CMASK
  #define CMASK(P0,P1,t) do{}while(0)
  for(;t+5<NT;t+=2){
    STEP(pB0,pB1,pA0,pA1,t,true,true,true);     WAIT_BAR(2); RESC(); ROT();
    STEP(pA0,pA1,pB0,pB1,t+1,true,true,true);   WAIT_BAR(2); RESC(); ROT();
  }
  #undef CMASK
  #define CMASK(P0,P1,t) do{int jb_=(t)-(NT-4); if(jb_>=0)cmask(P0,P1,jb_,qrel,hi);}while(0)
  #define ENDW(tt) do{ if((tt)+3<NT){WAIT_BAR(2);} else if((tt)+2<NT){WAIT_BAR(1);} else {WAIT_BAR(0);} }while(0)
  for(;t+1<NT;t+=2){
    STEP(pB0,pB1,pA0,pA1,t,(t+3<NT),(t+1<NT),(t+1<NT));       ENDW(t);   RESC(); ROT();
    STEP(pA0,pA1,pB0,pB1,t+1,(t+4<NT),(t+2<NT),(t+2<NT));     ENDW(t+1); RESC(); ROT();
  }
  STEP(pB0,pB1,pA0,pA1,NT-1,false,false,false); RESC();
  { float sacc=pB0[0]+pB0[1]; _Pragma("unroll") for(int r=2;r<16;++r)sacc+=pB0[r]; _Pragma("unroll") for(int r=0;r<16;++r)sacc+=pB1[r]; l_reg+=sacc;
    pw0=(u32x4){PKW(pB0,0),PKW(pB0,2),PKW(pB0,4),PKW(pB0,6)};pw1=(u32x4){PKW(pB0,8),PKW(pB0,10),PKW(pB0,12),PKW(pB0,14)};pw2=(u32x4){PKW(pB1,0),PKW(pB1,2),PKW(pB1,4),PKW(pB1,6)};pw3=(u32x4){PKW(pB1,8),PKW(pB1,10),PKW(pB1,12),PKW(pB1,14)};
    SBAR(); pv(o,vb0+sl_cur,PAF(0),PAF(1),PAF(2),PAF(3)); }
  #undef PKW
  #undef PAF
  #undef VFR
  #undef PIN
  #undef MX3
  #undef GAPA
  #undef GAPB
  #undef EX
  #undef VRD
  #undef KRD
  #undef STEP
  #undef ENDW
  {auto rr=__builtin_amdgcn_permlane32_swap(__float_as_uint(l_reg),__float_as_uint(l_reg),false,false);l_reg=__uint_as_float(rr[0])+__uint_as_float(rr[1]);}
  if(hi==0)wsf[32+r32]=l_reg;asm volatile("s_waitcnt lgkmcnt(0)":::"memory");
  float rli[16];
  #pragma unroll
  for(int r=0;r<16;++r)rli[r]=__builtin_amdgcn_rcpf(wsf[32+crow(r,hi)]);
  bf16*Ow=O+(rowbase+q0+wid*QBLK)*QP+h*D;
  float*ssw=ssa+rowbase+q0+wid*QBLK;
  { bf16*stg=(bf16*)(shm+LDS_OST)+wid*2048;
    #pragma unroll
    for(int r=0;r<16;++r){const int orow=crow(r,hi);
      #pragma unroll
      for(int d0=0;d0<2;++d0)stg[orow*64+d0*32+r32]=__float2bfloat16(o[d0][r]*rli[r]);}
    asm volatile("s_waitcnt lgkmcnt(0)":::"memory");
    #pragma unroll
    for(int i=0;i<4;++i){const int row=i*8+(lane>>3),ch=lane&7; const u32x4 v=*(const u32x4*)(stg+row*64+ch*8); *(u32x4*)(Ow+(long)row*QP+ch*8)=v;
      float q=0.f;
      #pragma unroll
      for(int e=0;e<4;++e){const float lo=__uint_as_float(v[e]<<16),hi2=__uint_as_float(v[e]&0xffff0000u); q+=lo*lo+hi2*hi2;}
      q+=swz_xor<1>(q);q+=swz_xor<2>(q);q+=swz_xor<4>(q);
      if(ch==0)atomicAdd(ssw+row,q);} }
  asm volatile("s_waitcnt lgkmcnt(0)\n\ts_barrier":::"memory");
  #undef DMA_K
  #undef DMA_V
  #undef CMASK
  #undef ADDB
  #undef START
  #undef RESC
  #undef ROT
}
#undef SBAR
#undef WAIT_BAR

constexpr int CONV_W=31, CONV_C=512, CONV_TOK=64, CONV_ROWS=CONV_TOK+CONV_W-1;
__device__ __forceinline__ float wsum64(float v){ return wave_sum64(v); }
__device__ __forceinline__ void conv_unit(int unit,const bf16*UB,const float*cw,const float*cbias,const float*lng,const float*lnb,bf16*Y,char*shm,const int tid){
  const int lane=tid&63,wid=tid>>6;
  const int b=unit>>5,t0=(unit&31)*CONV_TOK;
  ATT_LAS u32x4*L=(ATT_LAS u32x4*)shm;
  for(int idx=tid;idx<CONV_ROWS*64;idx+=512){
    const int row=idx>>6,ch=idx&63,t=t0-(CONV_W-1)+row;
    u32x4 v=(u32x4){0u,0u,0u,0u};
    if(t>=0)v=*(const u32x4*)(UB+((size_t)b*SEQ+t)*CONV_C+ch*8);
    L[idx]=v;
  }
  __syncthreads();
  float acc[8][8];
  { const f32x4_t b0=*(const f32x4_t*)(cbias+8*lane),b1=*(const f32x4_t*)(cbias+8*lane+4);
    #pragma unroll
    for(int tt=0;tt<8;++tt){acc[tt][0]=b0[0];acc[tt][1]=b0[1];acc[tt][2]=b0[2];acc[tt][3]=b0[3];acc[tt][4]=b1[0];acc[tt][5]=b1[1];acc[tt][6]=b1[2];acc[tt][7]=b1[3];} }
  #pragma unroll 1
  for(int j=0;j<CONV_W;++j){
    const f32x4_t w0=*(const f32x4_t*)(cw+j*CONV_C+8*lane),w1=*(const f32x4_t*)(cw+j*CONV_C+8*lane+4);
    #pragma unroll
    for(int tt=0;tt<8;++tt){
      const u32x4 u=L[(wid*8+tt+j)*64+lane];
      acc[tt][0]+=w0[0]*__uint_as_float(u[0]<<16); acc[tt][1]+=w0[1]*__uint_as_float(u[0]&0xffff0000u);
      acc[tt][2]+=w0[2]*__uint_as_float(u[1]<<16); acc[tt][3]+=w0[3]*__uint_as_float(u[1]&0xffff0000u);
      acc[tt][4]+=w1[0]*__uint_as_float(u[2]<<16); acc[tt][5]+=w1[1]*__uint_as_float(u[2]&0xffff0000u);
      acc[tt][6]+=w1[2]*__uint_as_float(u[3]<<16); acc[tt][7]+=w1[3]*__uint_as_float(u[3]&0xffff0000u);
    }
  }
  const f32x4_t g0=*(const f32x4_t*)(lng+8*lane),g1=*(const f32x4_t*)(lng+8*lane+4),e0=*(const f32x4_t*)(lnb+8*lane),e1=*(const f32x4_t*)(lnb+8*lane+4);
  const float gg[8]={g0[0],g0[1],g0[2],g0[3],g1[0],g1[1],g1[2],g1[3]},bb[8]={e0[0],e0[1],e0[2],e0[3],e1[0],e1[1],e1[2],e1[3]};
  #pragma unroll
  for(int tt=0;tt<8;++tt){
    float s=0.f;
    #pragma unroll
    for(int e=0;e<8;++e)s+=acc[tt][e];
    const float mu=wsum64(s)*(1.0f/CONV_C);
    float q=0.f;
    #pragma unroll
    for(int e=0;e<8;++e){acc[tt][e]-=mu;q+=acc[tt][e]*acc[tt][e];}
    const float rstd=__builtin_amdgcn_rsqf(wsum64(q)*(1.0f/CONV_C)+1e-6f);
    float q2=0.f;
    #pragma unroll
    for(int e=0;e<8;++e){float y=acc[tt][e]*rstd*gg[e]+bb[e]; y=y*__builtin_amdgcn_rcpf(1.0f+__builtin_amdgcn_exp2f(-y*1.4426950408889634f)); acc[tt][e]=y;q2+=y*y;}
    const float r2=__builtin_amdgcn_rsqf(wsum64(q2)*(1.0f/CONV_C)+1e-6f);
    u32x4 w;
    w[0]=cvtpk_s(acc[tt][0]*r2,acc[tt][1]*r2);w[1]=cvtpk_s(acc[tt][2]*r2,acc[tt][3]*r2);w[2]=cvtpk_s(acc[tt][4]*r2,acc[tt][5]*r2);w[3]=cvtpk_s(acc[tt][6]*r2,acc[tt][7]*r2);
    *(u32x4*)(Y+((size_t)b*SEQ+t0+wid*8+tt)*QP+CONV_C+8*lane)=w;
  }
  __syncthreads();
}
}
constexpr int NWAVES = 8;
constexpr int M = 16384, DM = 1024, DFF = 2816, SEQ = 2048, NBATCH = 8, NMEMROWS = 2048, NLAYER = 2;
constexpr size_t MiB = 1u << 20;
constexpr size_t WS_CTL = 0, CTL_ZERO_BYTES = 2 * MiB;
constexpr size_t WS_W = 2 * MiB;
constexpr size_t W_LAYER = 97 * MiB / 2;
constexpr size_t WO_1A = 0, WO_1B = 11 * MiB, WO_IN = WO_1B + 11 * MiB / 2, WO_OUT = WO_IN + 11 * MiB / 2, WO_XQ = WO_OUT + 2 * MiB, WO_XKV = WO_XQ + 2 * MiB, WO_XO = WO_XKV + 4 * MiB,
                 WO_2A = WO_XO + 2 * MiB, WO_2B = WO_2A + 11 * MiB;
static_assert(WO_2B + 11 * MiB / 2 == W_LAYER, "weight map");
constexpr size_t WS_XB = 100 * MiB;
constexpr size_t WS_MKV = 132 * MiB;
constexpr size_t WS_MEMB = 148 * MiB;
constexpr size_t WS_R1 = 152 * MiB;
constexpr size_t R1_H = 0;
constexpr size_t R1_Y = 0, R1_KB = 32 * MiB, R1_VB = 48 * MiB, R1_UB = 64 * MiB, R1_LOGF = 80 * MiB;
constexpr size_t R1_XP = 0, R1_WQK = 64 * MiB, R1_WVO = 80 * MiB;
constexpr size_t WS_END = 248 * MiB;
constexpr int CW_BAR = 4096;
constexpr size_t CTL_SS = 256 * 1024;
constexpr size_t CTL_SSA = CTL_SS + 9 * (size_t)M * 4, CTL_SSM = CTL_SSA + 2 * (size_t)M * 4;
static_assert(CTL_SSM + 2048 * 4 <= CTL_ZERO_BYTES, "ctl map");
constexpr int RING_OFF = 0, RING_BYTES = 131072;
constexpr int EPI_SCR_OFF = RING_BYTES;
constexpr int LDSCTL_OFF = RING_BYTES + 8192, MISC_OFF = LDSCTL_OFF + 320;
constexpr int LDS_BYTES = 147456;
static_assert(MISC_OFF + 128 <= LDS_BYTES, "LDS map");

#define GAS __attribute__((address_space(1)))
#define LAS __attribute__((address_space(3)))
typedef unsigned short bf16;
typedef unsigned v4u __attribute__((ext_vector_type(4)));
typedef float f32x4 __attribute__((ext_vector_type(4)));
typedef GAS unsigned gu32;
#define RLX_AGENT __ATOMIC_RELAXED, __HIP_MEMORY_SCOPE_AGENT
#define LDS_WAIT() asm volatile("s_waitcnt lgkmcnt(0)" ::: "memory")
__device__ __forceinline__ unsigned f2bf(float f) { unsigned u = __builtin_bit_cast(unsigned, f); return (u + 0x7fffu + ((u >> 16) & 1u)) >> 16; }
__device__ __forceinline__ unsigned pk2(float lo, float hi) { return f2bf(lo) | (f2bf(hi) << 16); }

#define XB_TMO      128
#define XB_XCNT(j)  (256  + 64 * (j))
#define XB_XSUB(j)  (1280 + 64 * (j))
#define XB_XGEN(j)  (2304 + 64 * (j))
#define XB_TOP      3328
#define XB_TOPGEN   3392
#define XCD_BAR_WORDS 3456
#define XB_SPIN_CAP (1u << 18)
__device__ __forceinline__ unsigned xb_ld(unsigned* p)              { return __hip_atomic_load(p, __ATOMIC_RELAXED, __HIP_MEMORY_SCOPE_AGENT); }
__device__ __forceinline__ unsigned xb_add(unsigned* p, unsigned v) { return __hip_atomic_fetch_add(p, v, __ATOMIC_RELAXED, __HIP_MEMORY_SCOPE_AGENT); }
__device__ __forceinline__ unsigned xb_xcc_id() { return (unsigned)__builtin_amdgcn_s_getreg((3 << 11) | 20) & 0xFu; }
#define XB_SPIN(cond, bar) do { unsigned _sp = 0; while (cond) { __builtin_amdgcn_s_sleep(1); \
    if ((++_sp & 255u) == 0u) { if (xb_ld(&(bar)[XB_TMO])) break; if (_sp > XB_SPIN_CAP) { atomicAdd(&(bar)[XB_TMO], 1u); break; } } } } while (0)
struct XcdBarrier { unsigned* bar; unsigned x; volatile LAS unsigned* st; };
__device__ __forceinline__ XcdBarrier xcd_barrier_post(unsigned* bar, volatile LAS unsigned* st) {
    XcdBarrier b; b.bar = bar; b.x = xb_xcc_id(); b.st = st;
    if (threadIdx.x == 0) (void)xb_add(&bar[XB_XCNT(b.x)], 1u);
    return b;
}
__device__ __forceinline__ void xcd_barrier_complete(unsigned* bar, unsigned x, unsigned& nloc, unsigned& nx) {
    const unsigned G = gridDim.x * gridDim.y * gridDim.z;
    unsigned sum, cnt, mine, sp = 0u;
    for (;;) {
        sum = 0u; cnt = 0u; mine = 0u;
#pragma unroll
        for (unsigned j = 0; j < 16; ++j) { const unsigned c = xb_ld(&bar[XB_XCNT(j)]); sum += c; cnt += (c > 0u) ? 1u : 0u; mine = (j == x) ? c : mine; }
        if (sum == G) break;
        __builtin_amdgcn_s_sleep(1);
        if ((++sp & 255u) == 0u) { if (xb_ld(&bar[XB_TMO])) break; if (sp > XB_SPIN_CAP) { atomicAdd(&bar[XB_TMO], 1u); break; } }
    }
    nloc = mine > 0u ? mine : 1u; nx = cnt > 0u ? cnt : 1u;
}
__device__ __forceinline__ void xcd_barrier(const XcdBarrier& b) {
    asm volatile("s_waitcnt vmcnt(0)" ::: "memory");
    __syncthreads();
    if (threadIdx.x == 0) {
        unsigned* bar = b.bar;
        __builtin_amdgcn_s_waitcnt(0);
        unsigned nloc = b.st[0], nx = b.st[1];
        if (nloc == 0u) { xcd_barrier_complete(bar, b.x, nloc, nx); b.st[0] = nloc; b.st[1] = nx; }
        const unsigned old = xb_add(&bar[XB_XSUB(b.x)], 1u);
        const unsigned gen = old / nloc;
        if (old + 1u == (gen + 1u) * nloc) {
            __builtin_amdgcn_fence(__ATOMIC_RELEASE, "agent");
            asm volatile("s_waitcnt vmcnt(0)" ::: "memory");
            const unsigned og = xb_add(&bar[XB_TOP], 1u);
            const unsigned tg = og / nx;
            if (og + 1u == (tg + 1u) * nx) xb_add(&bar[XB_TOPGEN], 1u);
            else XB_SPIN(xb_ld(&bar[XB_TOPGEN]) == tg, bar);
            __builtin_amdgcn_fence(__ATOMIC_ACQUIRE, "agent");
            xb_add(&bar[XB_XGEN(b.x)], 1u);
            asm volatile("s_waitcnt vmcnt(0)" ::: "memory");
        } else {
            XB_SPIN(xb_ld(&bar[XB_XGEN(b.x)]) == gen, bar);
            __builtin_amdgcn_fence(__ATOMIC_ACQUIRE, "agent");
            asm volatile("s_waitcnt vmcnt(0)" ::: "memory");
        }
    }
    __syncthreads();
}

__device__ __forceinline__ float wave_sum(float v) { return wave_sum64(v); }
__device__ __forceinline__ void tr_item(const float* W, int ldw, int col0, int nvalid, int k0, const float* gain, int gsplit, const float* gain2, bf16* WT, int ldt, int drow0, LAS float* scr, int lane) {
#pragma unroll 8
    for (int i = 0; i < 32; ++i) { const int kk = 2 * i + (lane >> 5), n = lane & 31, k = k0 + kk;
        float v = (n < nvalid) ? W[(size_t)k * ldw + col0 + n] : 0.f;
        if (gain) v *= (k < gsplit ? gain[k] : gain2[k - gsplit]);
        scr[kk * 33 + n] = v; }
    LDS_WAIT(); asm volatile("" ::: "memory");
    const int c = lane & 7;
#pragma unroll
    for (int j = 0; j < 4; ++j) { const int n = (lane >> 3) + 8 * j; const LAS float* s = scr + (8 * c) * 33 + n;
        v4u o; o.x = pk2(s[0 * 33], s[1 * 33]); o.y = pk2(s[2 * 33], s[3 * 33]); o.z = pk2(s[4 * 33], s[5 * 33]); o.w = pk2(s[6 * 33], s[7 * 33]);
        *(GAS v4u*)(WT + (size_t)(drow0 + n) * ldt + k0 + 8 * c) = o; }
    LDS_WAIT(); asm volatile("" ::: "memory");
}
__device__ __forceinline__ void tr_item64(const float* W, int ldw, int col0, int nvalid, int k0, const float* gain, int gsplit, const float* gain2, bf16* WT, int ldt, int drow0, int lane) {
    float v[64];
    const float* src = W + (size_t)k0 * ldw + col0 + lane; const bool ok = lane < nvalid;
#pragma unroll
    for (int j = 0; j < 64; ++j) v[j] = ok ? src[(size_t)j * ldw] : 0.f;
    if (gain) {
#pragma unroll
        for (int j = 0; j < 64; ++j) { const int k = k0 + j; v[j] *= (k < gsplit ? gain[k] : gain2[k - gsplit]); }
    }
    bf16* dst = WT + (size_t)(drow0 + lane) * ldt + k0;
#pragma unroll
    for (int c = 0; c < 8; ++c) { v4u o; o.x = pk2(v[8 * c], v[8 * c + 1]); o.y = pk2(v[8 * c + 2], v[8 * c + 3]); o.z = pk2(v[8 * c + 4], v[8 * c + 5]); o.w = pk2(v[8 * c + 6], v[8 * c + 7]);
        *(GAS v4u*)(dst + 8 * c) = o; }
}
__device__ __forceinline__ void row_to_bf16(const float* xrow, bf16* orow, float* ssp, int lane) {
    const GAS f32x4* xr = (const GAS f32x4*)xrow + lane;
    f32x4 v[4]; float s = 0.f;
#pragma unroll
    for (int j = 0; j < 4; ++j) { v[j] = xr[64 * j]; s += (v[j].x * v[j].x + v[j].y * v[j].y) + (v[j].z * v[j].z + v[j].w * v[j].w); }
    s = wave_sum(s);
    GAS unsigned long long* o8 = (GAS unsigned long long*)orow + lane;
#pragma unroll
    for (int j = 0; j < 4; ++j) o8[64 * j] = (unsigned long long)pk2(v[j].x, v[j].y) | ((unsigned long long)pk2(v[j].z, v[j].w) << 32);
    if (lane == 0) *ssp = s;
}

struct Args { const float* in[26]; float* out; unsigned char* ws; int ph_lo, ph_hi, li, pad; };

enum { PH_PRO = 0, PH_L0 = 1, PH_PER_LAYER = 9, PH_FINAL = PH_L0 + 2 * PH_PER_LAYER, PH_COUNT = PH_FINAL + 1 };

#define WSP() ({ unsigned char* w_ = args.ws; asm volatile("" : "+s"(w_)); w_; })
#define INP(i) ({ int i_ = (i); asm volatile("" : "+s"(i_)); args.in[i_]; })
#define XPTR() ({ float* x_ = args.out; asm volatile("" : "+s"(x_)); x_; })
#define TID() ({ int w_ = wid_s; asm volatile("" : "+s"(w_)); int t_ = (w_ << 6) | (int)__builtin_amdgcn_mbcnt_hi(~0u, __builtin_amdgcn_mbcnt_lo(~0u, 0u)); asm volatile("" : "+v"(t_)); t_; })

constexpr size_t T1K = (size_t)256 * 1024 * 2, TFF = (size_t)256 * 2816 * 2;
using G_1024 = pg8::Gemm<1024, 1024, 1024>; using G_down = pg8::Gemm<2816, 2816, 2816>; using G_qk = pg8::Gemm<2048, 1024, 256>; using G_vo = pg8::Gemm<1024, 2048, 256>;
using S_up = pg8::SchedT<0, 64, 22, T1K, T1K>; using S_mkv = pg8::SchedT<0, 8, 8, T1K, T1K>; using S_down = pg8::SchedT<0, 64, 4, TFF, TFF>; using S_win = pg8::SchedT<0, 64, 11, T1K, T1K>;
using S_sq = pg8::SchedT<0, 64, 4, T1K, T1K>; using S_xb = pg8::SchedT<1, 64, 4, T1K, T1K, (size_t)1024 * 1024 * 2>; using S_qk = pg8::SchedT<2, 128, 1, 0, 0>; using S_vo = pg8::SchedT<3, 128, 1, 0, 0>;

#ifndef PROBE_MASK
#define PROBE_MASK 0
#endif
#ifndef PROBE_REPS
#define PROBE_REPS 1
#endif
#ifndef PROBE_BARS
#define PROBE_BARS 0
#endif
#define NREP(k) (((PROBE_MASK >> (k)) & 1) ? (PROBE_REPS + 1) : 1)
#define REP_LOOP(k) _Pragma("unroll 1") for (int rep_ = 0; rep_ < NREP(k); ++rep_)
#define SHADOW(k) (NREP(k) > 1 && rep_ + 1 < NREP(k))
#define REP_SEAM(k) do { if (SHADOW(k)) GRIDBAR(); } while (0)
constexpr size_t CTL_DUMMY = 1 * MiB;

__global__ void __launch_bounds__(NWAVES * 64, 2) mega_fwd(Args args) {
    extern __shared__ __attribute__((aligned(16))) unsigned char lds[];
    LAS unsigned char* ldsp = (LAS unsigned char*)lds;
    volatile LAS unsigned* MISC = (volatile LAS unsigned*)(ldsp + MISC_OFF);
    constexpr int G = 256; const int bx = blockIdx.x;
    const int wid_s = __builtin_amdgcn_readfirstlane(threadIdx.x >> 6);
    for (int u = threadIdx.x; u < (LDS_BYTES - LDSCTL_OFF) / 4; u += NWAVES * 64) ((LAS unsigned*)(ldsp + LDSCTL_OFF))[u] = 0u;
    __syncthreads();
    (void)xcd_barrier_post((unsigned*)(args.ws + WS_CTL) + CW_BAR + args.li * XCD_BAR_WORDS, MISC + 8);
#define PHLO() ({ int i_ = 0; asm volatile("" : "+s"(i_)); (&args.ph_lo)[i_]; })
#define PHHI() ({ int i_ = 1; asm volatile("" : "+s"(i_)); (&args.ph_lo)[i_]; })
#define PHLI() ({ int i_ = 2; asm volatile("" : "+s"(i_)); (&args.ph_lo)[i_]; })
#define IN(k) (PHLO() <= (k) && (k) < PHHI())
#define GRIDBAR() do { XcdBarrier bar_; bar_.bar = (unsigned*)(WSP() + WS_CTL) + CW_BAR + PHLI() * XCD_BAR_WORDS; bar_.x = xb_xcc_id(); bar_.st = MISC + 8; xcd_barrier(bar_); } while (0)
#define SEAM(k) do { if (IN(k) && IN((k) + 1)) { XcdBarrier bar_; bar_.bar = (unsigned*)(WSP() + WS_CTL) + CW_BAR + PHLI() * XCD_BAR_WORDS; bar_.x = xb_xcc_id(); bar_.st = MISC + 8; xcd_barrier(bar_); } } while (0)
    constexpr float QSCALE = 0.125f * 1.4426950408889634f, XSCALE = 0.0625f * 1.4426950408889634f;

    if (IN(PH_PRO)) REP_LOOP(9) {
        unsigned char* ws = WSP(); const int tid = TID();
        const int lane = tid & 63, wave = __builtin_amdgcn_readfirstlane(tid >> 6);
        const int gw = bx * NWAVES + wave, NGW = G * NWAVES;
        for (int l = 0; l < NLAYER; ++l) {
            unsigned char* wl = ws + WS_W + (size_t)l * W_LAYER;
            for (int f = 0; f < 2; ++f) {
                const float* wg = INP(f ? 22 : 3) + (size_t)l * DM * DFF; const float* wu = INP(f ? 23 : 4) + (size_t)l * DM * DFF; const float* wd = INP(f ? 24 : 5) + (size_t)l * DFF * DM;
                const float* gn = INP(f ? 21 : 2) + l * DM;
                bf16* WA = (bf16*)(wl + (f ? WO_2A : WO_1A)); bf16* WB = (bf16*)(wl + (f ? WO_2B : WO_1B));
                for (int it = gw; it < 2 * 16 * 44; it += NGW) { const int which = it / (16 * 44), r = it % (16 * 44), kb = r / 44, nb = r % 44; const int j0 = nb * 64;
                    tr_item64(which ? wu : wg, DFF, j0, 64, kb * 64, gn, 1 << 30, gn, WA, DM, 256 * (j0 / 128) + which * 128 + (j0 % 128), lane); }
                for (int it = gw; it < 44 * 16; it += NGW) { const int kb = it / 16, nb = it % 16;
                    tr_item64(wd, DM, nb * 64, 64, kb * 64, nullptr, 0, wd, WB, DFF, nb * 64, lane); }
            }
            { const float* w = INP(7) + (size_t)l * DM * 2568; const float* gn = INP(6) + l * DM; bf16* WI = (bf16*)(wl + WO_IN);
              for (int it = gw; it < 16 * 41; it += NGW) { const int kb = it / 41, nb = it % 41; int col0, nvalid = 64, drow0;
                  if (nb < 24) { col0 = nb * 64; drow0 = col0; }
                  else if (nb == 24) { col0 = 1536; nvalid = 8; drow0 = 2560; }
                  else if (nb < 33) { const int ch = (nb - 25) * 64; col0 = 1544 + ch; drow0 = 1536 + 256 * (ch / 128) + (ch % 128); }
                  else { const int ch = (nb - 33) * 64; col0 = 2056 + ch; drow0 = 1536 + 256 * (ch / 128) + 128 + (ch % 128); }
                  tr_item64(w, 2568, col0, nvalid, kb * 64, gn, 1 << 30, gn, WI, DM, drow0, lane); } }
            { const float* w = INP(15) + (size_t)l * DM * DM; const float* g1 = INP(13) + l * 512; const float* g2 = INP(14) + l * 512;
              for (int it = gw; it < 16 * 16; it += NGW) { const int kb = it / 16, nb = it % 16;
                  tr_item64(w, DM, nb * 64, 64, kb * 64, g1, 512, g2, (bf16*)(wl + WO_OUT), DM, nb * 64, lane); } }
            { const float* w = INP(19) + (size_t)l * DM * 2048; const float* gn = INP(17) + l * DM;
              for (int it = gw; it < 16 * 32; it += NGW) { const int kb = it / 32, nb = it % 32;
                  tr_item64(w, 2048, nb * 64, 64, kb * 64, gn, 1 << 30, gn, (bf16*)(wl + WO_XKV), DM, nb * 64, lane); } }
            { const float* w = INP(20) + (size_t)l * DM * DM;
              for (int it = gw; it < 16 * 16; it += NGW) { const int kb = it / 16, nb = it % 16;
                  tr_item64(w, DM, nb * 64, 64, kb * 64, nullptr, 0, w, (bf16*)(wl + WO_XO), DM, nb * 64, lane); } }
            { const float* w = INP(18) + (size_t)l * DM * DM; const float* gn = INP(16) + l * DM; bf16* WQ = (bf16*)(wl + WO_XQ);
              for (int r = gw; r < DM; r += NGW) { const float g = gn[r] * XSCALE; const GAS f32x4* xr = (const GAS f32x4*)(w + (size_t)r * DM) + lane; GAS unsigned long long* o8 = (GAS unsigned long long*)(WQ + (size_t)r * DM) + lane;
#pragma unroll
                  for (int j = 0; j < 4; ++j) { const f32x4 v = xr[64 * j] * g; o8[64 * j] = (unsigned long long)pk2(v.x, v.y) | ((unsigned long long)pk2(v.z, v.w) << 32); } } }
        }
        { const float* xin = INP(0); bf16* XB = (bf16*)(ws + WS_XB); float* ssb = (float*)(ws + CTL_SS);
          for (int m = gw; m < M; m += NGW) row_to_bf16(xin + (size_t)m * DM, XB + (size_t)m * DM, ssb + m, lane); }
        { const float* mem = INP(1); bf16* MEMB = (bf16*)(ws + WS_MEMB); float* ssm = (float*)(ws + CTL_SSM);
          for (int m = gw; m < NMEMROWS; m += NGW) row_to_bf16(mem + (size_t)m * DM, MEMB + (size_t)m * DM, ssm + m, lane); }
        REP_SEAM(9);
    }
    SEAM(PH_PRO);

#pragma unroll 1
    for (int l = 0; l < NLAYER; ++l) {
        const int P = PH_L0 + l * PH_PER_LAYER;
#pragma unroll 1
        for (int f = 0; f < 2; ++f) {
            const int pu = P + (f ? 7 : 0), pd = pu + 1;
            if (IN(pu)) REP_LOOP(0) {
                unsigned char* ws = WSP(); unsigned char* wl = ws + WS_W + (size_t)l * W_LAYER;
                G_1024 g; S_up S; S.init(bx, ws + WS_XB, wl + (f ? WO_2A : WO_1A));
                pg8::EpiSwiGLU E{(bf16*)(ws + WS_R1 + R1_H), (float*)(ws + CTL_SS) + (size_t)(4 * l + (f ? 3 : 0)) * M};
                pg8::gemm_phase<pg8::EpiSwiGLU, decltype(S), decltype(g)>(ldsp + RING_OFF, g, S, E, TID());
                if (l == 0 && f == 0) {
#pragma unroll 1
                    for (int l2 = 0; l2 < NLAYER; ++l2) {
                        unsigned char* ws2 = WSP();
                        S_mkv S2; S2.init((bx + 128 - 64 * l2) % G, ws2 + WS_MEMB, ws2 + WS_W + (size_t)l2 * W_LAYER + WO_XKV);
                        pg8::EpiRowScale E2{(bf16*)(ws2 + WS_MKV) + (size_t)l2 * 2048 * 2048, (float*)(ws2 + CTL_SSM), 1.0f};
                        pg8::gemm_phase<pg8::EpiRowScale, decltype(S2), decltype(g)>(ldsp + RING_OFF, g, S2, E2, TID());
                    }
                }
                REP_SEAM(0);
            }
            SEAM(pu);
            if (IN(pd)) REP_LOOP(1) {
                unsigned char* ws = WSP(); unsigned char* wl = ws + WS_W + (size_t)l * W_LAYER; float* X = XPTR();
                G_down g; S_down S; S.init(bx, ws + WS_R1 + R1_H, wl + (f ? WO_2B : WO_1B));
                pg8::EpiResid<0> E{(l == 0 && f == 0) ? INP(0) : X, X, (bf16*)(ws + WS_XB), SHADOW(1) ? (float*)(ws + CTL_DUMMY) : (float*)(ws + CTL_SS) + (size_t)(4 * l + (f ? 4 : 1)) * M, nullptr, SHADOW(1) ? 0.f : 0.5f};
                pg8::gemm_phase<pg8::EpiResid<0>, decltype(S), decltype(g)>(ldsp + RING_OFF, g, S, E, TID());
                REP_SEAM(1);
            }
            SEAM(pd);
            if (f == 1) break;
            if (IN(P + 2)) REP_LOOP(2) {
                unsigned char* ws = WSP(); unsigned char* wl = ws + WS_W + (size_t)l * W_LAYER; unsigned char* R1 = ws + WS_R1;
                G_1024 g; S_win S; S.init(bx, ws + WS_XB, wl + WO_IN);
                pg8::EpiWin E{(bf16*)(R1 + R1_Y), (bf16*)(R1 + R1_KB), (bf16*)(R1 + R1_VB), (bf16*)(R1 + R1_UB), (float*)(R1 + R1_LOGF), (float*)(ws + CTL_SS) + (size_t)(4 * l + 1) * M, INP(8) + l * 8, QSCALE};
                pg8::gemm_phase<pg8::EpiWin, decltype(S), decltype(g)>(ldsp + RING_OFF, g, S, E, TID());
                REP_SEAM(2);
            }
            SEAM(P + 2);
            if (IN(P + 3)) REP_LOOP(3) {
                unsigned char* ws = WSP(); unsigned char* R1 = ws + WS_R1;
                char* shm = (char*)lds + RING_OFF;
                const int vcu = (G % 8 == 0) ? (bx % 8) * (G / 8) + bx / 8 : bx;
                const int bh = vcu >> 2, s4 = vcu & 3;
                attn_body::bf16* YB = (attn_body::bf16*)(R1 + R1_Y); const attn_body::bf16* KB = (const attn_body::bf16*)(R1 + R1_KB); const attn_body::bf16* VB = (const attn_body::bf16*)(R1 + R1_VB);
                float* ssa = SHADOW(3) ? (float*)(ws + CTL_DUMMY) : (float*)(ws + CTL_SSA) + (size_t)l * M;
                attn_body::bf16* OB = SHADOW(3) ? YB + 512 : YB;
                attn_body::scan_bias((const float*)(R1 + R1_LOGF), bh, shm, TID());
#pragma unroll 1
                for (int iu = 0; iu < 2; ++iu) attn_body::attn_unit<8>(bh >> 3, bh & 7, iu ? 7 - s4 : s4, YB, KB, VB, OB, ssa, shm, TID());
                __syncthreads();
                attn_body::conv_unit(bx, (const attn_body::bf16*)(R1 + R1_UB), INP(9) + (size_t)l * 31 * 512, INP(10) + l * 512, INP(11) + l * 512, INP(12) + l * 512, YB, shm, TID());
                REP_SEAM(3);
            }
            SEAM(P + 3);
            if (IN(P + 4)) REP_LOOP(4) {
                { unsigned char* ws = WSP(); unsigned char* wl = ws + WS_W + (size_t)l * W_LAYER; float* X = XPTR();
                  G_1024 g; S_sq S; S.init(bx, ws + WS_R1 + R1_Y, wl + WO_OUT);
                  pg8::EpiResid<8> E{X, X, (bf16*)(ws + WS_XB), SHADOW(4) ? (float*)(ws + CTL_DUMMY) : (float*)(ws + CTL_SS) + (size_t)(4 * l + 2) * M, (float*)(ws + CTL_SSA) + (size_t)l * M, SHADOW(4) ? 0.f : 1.0f};
                  pg8::gemm_phase<pg8::EpiResid<8>, decltype(S), decltype(g)>(ldsp + RING_OFF, g, S, E, TID()); }
                { unsigned char* ws = WSP(); unsigned char* wl = ws + WS_W + (size_t)l * W_LAYER;
                  G_qk g; S_qk S; S.init(bx, (bf16*)(ws + WS_MKV) + (size_t)l * 2048 * 2048, wl + WO_XQ);
                  pg8::EpiAux E{(bf16*)(ws + WS_R1 + R1_WQK), 1.0f};
                  pg8::gemm_phase<pg8::EpiAux, decltype(S), decltype(g)>(ldsp + RING_OFF, g, S, E, TID()); }
                { unsigned char* ws = WSP(); unsigned char* wl = ws + WS_W + (size_t)l * W_LAYER;
                  G_vo g; S_vo S; S.init((bx + 128) % G, wl + WO_XO, (bf16*)(ws + WS_MKV) + (size_t)l * 2048 * 2048);
                  pg8::EpiAux E{(bf16*)(ws + WS_R1 + R1_WVO), 1.0f};
                  pg8::gemm_phase<pg8::EpiAux, decltype(S), decltype(g)>(ldsp + RING_OFF, g, S, E, TID()); }
                REP_SEAM(4);
            }
            SEAM(P + 4);
            if (IN(P + 5)) REP_LOOP(5) {
                unsigned char* ws = WSP();
                G_1024 g; S_xb S; S.init(bx, ws + WS_XB, ws + WS_R1 + R1_WQK);
                pg8::EpiSoftmax E{(bf16*)(ws + WS_R1 + R1_XP), (float*)(ws + CTL_SS) + (size_t)(4 * l + 2) * M, (LAS float*)(ldsp + EPI_SCR_OFF)};
                pg8::gemm_phase<pg8::EpiSoftmax, decltype(S), decltype(g)>(ldsp + RING_OFF, g, S, E, TID());
                REP_SEAM(5);
            }
            SEAM(P + 5);
            if (IN(P + 6)) REP_LOOP(6) {
                unsigned char* ws = WSP(); float* X = XPTR();
                G_1024 g; S_xb S; S.init(bx, ws + WS_R1 + R1_XP, ws + WS_R1 + R1_WVO);
                pg8::EpiResid<0> E{X, X, (bf16*)(ws + WS_XB), SHADOW(6) ? (float*)(ws + CTL_DUMMY) : (float*)(ws + CTL_SS) + (size_t)(4 * l + 3) * M, nullptr, SHADOW(6) ? 0.f : 1.0f};
                pg8::gemm_phase<pg8::EpiResid<0>, decltype(S), decltype(g)>(ldsp + RING_OFF, g, S, E, TID());
                REP_SEAM(6);
            }
            SEAM(P + 6);
        }
    }
    for (int eb_ = 0; eb_ < PROBE_BARS; ++eb_) GRIDBAR();
    if (IN(PH_FINAL)) {
        unsigned char* ws = WSP(); float* X = XPTR(); const int tid = TID();
        const int lane = tid & 63, wave = __builtin_amdgcn_readfirstlane(tid >> 6);
        const int gw = bx * NWAVES + wave, NGW = G * NWAVES; const float* ssf = (float*)(ws + CTL_SS) + (size_t)8 * M; const float* gn = INP(25);
        f32x4 gv[4];
#pragma unroll
        for (int j = 0; j < 4; ++j) gv[j] = *((const GAS f32x4*)gn + lane + 64 * j);
        for (int m = gw; m < M; m += NGW) { GAS f32x4* xr = (GAS f32x4*)(X + (size_t)m * DM) + lane; const float rs = __builtin_amdgcn_rsqf(ssf[m] * (1.0f / 1024.0f) + 1e-6f);
#pragma unroll
            for (int j = 0; j < 4; ++j) xr[64 * j] = xr[64 * j] * rs * gv[j]; }
    }
#undef IN
#undef SEAM
}

static int g_grid = 0;
static bool mega_setup() {
    if (g_grid) return g_grid > 0;
    int dev = 0, cus = 0, per_cu = 0;
    if (hipGetDevice(&dev) != hipSuccess || hipDeviceGetAttribute(&cus, hipDeviceAttributeMultiprocessorCount, dev) != hipSuccess) { g_grid = -1; return false; }
    if (hipFuncSetAttribute((const void*)mega_fwd, hipFuncAttributeMaxDynamicSharedMemorySize, LDS_BYTES) != hipSuccess) { fprintf(stderr, "hipFuncSetAttribute failed\n"); g_grid = -1; return false; }
    if (hipOccupancyMaxActiveBlocksPerMultiprocessor(&per_cu, (const void*)mega_fwd, NWAVES * 64, LDS_BYTES) != hipSuccess || per_cu < 1) { fprintf(stderr, "occupancy query: %d blocks per CU\n", per_cu); (void)hipGetLastError(); g_grid = -1; return false; }
    g_grid = cus;
    if (g_grid != 256) { fprintf(stderr, "kernel_launch: %d CUs; the phase program is laid out for exactly 256: nothing launched\n", g_grid); g_grid = -1; return false; }
    return true;
}
static void mega_launch(void* const* d_in, void* d_out, void* d_ws, hipStream_t stream, int lo, int hi, int li) {
    Args a{};
    for (int i = 0; i < 26; ++i) a.in[i] = (const float*)d_in[i];
    a.out = (float*)d_out; a.ws = (unsigned char*)d_ws; a.ph_lo = lo; a.ph_hi = hi; a.li = li;
    hipLaunchKernelGGL(mega_fwd, dim3(g_grid), dim3(NWAVES * 64), LDS_BYTES, stream, a);
}
extern "C" void kernel_launch(void* const* d_in, const int* in_sizes, int n_in, void* d_out, int out_size, void* d_ws, size_t ws_size, hipStream_t stream) {
    if (!mega_setup()) return;
    if (ws_size < WS_END) { fprintf(stderr, "kernel_launch: workspace too small (%zu < %zu)\n", ws_size, (size_t)WS_END); return; }
    (void)hipMemsetAsync((char*)d_ws + WS_CTL, 0, CTL_ZERO_BYTES, stream);
    mega_launch(d_in, d_out, d_ws, stream, 0, PH_COUNT, 0);
}
```

```cpp
#include <hip/hip_runtime.h>
#include <cstdio>
#include <cstdint>
template <int X> __device__ __forceinline__ float swz_xor(float v) { return __int_as_float(__builtin_amdgcn_ds_swizzle(__float_as_int(v), (X << 10) | 0x1f)); }
__device__ __forceinline__ float sum_x32(float v) { auto rr = __builtin_amdgcn_permlane32_swap(__float_as_uint(v), __float_as_uint(v), false, false); return __uint_as_float(rr[0]) + __uint_as_float(rr[1]); }
__device__ __forceinline__ float max_x32(float v) { auto rr = __builtin_amdgcn_permlane32_swap(__float_as_uint(v), __float_as_uint(v), false, false); return fmaxf(__uint_as_float(rr[0]), __uint_as_float(rr[1])); }
__device__ __forceinline__ float wave_sum64(float v) { v += swz_xor<1>(v); v += swz_xor<2>(v); v += swz_xor<4>(v); v += swz_xor<8>(v); v += swz_xor<16>(v); return sum_x32(v); }
namespace pg8 {
#define PG8_LAS __attribute__((address_space(3)))
typedef unsigned short bf16_t;
typedef short bf16x8 __attribute__((ext_vector_type(8)));
typedef float f32x4 __attribute__((ext_vector_type(4)));
typedef float f32x2 __attribute__((ext_vector_type(2)));
typedef unsigned u32x4 __attribute__((ext_vector_type(4)));
constexpr int BM = 256, BK = 64, HALF = 128, HTB = HALF * BK * 2  , STAGE_BYTES = 8 * HTB, NXCD = 8, WGM = 8;

__host__ __device__ __forceinline__ int lds_byte(int r, int c) { const int st = (r >> 4) * 2 + (c >> 5), rr = r & 15, cc = c & 31, ob = rr * 64 + cc * 2; return st * 1024 + (ob ^ (((ob >> 9) & 1) << 5)); }
__host__ __device__ __forceinline__ void stage_rc(int b, int& R, int& C) { const int st = b / 1024, sb = b % 1024, swz = sb ^ (((sb >> 9) & 1) << 5); R = (st >> 1) * 16 + swz / 64; C = (st & 1) * 32 + (swz % 64) / 2; }
__host__ __device__ __forceinline__ int perm32(int rho) { const int n = rho >> 4, i = rho & 15; return 8 * (i >> 2) + 4 * n + (i & 3); }

struct Unit { int pm, pn; const char* a; const char* b; int aux; };
template <int LDA, int LDB, int K_> struct Gemm { static constexpr int lda = LDA, ldb = LDB, K = K_; };

__device__ __forceinline__ unsigned cvt_pk_bf16(float lo, float hi) { unsigned r; asm volatile("v_cvt_pk_bf16_f32 %0, %1, %2" : "=v"(r) : "v"(lo), "v"(hi)); return r; }


template <class Epi, class Sched, class Gemm, bool ALIGN_EPI = true, bool SP2 = true>
__device__ __forceinline__ void gemm_phase(PG8_LAS unsigned char* lds, const Gemm g, const Sched& S, const Epi& E, const int tid) {
    const int wid = __builtin_amdgcn_readfirstlane(tid >> 6), lane = tid & 63, wr = wid >> 2, wc = wid & 3, fr = lane & 15, fq = lane >> 4;
    constexpr int K = Gemm::K, nt = K / BK;
    unsigned voffA[2], voffB[2];
#pragma unroll
    for (int i = 0; i < 2; ++i) { int R, C; stage_rc(tid * 16 + i * 8192, R, C); const int Rb = Epi::PERM ? ((R & ~31) + perm32(R & 31)) : R;
        voffA[i] = (unsigned)(R * Gemm::lda + C) * 2u; voffB[i] = (unsigned)(Rb * Gemm::ldb + C) * 2u; }
    constexpr size_t kstep = (size_t)(BK * 2);
    constexpr size_t hstepA = (size_t)HALF * Gemm::lda * 2, hstepB = (size_t)HALF * Gemm::ldb * 2;
    const unsigned ldsw = (unsigned)wid * 1024u;
    const int aoff = lds_byte(wr * 64 + fr, fq * 8), boff = lds_byte(wc * 32 + fr, fq * 8);
#define PG8_SA(b, h) (((b) * 2 + (h)) * HTB)
#define PG8_SB(b, h) ((4 + (b) * 2 + (h)) * HTB)
#define PG8_STAGE(bufoff, gbase, voff) do { _Pragma("unroll") for (int _i = 0; _i < 2; ++_i) \
        __builtin_amdgcn_global_load_lds((const unsigned*)((const char*)(gbase) + (voff)[_i]), (PG8_LAS unsigned*)(lds + (bufoff) + ldsw + _i * 8192), 16, 0, 0); } while (0)
#define PG8_LDA(dst, b, h) do { _Pragma("unroll") for (int m = 0; m < 4; ++m) _Pragma("unroll") for (int k = 0; k < 2; ++k) dst[m][k] = *(const PG8_LAS bf16x8*)(lds + PG8_SA(b, h) + aoff + m * 2048 + k * 1024); } while (0)
#define PG8_LDB(dst, b, h) do { _Pragma("unroll") for (int n = 0; n < 2; ++n) _Pragma("unroll") for (int k = 0; k < 2; ++k) dst[n][k] = *(const PG8_LAS bf16x8*)(lds + PG8_SB(b, h) + boff + n * 2048 + k * 1024); } while (0)
#define PG8_MMA(ai, bj, At, Bt) do { __builtin_amdgcn_s_setprio(1); _Pragma("unroll") for (int m = 0; m < 4; ++m) _Pragma("unroll") for (int n = 0; n < 2; ++n) _Pragma("unroll") for (int k = 0; k < 2; ++k) \
        acc[ai][bj][m][n] = __builtin_amdgcn_mfma_f32_16x16x32_bf16(Bt[n][k], At[m][k], acc[ai][bj][m][n], 0, 0, 0); __builtin_amdgcn_s_setprio(0); } while (0)
#define PG8_WAIT_V(n) asm volatile("s_waitcnt vmcnt(" #n ")" ::: "memory")
#define PG8_WAIT_L(n) asm volatile("s_waitcnt lgkmcnt(" #n ")" ::: "memory")
#define PG8_BAR __builtin_amdgcn_s_barrier()
#define PG8_SCHED __builtin_amdgcn_sched_barrier(0)
    Unit cur, nxt; int ui = 0;
    if (!S.next(0, cur)) return;
    f32x4 acc[2][2][4][2];
#pragma unroll
    for (int a = 0; a < 2; ++a)
#pragma unroll
        for (int b = 0; b < 2; ++b)
#pragma unroll
            for (int m = 0; m < 4; ++m)
#pragma unroll
                for (int n = 0; n < 2; ++n) acc[a][b][m][n] = (f32x4){0.f, 0.f, 0.f, 0.f};
    bf16x8 At[4][2], B0[2][2], B1[2][2];
    const char* cA = cur.a; const char* cB = cur.b;
    if constexpr (SP2) {
        PG8_STAGE(PG8_SB(0, 0), cB, voffB); PG8_STAGE(PG8_SB(0, 1), cB + hstepB, voffB); PG8_STAGE(PG8_SA(0, 0), cA, voffA); PG8_STAGE(PG8_SA(0, 1), cA + hstepA, voffA);
        if (wr == 1) PG8_BAR;
        PG8_WAIT_V(2); PG8_BAR;
        PG8_STAGE(PG8_SB(1, 0), cB + kstep, voffB); PG8_STAGE(PG8_SA(1, 0), cA + kstep, voffA); PG8_STAGE(PG8_SB(1, 1), cB + hstepB + kstep, voffB);
        PG8_WAIT_V(6); PG8_BAR;
    } else {
        PG8_STAGE(PG8_SB(0, 0), cB, voffB); PG8_STAGE(PG8_SA(0, 0), cA, voffA); PG8_STAGE(PG8_SB(0, 1), cB + hstepB, voffB); PG8_STAGE(PG8_SA(0, 1), cA + hstepA, voffA);
        if (wr == 1) PG8_BAR;
        PG8_WAIT_V(4); PG8_BAR;
        PG8_STAGE(PG8_SB(1, 0), cB + kstep, voffB); PG8_STAGE(PG8_SA(1, 0), cA + kstep, voffA); PG8_STAGE(PG8_SB(1, 1), cB + hstepB + kstep, voffB);
        PG8_WAIT_V(6); PG8_BAR;
    }
    for (;;) {
        const bool has_next = S.next(ui + 1, nxt);
        const char* nA = has_next ? nxt.a : cA; const char* nB = has_next ? nxt.b : cB;
#pragma unroll 1
        for (int t = 0; t < nt; t += 2) {
            const bool last = (t == nt - 2);
            const char* a1 = cA + (size_t)(t + 1) * kstep;
            const char* a2 = last ? nA : cA + (size_t)(t + 2) * kstep; const char* b2 = last ? nB : cB + (size_t)(t + 2) * kstep;
            const char* a3 = a2 + kstep; const char* b3 = b2 + kstep;
            if constexpr (Epi::MIDK > 0) { if (t == Epi::MIDK) E.midk(acc, cur, wr, wc, fr, fq); }
            if constexpr (SP2) {
            PG8_LDB(B0, 0, 0); PG8_LDB(B1, 0, 1); PG8_SCHED; PG8_LDA(At, 0, 0); PG8_STAGE(PG8_SA(1, 1), a1 + hstepA, voffA);
            PG8_WAIT_V(8); PG8_WAIT_L(0); PG8_BAR; PG8_MMA(0, 0, At, B0); PG8_MMA(0, 1, At, B1); PG8_BAR; PG8_SCHED;
            PG8_LDA(At, 0, 1); PG8_STAGE(PG8_SB(0, 0), b2, voffB); PG8_STAGE(PG8_SB(0, 1), b2 + hstepB, voffB); PG8_STAGE(PG8_SA(0, 0), a2, voffA);
            PG8_WAIT_V(8); PG8_WAIT_L(0); PG8_BAR; PG8_MMA(1, 0, At, B0); PG8_MMA(1, 1, At, B1); PG8_BAR; PG8_SCHED;
            PG8_LDB(B0, 1, 0); PG8_LDB(B1, 1, 1); PG8_SCHED; PG8_LDA(At, 1, 0); PG8_STAGE(PG8_SA(0, 1), a2 + hstepA, voffA);
            PG8_WAIT_V(8); PG8_WAIT_L(0); PG8_BAR; PG8_MMA(0, 0, At, B0); PG8_MMA(0, 1, At, B1); PG8_BAR; PG8_SCHED;
            PG8_LDA(At, 1, 1); PG8_STAGE(PG8_SB(1, 0), b3, voffB); PG8_STAGE(PG8_SB(1, 1), b3 + hstepB, voffB); PG8_STAGE(PG8_SA(1, 0), a3, voffA);
            PG8_WAIT_V(8); PG8_WAIT_L(0); PG8_BAR; PG8_MMA(1, 0, At, B0); PG8_MMA(1, 1, At, B1); PG8_BAR; PG8_SCHED;
            } else {
            PG8_LDB(B0, 0, 0); PG8_SCHED; PG8_LDA(At, 0, 0); PG8_STAGE(PG8_SA(1, 1), a1 + hstepA, voffA);
            PG8_WAIT_L(8); PG8_BAR; PG8_WAIT_L(0); PG8_MMA(0, 0, At, B0); PG8_BAR; PG8_SCHED;
            PG8_LDB(B1, 0, 1); PG8_STAGE(PG8_SB(0, 0), b2, voffB);
            PG8_BAR; PG8_WAIT_L(0); PG8_MMA(0, 1, At, B1); PG8_BAR;
            PG8_LDA(At, 0, 1); PG8_STAGE(PG8_SA(0, 0), a2, voffA);
            PG8_BAR; PG8_WAIT_L(0); PG8_MMA(1, 0, At, B0); PG8_BAR; PG8_SCHED;
            PG8_STAGE(PG8_SB(0, 1), b2 + hstepB, voffB);
            PG8_WAIT_V(6); PG8_BAR; PG8_MMA(1, 1, At, B1); PG8_BAR;
            PG8_LDB(B0, 1, 0); PG8_SCHED; PG8_LDA(At, 1, 0); PG8_STAGE(PG8_SA(0, 1), a2 + hstepA, voffA);
            PG8_WAIT_L(8); PG8_BAR; PG8_WAIT_L(0); PG8_MMA(0, 0, At, B0); PG8_BAR; PG8_SCHED;
            PG8_LDB(B1, 1, 1); PG8_STAGE(PG8_SB(1, 0), b3, voffB);
            PG8_BAR; PG8_WAIT_L(0); PG8_MMA(0, 1, At, B1); PG8_BAR;
            PG8_LDA(At, 1, 1); PG8_STAGE(PG8_SA(1, 0), a3, voffA);
            PG8_BAR; PG8_WAIT_L(0); PG8_MMA(1, 0, At, B0); PG8_BAR; PG8_SCHED;
            PG8_STAGE(PG8_SB(1, 1), b3 + hstepB, voffB);
            PG8_WAIT_V(6); PG8_BAR; PG8_MMA(1, 1, At, B1); PG8_BAR;
            }
        }
        if constexpr (ALIGN_EPI) { if (wr == 0) PG8_BAR; }
        E(acc, cur, wr, wc, fr, fq);
        if (!has_next) break;
#pragma unroll
        for (int a = 0; a < 2; ++a)
#pragma unroll
            for (int b = 0; b < 2; ++b)
#pragma unroll
                for (int m = 0; m < 4; ++m)
#pragma unroll
                    for (int n = 0; n < 2; ++n) acc[a][b][m][n] = (f32x4){0.f, 0.f, 0.f, 0.f};
        cur = nxt; cA = nA; cB = nB; ++ui;
        if constexpr (ALIGN_EPI) { if (wr == 1) PG8_BAR; }
    }
    PG8_WAIT_V(0);
    if constexpr (!ALIGN_EPI) { if (wr == 0) PG8_BAR; }
    PG8_BAR;
#undef PG8_SA
#undef PG8_SB
#undef PG8_STAGE
#undef PG8_LDA
#undef PG8_LDB
#undef PG8_MMA
#undef PG8_WAIT_V
#undef PG8_WAIT_L
#undef PG8_BAR
#undef PG8_SCHED
}
}
namespace pg8 {
constexpr float LOG2E = 1.4426950408889634f;
constexpr float RMS_EPS = 1e-6f;

template <int kind, int nM, int nN, size_t sA, size_t sB, size_t batchB = 0>
struct SchedT {
    static constexpr int nwg = nM * nN, G = 256;
    int c; const char* A; const char* B;
    __device__ __forceinline__ void init(int c_, const void* A_, const void* B_) { c = c_; A = (const char*)A_; B = (const char*)B_; }
    __device__ __forceinline__ bool next(int i, Unit& u) const {
        const int L = i * G + c; if (L >= nwg) return false;
        if constexpr (kind <= 1) {
            int wgid = L; { constexpr int q = nwg / NXCD, r = nwg % NXCD; const int xcd = wgid % NXCD, off = wgid / NXCD; wgid = (xcd < r ? xcd * (q + 1) : r * (q + 1) + (xcd - r) * q) + off; }
            constexpr int nig = WGM * nN; const int gid = wgid / nig, fm = gid * WGM, gsz = (nM - fm) < WGM ? (nM - fm) : WGM;
            u.pm = fm + ((wgid % nig) % gsz); u.pn = (wgid % nig) / gsz;
            u.a = A + (size_t)u.pm * sA; u.b = B + (size_t)u.pn * sB + (kind == 1 ? (size_t)(u.pm >> 3) * batchB : (size_t)0); u.aux = 0;
        } else if constexpr (kind == 2) {
            const int b_ = L >> 4, h = (L >> 2) & 3, t4 = L & 3;
            u.pm = b_ * 4 + h; u.pn = t4;
            u.a = A + ((size_t)b_ * 256 * 2048 + (size_t)h * 256) * 2; u.b = B + ((size_t)t4 * 256 * 1024 + (size_t)h * 256) * 2;
            u.aux = b_ * 1048576 + (h * 256) * 1024 + t4 * 256;
        } else {
            const int b_ = L >> 4, h = (L >> 2) & 3, t4 = L & 3;
            u.pm = t4; u.pn = b_ * 4 + h;
            u.a = A + ((size_t)t4 * 256 * 1024 + (size_t)h * 256) * 2; u.b = B + ((size_t)b_ * 256 * 2048 + 1024 + (size_t)h * 256) * 2;
            u.aux = b_ * 1048576 + (t4 * 256) * 1024 + h * 256;
        }
        return true;
    }
};

__device__ __forceinline__ void store8(bf16_t* p, const f32x4 v0, const f32x4 v1) {
    u32x4 w; w.x = cvt_pk_bf16(v0[0], v0[1]); w.y = cvt_pk_bf16(v0[2], v0[3]); w.z = cvt_pk_bf16(v1[0], v1[1]); w.w = cvt_pk_bf16(v1[2], v1[3]); *(u32x4*)p = w;
}
__device__ __forceinline__ float sigmoidf_fast(float z) { return __builtin_amdgcn_rcpf(1.0f + __builtin_amdgcn_exp2f(-z * LOG2E)); }
__device__ __forceinline__ f32x4 sig4(f32x4 z) { f32x4 r; r[0] = sigmoidf_fast(z[0]); r[1] = sigmoidf_fast(z[1]); r[2] = sigmoidf_fast(z[2]); r[3] = sigmoidf_fast(z[3]); return r; }

struct EpiSwiGLU {
    static constexpr bool PERM = true; static constexpr int MIDK = 0;
    bf16_t* H; const float* ss; static constexpr int ldh = 2816;
    __device__ __forceinline__ void midk(f32x4 (&)[2][2][4][2], const Unit&, int, int, int, int) const {}
    __device__ __forceinline__ void operator()(f32x4 (&acc)[2][2][4][2], const Unit& u, int wr, int wc, int fr, int fq) const {
        const int row0 = u.pm * BM + wr * 64 + fr, col0 = u.pn * HALF + wc * 32 + 8 * fq;
#pragma unroll
        for (int ai = 0; ai < 2; ++ai)
#pragma unroll
            for (int m = 0; m < 4; ++m) {
                const int row = row0 + ai * HALF + m * 16;
                const float rs = __builtin_amdgcn_rsqf(ss[row] * (1.0f / 1024.0f) + RMS_EPS);
                const f32x4 g0 = acc[ai][0][m][0] * rs, g1 = acc[ai][0][m][1] * rs, u0 = acc[ai][1][m][0] * rs, u1 = acc[ai][1][m][1] * rs;
                store8(H + (size_t)row * ldh + col0, g0 * sig4(g0) * u0, g1 * sig4(g1) * u1);
            }
    }
};

template <int MIDK_>
struct EpiResid {
    static constexpr bool PERM = true; static constexpr int MIDK = MIDK_;
    const float* xin; float* xout; bf16_t* xb; float* ssn; const float* ssa; float alpha;
    __device__ __forceinline__ void midk(f32x4 (&acc)[2][2][4][2], const Unit& u, int wr, int wc, int fr, int fq) const {
        const int row0 = u.pm * BM + wr * 64 + fr;
#pragma unroll
        for (int ai = 0; ai < 2; ++ai)
#pragma unroll
            for (int m = 0; m < 4; ++m) {
                const float rs = __builtin_amdgcn_rsqf(ssa[row0 + ai * HALF + m * 16] * (1.0f / 512.0f) + RMS_EPS);
#pragma unroll
                for (int bj = 0; bj < 2; ++bj)
#pragma unroll
                    for (int n = 0; n < 2; ++n) acc[ai][bj][m][n] *= rs;
            }
    }
    __device__ __forceinline__ void operator()(f32x4 (&acc)[2][2][4][2], const Unit& u, int wr, int wc, int fr, int fq) const {
        const int row0 = u.pm * BM + wr * 64 + fr, col0 = u.pn * BM + wc * 32 + 8 * fq;
#pragma unroll
        for (int ai = 0; ai < 2; ++ai)
#pragma unroll
            for (int m = 0; m < 4; ++m) {
                const int row = row0 + ai * HALF + m * 16; float q = 0.f;
#pragma unroll
                for (int bj = 0; bj < 2; ++bj) {
                    const size_t off = (size_t)row * 1024 + col0 + bj * HALF;
                    const f32x4 r0 = *(const f32x4*)(xin + off), r1 = *(const f32x4*)(xin + off + 4);
                    const f32x4 v0 = r0 + acc[ai][bj][m][0] * alpha, v1 = r1 + acc[ai][bj][m][1] * alpha;
                    *(f32x4*)(xout + off) = v0; *(f32x4*)(xout + off + 4) = v1;
                    store8(xb + off, v0, v1);
                    q += (v0[0] * v0[0] + v0[1] * v0[1]) + (v0[2] * v0[2] + v0[3] * v0[3]) + (v1[0] * v1[0] + v1[1] * v1[1]) + (v1[2] * v1[2] + v1[3] * v1[3]);
                }
                q += swz_xor<16>(q); q = sum_x32(q);
                if (fq == 0) atomicAdd(ssn + row, q);
            }
    }
};

struct EpiWin {
    static constexpr bool PERM = true; static constexpr int MIDK = 0;
    bf16_t *Y, *KB, *VB, *UB; float* LOGFT; const float* ss; const float* bfp; float qscale;
    __device__ __forceinline__ void midk(f32x4 (&)[2][2][4][2], const Unit&, int, int, int, int) const {}
    __device__ __forceinline__ void operator()(f32x4 (&acc)[2][2][4][2], const Unit& u, int wr, int wc, int fr, int fq) const {
        const int row0 = u.pm * BM + wr * 64 + fr, cw = wc * 32 + 8 * fq; const int pn = u.pn;
#pragma unroll
        for (int ai = 0; ai < 2; ++ai)
#pragma unroll
            for (int m = 0; m < 4; ++m) {
                const int row = row0 + ai * HALF + m * 16;
                const float rs = __builtin_amdgcn_rsqf(ss[row] * (1.0f / 1024.0f) + RMS_EPS);
                if (pn < 6) {
                    bf16_t* base; int ld; float sc = rs;
                    if (pn < 2) { base = Y + pn * BM; ld = 1024; sc = rs * qscale; } else if (pn < 4) { base = KB + (pn - 2) * BM; ld = 512; } else { base = VB + (pn - 4) * BM; ld = 512; }
#pragma unroll
                    for (int bj = 0; bj < 2; ++bj) store8(base + (size_t)row * ld + bj * HALF + cw, acc[ai][bj][m][0] * sc, acc[ai][bj][m][1] * sc);
                } else if (pn < 10) {
                    const f32x4 a0 = acc[ai][0][m][0] * rs, a1 = acc[ai][0][m][1] * rs, g0 = acc[ai][1][m][0] * rs, g1 = acc[ai][1][m][1] * rs;
                    store8(UB + (size_t)row * 512 + (pn - 6) * HALF + cw, a0 * sig4(g0), a1 * sig4(g1));
                } else {
                    if (wc == 0 && fq == 0) {
                        const int b = row >> 11, t = row & 2047;
#pragma unroll
                        for (int n = 0; n < 2; ++n)
#pragma unroll
                            for (int e = 0; e < 4; ++e) {
                                const int h = 4 * n + e; const float z = acc[ai][0][m][n][e] * rs + bfp[h];
                                LOGFT[(size_t)(b * 8 + h) * 2048 + t] = fminf(z, 0.f) - log1pf(expf(-fabsf(z)));
                            }
                    }
                }
            }
    }
};

struct EpiRowScale {
    static constexpr bool PERM = true; static constexpr int MIDK = 0;
    bf16_t* O; const float* ssr; float scale; static constexpr int ldc = 2048;
    __device__ __forceinline__ void midk(f32x4 (&)[2][2][4][2], const Unit&, int, int, int, int) const {}
    __device__ __forceinline__ void operator()(f32x4 (&acc)[2][2][4][2], const Unit& u, int wr, int wc, int fr, int fq) const {
        const int row0 = u.pm * BM + wr * 64 + fr, col0 = u.pn * BM + wc * 32 + 8 * fq;
#pragma unroll
        for (int ai = 0; ai < 2; ++ai)
#pragma unroll
            for (int m = 0; m < 4; ++m) {
                const int row = row0 + ai * HALF + m * 16;
                const float rs = (ssr ? __builtin_amdgcn_rsqf(ssr[row] * (1.0f / 1024.0f) + RMS_EPS) : 1.0f) * scale;
#pragma unroll
                for (int bj = 0; bj < 2; ++bj) store8(O + (size_t)row * ldc + col0 + bj * HALF, acc[ai][bj][m][0] * rs, acc[ai][bj][m][1] * rs);
            }
    }
};

struct EpiAux {
    static constexpr bool PERM = true; static constexpr int MIDK = 0;
    bf16_t* O; float scale; static constexpr int ldc = 1024;
    __device__ __forceinline__ void midk(f32x4 (&)[2][2][4][2], const Unit&, int, int, int, int) const {}
    __device__ __forceinline__ void operator()(f32x4 (&acc)[2][2][4][2], const Unit& u, int wr, int wc, int fr, int fq) const {
        bf16_t* base = O + u.aux + (size_t)(wr * 64 + fr) * ldc + wc * 32 + 8 * fq;
#pragma unroll
        for (int ai = 0; ai < 2; ++ai)
#pragma unroll
            for (int m = 0; m < 4; ++m)
#pragma unroll
                for (int bj = 0; bj < 2; ++bj) store8(base + (size_t)(ai * HALF + m * 16) * ldc + bj * HALF, acc[ai][bj][m][0] * scale, acc[ai][bj][m][1] * scale);
    }
};

struct EpiSoftmax {
    static constexpr bool PERM = true; static constexpr int MIDK = 0;
    bf16_t* XP; const float* ss; PG8_LAS float* scr;
    __device__ __forceinline__ void midk(f32x4 (&)[2][2][4][2], const Unit&, int, int, int, int) const {}
    __device__ __forceinline__ void operator()(f32x4 (&acc)[2][2][4][2], const Unit& u, int wr, int wc, int fr, int fq) const {
        const int row0 = u.pm * BM + wr * 64 + fr, col0 = u.pn * BM + wc * 32 + 8 * fq;
        PG8_LAS float* TM = scr; PG8_LAS float* TS = scr + 1024;
        float rs[2][4];
#pragma unroll
        for (int ai = 0; ai < 2; ++ai)
#pragma unroll
            for (int m = 0; m < 4; ++m) {
                const int rl = ai * HALF + wr * 64 + m * 16 + fr;
                rs[ai][m] = __builtin_amdgcn_rsqf(ss[u.pm * BM + rl] * (1.0f / 1024.0f) + RMS_EPS);
                float v = -3.0e38f;
#pragma unroll
                for (int bj = 0; bj < 2; ++bj)
#pragma unroll
                    for (int n = 0; n < 2; ++n) { const f32x4 x = acc[ai][bj][m][n]; v = fmaxf(v, fmaxf(fmaxf(x[0], x[1]), fmaxf(x[2], x[3]))); }
                v = fmaxf(v, swz_xor<16>(v)); v = max_x32(v);
                if (fq == 0) TM[rl * 4 + wc] = v * rs[ai][m];
            }
        asm volatile("s_waitcnt lgkmcnt(0)" ::: "memory"); __builtin_amdgcn_s_barrier(); asm volatile("" ::: "memory");
#pragma unroll
        for (int ai = 0; ai < 2; ++ai)
#pragma unroll
            for (int m = 0; m < 4; ++m) {
                const int rl = ai * HALF + wr * 64 + m * 16 + fr;
                const f32x4 t = *(const PG8_LAS f32x4*)(TM + rl * 4);
                const float mrow = fmaxf(fmaxf(t[0], t[1]), fmaxf(t[2], t[3]));
                float s = 0.f;
#pragma unroll
                for (int bj = 0; bj < 2; ++bj)
#pragma unroll
                    for (int n = 0; n < 2; ++n) { f32x4 x = acc[ai][bj][m][n] * rs[ai][m] - mrow;
                        x[0] = __builtin_amdgcn_exp2f(x[0]); x[1] = __builtin_amdgcn_exp2f(x[1]); x[2] = __builtin_amdgcn_exp2f(x[2]); x[3] = __builtin_amdgcn_exp2f(x[3]);
                        acc[ai][bj][m][n] = x; s += (x[0] + x[1]) + (x[2] + x[3]); }
                s += swz_xor<16>(s); s = sum_x32(s);
                if (fq == 0) TS[rl * 4 + wc] = s;
            }
        asm volatile("s_waitcnt lgkmcnt(0)" ::: "memory"); __builtin_amdgcn_s_barrier(); asm volatile("" ::: "memory");
#pragma unroll
        for (int ai = 0; ai < 2; ++ai)
#pragma unroll
            for (int m = 0; m < 4; ++m) {
                const int rl = ai * HALF + wr * 64 + m * 16 + fr;
                const f32x4 t = *(const PG8_LAS f32x4*)(TS + rl * 4);
                const float inv = __builtin_amdgcn_rcpf((t[0] + t[1]) + (t[2] + t[3]));
#pragma unroll
                for (int bj = 0; bj < 2; ++bj) store8(XP + (size_t)(u.pm * BM + rl) * 1024 + col0 + bj * HALF, acc[ai][bj][m][0] * inv, acc[ai][bj][m][1] * inv);
            }
    }
};
}
#include <hip/hip_bf16.h>
namespace attn_body {
using bf16=__hip_bfloat16;
using bf16x8=__attribute__((ext_vector_type(8)))short;
using s16x4=__attribute__((ext_vector_type(4)))short;
using f32x16=__attribute__((ext_vector_type(16)))float;
using f32x4_t=__attribute__((ext_vector_type(4)))float;
using u32x4=__attribute__((ext_vector_type(4)))unsigned;
#define ATT_LAS __attribute__((address_space(3)))
constexpr int BATCH=8,NHEAD=8,SEQ=2048,D=64,QP=1024,KP=512;
constexpr int NW=8,QBLK=32,QB=QBLK*NW,KVBLK=64,NQB=SEQ/QB;
__device__ __forceinline__ int crow(int r,int hi){return (r&3)+8*(r>>2)+4*hi;}
#define SBAR() __builtin_amdgcn_sched_barrier(0)
__device__ __forceinline__ void cmask(f32x16&p0,f32x16&p1,int jb,int qrel,int hi){
  const float NEG=-INFINITY; int kb=64*jb+4*hi;
  #pragma unroll
  for(int r=0;r<16;++r){int kv=kb+(r&3)+8*(r>>2); if(kv>qrel)p0[r]=NEG; if(kv+32>qrel)p1[r]=NEG;}
}
constexpr int NSLOT=3, SLOTB=8192;
constexpr int LDS_K=0, LDS_V=NSLOT*SLOTB, LDS_WS=2*NSLOT*SLOTB, LDS_OST=LDS_WS+NW*64*4, LDS_CB=LDS_OST+NW*4096  , LDS_WT=LDS_CB+SEQ*4, LDS_BYTES=LDS_WT+64;
__device__ __forceinline__ void glds16(const void*gsrc,unsigned lds_dst){unsigned keep;
  asm volatile("s_mov_b32 %0, m0\n\ts_mov_b32 m0, %2\n\ts_nop 0\n\tglobal_load_lds_dwordx4 %1, off\n\ts_mov_b32 m0, %0":"=&s"(keep):"v"(gsrc),"s"(lds_dst):"memory");}
__device__ __forceinline__ float max3f(float a,float b,float c){float r;asm("v_max3_f32 %0, %1, %2, %3":"=v"(r):"v"(a),"v"(b),"v"(c));return r;}
__device__ __forceinline__ float max2f(float a,float b){float r;asm("v_max_f32_e32 %0, %1, %2":"=v"(r):"v"(a),"v"(b));return r;}
__device__ __forceinline__ float fadd_s(float a,float b){float r;asm("v_add_f32_e32 %0, %1, %2":"=v"(r):"v"(a),"v"(b));return r;}
__device__ __forceinline__ float fsub_s(float a,float b){float r;asm("v_sub_f32_e32 %0, %1, %2":"=v"(r):"v"(a),"v"(b));return r;}
typedef float f32x2_t __attribute__((ext_vector_type(2))); typedef __bf16 bf16x2_t __attribute__((ext_vector_type(2)));
__device__ __forceinline__ unsigned cvtpk_s(float lo,float hi){f32x2_t v={lo,hi};bf16x2_t b=__builtin_convertvector(v,bf16x2_t);return __builtin_bit_cast(unsigned,b);}
#define WAIT_BAR(N) asm volatile("s_waitcnt vmcnt(" #N ") lgkmcnt(0)\n\ts_barrier":::"memory")

__device__ __forceinline__ void qkt(f32x16&p0,f32x16&p1,const char*Kslot,const bf16x8*qr,const f32x16&negm,int r32,int hi){
  const char*kb=Kslot+hi*1024+r32*16;
  #pragma unroll
  for(int d0=0;d0<4;++d0){
    const bf16x8 b0=*reinterpret_cast<const bf16x8*>(kb+d0*2048);
    const bf16x8 b1=*reinterpret_cast<const bf16x8*>(kb+d0*2048+512);
    if(d0==0){p0=__builtin_amdgcn_mfma_f32_32x32x16_bf16(b0,qr[0],negm,0,0,0);p1=__builtin_amdgcn_mfma_f32_32x32x16_bf16(b1,qr[0],negm,0,0,0);}
    else{p0=__builtin_amdgcn_mfma_f32_32x32x16_bf16(b0,qr[d0],p0,0,0,0);p1=__builtin_amdgcn_mfma_f32_32x32x16_bf16(b1,qr[d0],p1,0,0,0);}}
}
typedef ATT_LAS const char* lds_cptr;
typedef short v4i16_t __attribute__((ext_vector_type(4)));
__device__ __forceinline__ void kload8(bf16x8*kf,lds_cptr kp){
  kf[0]=*(const ATT_LAS bf16x8*)(kp);      kf[1]=*(const ATT_LAS bf16x8*)(kp+512);
  kf[2]=*(const ATT_LAS bf16x8*)(kp+2048); kf[3]=*(const ATT_LAS bf16x8*)(kp+2560);
  kf[4]=*(const ATT_LAS bf16x8*)(kp+4096); kf[5]=*(const ATT_LAS bf16x8*)(kp+4608);
  kf[6]=*(const ATT_LAS bf16x8*)(kp+6144); kf[7]=*(const ATT_LAS bf16x8*)(kp+6656);
}
__device__ __forceinline__ void kload2(bf16x8*kf,lds_cptr kp,int j){ kf[2*j]=*(const ATT_LAS bf16x8*)(kp+j*2048); kf[2*j+1]=*(const ATT_LAS bf16x8*)(kp+j*2048+512); }
__device__ __forceinline__ s16x4 vtr(lds_cptr p){ return __builtin_bit_cast(s16x4,__builtin_amdgcn_ds_read_tr16_b64_v4i16((ATT_LAS v4i16_t*)p)); }
__device__ __forceinline__ float rowmax(const f32x16&p0,const f32x16&p1){
  float a=max3f(p0[0],p0[1],p1[0]),b=max3f(p0[2],p0[3],p1[1]);a=max3f(a,p1[2],p1[3]);
  #pragma unroll
  for(int r=4;r<16;r+=4){a=max3f(a,p0[r],p0[r+1]);b=max3f(b,p0[r+2],p0[r+3]);a=max3f(a,p1[r],p1[r+1]);b=max3f(b,p1[r+2],p1[r+3]);}
  const float m=max2f(a,b);
  auto rr=__builtin_amdgcn_permlane32_swap(__float_as_uint(m),__float_as_uint(m),false,false);
  return max2f(__uint_as_float(rr[0]),__uint_as_float(rr[1]));
}
__device__ __forceinline__ void pv(f32x16*o,int vb,bf16x8 pa0,bf16x8 pa1,bf16x8 pa2,bf16x8 pa3){
  #pragma unroll
  for(int d0=0;d0<2;++d0){s16x4 lo[4],hi[4];
    #pragma unroll
    for(int ks=0;ks<4;++ks){
      asm volatile("ds_read_b64_tr_b16 %0,%1 offset:%c2":"=&v"(lo[ks]):"v"(vb),"i"(d0*4096+ks*1024):"memory");
      asm volatile("ds_read_b64_tr_b16 %0,%1 offset:%c2":"=&v"(hi[ks]):"v"(vb),"i"(d0*4096+ks*1024+512):"memory");}
    asm volatile("s_waitcnt lgkmcnt(0)":::"memory");SBAR();
    #define PK(k) (bf16x8){lo[k][0],lo[k][1],lo[k][2],lo[k][3],hi[k][0],hi[k][1],hi[k][2],hi[k][3]}
    o[d0]=__builtin_amdgcn_mfma_f32_32x32x16_bf16(pa0,PK(0),o[d0],0,0,0);
    o[d0]=__builtin_amdgcn_mfma_f32_32x32x16_bf16(pa1,PK(1),o[d0],0,0,0);
    o[d0]=__builtin_amdgcn_mfma_f32_32x32x16_bf16(pa2,PK(2),o[d0],0,0,0);
    o[d0]=__builtin_amdgcn_mfma_f32_32x32x16_bf16(pa3,PK(3),o[d0],0,0,0);
    #undef PK
  }
}
__device__ __forceinline__ void scan_bias(const float*LOGFT,int bh,char*shm,const int tid){
  const int lane=tid&63,wid=tid>>6;
  ATT_LAS float*cb=(ATT_LAS float*)(shm+LDS_CB); ATT_LAS float*wt=(ATT_LAS float*)(shm+LDS_WT);
  const f32x4_t v=*(const f32x4_t*)(LOGFT+(size_t)bh*SEQ+4*tid);
  const float s0=v[0],s1=s0+v[1],s2=s1+v[2],s3=s2+v[3];
  float incl=s3;
  #pragma unroll
  for(int o=1;o<64;o<<=1){const float n=__int_as_float(__builtin_amdgcn_ds_bpermute((lane-o)<<2,__float_as_int(incl))); if(lane>=o)incl+=n;}
  if(lane==63)wt[wid]=incl;
  asm volatile("s_waitcnt lgkmcnt(0)\n\ts_barrier":::"memory");
  float woff=0.f;
  #pragma unroll
  for(int w=0;w<8;++w){const float x=wt[w]; if(w<wid)woff+=x;}
  const float ex=woff+incl-s3; const float L2E=-1.4426950408889634f;
  f32x4_t o4; o4[0]=(ex+s0)*L2E;o4[1]=(ex+s1)*L2E;o4[2]=(ex+s2)*L2E;o4[3]=(ex+s3)*L2E;
  *(ATT_LAS f32x4_t*)(cb+4*tid)=o4;
  asm volatile("s_waitcnt lgkmcnt(0)\n\ts_barrier":::"memory");
}
template<int THRL> __device__ __forceinline__ void attn_unit(int b,int h,int qb,const bf16*Q,const bf16*K,const bf16*V,bf16*O,float*ssa,char*shm,const int tid){
  const int lane=tid&63,r32=lane&31,hi=lane>>5; const int wid=__builtin_amdgcn_readfirstlane(tid>>6);
  const long rowbase=(long)b*SEQ; const int q0=qb*QB;
  const bf16*Qw=Q+(rowbase+q0+wid*QBLK)*QP+h*D;
  const bf16*Kh=K+rowbase*KP+h*D,*Vh=V+rowbase*KP+h*D;
  const unsigned lds0=(unsigned)(uintptr_t)shm;
  float*wsf=(float*)(shm+LDS_WS)+wid*64;
  const ATT_LAS float*cbh=(const ATT_LAS float*)(shm+LDS_CB)+4*hi;
  const bf16*ksrc=Kh+(long)lane*KP+wid*8;
  const bf16*vsrc=Vh+(long)(16*(wid&3)+(lane>>2))*KP+(wid>>2)*32+(lane&3)*8;
  const unsigned kdst=lds0+LDS_K+wid*1024, vdst=lds0+LDS_V+wid*1024;
  #define DMA_K(t,slot) glds16(ksrc+(long)(t)*KVBLK*KP,(unsigned)__builtin_amdgcn_readfirstlane(kdst+(slot)))
  #define DMA_V(t,slot) glds16(vsrc+(long)(t)*KVBLK*KP,(unsigned)__builtin_amdgcn_readfirstlane(vdst+(slot)))
  const int vb0=(int)(lds0+LDS_V)+((lane>>4)&1)*32+(lane&3)*8+(4*hi+((lane&15)>>2))*64;
  const char*Kbase=shm+LDS_K; bf16x8 kf[8];
  const lds_cptr shm3=(lds_cptr)shm; const lds_cptr kp0=shm3+LDS_K+hi*1024+r32*16; const lds_cptr vp0=shm3+LDS_V+((lane>>4)&1)*32+(lane&3)*8+(4*hi+((lane&15)>>2))*64;
  const int NT=(q0+QB)/KVBLK;
  DMA_K(0,0);DMA_V(0,0);DMA_K(1,SLOTB);
  bf16x8 qr[4];
  #pragma unroll
  for(int d0=0;d0<4;++d0)qr[d0]=*reinterpret_cast<const bf16x8*>(&Qw[(long)r32*QP+d0*16+hi*8]);
  float mhat=0.f,l_reg=0.f;f32x16 o[2];o[0]=f32x16{};o[1]=f32x16{};f32x16 negm=f32x16{};asm volatile("":"+v"(negm));
  const int qrel=wid*QBLK+r32;
  #define CMASK(P0,P1,t) do{int jb_=(t)-(NT-4); if(jb_>=0)cmask(P0,P1,jb_,qrel,hi);}while(0)
  #define ADDB(P0,P1,t) do{ const ATT_LAS float*cbt_=cbh+64*(t); \
    _Pragma("unroll") for(int j_=0;j_<4;++j_){ const f32x4_t b0_=*(const ATT_LAS f32x4_t*)(cbt_+8*j_), b1_=*(const ATT_LAS f32x4_t*)(cbt_+32+8*j_); \
      _Pragma("unroll") for(int i_=0;i_<4;++i_){P0[4*j_+i_]+=b0_[i_];P1[4*j_+i_]+=b1_[i_];} } }while(0)
  bool resc=false;
  #define START(P0,P1) do{ const float rm=rowmax(P0,P1); resc=false; \
    { const float dl=rm; mhat=fadd_s(mhat,dl); \
      _Pragma("unroll") for(int r=0;r<16;++r){P0[r]=fsub_s(P0[r],dl);P1[r]=fsub_s(P1[r],dl);} \
      _Pragma("unroll") for(int r=0;r<16;++r)negm[r]=-mhat; asm volatile("":"+v"(negm)); } \
    _Pragma("unroll") for(int r=0;r<16;++r)P0[r]=__builtin_amdgcn_exp2f(P0[r]); }while(0)
  #define RESC() do{ if(resc){ asm volatile("s_waitcnt lgkmcnt(0)":::"memory"); \
      _Pragma("unroll") for(int d_=0;d_<2;++d_) _Pragma("unroll") for(int r=0;r<16;++r)o[d_][r]*=wsf[crow(r,hi)]; } }while(0)
  f32x16 pA0,pA1,pB0,pB1;
  int sl_prev=0,sl_cur=0,sl_next=SLOTB;
  #define ROT() do{sl_prev=sl_cur;sl_cur=sl_next;sl_next=(sl_next==(NSLOT-1)*SLOTB)?0:sl_next+SLOTB;}while(0)
  DMA_K(2,2*SLOTB);
  WAIT_BAR(3);
  qkt(pA0,pA1,Kbase,qr,negm,r32,hi);asm volatile("s_nop 15\n\ts_nop 7":"+v"(pA0),"+v"(pA1));ADDB(pA0,pA1,0);asm volatile("s_nop 3":"+v"(pA0),"+v"(pA1));CMASK(pA0,pA1,0);
  START(pA0,pA1);
  _Pragma("unroll") for(int r=0;r<16;++r)pA1[r]=__builtin_amdgcn_exp2f(pA1[r]);
  WAIT_BAR(0);
  DMA_K(3,0);DMA_V(1,SLOTB);
  ROT();
  kload8(kf,kp0+sl_cur);
  WAIT_BAR(2);
  s16x4 vlo[8],vhi[8]; u32x4 pw0,pw1,pw2,pw3;
  #define PKW(P,B) cvtpk_s(P[B],P[B+1])
  #define PAF(k) __builtin_bit_cast(bf16x8,pw##k)
  #define VFR(i) (bf16x8){vlo[i][0],vlo[i][1],vlo[i][2],vlo[i][3],vhi[i][0],vhi[i][1],vhi[i][2],vhi[i][3]}
  #define PIN(x) asm volatile("":"+v"(x))
  #define MX3(a,b,c) __builtin_fmaxf(__builtin_fmaxf((a),(b)),(c))
  #define GAPA(MF,A0,A1,A2,A3,W0,W1,PW) do{ MF; sacc+=A0; sacc+=A1; sacc+=A2; sacc+=A3; PIN(sacc); W0; W1; PIN(PW); SBAR(); }while(0)
  #define EX(v) __builtin_amdgcn_exp2f(v)
  #define GAPB(MF,X,B) do{ MF; X[B]=EX(X[B]); X[B+1]=EX(X[B+1]); X[B+2]=EX(X[B+2]); X[B+3]=EX(X[B+3]); PIN(X); SBAR(); }while(0)
  #define VRD(i) do{ vlo[i]=vtr(vp_+(((i)>>2)*4096+((i)&3)*1024)); vhi[i]=vtr(vp_+(((i)>>2)*4096+((i)&3)*1024+512)); }while(0)
  #define KRD(G,j) do{ if(G){ kload2(kf,kp0+sl_next,j); SBAR(); } }while(0)
  #define STEP(C0,C1,P0,P1,t,GK,GV,GL) do{ SBAR(); \
    const lds_cptr vp_=vp0+sl_prev; \
    VRD(0); SBAR(); float sacc=(P0[0]+P0[1]); \
    GAPA(C0=__builtin_amdgcn_mfma_f32_32x32x16_bf16(kf[0],qr[0],negm,0,0,0), P0[2],P0[3],P0[4],P0[5],     pw0[0]=PKW(P0,0), pw0[1]=PKW(P0,2), pw0); \
    VRD(4); SBAR(); GAPA(C1=__builtin_amdgcn_mfma_f32_32x32x16_bf16(kf[1],qr[0],negm,0,0,0), P0[6],P0[7],P0[8],P0[9],     pw0[2]=PKW(P0,4), pw0[3]=PKW(P0,6), pw0); \
    VRD(1); SBAR(); GAPA(C0=__builtin_amdgcn_mfma_f32_32x32x16_bf16(kf[2],qr[1],C0,0,0,0),   P0[10],P0[11],P0[12],P0[13], pw1[0]=PKW(P0,8), pw1[1]=PKW(P0,10), pw1); \
    VRD(5); SBAR(); GAPA(C1=__builtin_amdgcn_mfma_f32_32x32x16_bf16(kf[3],qr[1],C1,0,0,0),   P0[14],P0[15],P1[0],P1[1],   pw1[2]=PKW(P0,12),pw1[3]=PKW(P0,14), pw1); \
    VRD(2); SBAR(); GAPA(C0=__builtin_amdgcn_mfma_f32_32x32x16_bf16(kf[4],qr[2],C0,0,0,0),   P1[2],P1[3],P1[4],P1[5],     pw2[0]=PKW(P1,0), pw2[1]=PKW(P1,2), pw2); \
    VRD(6); SBAR(); GAPA(C1=__builtin_amdgcn_mfma_f32_32x32x16_bf16(kf[5],qr[2],C1,0,0,0),   P1[6],P1[7],P1[8],P1[9],     pw2[2]=PKW(P1,4), pw2[3]=PKW(P1,6), pw2); \
    VRD(3); SBAR(); GAPA(C0=__builtin_amdgcn_mfma_f32_32x32x16_bf16(kf[6],qr[3],C0,0,0,0),   P1[10],P1[11],P1[12],P1[13], pw3[0]=PKW(P1,8), pw3[1]=PKW(P1,10), pw3); \
    VRD(7); SBAR(); GAPA(C1=__builtin_amdgcn_mfma_f32_32x32x16_bf16(kf[7],qr[3],C1,0,0,0),   P1[14],P1[15],0.f,0.f,       pw3[2]=PKW(P1,12),pw3[3]=PKW(P1,14), pw3); \
    l_reg+=sacc; \
    if(GK){DMA_K((t)+3,sl_cur);} if(GV){DMA_V((t)+1,sl_next);} \
    ADDB(C0,C1,t); \
    CMASK(C0,C1,t); \
    { float a=MX3(C0[0],C0[1],C1[0]),b=MX3(C0[2],C0[3],C1[1]); a=MX3(a,C1[2],C1[3]); \
      _Pragma("unroll") for(int r=4;r<16;r+=4){a=MX3(a,C0[r],C0[r+1]);b=MX3(b,C0[r+2],C0[r+3]);a=MX3(a,C1[r],C1[r+1]);b=MX3(b,C1[r+2],C1[r+3]);} \
      float rm=__builtin_fmaxf(a,b); { auto rr=__builtin_amdgcn_permlane32_swap(__float_as_uint(rm),__float_as_uint(rm),false,false); rm=__builtin_fmaxf(__uint_as_float(rr[0]),__uint_as_float(rr[1])); } \
      resc=false; \
      if(__builtin_expect(__any(rm>(float)THRL),0)){ const float dl=__builtin_fmaxf(rm,0.f); mhat+=dl; \
        _Pragma("unroll") for(int r=0;r<16;++r){C0[r]-=dl;C1[r]-=dl;} \
        _Pragma("unroll") for(int r=0;r<16;++r)negm[r]=-mhat; asm volatile("":"+v"(negm)); \
        const float f=__builtin_amdgcn_exp2f(-dl); l_reg*=f; if(hi==0)wsf[r32]=f; resc=true; } } \
    SBAR(); \
    GAPB(o[0]=__builtin_amdgcn_mfma_f32_32x32x16_bf16(PAF(0),VFR(0),o[0],0,0,0), C0,0); \
    GAPB(o[1]=__builtin_amdgcn_mfma_f32_32x32x16_bf16(PAF(0),VFR(4),o[1],0,0,0), C0,4); \
    KRD(GL,0); GAPB(o[0]=__builtin_amdgcn_mfma_f32_32x32x16_bf16(PAF(1),VFR(1),o[0],0,0,0), C0,8); \
    KRD(GL,1); GAPB(o[1]=__builtin_amdgcn_mfma_f32_32x32x16_bf16(PAF(1),VFR(5),o[1],0,0,0), C0,12); \
    KRD(GL,2); GAPB(o[0]=__builtin_amdgcn_mfma_f32_32x32x16_bf16(PAF(2),VFR(2),o[0],0,0,0), C1,0); \
    KRD(GL,3); GAPB(o[1]=__builtin_amdgcn_mfma_f32_32x32x16_bf16(PAF(2),VFR(6),o[1],0,0,0), C1,4); \
    GAPB(o[0]=__builtin_amdgcn_mfma_f32_32x32x16_bf16(PAF(3),VFR(3),o[0],0,0,0), C1,8); \
    GAPB(o[1]=__builtin_amdgcn_mfma_f32_32x32x16_bf16(PAF(3),VFR(7),o[1],0,0,0), C1,12); \
    }while(0)
  int t=1;
  #undef CMASK
  #define CMASK(P0,P1,t) do{}while(0)
  for(;t+5<NT;t+=2){
    STEP(pB0,pB1,pA0,pA1,t,true,true,true);     WAIT_BAR(2); RESC(); ROT();
    STEP(pA0,pA1,pB0,pB1,t+1,true,true,true);   WAIT_BAR(2); RESC(); ROT();
  }
  #undef CMASK
  #define CMASK(P0,P1,t) do{int jb_=(t)-(NT-4); if(jb_>=0)cmask(P0,P1,jb_,qrel,hi);}while(0)
  #define ENDW(tt) do{ if((tt)+3<NT){WAIT_BAR(2);} else if((tt)+2<NT){WAIT_BAR(1);} else {WAIT_BAR(0);} }while(0)
  for(;t+1<NT;t+=2){
    STEP(pB0,pB1,pA0,pA1,t,(t+3<NT),(t+1<NT),(t+1<NT));       ENDW(t);   RESC(); ROT();
    STEP(pA0,pA1,pB0,pB1,t+1,(t+4<NT),(t+2<NT),(t+2<NT));     ENDW(t+1); RESC(); ROT();
  }
  STEP(pB0,pB1,pA0,pA1,NT-1,false,false,false); RESC();
  { float sacc=pB0[0]+pB0[1]; _Pragma("unroll") for(int r=2;r<16;++r)sacc+=pB0[r]; _Pragma("unroll") for(int r=0;r<16;++r)sacc+=pB1[r]; l_reg+=sacc;
    pw0=(u32x4){PKW(pB0,0),PKW(pB0,2),PKW(pB0,4),PKW(pB0,6)};pw1=(u32x4){PKW(pB0,8),PKW(pB0,10),PKW(pB0,12),PKW(pB0,14)};pw2=(u32x4){PKW(pB1,0),PKW(pB1,2),PKW(pB1,4),PKW(pB1,6)};pw3=(u32x4){PKW(pB1,8),PKW(pB1,10),PKW(pB1,12),PKW(pB1,14)};
    SBAR(); pv(o,vb0+sl_cur,PAF(0),PAF(1),PAF(2),PAF(3)); }
  #undef PKW
  #undef PAF
  #undef VFR
  #undef PIN
  #undef MX3
  #undef GAPA
  #undef GAPB
  #undef EX
  #undef VRD
  #undef KRD
  #undef STEP
  #undef ENDW
  {auto rr=__builtin_amdgcn_permlane32_swap(__float_as_uint(l_reg),__float_as_uint(l_reg),false,false);l_reg=__uint_as_float(rr[0])+__uint_as_float(rr[1]);}
  if(hi==0)wsf[32+r32]=l_reg;asm volatile("s_waitcnt lgkmcnt(0)":::"memory");
  float rli[16];
  #pragma unroll
  for(int r=0;r<16;++r)rli[r]=__builtin_amdgcn_rcpf(wsf[32+crow(r,hi)]);
  bf16*Ow=O+(rowbase+q0+wid*QBLK)*QP+h*D;
  float*ssw=ssa+rowbase+q0+wid*QBLK;
  { bf16*stg=(bf16*)(shm+LDS_OST)+wid*2048;
    #pragma unroll
    for(int r=0;r<16;++r){const int orow=crow(r,hi);
      #pragma unroll
      for(int d0=0;d0<2;++d0)stg[orow*64+d0*32+r32]=__float2bfloat16(o[d0][r]*rli[r]);}
    asm volatile("s_waitcnt lgkmcnt(0)":::"memory");
    #pragma unroll
    for(int i=0;i<4;++i){const int row=i*8+(lane>>3),ch=lane&7; const u32x4 v=*(const u32x4*)(stg+row*64+ch*8); *(u32x4*)(Ow+(long)row*QP+ch*8)=v;
      float q=0.f;
      #pragma unroll
      for(int e=0;e<4;++e){const float lo=__uint_as_float(v[e]<<16),hi2=__uint_as_float(v[e]&0xffff0000u); q+=lo*lo+hi2*hi2;}
      q+=swz_xor<1>(q);q+=swz_xor<2>(q);q+=swz_xor<4>(q);
      if(ch==0)atomicAdd(ssw+row,q);} }
  asm volatile("s_waitcnt lgkmcnt(0)\n\ts_barrier":::"memory");
  #undef DMA_K
  #undef DMA_V
  #undef CMASK
  #undef ADDB
  #undef START
  #undef RESC
  #undef ROT
}
#undef SBAR
#undef WAIT_BAR

constexpr int CONV_W=31, CONV_C=512, CONV_TOK=64, CONV_ROWS=CONV_TOK+CONV_W-1;
__device__ __forceinline__ float wsum64(float v){ return wave_sum64(v); }
__device__ __forceinline__ void conv_unit(int unit,const bf16*UB,const float*cw,const float*cbias,const float*lng,const float*lnb,bf16*Y,char*shm,const int tid){
  const int lane=tid&63,wid=tid>>6;
  const int b=unit>>5,t0=(unit&31)*CONV_TOK;
  ATT_LAS u32x4*L=(ATT_LAS u32x4*)shm;
  for(int idx=tid;idx<CONV_ROWS*64;idx+=512){
    const int row=idx>>6,ch=idx&63,t=t0-(CONV_W-1)+row;
    u32x4 v=(u32x4){0u,0u,0u,0u};
    if(t>=0)v=*(const u32x4*)(UB+((size_t)b*SEQ+t)*CONV_C+ch*8);
    L[idx]=v;
  }
  __syncthreads();
  float acc[8][8];
  { const f32x4_t b0=*(const f32x4_t*)(cbias+8*lane),b1=*(const f32x4_t*)(cbias+8*lane+4);
    #pragma unroll
    for(int tt=0;tt<8;++tt){acc[tt][0]=b0[0];acc[tt][1]=b0[1];acc[tt][2]=b0[2];acc[tt][3]=b0[3];acc[tt][4]=b1[0];acc[tt][5]=b1[1];acc[tt][6]=b1[2];acc[tt][7]=b1[3];} }
  #pragma unroll 1
  for(int j=0;j<CONV_W;++j){
    const f32x4_t w0=*(const f32x4_t*)(cw+j*CONV_C+8*lane),w1=*(const f32x4_t*)(cw+j*CONV_C+8*lane+4);
    #pragma unroll
    for(int tt=0;tt<8;++tt){
      const u32x4 u=L[(wid*8+tt+j)*64+lane];
      acc[tt][0]+=w0[0]*__uint_as_float(u[0]<<16); acc[tt][1]+=w0[1]*__uint_as_float(u[0]&0xffff0000u);
      acc[tt][2]+=w0[2]*__uint_as_float(u[1]<<16); acc[tt][3]+=w0[3]*__uint_as_float(u[1]&0xffff0000u);
      acc[tt][4]+=w1[0]*__uint_as_float(u[2]<<16); acc[tt][5]+=w1[1]*__uint_as_float(u[2]&0xffff0000u);
      acc[tt][6]+=w1[2]*__uint_as_float(u[3]<<16); acc[tt][7]+=w1[3]*__uint_as_float(u[3]&0xffff0000u);
    }
  }
  const f32x4_t g0=*(const f32x4_t*)(lng+8*lane),g1=*(const f32x4_t*)(lng+8*lane+4),e0=*(const f32x4_t*)(lnb+8*lane),e1=*(const f32x4_t*)(lnb+8*lane+4);
  const float gg[8]={g0[0],g0[1],g0[2],g0[3],g1[0],g1[1],g1[2],g1[3]},bb[8]={e0[0],e0[1],e0[2],e0[3],e1[0],e1[1],e1[2],e1[3]};
  #pragma unroll
  for(int tt=0;tt<8;++tt){
    float s=0.f;
    #pragma unroll
    for(int e=0;e<8;++e)s+=acc[tt][e];
    const float mu=wsum64(s)*(1.0f/CONV_C);
    float q=0.f;
    #pragma unroll
    for(int e=0;e<8;++e){acc[tt][e]-=mu;q+=acc[tt][e]*acc[tt][e];}
    const float rstd=__builtin_amdgcn_rsqf(wsum64(q)*(1.0f/CONV_C)+1e-6f);
    float q2=0.f;
    #pragma unroll
    for(int e=0;e<8;++e){float y=acc[tt][e]*rstd*gg[e]+bb[e]; y=y*__builtin_amdgcn_rcpf(1.0f+__builtin_amdgcn_exp2f(-y*1.4426950408889634f)); acc[tt][e]=y;q2+=y*y;}
    const float r2=__builtin_amdgcn_rsqf(wsum64(q2)*(1.0f/CONV_C)+1e-6f);
    u32x4 w;
    w[0]=cvtpk_s(acc[tt][0]*r2,acc[tt][1]*r2);w[1]=cvtpk_s(acc[tt][2]*r2,acc[tt][3]*r2);w[2]=cvtpk_s(acc[tt][4]*r2,acc[tt][5]*r2);w[3]=cvtpk_s(acc[tt][6]*r2,acc[tt][7]*r2);
    *(u32x4*)(Y+((size_t)b*SEQ+t0+wid*8+tt)*QP+CONV_C+8*lane)=w;
  }
  __syncthreads();
}
}
constexpr int NWAVES = 8;
constexpr int M = 16384, DM = 1024, DFF = 2816, SEQ = 2048, NBATCH = 8, NMEMROWS = 2048, NLAYER = 2;
constexpr size_t MiB = 1u << 20;
constexpr size_t WS_CTL = 0, CTL_ZERO_BYTES = 2 * MiB;
constexpr size_t WS_W = 2 * MiB;
constexpr size_t W_LAYER = 97 * MiB / 2;
constexpr size_t WO_1A = 0, WO_1B = 11 * MiB, WO_IN = WO_1B + 11 * MiB / 2, WO_OUT = WO_IN + 11 * MiB / 2, WO_XQ = WO_OUT + 2 * MiB, WO_XKV = WO_XQ + 2 * MiB, WO_XO = WO_XKV + 4 * MiB,
                 WO_2A = WO_XO + 2 * MiB, WO_2B = WO_2A + 11 * MiB;
static_assert(WO_2B + 11 * MiB / 2 == W_LAYER, "weight map");
constexpr size_t WS_XB = 100 * MiB;
constexpr size_t WS_MKV = 132 * MiB;
constexpr size_t WS_MEMB = 148 * MiB;
constexpr size_t WS_R1 = 152 * MiB;
constexpr size_t R1_H = 0;
constexpr size_t R1_Y = 0, R1_KB = 32 * MiB, R1_VB = 48 * MiB, R1_UB = 64 * MiB, R1_LOGF = 80 * MiB;
constexpr size_t R1_XP = 0, R1_WQK = 64 * MiB, R1_WVO = 80 * MiB;
constexpr size_t WS_END = 248 * MiB;
constexpr int CW_BAR = 4096;
constexpr size_t CTL_SS = 256 * 1024;
constexpr size_t CTL_SSA = CTL_SS + 9 * (size_t)M * 4, CTL_SSM = CTL_SSA + 2 * (size_t)M * 4;
static_assert(CTL_SSM + 2048 * 4 <= CTL_ZERO_BYTES, "ctl map");
constexpr int RING_OFF = 0, RING_BYTES = 131072;
constexpr int EPI_SCR_OFF = RING_BYTES;
constexpr int LDSCTL_OFF = RING_BYTES + 8192, MISC_OFF = LDSCTL_OFF + 320;
constexpr int LDS_BYTES = 147456;
static_assert(MISC_OFF + 128 <= LDS_BYTES, "LDS map");

#define GAS __attribute__((address_space(1)))
#define LAS __attribute__((address_space(3)))
typedef unsigned short bf16;
typedef unsigned v4u __attribute__((ext_vector_type(4)));
typedef float f32x4 __attribute__((ext_vector_type(4)));
typedef GAS unsigned gu32;
#define RLX_AGENT __ATOMIC_RELAXED, __HIP_MEMORY_SCOPE_AGENT
#define LDS_WAIT() asm volatile("s_waitcnt lgkmcnt(0)" ::: "memory")
__device__ __forceinline__ unsigned f2bf(float f) { unsigned u = __builtin_bit_cast(unsigned, f); return (u + 0x7fffu + ((u >> 16) & 1u)) >> 16; }
__device__ __forceinline__ unsigned pk2(float lo, float hi) { return f2bf(lo) | (f2bf(hi) << 16); }

#define XB_TMO      128
#define XB_XCNT(j)  (256  + 64 * (j))
#define XB_XSUB(j)  (1280 + 64 * (j))
#define XB_XGEN(j)  (2304 + 64 * (j))
#define XB_TOP      3328
#define XB_TOPGEN   3392
#define XCD_BAR_WORDS 3456
#define XB_SPIN_CAP (1u << 18)
__device__ __forceinline__ unsigned xb_ld(unsigned* p)              { return __hip_atomic_load(p, __ATOMIC_RELAXED, __HIP_MEMORY_SCOPE_AGENT); }
__device__ __forceinline__ unsigned xb_add(unsigned* p, unsigned v) { return __hip_atomic_fetch_add(p, v, __ATOMIC_RELAXED, __HIP_MEMORY_SCOPE_AGENT); }
__device__ __forceinline__ unsigned xb_xcc_id() { return (unsigned)__builtin_amdgcn_s_getreg((3 << 11) | 20) & 0xFu; }
#define XB_SPIN(cond, bar) do { unsigned _sp = 0; while (cond) { __builtin_amdgcn_s_sleep(1); \
    if ((++_sp & 255u) == 0u) { if (xb_ld(&(bar)[XB_TMO])) break; if (_sp > XB_SPIN_CAP) { atomicAdd(&(bar)[XB_TMO], 1u); break; } } } } while (0)
struct XcdBarrier { unsigned* bar; unsigned x; volatile LAS unsigned* st; };
__device__ __forceinline__ XcdBarrier xcd_barrier_post(unsigned* bar, volatile LAS unsigned* st) {
    XcdBarrier b; b.bar = bar; b.x = xb_xcc_id(); b.st = st;
    if (threadIdx.x == 0) (void)xb_add(&bar[XB_XCNT(b.x)], 1u);
    return b;
}
__device__ __forceinline__ void xcd_barrier_complete(unsigned* bar, unsigned x, unsigned& nloc, unsigned& nx) {
    const unsigned G = gridDim.x * gridDim.y * gridDim.z;
    unsigned sum, cnt, mine, sp = 0u;
    for (;;) {
        sum = 0u; cnt = 0u; mine = 0u;
#pragma unroll
        for (unsigned j = 0; j < 16; ++j) { const unsigned c = xb_ld(&bar[XB_XCNT(j)]); sum += c; cnt += (c > 0u) ? 1u : 0u; mine = (j == x) ? c : mine; }
        if (sum == G) break;
        __builtin_amdgcn_s_sleep(1);
        if ((++sp & 255u) == 0u) { if (xb_ld(&bar[XB_TMO])) break; if (sp > XB_SPIN_CAP) { atomicAdd(&bar[XB_TMO], 1u); break; } }
    }
    nloc = mine > 0u ? mine : 1u; nx = cnt > 0u ? cnt : 1u;
}
__device__ __forceinline__ void xcd_barrier(const XcdBarrier& b) {
    asm volatile("s_waitcnt vmcnt(0)" ::: "memory");
    __syncthreads();
    if (threadIdx.x == 0) {
        unsigned* bar = b.bar;
        __builtin_amdgcn_s_waitcnt(0);
        unsigned nloc = b.st[0], nx = b.st[1];
        if (nloc == 0u) { xcd_barrier_complete(bar, b.x, nloc, nx); b.st[0] = nloc; b.st[1] = nx; }
        const unsigned old = xb_add(&bar[XB_XSUB(b.x)], 1u);
        const unsigned gen = old / nloc;
        if (old + 1u == (gen + 1u) * nloc) {
            __builtin_amdgcn_fence(__ATOMIC_RELEASE, "agent");
            asm volatile("s_waitcnt vmcnt(0)" ::: "memory");
            const unsigned og = xb_add(&bar[XB_TOP], 1u);
            const unsigned tg = og / nx;
            if (og + 1u == (tg + 1u) * nx) xb_add(&bar[XB_TOPGEN], 1u);
            else XB_SPIN(xb_ld(&bar[XB_TOPGEN]) == tg, bar);
            __builtin_amdgcn_fence(__ATOMIC_ACQUIRE, "agent");
            xb_add(&bar[XB_XGEN(b.x)], 1u);
            asm volatile("s_waitcnt vmcnt(0)" ::: "memory");
        } else {
            XB_SPIN(xb_ld(&bar[XB_XGEN(b.x)]) == gen, bar);
            __builtin_amdgcn_fence(__ATOMIC_ACQUIRE, "agent");
            asm volatile("s_waitcnt vmcnt(0)" ::: "memory");
        }
    }
    __syncthreads();
}

__device__ __forceinline__ float wave_sum(float v) { return wave_sum64(v); }
__device__ __forceinline__ void tr_item(const float* W, int ldw, int col0, int nvalid, int k0, const float* gain, int gsplit, const float* gain2, bf16* WT, int ldt, int drow0, LAS float* scr, int lane) {
#pragma unroll 8
    for (int i = 0; i < 32; ++i) { const int kk = 2 * i + (lane >> 5), n = lane & 31, k = k0 + kk;
        float v = (n < nvalid) ? W[(size_t)k * ldw + col0 + n] : 0.f;
        if (gain) v *= (k < gsplit ? gain[k] : gain2[k - gsplit]);
        scr[kk * 33 + n] = v; }
    LDS_WAIT(); asm volatile("" ::: "memory");
    const int c = lane & 7;
#pragma unroll
    for (int j = 0; j < 4; ++j) { const int n = (lane >> 3) + 8 * j; const LAS float* s = scr + (8 * c) * 33 + n;
        v4u o; o.x = pk2(s[0 * 33], s[1 * 33]); o.y = pk2(s[2 * 33], s[3 * 33]); o.z = pk2(s[4 * 33], s[5 * 33]); o.w = pk2(s[6 * 33], s[7 * 33]);
        *(GAS v4u*)(WT + (size_t)(drow0 + n) * ldt + k0 + 8 * c) = o; }
    LDS_WAIT(); asm volatile("" ::: "memory");
}
__device__ __forceinline__ void tr_item64(const float* W, int ldw, int col0, int nvalid, int k0, const float* gain, int gsplit, const float* gain2, bf16* WT, int ldt, int drow0, int lane) {
    float v[64];
    const float* src = W + (size_t)k0 * ldw + col0 + lane; const bool ok = lane < nvalid;
#pragma unroll
    for (int j = 0; j < 64; ++j) v[j] = ok ? src[(size_t)j * ldw] : 0.f;
    if (gain) {
#pragma unroll
        for (int j = 0; j < 64; ++j) { const int k = k0 + j; v[j] *= (k < gsplit ? gain[k] : gain2[k - gsplit]); }
    }
    bf16* dst = WT + (size_t)(drow0 + lane) * ldt + k0;
#pragma unroll
    for (int c = 0; c < 8; ++c) { v4u o; o.x = pk2(v[8 * c], v[8 * c + 1]); o.y = pk2(v[8 * c + 2], v[8 * c + 3]); o.z = pk2(v[8 * c + 4], v[8 * c + 5]); o.w = pk2(v[8 * c + 6], v[8 * c + 7]);
        *(GAS v4u*)(dst + 8 * c) = o; }
}
__device__ __forceinline__ void row_to_bf16(const float* xrow, bf16* orow, float* ssp, int lane) {
    const GAS f32x4* xr = (const GAS f32x4*)xrow + lane;
    f32x4 v[4]; float s = 0.f;
#pragma unroll
    for (int j = 0; j < 4; ++j) { v[j] = xr[64 * j]; s += (v[j].x * v[j].x + v[j].y * v[j].y) + (v[j].z * v[j].z + v[j].w * v[j].w); }
    s = wave_sum(s);
    GAS unsigned long long* o8 = (GAS unsigned long long*)orow + lane;
#pragma unroll
    for (int j = 0; j < 4; ++j) o8[64 * j] = (unsigned long long)pk2(v[j].x, v[j].y) | ((unsigned long long)pk2(v[j].z, v[j].w) << 32);
    if (lane == 0) *ssp = s;
}

struct Args { const float* in[26]; float* out; unsigned char* ws; int ph_lo, ph_hi, li, pad; };

enum { PH_PRO = 0, PH_L0 = 1, PH_PER_LAYER = 9, PH_FINAL = PH_L0 + 2 * PH_PER_LAYER, PH_COUNT = PH_FINAL + 1 };

#define WSP() ({ unsigned char* w_ = args.ws; asm volatile("" : "+s"(w_)); w_; })
#define INP(i) ({ int i_ = __builtin_amdgcn_readfirstlane(i); asm volatile("" : "+s"(i_)); args.in[i_]; })
#define XPTR() ({ float* x_ = args.out; asm volatile("" : "+s"(x_)); x_; })
#define TID() ({ int w_ = wid_s; asm volatile("" : "+s"(w_)); int t_ = (w_ << 6) | (int)__builtin_amdgcn_mbcnt_hi(~0u, __builtin_amdgcn_mbcnt_lo(~0u, 0u)); asm volatile("" : "+v"(t_)); t_; })

constexpr size_t T1K = (size_t)256 * 1024 * 2, TFF = (size_t)256 * 2816 * 2;
using G_1024 = pg8::Gemm<1024, 1024, 1024>; using G_down = pg8::Gemm<2816, 2816, 2816>; using G_qk = pg8::Gemm<2048, 1024, 256>; using G_vo = pg8::Gemm<1024, 2048, 256>;
using S_up = pg8::SchedT<0, 64, 22, T1K, T1K>; using S_mkv = pg8::SchedT<0, 8, 8, T1K, T1K>; using S_down = pg8::SchedT<0, 64, 4, TFF, TFF>; using S_win = pg8::SchedT<0, 64, 11, T1K, T1K>;
using S_sq = pg8::SchedT<0, 64, 4, T1K, T1K>; using S_xb = pg8::SchedT<1, 64, 4, T1K, T1K, (size_t)1024 * 1024 * 2>; using S_qk = pg8::SchedT<2, 128, 1, 0, 0>; using S_vo = pg8::SchedT<3, 128, 1, 0, 0>;

#ifndef PROBE_MASK
#define PROBE_MASK 0
#endif
#ifndef PROBE_REPS
#define PROBE_REPS 1
#endif
#ifndef PROBE_BARS
#define PROBE_BARS 0
#endif
#define NREP(k) (((PROBE_MASK >> (k)) & 1) ? (PROBE_REPS + 1) : 1)
#define REP_LOOP(k) _Pragma("unroll 1") for (int rep_ = 0; rep_ < NREP(k); ++rep_)
#define SHADOW(k) (NREP(k) > 1 && rep_ + 1 < NREP(k))
#define REP_SEAM(k) do { if (SHADOW(k)) GRIDBAR(); } while (0)
constexpr size_t CTL_DUMMY = 1 * MiB;

__global__ void __launch_bounds__(NWAVES * 64, 2) mega_fwd(Args args) {
    extern __shared__ __attribute__((aligned(16))) unsigned char lds[];
    LAS unsigned char* ldsp = (LAS unsigned char*)lds;
    volatile LAS unsigned* MISC = (volatile LAS unsigned*)(ldsp + MISC_OFF);
    constexpr int G = 256; const int bx = blockIdx.x;
    const int wid_s = __builtin_amdgcn_readfirstlane(threadIdx.x >> 6);
    for (int u = threadIdx.x; u < (LDS_BYTES - LDSCTL_OFF) / 4; u += NWAVES * 64) ((LAS unsigned*)(ldsp + LDSCTL_OFF))[u] = 0u;
    __syncthreads();
    (void)xcd_barrier_post((unsigned*)(args.ws + WS_CTL) + CW_BAR + args.li * XCD_BAR_WORDS, MISC + 8);
#define PHLO() ({ int i_ = 0; asm volatile("" : "+s"(i_)); (&args.ph_lo)[i_]; })
#define PHHI() ({ int i_ = 1; asm volatile("" : "+s"(i_)); (&args.ph_lo)[i_]; })
#define PHLI() ({ int i_ = 2; asm volatile("" : "+s"(i_)); (&args.ph_lo)[i_]; })
#define IN(k) (PHLO() <= (k) && (k) < PHHI())
#define GRIDBAR() do { XcdBarrier bar_; bar_.bar = (unsigned*)(WSP() + WS_CTL) + CW_BAR + PHLI() * XCD_BAR_WORDS; bar_.x = xb_xcc_id(); bar_.st = MISC + 8; xcd_barrier(bar_); } while (0)
#define SEAM(k) do { if (IN(k) && IN((k) + 1)) { XcdBarrier bar_; bar_.bar = (unsigned*)(WSP() + WS_CTL) + CW_BAR + PHLI() * XCD_BAR_WORDS; bar_.x = xb_xcc_id(); bar_.st = MISC + 8; xcd_barrier(bar_); } } while (0)
    constexpr float QSCALE = 0.125f * 1.4426950408889634f, XSCALE = 0.0625f * 1.4426950408889634f;

    if (IN(PH_PRO)) REP_LOOP(9) {
        unsigned char* ws = WSP(); const int tid = TID();
        const int lane = tid & 63, wave = __builtin_amdgcn_readfirstlane(tid >> 6);
        const int gw = bx * NWAVES + wave, NGW = G * NWAVES;
        constexpr int I_GU = 2 * 16 * 44, I_DN = 44 * 16, I_IN = 16 * 41, I_SQ = 16 * 16, I_KV = 16 * 32, I_WQ = 256;
        constexpr int L_ITEMS = 2 * (I_GU + I_DN) + I_IN + I_SQ + I_KV + I_SQ + I_WQ, W_ITEMS = NLAYER * L_ITEMS, X_ITEMS = M / 4, MEM_ITEMS = NMEMROWS / 4;
#pragma unroll 1
        for (int it = gw; it < W_ITEMS + X_ITEMS + MEM_ITEMS; it += NGW) {
            if (it < W_ITEMS) {
                const int l = it / L_ITEMS; int r = it % L_ITEMS;
                unsigned char* wl = ws + WS_W + (size_t)l * W_LAYER;
                if (r < 2 * (I_GU + I_DN)) {
                    const int f = r / (I_GU + I_DN); r %= (I_GU + I_DN);
                    if (r < I_GU) { const int which = r / (16 * 44), q = r % (16 * 44), kb = q / 44, nb = q % 44, j0 = nb * 64;
                        const float* w = INP(which ? (f ? 23 : 4) : (f ? 22 : 3)) + (size_t)l * DM * DFF; const float* gn = INP(f ? 21 : 2) + l * DM;
                        tr_item64(w, DFF, j0, 64, kb * 64, gn, 1 << 30, gn, (bf16*)(wl + (f ? WO_2A : WO_1A)), DM, 256 * (j0 / 128) + which * 128 + (j0 % 128), lane); }
                    else { r -= I_GU; const int kb = r / 16, nb = r % 16; const float* w = INP(f ? 24 : 5) + (size_t)l * DFF * DM;
                        tr_item64(w, DM, nb * 64, 64, kb * 64, nullptr, 0, w, (bf16*)(wl + (f ? WO_2B : WO_1B)), DFF, nb * 64, lane); }
                    continue;
                }
                r -= 2 * (I_GU + I_DN);
                if (r < I_IN) {
                    const int kb = r / 41, nb = r % 41; int col0, nvalid = 64, drow0;
                    if (nb < 24) { col0 = nb * 64; drow0 = col0; }
                    else if (nb == 24) { col0 = 1536; nvalid = 8; drow0 = 2560; }
                    else if (nb < 33) { const int ch = (nb - 25) * 64; col0 = 1544 + ch; drow0 = 1536 + 256 * (ch / 128) + (ch % 128); }
                    else { const int ch = (nb - 33) * 64; col0 = 2056 + ch; drow0 = 1536 + 256 * (ch / 128) + 128 + (ch % 128); }
                    const float* w = INP(7) + (size_t)l * DM * 2568; const float* gn = INP(6) + l * DM;
                    tr_item64(w, 2568, col0, nvalid, kb * 64, gn, 1 << 30, gn, (bf16*)(wl + WO_IN), DM, drow0, lane); continue; }
                r -= I_IN;
                if (r < I_SQ) { const int kb = r / 16, nb = r % 16; const float* w = INP(15) + (size_t)l * DM * DM;
                    tr_item64(w, DM, nb * 64, 64, kb * 64, INP(13) + l * 512, 512, INP(14) + l * 512, (bf16*)(wl + WO_OUT), DM, nb * 64, lane); continue; }
                r -= I_SQ;
                if (r < I_KV) { const int kb = r / 32, nb = r % 32; const float* w = INP(19) + (size_t)l * DM * 2048; const float* gn = INP(17) + l * DM;
                    tr_item64(w, 2048, nb * 64, 64, kb * 64, gn, 1 << 30, gn, (bf16*)(wl + WO_XKV), DM, nb * 64, lane); continue; }
                r -= I_KV;
                if (r < I_SQ) { const int kb = r / 16, nb = r % 16; const float* w = INP(20) + (size_t)l * DM * DM;
                    tr_item64(w, DM, nb * 64, 64, kb * 64, nullptr, 0, w, (bf16*)(wl + WO_XO), DM, nb * 64, lane); continue; }
                r -= I_SQ;
                { const float* w = INP(18) + (size_t)l * DM * DM; const float* gn = INP(16) + l * DM; bf16* WQ = (bf16*)(wl + WO_XQ);
                  f32x4 v[4][4];
#pragma unroll
                  for (int q = 0; q < 4; ++q)
#pragma unroll
                      for (int j = 0; j < 4; ++j) v[q][j] = *((const GAS f32x4*)(w + (size_t)(4 * r + q) * DM) + lane + 64 * j);
#pragma unroll
                  for (int q = 0; q < 4; ++q) { const float g = gn[4 * r + q] * XSCALE; GAS unsigned long long* o8 = (GAS unsigned long long*)(WQ + (size_t)(4 * r + q) * DM) + lane;
#pragma unroll
                      for (int j = 0; j < 4; ++j) { const f32x4 t = v[q][j] * g; o8[64 * j] = (unsigned long long)pk2(t.x, t.y) | ((unsigned long long)pk2(t.z, t.w) << 32); } } }
            } else {
                int r = it - W_ITEMS; const bool ismem = r >= X_ITEMS; if (ismem) r -= X_ITEMS;
                const float* src = INP(ismem ? 1 : 0) + (size_t)(4 * r) * DM; bf16* dst = (bf16*)(ws + (ismem ? WS_MEMB : WS_XB)) + (size_t)(4 * r) * DM; float* ssp = (float*)(ws + (ismem ? CTL_SSM : CTL_SS)) + 4 * r;
                f32x4 v[4][4]; float s[4];
#pragma unroll
                for (int q = 0; q < 4; ++q)
#pragma unroll
                    for (int j = 0; j < 4; ++j) v[q][j] = *((const GAS f32x4*)(src + (size_t)q * DM) + lane + 64 * j);
#pragma unroll
                for (int q = 0; q < 4; ++q) { s[q] = 0.f;
#pragma unroll
                    for (int j = 0; j < 4; ++j) s[q] += (v[q][j].x * v[q][j].x + v[q][j].y * v[q][j].y) + (v[q][j].z * v[q][j].z + v[q][j].w * v[q][j].w); }
#pragma unroll
                for (int q = 0; q < 4; ++q) { s[q] = wave_sum64(s[q]); GAS unsigned long long* o8 = (GAS unsigned long long*)(dst + (size_t)q * DM) + lane;
#pragma unroll
                    for (int j = 0; j < 4; ++j) o8[64 * j] = (unsigned long long)pk2(v[q][j].x, v[q][j].y) | ((unsigned long long)pk2(v[q][j].z, v[q][j].w) << 32);
                    if (lane == 0) ssp[q] = s[q]; }
            }
        }
        REP_SEAM(9);
    }
    SEAM(PH_PRO);

#pragma unroll 1
    for (int l = 0; l < NLAYER; ++l) {
        const int P = PH_L0 + l * PH_PER_LAYER;
#pragma unroll 1
        for (int f = 0; f < 2; ++f) {
            const int pu = P + (f ? 7 : 0), pd = pu + 1;
            if (IN(pu)) REP_LOOP(0) {
                unsigned char* ws = WSP(); unsigned char* wl = ws + WS_W + (size_t)l * W_LAYER;
                G_1024 g; S_up S; S.init(bx, ws + WS_XB, wl + (f ? WO_2A : WO_1A));
                pg8::EpiSwiGLU E{(bf16*)(ws + WS_R1 + R1_H), (float*)(ws + CTL_SS) + (size_t)(4 * l + (f ? 3 : 0)) * M};
                pg8::gemm_phase<pg8::EpiSwiGLU, decltype(S), decltype(g)>(ldsp + RING_OFF, g, S, E, TID());
                if (l == 0 && f == 0) {
#pragma unroll 1
                    for (int l2 = 0; l2 < NLAYER; ++l2) {
                        unsigned char* ws2 = WSP();
                        S_mkv S2; S2.init((bx + 128 - 64 * l2) % G, ws2 + WS_MEMB, ws2 + WS_W + (size_t)l2 * W_LAYER + WO_XKV);
                        pg8::EpiRowScale E2{(bf16*)(ws2 + WS_MKV) + (size_t)l2 * 2048 * 2048, (float*)(ws2 + CTL_SSM), 1.0f};
                        pg8::gemm_phase<pg8::EpiRowScale, decltype(S2), decltype(g)>(ldsp + RING_OFF, g, S2, E2, TID());
                    }
                }
                REP_SEAM(0);
            }
            SEAM(pu);
            if (IN(pd)) REP_LOOP(1) {
                unsigned char* ws = WSP(); unsigned char* wl = ws + WS_W + (size_t)l * W_LAYER; float* X = XPTR();
                G_down g; S_down S; S.init(bx, ws + WS_R1 + R1_H, wl + (f ? WO_2B : WO_1B));
                pg8::EpiResid<0> E{(l == 0 && f == 0) ? INP(0) : X, X, (bf16*)(ws + WS_XB), SHADOW(1) ? (float*)(ws + CTL_DUMMY) : (float*)(ws + CTL_SS) + (size_t)(4 * l + (f ? 4 : 1)) * M, nullptr, SHADOW(1) ? 0.f : 0.5f};
                pg8::gemm_phase<pg8::EpiResid<0>, decltype(S), decltype(g)>(ldsp + RING_OFF, g, S, E, TID());
                REP_SEAM(1);
            }
            SEAM(pd);
            if (f == 1) break;
            if (IN(P + 2)) REP_LOOP(2) {
                unsigned char* ws = WSP(); unsigned char* wl = ws + WS_W + (size_t)l * W_LAYER; unsigned char* R1 = ws + WS_R1;
                G_1024 g; S_win S; S.init(bx, ws + WS_XB, wl + WO_IN);
                pg8::EpiWin E{(bf16*)(R1 + R1_Y), (bf16*)(R1 + R1_KB), (bf16*)(R1 + R1_VB), (bf16*)(R1 + R1_UB), (float*)(R1 + R1_LOGF), (float*)(ws + CTL_SS) + (size_t)(4 * l + 1) * M, INP(8) + l * 8, QSCALE};
                pg8::gemm_phase<pg8::EpiWin, decltype(S), decltype(g)>(ldsp + RING_OFF, g, S, E, TID());
                REP_SEAM(2);
            }
            SEAM(P + 2);
            if (IN(P + 3)) REP_LOOP(3) {
                unsigned char* ws = WSP(); unsigned char* R1 = ws + WS_R1;
                char* shm = (char*)lds + RING_OFF;
                const int vcu = (G % 8 == 0) ? (bx % 8) * (G / 8) + bx / 8 : bx;
                const int bh = vcu >> 2, s4 = vcu & 3;
                attn_body::bf16* YB = (attn_body::bf16*)(R1 + R1_Y); const attn_body::bf16* KB = (const attn_body::bf16*)(R1 + R1_KB); const attn_body::bf16* VB = (const attn_body::bf16*)(R1 + R1_VB);
                float* ssa = SHADOW(3) ? (float*)(ws + CTL_DUMMY) : (float*)(ws + CTL_SSA) + (size_t)l * M;
                attn_body::bf16* OB = SHADOW(3) ? YB + 512 : YB;
                attn_body::scan_bias((const float*)(R1 + R1_LOGF), bh, shm, TID());
#pragma unroll 1
                for (int iu = 0; iu < 2; ++iu) attn_body::attn_unit<8>(bh >> 3, bh & 7, iu ? 7 - s4 : s4, YB, KB, VB, OB, ssa, shm, TID());
                __syncthreads();
                attn_body::conv_unit(bx, (const attn_body::bf16*)(R1 + R1_UB), INP(9) + (size_t)l * 31 * 512, INP(10) + l * 512, INP(11) + l * 512, INP(12) + l * 512, YB, shm, TID());
                REP_SEAM(3);
            }
            SEAM(P + 3);
            if (IN(P + 4)) REP_LOOP(4) {
                { unsigned char* ws = WSP(); unsigned char* wl = ws + WS_W + (size_t)l * W_LAYER; float* X = XPTR();
                  G_1024 g; S_sq S; S.init(bx, ws + WS_R1 + R1_Y, wl + WO_OUT);
                  pg8::EpiResid<8> E{X, X, (bf16*)(ws + WS_XB), SHADOW(4) ? (float*)(ws + CTL_DUMMY) : (float*)(ws + CTL_SS) + (size_t)(4 * l + 2) * M, (float*)(ws + CTL_SSA) + (size_t)l * M, SHADOW(4) ? 0.f : 1.0f};
                  pg8::gemm_phase<pg8::EpiResid<8>, decltype(S), decltype(g)>(ldsp + RING_OFF, g, S, E, TID()); }
                { unsigned char* ws = WSP(); unsigned char* wl = ws + WS_W + (size_t)l * W_LAYER;
                  G_qk g; S_qk S; S.init(bx, (bf16*)(ws + WS_MKV) + (size_t)l * 2048 * 2048, wl + WO_XQ);
                  pg8::EpiAux E{(bf16*)(ws + WS_R1 + R1_WQK), 1.0f};
                  pg8::gemm_phase<pg8::EpiAux, decltype(S), decltype(g)>(ldsp + RING_OFF, g, S, E, TID()); }
                { unsigned char* ws = WSP(); unsigned char* wl = ws + WS_W + (size_t)l * W_LAYER;
                  G_vo g; S_vo S; S.init((bx + 128) % G, wl + WO_XO, (bf16*)(ws + WS_MKV) + (size_t)l * 2048 * 2048);
                  pg8::EpiAux E{(bf16*)(ws + WS_R1 + R1_WVO), 1.0f};
                  pg8::gemm_phase<pg8::EpiAux, decltype(S), decltype(g)>(ldsp + RING_OFF, g, S, E, TID()); }
                REP_SEAM(4);
            }
            SEAM(P + 4);
            if (IN(P + 5)) REP_LOOP(5) {
                unsigned char* ws = WSP();
                G_1024 g; S_xb S; S.init(bx, ws + WS_XB, ws + WS_R1 + R1_WQK);
                pg8::EpiSoftmax E{(bf16*)(ws + WS_R1 + R1_XP), (float*)(ws + CTL_SS) + (size_t)(4 * l + 2) * M, (LAS float*)(ldsp + EPI_SCR_OFF)};
                pg8::gemm_phase<pg8::EpiSoftmax, decltype(S), decltype(g)>(ldsp + RING_OFF, g, S, E, TID());
                REP_SEAM(5);
            }
            SEAM(P + 5);
            if (IN(P + 6)) REP_LOOP(6) {
                unsigned char* ws = WSP(); float* X = XPTR();
                G_1024 g; S_xb S; S.init(bx, ws + WS_R1 + R1_XP, ws + WS_R1 + R1_WVO);
                pg8::EpiResid<0> E{X, X, (bf16*)(ws + WS_XB), SHADOW(6) ? (float*)(ws + CTL_DUMMY) : (float*)(ws + CTL_SS) + (size_t)(4 * l + 3) * M, nullptr, SHADOW(6) ? 0.f : 1.0f};
                pg8::gemm_phase<pg8::EpiResid<0>, decltype(S), decltype(g)>(ldsp + RING_OFF, g, S, E, TID());
                REP_SEAM(6);
            }
            SEAM(P + 6);
        }
    }
    for (int eb_ = 0; eb_ < PROBE_BARS; ++eb_) GRIDBAR();
    if (IN(PH_FINAL)) {
        unsigned char* ws = WSP(); float* X = XPTR(); const int tid = TID();
        const int lane = tid & 63, wave = __builtin_amdgcn_readfirstlane(tid >> 6);
        const int gw = bx * NWAVES + wave, NGW = G * NWAVES; const float* ssf = (float*)(ws + CTL_SS) + (size_t)8 * M; const float* gn = INP(25);
        f32x4 gv[4];
#pragma unroll
        for (int j = 0; j < 4; ++j) gv[j] = *((const GAS f32x4*)gn + lane + 64 * j);
        for (int m = gw; m < M; m += NGW) { GAS f32x4* xr = (GAS f32x4*)(X + (size_t)m * DM) + lane; const float rs = __builtin_amdgcn_rsqf(ssf[m] * (1.0f / 1024.0f) + 1e-6f);
#pragma unroll
            for (int j = 0; j < 4; ++j) xr[64 * j] = xr[64 * j] * rs * gv[j]; }
    }
#undef IN
#undef SEAM
}

static int g_grid = 0;
static bool mega_setup() {
    if (g_grid) return g_grid > 0;
    int dev = 0, cus = 0, per_cu = 0;
    if (hipGetDevice(&dev) != hipSuccess || hipDeviceGetAttribute(&cus, hipDeviceAttributeMultiprocessorCount, dev) != hipSuccess) { g_grid = -1; return false; }
    if (hipFuncSetAttribute((const void*)mega_fwd, hipFuncAttributeMaxDynamicSharedMemorySize, LDS_BYTES) != hipSuccess) { fprintf(stderr, "hipFuncSetAttribute failed\n"); g_grid = -1; return false; }
    if (hipOccupancyMaxActiveBlocksPerMultiprocessor(&per_cu, (const void*)mega_fwd, NWAVES * 64, LDS_BYTES) != hipSuccess || per_cu < 1) { fprintf(stderr, "occupancy query: %d blocks per CU\n", per_cu); (void)hipGetLastError(); g_grid = -1; return false; }
    g_grid = cus;
    if (g_grid != 256) { fprintf(stderr, "kernel_launch: %d CUs; the phase program is laid out for exactly 256: nothing launched\n", g_grid); g_grid = -1; return false; }
    return true;
}
static void mega_launch(void* const* d_in, void* d_out, void* d_ws, hipStream_t stream, int lo, int hi, int li) {
    Args a{};
    for (int i = 0; i < 26; ++i) a.in[i] = (const float*)d_in[i];
    a.out = (float*)d_out; a.ws = (unsigned char*)d_ws; a.ph_lo = lo; a.ph_hi = hi; a.li = li;
    hipLaunchKernelGGL(mega_fwd, dim3(g_grid), dim3(NWAVES * 64), LDS_BYTES, stream, a);
}
extern "C" void kernel_launch(void* const* d_in, const int* in_sizes, int n_in, void* d_out, int out_size, void* d_ws, size_t ws_size, hipStream_t stream) {
    if (!mega_setup()) return;
    if (ws_size < WS_END) { fprintf(stderr, "kernel_launch: workspace too small (%zu < %zu)\n", ws_size, (size_t)WS_END); return; }
    (void)hipMemsetAsync((char*)d_ws + WS_CTL, 0, CTL_ZERO_BYTES, stream);
    mega_launch(d_in, d_out, d_ws, stream, 0, PH_COUNT, 0);
}
```

```cpp
#include <hip/hip_runtime.h>
#include <cstdio>
#include <cstdint>
template <int X> __device__ __forceinline__ float swz_xor(float v) { return __int_as_float(__builtin_amdgcn_ds_swizzle(__float_as_int(v), (X << 10) | 0x1f)); }
__device__ __forceinline__ float sum_x32(float v) { auto rr = __builtin_amdgcn_permlane32_swap(__float_as_uint(v), __float_as_uint(v), false, false); return __uint_as_float(rr[0]) + __uint_as_float(rr[1]); }
__device__ __forceinline__ float max_x32(float v) { auto rr = __builtin_amdgcn_permlane32_swap(__float_as_uint(v), __float_as_uint(v), false, false); return fmaxf(__uint_as_float(rr[0]), __uint_as_float(rr[1])); }
__device__ __forceinline__ float wave_sum64(float v) { v += swz_xor<1>(v); v += swz_xor<2>(v); v += swz_xor<4>(v); v += swz_xor<8>(v); v += swz_xor<16>(v); return sum_x32(v); }
namespace pg8 {
#define PG8_LAS __attribute__((address_space(3)))
typedef unsigned short bf16_t;
typedef short bf16x8 __attribute__((ext_vector_type(8)));
typedef float f32x4 __attribute__((ext_vector_type(4)));
typedef float f32x2 __attribute__((ext_vector_type(2)));
typedef unsigned u32x4 __attribute__((ext_vector_type(4)));
constexpr int BM = 256, BK = 64, HALF = 128, HTB = HALF * BK * 2  , STAGE_BYTES = 8 * HTB, NXCD = 8, WGM = 8;

__host__ __device__ __forceinline__ int lds_byte(int r, int c) { const int st = (r >> 4) * 2 + (c >> 5), rr = r & 15, cc = c & 31, ob = rr * 64 + cc * 2; return st * 1024 + (ob ^ (((ob >> 9) & 1) << 5)); }
__host__ __device__ __forceinline__ void stage_rc(int b, int& R, int& C) { const int st = b / 1024, sb = b % 1024, swz = sb ^ (((sb >> 9) & 1) << 5); R = (st >> 1) * 16 + swz / 64; C = (st & 1) * 32 + (swz % 64) / 2; }
__host__ __device__ __forceinline__ int perm32(int rho) { const int n = rho >> 4, i = rho & 15; return 8 * (i >> 2) + 4 * n + (i & 3); }

struct Unit { int pm, pn; const char* a; const char* b; int aux; };
template <int LDA, int LDB, int K_> struct Gemm { static constexpr int lda = LDA, ldb = LDB, K = K_; };

__device__ __forceinline__ unsigned cvt_pk_bf16(float lo, float hi) { unsigned r; asm volatile("v_cvt_pk_bf16_f32 %0, %1, %2" : "=v"(r) : "v"(lo), "v"(hi)); return r; }


template <class Epi, class Sched, class Gemm, bool ALIGN_EPI = true, bool SP2 = true>
__device__ __forceinline__ void gemm_phase(PG8_LAS unsigned char* lds, const Gemm g, const Sched& S, const Epi& E, const int tid) {
    const int wid = __builtin_amdgcn_readfirstlane(tid >> 6), lane = tid & 63, wr = wid >> 2, wc = wid & 3, fr = lane & 15, fq = lane >> 4;
    constexpr int K = Gemm::K, nt = K / BK;
    unsigned voffA[2], voffB[2];
#pragma unroll
    for (int i = 0; i < 2; ++i) { int R, C; stage_rc(tid * 16 + i * 8192, R, C); const int Rb = Epi::PERM ? ((R & ~31) + perm32(R & 31)) : R;
        voffA[i] = (unsigned)(R * Gemm::lda + C) * 2u; voffB[i] = (unsigned)(Rb * Gemm::ldb + C) * 2u; }
    constexpr size_t kstep = (size_t)(BK * 2);
    constexpr size_t hstepA = (size_t)HALF * Gemm::lda * 2, hstepB = (size_t)HALF * Gemm::ldb * 2;
    const unsigned ldsw = (unsigned)wid * 1024u;
    const int aoff = lds_byte(wr * 64 + fr, fq * 8), boff = lds_byte(wc * 32 + fr, fq * 8);
#define PG8_SA(b, h) (((b) * 2 + (h)) * HTB)
#define PG8_SB(b, h) ((4 + (b) * 2 + (h)) * HTB)
#define PG8_STAGE(bufoff, gbase, voff) do { _Pragma("unroll") for (int _i = 0; _i < 2; ++_i) \
        __builtin_amdgcn_global_load_lds((const unsigned*)((const char*)(gbase) + (voff)[_i]), (PG8_LAS unsigned*)(lds + (bufoff) + ldsw + _i * 8192), 16, 0, 0); } while (0)
#define PG8_LDA(dst, b, h) do { _Pragma("unroll") for (int m = 0; m < 4; ++m) _Pragma("unroll") for (int k = 0; k < 2; ++k) dst[m][k] = *(const PG8_LAS bf16x8*)(lds + PG8_SA(b, h) + aoff + m * 2048 + k * 1024); } while (0)
#define PG8_LDB(dst, b, h) do { _Pragma("unroll") for (int n = 0; n < 2; ++n) _Pragma("unroll") for (int k = 0; k < 2; ++k) dst[n][k] = *(const PG8_LAS bf16x8*)(lds + PG8_SB(b, h) + boff + n * 2048 + k * 1024); } while (0)
#define PG8_MMA(ai, bj, At, Bt) do { __builtin_amdgcn_s_setprio(1); _Pragma("unroll") for (int m = 0; m < 4; ++m) _Pragma("unroll") for (int n = 0; n < 2; ++n) _Pragma("unroll") for (int k = 0; k < 2; ++k) \
        acc[ai][bj][m][n] = __builtin_amdgcn_mfma_f32_16x16x32_bf16(Bt[n][k], At[m][k], acc[ai][bj][m][n], 0, 0, 0); __builtin_amdgcn_s_setprio(0); } while (0)
#define PG8_WAIT_V(n) asm volatile("s_waitcnt vmcnt(" #n ")" ::: "memory")
#define PG8_WAIT_L(n) asm volatile("s_waitcnt lgkmcnt(" #n ")" ::: "memory")
#define PG8_BAR __builtin_amdgcn_s_barrier()
#define PG8_SCHED __builtin_amdgcn_sched_barrier(0)
    Unit cur, nxt; int ui = 0;
    if (!S.next(0, cur)) return;
    f32x4 acc[2][2][4][2];
#pragma unroll
    for (int a = 0; a < 2; ++a)
#pragma unroll
        for (int b = 0; b < 2; ++b)
#pragma unroll
            for (int m = 0; m < 4; ++m)
#pragma unroll
                for (int n = 0; n < 2; ++n) acc[a][b][m][n] = (f32x4){0.f, 0.f, 0.f, 0.f};
    bf16x8 At[4][2], B0[2][2], B1[2][2];
    const char* cA = cur.a; const char* cB = cur.b;
    if constexpr (SP2) {
        PG8_STAGE(PG8_SB(0, 0), cB, voffB); PG8_STAGE(PG8_SB(0, 1), cB + hstepB, voffB); PG8_STAGE(PG8_SA(0, 0), cA, voffA); PG8_STAGE(PG8_SA(0, 1), cA + hstepA, voffA);
        if (wr == 1) PG8_BAR;
        PG8_WAIT_V(2); PG8_BAR;
        PG8_STAGE(PG8_SB(1, 0), cB + kstep, voffB); PG8_STAGE(PG8_SA(1, 0), cA + kstep, voffA); PG8_STAGE(PG8_SB(1, 1), cB + hstepB + kstep, voffB);
        PG8_WAIT_V(6); PG8_BAR;
    } else {
        PG8_STAGE(PG8_SB(0, 0), cB, voffB); PG8_STAGE(PG8_SA(0, 0), cA, voffA); PG8_STAGE(PG8_SB(0, 1), cB + hstepB, voffB); PG8_STAGE(PG8_SA(0, 1), cA + hstepA, voffA);
        if (wr == 1) PG8_BAR;
        PG8_WAIT_V(4); PG8_BAR;
        PG8_STAGE(PG8_SB(1, 0), cB + kstep, voffB); PG8_STAGE(PG8_SA(1, 0), cA + kstep, voffA); PG8_STAGE(PG8_SB(1, 1), cB + hstepB + kstep, voffB);
        PG8_WAIT_V(6); PG8_BAR;
    }
    for (;;) {
        const bool has_next = S.next(ui + 1, nxt);
        const char* nA = has_next ? nxt.a : cA; const char* nB = has_next ? nxt.b : cB;
#pragma unroll 1
        for (int t = 0; t < nt; t += 2) {
            const bool last = (t == nt - 2);
            const char* a1 = cA + (size_t)(t + 1) * kstep;
            const char* a2 = last ? nA : cA + (size_t)(t + 2) * kstep; const char* b2 = last ? nB : cB + (size_t)(t + 2) * kstep;
            const char* a3 = a2 + kstep; const char* b3 = b2 + kstep;
            if constexpr (Epi::MIDK > 0) { if (t == Epi::MIDK) E.midk(acc, cur, wr, wc, fr, fq); }
            if constexpr (SP2) {
            PG8_LDB(B0, 0, 0); PG8_LDB(B1, 0, 1); PG8_SCHED; PG8_LDA(At, 0, 0); PG8_STAGE(PG8_SA(1, 1), a1 + hstepA, voffA);
            PG8_WAIT_V(8); PG8_WAIT_L(0); PG8_BAR; PG8_MMA(0, 0, At, B0); PG8_MMA(0, 1, At, B1); PG8_BAR; PG8_SCHED;
            PG8_LDA(At, 0, 1); PG8_STAGE(PG8_SB(0, 0), b2, voffB); PG8_STAGE(PG8_SB(0, 1), b2 + hstepB, voffB); PG8_STAGE(PG8_SA(0, 0), a2, voffA);
            PG8_WAIT_V(8); PG8_WAIT_L(0); PG8_BAR; PG8_MMA(1, 0, At, B0); PG8_MMA(1, 1, At, B1); PG8_BAR; PG8_SCHED;
            PG8_LDB(B0, 1, 0); PG8_LDB(B1, 1, 1); PG8_SCHED; PG8_LDA(At, 1, 0); PG8_STAGE(PG8_SA(0, 1), a2 + hstepA, voffA);
            PG8_WAIT_V(8); PG8_WAIT_L(0); PG8_BAR; PG8_MMA(0, 0, At, B0); PG8_MMA(0, 1, At, B1); PG8_BAR; PG8_SCHED;
            PG8_LDA(At, 1, 1); PG8_STAGE(PG8_SB(1, 0), b3, voffB); PG8_STAGE(PG8_SB(1, 1), b3 + hstepB, voffB); PG8_STAGE(PG8_SA(1, 0), a3, voffA);
            PG8_WAIT_V(8); PG8_WAIT_L(0); PG8_BAR; PG8_MMA(1, 0, At, B0); PG8_MMA(1, 1, At, B1); PG8_BAR; PG8_SCHED;
            } else {
            PG8_LDB(B0, 0, 0); PG8_SCHED; PG8_LDA(At, 0, 0); PG8_STAGE(PG8_SA(1, 1), a1 + hstepA, voffA);
            PG8_WAIT_L(8); PG8_BAR; PG8_WAIT_L(0); PG8_MMA(0, 0, At, B0); PG8_BAR; PG8_SCHED;
            PG8_LDB(B1, 0, 1); PG8_STAGE(PG8_SB(0, 0), b2, voffB);
            PG8_BAR; PG8_WAIT_L(0); PG8_MMA(0, 1, At, B1); PG8_BAR;
            PG8_LDA(At, 0, 1); PG8_STAGE(PG8_SA(0, 0), a2, voffA);
            PG8_BAR; PG8_WAIT_L(0); PG8_MMA(1, 0, At, B0); PG8_BAR; PG8_SCHED;
            PG8_STAGE(PG8_SB(0, 1), b2 + hstepB, voffB);
            PG8_WAIT_V(6); PG8_BAR; PG8_MMA(1, 1, At, B1); PG8_BAR;
            PG8_LDB(B0, 1, 0); PG8_SCHED; PG8_LDA(At, 1, 0); PG8_STAGE(PG8_SA(0, 1), a2 + hstepA, voffA);
            PG8_WAIT_L(8); PG8_BAR; PG8_WAIT_L(0); PG8_MMA(0, 0, At, B0); PG8_BAR; PG8_SCHED;
            PG8_LDB(B1, 1, 1); PG8_STAGE(PG8_SB(1, 0), b3, voffB);
            PG8_BAR; PG8_WAIT_L(0); PG8_MMA(0, 1, At, B1); PG8_BAR;
            PG8_LDA(At, 1, 1); PG8_STAGE(PG8_SA(1, 0), a3, voffA);
            PG8_BAR; PG8_WAIT_L(0); PG8_MMA(1, 0, At, B0); PG8_BAR; PG8_SCHED;
            PG8_STAGE(PG8_SB(1, 1), b3 + hstepB, voffB);
            PG8_WAIT_V(6); PG8_BAR; PG8_MMA(1, 1, At, B1); PG8_BAR;
            }
        }
        if constexpr (ALIGN_EPI) { if (wr == 0) PG8_BAR; }
        { int fr_ = fr, fq_ = fq; asm volatile("" : "+v"(fr_), "+v"(fq_));
#if defined(PROBE_NOEPI) && PROBE_NOEPI
        if (!E.shadow_skip) E(acc, cur, wr, wc, fr_, fq_);
#else
        E(acc, cur, wr, wc, fr_, fq_);
#endif
        }
        if (!has_next) break;
#pragma unroll
        for (int a = 0; a < 2; ++a)
#pragma unroll
            for (int b = 0; b < 2; ++b)
#pragma unroll
                for (int m = 0; m < 4; ++m)
#pragma unroll
                    for (int n = 0; n < 2; ++n) acc[a][b][m][n] = (f32x4){0.f, 0.f, 0.f, 0.f};
        cur = nxt; cA = nA; cB = nB; ++ui;
        if constexpr (ALIGN_EPI) { if (wr == 1) PG8_BAR; }
    }
    PG8_WAIT_V(0);
    if constexpr (!ALIGN_EPI) { if (wr == 0) PG8_BAR; }
    PG8_BAR;
#undef PG8_SA
#undef PG8_SB
#undef PG8_STAGE
#undef PG8_LDA
#undef PG8_LDB
#undef PG8_MMA
#undef PG8_WAIT_V
#undef PG8_WAIT_L
#undef PG8_BAR
#undef PG8_SCHED
}
}
namespace pg8 {
constexpr float LOG2E = 1.4426950408889634f;
constexpr float RMS_EPS = 1e-6f;

template <int kind, int nM, int nN, size_t sA, size_t sB, size_t batchB = 0>
struct SchedT {
    static constexpr int nwg = nM * nN, G = 256;
    int c; const char* A; const char* B;
    __device__ __forceinline__ void init(int c_, const void* A_, const void* B_) { c = c_; A = (const char*)A_; B = (const char*)B_; }
    __device__ __forceinline__ bool next(int i, Unit& u) const {
        const int L = i * G + c; if (L >= nwg) return false;
        if constexpr (kind <= 1) {
            int wgid = L; { constexpr int q = nwg / NXCD, r = nwg % NXCD; const int xcd = wgid % NXCD, off = wgid / NXCD; wgid = (xcd < r ? xcd * (q + 1) : r * (q + 1) + (xcd - r) * q) + off; }
            constexpr int nig = WGM * nN; const int gid = wgid / nig, fm = gid * WGM, gsz = (nM - fm) < WGM ? (nM - fm) : WGM;
            u.pm = fm + ((wgid % nig) % gsz); u.pn = (wgid % nig) / gsz;
            u.a = A + (size_t)u.pm * sA; u.b = B + (size_t)u.pn * sB + (kind == 1 ? (size_t)(u.pm >> 3) * batchB : (size_t)0); u.aux = 0;
        } else if constexpr (kind == 2) {
            const int b_ = L >> 4, h = (L >> 2) & 3, t4 = L & 3;
            u.pm = b_ * 4 + h; u.pn = t4;
            u.a = A + ((size_t)b_ * 256 * 2048 + (size_t)h * 256) * 2; u.b = B + ((size_t)t4 * 256 * 1024 + (size_t)h * 256) * 2;
            u.aux = b_ * 1048576 + (h * 256) * 1024 + t4 * 256;
        } else {
            const int b_ = L >> 4, h = (L >> 2) & 3, t4 = L & 3;
            u.pm = t4; u.pn = b_ * 4 + h;
            u.a = A + ((size_t)t4 * 256 * 1024 + (size_t)h * 256) * 2; u.b = B + ((size_t)b_ * 256 * 2048 + 1024 + (size_t)h * 256) * 2;
            u.aux = b_ * 1048576 + (t4 * 256) * 1024 + h * 256;
        }
        return true;
    }
};

__device__ __forceinline__ void store8(bf16_t* p, const f32x4 v0, const f32x4 v1) {
    u32x4 w; w.x = cvt_pk_bf16(v0[0], v0[1]); w.y = cvt_pk_bf16(v0[2], v0[3]); w.z = cvt_pk_bf16(v1[0], v1[1]); w.w = cvt_pk_bf16(v1[2], v1[3]); *(u32x4*)p = w;
}
__device__ __forceinline__ float ss_sum16(const float* ssp, int row) {
    const f32x4* p = (const f32x4*)(ssp + (size_t)row * 16); const f32x4 a = p[0], b = p[1], c = p[2], d = p[3];
    return (((a[0] + a[1]) + (a[2] + a[3])) + ((b[0] + b[1]) + (b[2] + b[3]))) + (((c[0] + c[1]) + (c[2] + c[3])) + ((d[0] + d[1]) + (d[2] + d[3])));
}
__device__ __forceinline__ float rs_row(const float* ssp, int row) { return __builtin_amdgcn_rsqf(ss_sum16(ssp, row) * (1.0f / 1024.0f) + RMS_EPS); }
__device__ __forceinline__ float sigmoidf_fast(float z) { return __builtin_amdgcn_rcpf(1.0f + __builtin_amdgcn_exp2f(-z * LOG2E)); }
__device__ __forceinline__ f32x4 sig4(f32x4 z) { f32x4 r; r[0] = sigmoidf_fast(z[0]); r[1] = sigmoidf_fast(z[1]); r[2] = sigmoidf_fast(z[2]); r[3] = sigmoidf_fast(z[3]); return r; }

struct EpiSwiGLU {
    static constexpr bool PERM = true; static constexpr int MIDK = 0;
    bf16_t* H; const float* ss; static constexpr int ldh = 2816;
    bool shadow_skip = false;
    __device__ __forceinline__ void midk(f32x4 (&)[2][2][4][2], const Unit&, int, int, int, int) const {}
    __device__ __forceinline__ void operator()(f32x4 (&acc)[2][2][4][2], const Unit& u, int wr, int wc, int fr, int fq) const {
        const int row0 = u.pm * BM + wr * 64 + fr, col0 = u.pn * HALF + wc * 32 + 8 * fq;
#pragma unroll
        for (int ai = 0; ai < 2; ++ai)
#pragma unroll
            for (int m = 0; m < 4; ++m) {
                const int row = row0 + ai * HALF + m * 16;
                const float rs = rs_row(ss, row);
                const f32x4 g0 = acc[ai][0][m][0] * rs, g1 = acc[ai][0][m][1] * rs, u0 = acc[ai][1][m][0] * rs, u1 = acc[ai][1][m][1] * rs;
                store8(H + (size_t)row * ldh + col0, g0 * sig4(g0) * u0, g1 * sig4(g1) * u1);
            }
    }
};

template <int MIDK_>
struct EpiResid {
    static constexpr bool PERM = true; static constexpr int MIDK = MIDK_;
    const float* xin; float* xout; bf16_t* xb; float* ssn; const float* ssa; float alpha;
    bool shadow_skip = false;
    __device__ __forceinline__ void midk(f32x4 (&acc)[2][2][4][2], const Unit& u, int wr, int wc, int fr, int fq) const {
        const int row0 = u.pm * BM + wr * 64 + fr;
#pragma unroll
        for (int ai = 0; ai < 2; ++ai)
#pragma unroll
            for (int m = 0; m < 4; ++m) {
                const f32x4* pa = (const f32x4*)(ssa + (size_t)(row0 + ai * HALF + m * 16) * 8); const f32x4 sa = pa[0], sb = pa[1];
                const float rs = __builtin_amdgcn_rsqf((((sa[0] + sa[1]) + (sa[2] + sa[3])) + ((sb[0] + sb[1]) + (sb[2] + sb[3]))) * (1.0f / 512.0f) + RMS_EPS);
#pragma unroll
                for (int bj = 0; bj < 2; ++bj)
#pragma unroll
                    for (int n = 0; n < 2; ++n) acc[ai][bj][m][n] *= rs;
            }
    }
    __device__ __forceinline__ void operator()(f32x4 (&acc)[2][2][4][2], const Unit& u, int wr, int wc, int fr, int fq) const {
        const int row0 = u.pm * BM + wr * 64 + fr, col0 = u.pn * BM + wc * 32 + 8 * fq;
#pragma unroll
        for (int ai = 0; ai < 2; ++ai)
#pragma unroll
            for (int m = 0; m < 4; ++m) {
                const int row = row0 + ai * HALF + m * 16; float q = 0.f;
#pragma unroll
                for (int bj = 0; bj < 2; ++bj) {
                    const size_t off = (size_t)row * 1024 + col0 + bj * HALF;
                    f32x4 r0, r1;
                    if (xin) { r0 = *(const f32x4*)(xin + off); r1 = *(const f32x4*)(xin + off + 4); }
                    else { const u32x4 w = *(const u32x4*)(xb + off);
                        r0 = (f32x4){__uint_as_float(w.x << 16), __uint_as_float(w.x & 0xffff0000u), __uint_as_float(w.y << 16), __uint_as_float(w.y & 0xffff0000u)};
                        r1 = (f32x4){__uint_as_float(w.z << 16), __uint_as_float(w.z & 0xffff0000u), __uint_as_float(w.w << 16), __uint_as_float(w.w & 0xffff0000u)}; }
                    const f32x4 v0 = r0 + acc[ai][bj][m][0] * alpha, v1 = r1 + acc[ai][bj][m][1] * alpha;
                    if (xout) { *(f32x4*)(xout + off) = v0; *(f32x4*)(xout + off + 4) = v1; }
                    else store8(xb + off, v0, v1);
                    q += (v0[0] * v0[0] + v0[1] * v0[1]) + (v0[2] * v0[2] + v0[3] * v0[3]) + (v1[0] * v1[0] + v1[1] * v1[1]) + (v1[2] * v1[2] + v1[3] * v1[3]);
                }
                q += swz_xor<16>(q); q = sum_x32(q);
                if (fq == 0) ssn[(size_t)row * 16 + u.pn * 4 + wc] = q;
            }
    }
};

struct EpiWin {
    static constexpr bool PERM = true; static constexpr int MIDK = 0;
    bf16_t *Y, *KB, *VB, *UB; float* LOGFT; const float* ss; const float* bfp; float qscale;
    bool shadow_skip = false;
    __device__ __forceinline__ void midk(f32x4 (&)[2][2][4][2], const Unit&, int, int, int, int) const {}
    __device__ __forceinline__ void operator()(f32x4 (&acc)[2][2][4][2], const Unit& u, int wr, int wc, int fr, int fq) const {
        const int row0 = u.pm * BM + wr * 64 + fr, cw = wc * 32 + 8 * fq; const int pn = u.pn;
#pragma unroll
        for (int ai = 0; ai < 2; ++ai)
#pragma unroll
            for (int m = 0; m < 4; ++m) {
                const int row = row0 + ai * HALF + m * 16;
                const float rs = rs_row(ss, row);
                if (pn < 6) {
                    bf16_t* base; int ld; float sc = rs;
                    if (pn < 2) { base = Y + pn * BM; ld = 1024; sc = rs * qscale; } else if (pn < 4) { base = KB + (pn - 2) * BM; ld = 512; } else { base = VB + (pn - 4) * BM; ld = 512; }
#pragma unroll
                    for (int bj = 0; bj < 2; ++bj) store8(base + (size_t)row * ld + bj * HALF + cw, acc[ai][bj][m][0] * sc, acc[ai][bj][m][1] * sc);
                } else if (pn < 10) {
                    const f32x4 a0 = acc[ai][0][m][0] * rs, a1 = acc[ai][0][m][1] * rs, g0 = acc[ai][1][m][0] * rs, g1 = acc[ai][1][m][1] * rs;
                    store8(UB + (size_t)row * 512 + (pn - 6) * HALF + cw, a0 * sig4(g0), a1 * sig4(g1));
                } else {
                    if (wc == 0 && fq == 0) {
                        const int b = row >> 11, t = row & 2047;
#pragma unroll
                        for (int n = 0; n < 2; ++n)
#pragma unroll
                            for (int e = 0; e < 4; ++e) {
                                const int h = 4 * n + e; const float z = acc[ai][0][m][n][e] * rs + bfp[h];
                                LOGFT[(size_t)(b * 8 + h) * 2048 + t] = fminf(z, 0.f) - log1pf(expf(-fabsf(z)));
                            }
                    }
                }
            }
    }
};

struct EpiRowScale {
    static constexpr bool PERM = true; static constexpr int MIDK = 0;
    bf16_t* O; const float* ssr; float scale; static constexpr int ldc = 2048;
    bool shadow_skip = false;
    __device__ __forceinline__ void midk(f32x4 (&)[2][2][4][2], const Unit&, int, int, int, int) const {}
    __device__ __forceinline__ void operator()(f32x4 (&acc)[2][2][4][2], const Unit& u, int wr, int wc, int fr, int fq) const {
        const int row0 = u.pm * BM + wr * 64 + fr, col0 = u.pn * BM + wc * 32 + 8 * fq;
#pragma unroll
        for (int ai = 0; ai < 2; ++ai)
#pragma unroll
            for (int m = 0; m < 4; ++m) {
                const int row = row0 + ai * HALF + m * 16;
                const float rs = (ssr ? __builtin_amdgcn_rsqf(ssr[row] * (1.0f / 1024.0f) + RMS_EPS) : 1.0f) * scale;
#pragma unroll
                for (int bj = 0; bj < 2; ++bj) store8(O + (size_t)row * ldc + col0 + bj * HALF, acc[ai][bj][m][0] * rs, acc[ai][bj][m][1] * rs);
            }
    }
};

struct EpiAux {
    static constexpr bool PERM = true; static constexpr int MIDK = 0;
    bf16_t* O; float scale; static constexpr int ldc = 1024;
    bool shadow_skip = false;
    __device__ __forceinline__ void midk(f32x4 (&)[2][2][4][2], const Unit&, int, int, int, int) const {}
    __device__ __forceinline__ void operator()(f32x4 (&acc)[2][2][4][2], const Unit& u, int wr, int wc, int fr, int fq) const {
        bf16_t* base = O + u.aux + (size_t)(wr * 64 + fr) * ldc + wc * 32 + 8 * fq;
#pragma unroll
        for (int ai = 0; ai < 2; ++ai)
#pragma unroll
            for (int m = 0; m < 4; ++m)
#pragma unroll
                for (int bj = 0; bj < 2; ++bj) store8(base + (size_t)(ai * HALF + m * 16) * ldc + bj * HALF, acc[ai][bj][m][0] * scale, acc[ai][bj][m][1] * scale);
    }
};

struct EpiSoftmax {
    static constexpr bool PERM = true; static constexpr int MIDK = 0;
    bf16_t* XP; const float* ss; PG8_LAS float* scr;
    bool shadow_skip = false;
    __device__ __forceinline__ void midk(f32x4 (&)[2][2][4][2], const Unit&, int, int, int, int) const {}
    __device__ __forceinline__ void operator()(f32x4 (&acc)[2][2][4][2], const Unit& u, int wr, int wc, int fr, int fq) const {
        const int col0 = u.pn * BM + wc * 32 + 8 * fq;
        PG8_LAS float* TM = scr; PG8_LAS float* TS = scr + 1024;
        const float* ssr = ss + (size_t)(u.pm * BM + wr * 64 + fr) * 16;
#pragma unroll
        for (int ai = 0; ai < 2; ++ai)
#pragma unroll
            for (int m = 0; m < 4; ++m) {
                const int rl = ai * HALF + wr * 64 + m * 16 + fr;
                const float rs = rs_row(ssr, ai * HALF + m * 16);
                float v = -3.0e38f;
#pragma unroll
                for (int bj = 0; bj < 2; ++bj)
#pragma unroll
                    for (int n = 0; n < 2; ++n) { const f32x4 x = acc[ai][bj][m][n] * rs; acc[ai][bj][m][n] = x; v = fmaxf(v, fmaxf(fmaxf(x[0], x[1]), fmaxf(x[2], x[3]))); }
                v = fmaxf(v, swz_xor<16>(v)); v = max_x32(v);
                if (fq == 0) TM[rl * 4 + wc] = v;
            }
        asm volatile("s_waitcnt lgkmcnt(0)" ::: "memory"); __builtin_amdgcn_s_barrier(); asm volatile("" ::: "memory");
#pragma unroll
        for (int ai = 0; ai < 2; ++ai)
#pragma unroll
            for (int m = 0; m < 4; ++m) {
                const int rl = ai * HALF + wr * 64 + m * 16 + fr;
                const f32x4 t = *(const PG8_LAS f32x4*)(TM + rl * 4);
                const float mrow = fmaxf(fmaxf(t[0], t[1]), fmaxf(t[2], t[3]));
                float s = 0.f;
#pragma unroll
                for (int bj = 0; bj < 2; ++bj)
#pragma unroll
                    for (int n = 0; n < 2; ++n) { f32x4 x = acc[ai][bj][m][n] - mrow;
                        x[0] = __builtin_amdgcn_exp2f(x[0]); x[1] = __builtin_amdgcn_exp2f(x[1]); x[2] = __builtin_amdgcn_exp2f(x[2]); x[3] = __builtin_amdgcn_exp2f(x[3]);
                        acc[ai][bj][m][n] = x; s += (x[0] + x[1]) + (x[2] + x[3]); }
                s += swz_xor<16>(s); s = sum_x32(s);
                if (fq == 0) TS[rl * 4 + wc] = s;
            }
        asm volatile("s_waitcnt lgkmcnt(0)" ::: "memory"); __builtin_amdgcn_s_barrier(); asm volatile("" ::: "memory");
        bf16_t* xp = XP + (size_t)(u.pm * BM + wr * 64 + fr) * 1024 + col0;
#pragma unroll
        for (int ai = 0; ai < 2; ++ai)
#pragma unroll
            for (int m = 0; m < 4; ++m) {
                const int rl = ai * HALF + wr * 64 + m * 16 + fr;
                const f32x4 t = *(const PG8_LAS f32x4*)(TS + rl * 4);
                const float inv = __builtin_amdgcn_rcpf((t[0] + t[1]) + (t[2] + t[3]));
#pragma unroll
                for (int bj = 0; bj < 2; ++bj) store8(xp + (size_t)(ai * HALF + m * 16) * 1024 + bj * HALF, acc[ai][bj][m][0] * inv, acc[ai][bj][m][1] * inv);
            }
    }
};
}
#include <hip/hip_bf16.h>
namespace attn_body {
using bf16=__hip_bfloat16;
using bf16x8=__attribute__((ext_vector_type(8)))short;
using s16x4=__attribute__((ext_vector_type(4)))short;
using f32x16=__attribute__((ext_vector_type(16)))float;
using f32x4_t=__attribute__((ext_vector_type(4)))float;
using u32x4=__attribute__((ext_vector_type(4)))unsigned;
#define ATT_LAS __attribute__((address_space(3)))
constexpr int BATCH=8,NHEAD=8,SEQ=2048,D=64,QP=1024,KP=512;
constexpr int NW=8,QBLK=32,QB=QBLK*NW,KVBLK=64,NQB=SEQ/QB;
__device__ __forceinline__ int crow(int r,int hi){return (r&3)+8*(r>>2)+4*hi;}
#define SBAR() __builtin_amdgcn_sched_barrier(0)
__device__ __forceinline__ void cmask(f32x16&p0,f32x16&p1,int jb,int qrel,int hi){
  const float NEG=-INFINITY; int kb=64*jb+4*hi;
  #pragma unroll
  for(int r=0;r<16;++r){int kv=kb+(r&3)+8*(r>>2); if(kv>qrel)p0[r]=NEG; if(kv+32>qrel)p1[r]=NEG;}
}
constexpr int NSLOT=3, SLOTB=8192;
constexpr int LDS_K=0, LDS_V=NSLOT*SLOTB, LDS_WS=2*NSLOT*SLOTB, LDS_OST=LDS_WS+NW*64*4, LDS_CB=LDS_OST+NW*4096  , LDS_WT=LDS_CB+SEQ*4, LDS_BYTES=LDS_WT+64;
__device__ __forceinline__ void glds16(const void*gsrc,unsigned lds_dst){unsigned keep;
  asm volatile("s_mov_b32 %0, m0\n\ts_mov_b32 m0, %2\n\ts_nop 0\n\tglobal_load_lds_dwordx4 %1, off\n\ts_mov_b32 m0, %0":"=&s"(keep):"v"(gsrc),"s"(lds_dst):"memory");}
__device__ __forceinline__ float max3f(float a,float b,float c){float r;asm("v_max3_f32 %0, %1, %2, %3":"=v"(r):"v"(a),"v"(b),"v"(c));return r;}
__device__ __forceinline__ float max2f(float a,float b){float r;asm("v_max_f32_e32 %0, %1, %2":"=v"(r):"v"(a),"v"(b));return r;}
__device__ __forceinline__ float fadd_s(float a,float b){float r;asm("v_add_f32_e32 %0, %1, %2":"=v"(r):"v"(a),"v"(b));return r;}
__device__ __forceinline__ float fsub_s(float a,float b){float r;asm("v_sub_f32_e32 %0, %1, %2":"=v"(r):"v"(a),"v"(b));return r;}
typedef float f32x2_t __attribute__((ext_vector_type(2))); typedef __bf16 bf16x2_t __attribute__((ext_vector_type(2)));
__device__ __forceinline__ unsigned cvtpk_s(float lo,float hi){f32x2_t v={lo,hi};bf16x2_t b=__builtin_convertvector(v,bf16x2_t);return __builtin_bit_cast(unsigned,b);}
#define WAIT_BAR(N) asm volatile("s_waitcnt vmcnt(" #N ") lgkmcnt(0)\n\ts_barrier":::"memory")

__device__ __forceinline__ void qkt(f32x16&p0,f32x16&p1,const char*Kslot,const bf16x8*qr,const f32x16&negm,int r32,int hi){
  const char*kb=Kslot+hi*1024+r32*16;
  #pragma unroll
  for(int d0=0;d0<4;++d0){
    const bf16x8 b0=*reinterpret_cast<const bf16x8*>(kb+d0*2048);
    const bf16x8 b1=*reinterpret_cast<const bf16x8*>(kb+d0*2048+512);
    if(d0==0){p0=__builtin_amdgcn_mfma_f32_32x32x16_bf16(b0,qr[0],negm,0,0,0);p1=__builtin_amdgcn_mfma_f32_32x32x16_bf16(b1,qr[0],negm,0,0,0);}
    else{p0=__builtin_amdgcn_mfma_f32_32x32x16_bf16(b0,qr[d0],p0,0,0,0);p1=__builtin_amdgcn_mfma_f32_32x32x16_bf16(b1,qr[d0],p1,0,0,0);}}
}
typedef ATT_LAS const char* lds_cptr;
typedef short v4i16_t __attribute__((ext_vector_type(4)));
__device__ __forceinline__ void kload8(bf16x8*kf,lds_cptr kp){
  kf[0]=*(const ATT_LAS bf16x8*)(kp);      kf[1]=*(const ATT_LAS bf16x8*)(kp+512);
  kf[2]=*(const ATT_LAS bf16x8*)(kp+2048); kf[3]=*(const ATT_LAS bf16x8*)(kp+2560);
  kf[4]=*(const ATT_LAS bf16x8*)(kp+4096); kf[5]=*(const ATT_LAS bf16x8*)(kp+4608);
  kf[6]=*(const ATT_LAS bf16x8*)(kp+6144); kf[7]=*(const ATT_LAS bf16x8*)(kp+6656);
}
__device__ __forceinline__ void kload2(bf16x8*kf,lds_cptr kp,int j){ kf[2*j]=*(const ATT_LAS bf16x8*)(kp+j*2048); kf[2*j+1]=*(const ATT_LAS bf16x8*)(kp+j*2048+512); }
__device__ __forceinline__ s16x4 vtr(lds_cptr p){ return __builtin_bit_cast(s16x4,__builtin_amdgcn_ds_read_tr16_b64_v4i16((ATT_LAS v4i16_t*)p)); }
__device__ __forceinline__ float rowmax(const f32x16&p0,const f32x16&p1){
  float a=max3f(p0[0],p0[1],p1[0]),b=max3f(p0[2],p0[3],p1[1]);a=max3f(a,p1[2],p1[3]);
  #pragma unroll
  for(int r=4;r<16;r+=4){a=max3f(a,p0[r],p0[r+1]);b=max3f(b,p0[r+2],p0[r+3]);a=max3f(a,p1[r],p1[r+1]);b=max3f(b,p1[r+2],p1[r+3]);}
  const float m=max2f(a,b);
  auto rr=__builtin_amdgcn_permlane32_swap(__float_as_uint(m),__float_as_uint(m),false,false);
  return max2f(__uint_as_float(rr[0]),__uint_as_float(rr[1]));
}
__device__ __forceinline__ void pv(f32x16*o,int vb,bf16x8 pa0,bf16x8 pa1,bf16x8 pa2,bf16x8 pa3){
  #pragma unroll
  for(int d0=0;d0<2;++d0){s16x4 lo[4],hi[4];
    #pragma unroll
    for(int ks=0;ks<4;++ks){
      asm volatile("ds_read_b64_tr_b16 %0,%1 offset:%c2":"=&v"(lo[ks]):"v"(vb),"i"(d0*4096+ks*1024):"memory");
      asm volatile("ds_read_b64_tr_b16 %0,%1 offset:%c2":"=&v"(hi[ks]):"v"(vb),"i"(d0*4096+ks*1024+512):"memory");}
    asm volatile("s_waitcnt lgkmcnt(0)":::"memory");SBAR();
    #define PK(k) (bf16x8){lo[k][0],lo[k][1],lo[k][2],lo[k][3],hi[k][0],hi[k][1],hi[k][2],hi[k][3]}
    o[d0]=__builtin_amdgcn_mfma_f32_32x32x16_bf16(pa0,PK(0),o[d0],0,0,0);
    o[d0]=__builtin_amdgcn_mfma_f32_32x32x16_bf16(pa1,PK(1),o[d0],0,0,0);
    o[d0]=__builtin_amdgcn_mfma_f32_32x32x16_bf16(pa2,PK(2),o[d0],0,0,0);
    o[d0]=__builtin_amdgcn_mfma_f32_32x32x16_bf16(pa3,PK(3),o[d0],0,0,0);
    #undef PK
  }
}
__device__ __forceinline__ void scan_bias(const float*LOGFT,int bh,char*shm,const int tid){
  const int lane=tid&63,wid=tid>>6;
  ATT_LAS float*cb=(ATT_LAS float*)(shm+LDS_CB); ATT_LAS float*wt=(ATT_LAS float*)(shm+LDS_WT);
  const f32x4_t v=*(const f32x4_t*)(LOGFT+(size_t)bh*SEQ+4*tid);
  const float s0=v[0],s1=s0+v[1],s2=s1+v[2],s3=s2+v[3];
  float incl=s3;
  #pragma unroll
  for(int o=1;o<64;o<<=1){const float n=__int_as_float(__builtin_amdgcn_ds_bpermute((lane-o)<<2,__float_as_int(incl))); if(lane>=o)incl+=n;}
  if(lane==63)wt[wid]=incl;
  asm volatile("s_waitcnt lgkmcnt(0)\n\ts_barrier":::"memory");
  float woff=0.f;
  #pragma unroll
  for(int w=0;w<8;++w){const float x=wt[w]; if(w<wid)woff+=x;}
  const float ex=woff+incl-s3; const float L2E=-1.4426950408889634f;
  f32x4_t o4; o4[0]=(ex+s0)*L2E;o4[1]=(ex+s1)*L2E;o4[2]=(ex+s2)*L2E;o4[3]=(ex+s3)*L2E;
  *(ATT_LAS f32x4_t*)(cb+4*tid)=o4;
  asm volatile("s_waitcnt lgkmcnt(0)\n\ts_barrier":::"memory");
}
template<int THRL> __device__ __forceinline__ void attn_unit(int b,int h,int qb,const bf16*Q,const bf16*K,const bf16*V,bf16*O,float*ssa  ,char*shm,const int tid){
  const int lane=tid&63,r32=lane&31,hi=lane>>5; const int wid=__builtin_amdgcn_readfirstlane(tid>>6);
  const long rowbase=(long)b*SEQ; const int q0=qb*QB;
  const bf16*Qw=Q+(rowbase+q0+wid*QBLK)*QP+h*D;
  const bf16*Kh=K+rowbase*KP+h*D,*Vh=V+rowbase*KP+h*D;
  const unsigned lds0=(unsigned)(uintptr_t)shm;
  float*wsf=(float*)(shm+LDS_WS)+wid*64;
  const ATT_LAS float*cbh=(const ATT_LAS float*)(shm+LDS_CB)+4*hi;
  const bf16*ksrc=Kh+(long)lane*KP+wid*8;
  const bf16*vsrc=Vh+(long)(16*(wid&3)+(lane>>2))*KP+(wid>>2)*32+(lane&3)*8;
  const unsigned kdst=lds0+LDS_K+wid*1024, vdst=lds0+LDS_V+wid*1024;
  #define DMA_K(t,slot) glds16(ksrc+(long)(t)*KVBLK*KP,(unsigned)__builtin_amdgcn_readfirstlane(kdst+(slot)))
  #define DMA_V(t,slot) glds16(vsrc+(long)(t)*KVBLK*KP,(unsigned)__builtin_amdgcn_readfirstlane(vdst+(slot)))
  const int vb0=(int)(lds0+LDS_V)+((lane>>4)&1)*32+(lane&3)*8+(4*hi+((lane&15)>>2))*64;
  const char*Kbase=shm+LDS_K; bf16x8 kf[8];
  const lds_cptr shm3=(lds_cptr)shm; const lds_cptr kp0=shm3+LDS_K+hi*1024+r32*16; const lds_cptr vp0=shm3+LDS_V+((lane>>4)&1)*32+(lane&3)*8+(4*hi+((lane&15)>>2))*64;
  const int NT=(q0+QB)/KVBLK;
  DMA_K(0,0);DMA_V(0,0);DMA_K(1,SLOTB);
  bf16x8 qr[4];
  #pragma unroll
  for(int d0=0;d0<4;++d0)qr[d0]=*reinterpret_cast<const bf16x8*>(&Qw[(long)r32*QP+d0*16+hi*8]);
  float mhat=0.f,l_reg=0.f;f32x16 o[2];o[0]=f32x16{};o[1]=f32x16{};f32x16 negm=f32x16{};asm volatile("":"+v"(negm));
  const int qrel=wid*QBLK+r32;
  #define CMASK(P0,P1,t) do{int jb_=(t)-(NT-4); if(jb_>=0)cmask(P0,P1,jb_,qrel,hi);}while(0)
  #define ADDB(P0,P1,t) do{ const ATT_LAS float*cbt_=cbh+64*(t); \
    _Pragma("unroll") for(int j_=0;j_<4;++j_){ const f32x4_t b0_=*(const ATT_LAS f32x4_t*)(cbt_+8*j_), b1_=*(const ATT_LAS f32x4_t*)(cbt_+32+8*j_); \
      _Pragma("unroll") for(int i_=0;i_<4;++i_){P0[4*j_+i_]+=b0_[i_];P1[4*j_+i_]+=b1_[i_];} } }while(0)
  bool resc=false;
  #define START(P0,P1) do{ const float rm=rowmax(P0,P1); resc=false; \
    { const float dl=rm; mhat=fadd_s(mhat,dl); \
      _Pragma("unroll") for(int r=0;r<16;++r){P0[r]=fsub_s(P0[r],dl);P1[r]=fsub_s(P1[r],dl);} \
      _Pragma("unroll") for(int r=0;r<16;++r)negm[r]=-mhat; asm volatile("":"+v"(negm)); } \
    _Pragma("unroll") for(int r=0;r<16;++r)P0[r]=__builtin_amdgcn_exp2f(P0[r]); }while(0)
  #define RESC() do{ if(resc){ asm volatile("s_waitcnt lgkmcnt(0)":::"memory"); \
      _Pragma("unroll") for(int d_=0;d_<2;++d_) _Pragma("unroll") for(int r=0;r<16;++r)o[d_][r]*=wsf[crow(r,hi)]; } }while(0)
  f32x16 pA0,pA1,pB0,pB1;
  int sl_prev=0,sl_cur=0,sl_next=SLOTB;
  #define ROT() do{sl_prev=sl_cur;sl_cur=sl_next;sl_next=(sl_next==(NSLOT-1)*SLOTB)?0:sl_next+SLOTB;}while(0)
  DMA_K(2,2*SLOTB);
  WAIT_BAR(3);
  qkt(pA0,pA1,Kbase,qr,negm,r32,hi);asm volatile("s_nop 15\n\ts_nop 7":"+v"(pA0),"+v"(pA1));ADDB(pA0,pA1,0);asm volatile("s_nop 3":"+v"(pA0),"+v"(pA1));CMASK(pA0,pA1,0);
  START(pA0,pA1);
  _Pragma("unroll") for(int r=0;r<16;++r)pA1[r]=__builtin_amdgcn_exp2f(pA1[r]);
  WAIT_BAR(0);
  DMA_K(3,0);DMA_V(1,SLOTB);
  ROT();
  kload8(kf,kp0+sl_cur);
  WAIT_BAR(2);
  s16x4 vlo[8],vhi[8]; u32x4 pw0,pw1,pw2,pw3;
  #define PKW(P,B) cvtpk_s(P[B],P[B+1])
  #define PAF(k) __builtin_bit_cast(bf16x8,pw##k)
  #define VFR(i) (bf16x8){vlo[i][0],vlo[i][1],vlo[i][2],vlo[i][3],vhi[i][0],vhi[i][1],vhi[i][2],vhi[i][3]}
  #define PIN(x) asm volatile("":"+v"(x))
  #define MX3(a,b,c) __builtin_fmaxf(__builtin_fmaxf((a),(b)),(c))
  #define GAPA(MF,A0,A1,A2,A3,W0,W1,PW) do{ MF; sacc+=A0; sacc+=A1; sacc+=A2; sacc+=A3; PIN(sacc); W0; W1; PIN(PW); SBAR(); }while(0)
  #define EX(v) __builtin_amdgcn_exp2f(v)
  #define GAPB(MF,X,B) do{ MF; X[B]=EX(X[B]); X[B+1]=EX(X[B+1]); X[B+2]=EX(X[B+2]); X[B+3]=EX(X[B+3]); PIN(X); SBAR(); }while(0)
  #define VRD(i) do{ vlo[i]=vtr(vp_+(((i)>>2)*4096+((i)&3)*1024)); vhi[i]=vtr(vp_+(((i)>>2)*4096+((i)&3)*1024+512)); }while(0)
  #define KRD(G,j) do{ if(G){ kload2(kf,kp0+sl_next,j); SBAR(); } }while(0)
  #define STEP(C0,C1,P0,P1,t,GK,GV,GL) do{ SBAR(); \
    const lds_cptr vp_=vp0+sl_prev; \
    VRD(0); SBAR(); float sacc=(P0[0]+P0[1]); \
    GAPA(C0=__builtin_amdgcn_mfma_f32_32x32x16_bf16(kf[0],qr[0],negm,0,0,0), P0[2],P0[3],P0[4],P0[5],     pw0[0]=PKW(P0,0), pw0[1]=PKW(P0,2), pw0); \
    VRD(4); SBAR(); GAPA(C1=__builtin_amdgcn_mfma_f32_32x32x16_bf16(kf[1],qr[0],negm,0,0,0), P0[6],P0[7],P0[8],P0[9],     pw0[2]=PKW(P0,4), pw0[3]=PKW(P0,6), pw0); \
    VRD(1); SBAR(); GAPA(C0=__builtin_amdgcn_mfma_f32_32x32x16_bf16(kf[2],qr[1],C0,0,0,0),   P0[10],P0[11],P0[12],P0[13], pw1[0]=PKW(P0,8), pw1[1]=PKW(P0,10), pw1); \
    VRD(5); SBAR(); GAPA(C1=__builtin_amdgcn_mfma_f32_32x32x16_bf16(kf[3],qr[1],C1,0,0,0),   P0[14],P0[15],P1[0],P1[1],   pw1[2]=PKW(P0,12),pw1[3]=PKW(P0,14), pw1); \
    VRD(2); SBAR(); GAPA(C0=__builtin_amdgcn_mfma_f32_32x32x16_bf16(kf[4],qr[2],C0,0,0,0),   P1[2],P1[3],P1[4],P1[5],     pw2[0]=PKW(P1,0), pw2[1]=PKW(P1,2), pw2); \
    VRD(6); SBAR(); GAPA(C1=__builtin_amdgcn_mfma_f32_32x32x16_bf16(kf[5],qr[2],C1,0,0,0),   P1[6],P1[7],P1[8],P1[9],     pw2[2]=PKW(P1,4), pw2[3]=PKW(P1,6), pw2); \
    VRD(3); SBAR(); GAPA(C0=__builtin_amdgcn_mfma_f32_32x32x16_bf16(kf[6],qr[3],C0,0,0,0),   P1[10],P1[11],P1[12],P1[13], pw3[0]=PKW(P1,8), pw3[1]=PKW(P1,10), pw3); \
    VRD(7); SBAR(); GAPA(C1=__builtin_amdgcn_mfma_f32_32x32x16_bf16(kf[7],qr[3],C1,0,0,0),   P1[14],P1[15],0.f,0.f,       pw3[2]=PKW(P1,12),pw3[3]=PKW(P1,14), pw3); \
    l_reg+=sacc; \
    if(GK){DMA_K((t)+3,sl_cur);} if(GV){DMA_V((t)+1,sl_next);} \
    ADDB(C0,C1,t); \
    CMASK(C0,C1,t); \
    { float a=MX3(C0[0],C0[1],C1[0]),b=MX3(C0[2],C0[3],C1[1]); a=MX3(a,C1[2],C1[3]); \
      _Pragma("unroll") for(int r=4;r<16;r+=4){a=MX3(a,C0[r],C0[r+1]);b=MX3(b,C0[r+2],C0[r+3]);a=MX3(a,C1[r],C1[r+1]);b=MX3(b,C1[r+2],C1[r+3]);} \
      float rm=__builtin_fmaxf(a,b); { auto rr=__builtin_amdgcn_permlane32_swap(__float_as_uint(rm),__float_as_uint(rm),false,false); rm=__builtin_fmaxf(__uint_as_float(rr[0]),__uint_as_float(rr[1])); } \
      resc=false; \
      if(__builtin_expect(__any(rm>(float)THRL),0)){ const float dl=__builtin_fmaxf(rm,0.f); mhat+=dl; \
        _Pragma("unroll") for(int r=0;r<16;++r){C0[r]-=dl;C1[r]-=dl;} \
        _Pragma("unroll") for(int r=0;r<16;++r)negm[r]=-mhat; asm volatile("":"+v"(negm)); \
        const float f=__builtin_amdgcn_exp2f(-dl); l_reg*=f; if(hi==0)wsf[r32]=f; resc=true; } } \
    SBAR(); \
    GAPB(o[0]=__builtin_amdgcn_mfma_f32_32x32x16_bf16(PAF(0),VFR(0),o[0],0,0,0), C0,0); \
    GAPB(o[1]=__builtin_amdgcn_mfma_f32_32x32x16_bf16(PAF(0),VFR(4),o[1],0,0,0), C0,4); \
    KRD(GL,0); GAPB(o[0]=__builtin_amdgcn_mfma_f32_32x32x16_bf16(PAF(1),VFR(1),o[0],0,0,0), C0,8); \
    KRD(GL,1); GAPB(o[1]=__builtin_amdgcn_mfma_f32_32x32x16_bf16(PAF(1),VFR(5),o[1],0,0,0), C0,12); \
    KRD(GL,2); GAPB(o[0]=__builtin_amdgcn_mfma_f32_32x32x16_bf16(PAF(2),VFR(2),o[0],0,0,0), C1,0); \
    KRD(GL,3); GAPB(o[1]=__builtin_amdgcn_mfma_f32_32x32x16_bf16(PAF(2),VFR(6),o[1],0,0,0), C1,4); \
    GAPB(o[0]=__builtin_amdgcn_mfma_f32_32x32x16_bf16(PAF(3),VFR(3),o[0],0,0,0), C1,8); \
    GAPB(o[1]=__builtin_amdgcn_mfma_f32_32x32x16_bf16(PAF(3),VFR(7),o[1],0,0,0), C1,12); \
    }while(0)
  int t=1;
  #undef CMASK
  #define CMASK(P0,P1,t) do{}while(0)
  for(;t+5<NT;t+=2){
    STEP(pB0,pB1,pA0,pA1,t,true,true,true);     WAIT_BAR(2); RESC(); ROT();
    STEP(pA0,pA1,pB0,pB1,t+1,true,true,true);   WAIT_BAR(2); RESC(); ROT();
  }
  #undef CMASK
  #define CMASK(P0,P1,t) do{int jb_=(t)-(NT-4); if(jb_>=0)cmask(P0,P1,jb_,qrel,hi);}while(0)
  #define ENDW(tt) do{ if((tt)+3<NT){WAIT_BAR(2);} else if((tt)+2<NT){WAIT_BAR(1);} else {WAIT_BAR(0);} }while(0)
  for(;t+1<NT;t+=2){
    STEP(pB0,pB1,pA0,pA1,t,(t+3<NT),(t+1<NT),(t+1<NT));       ENDW(t);   RESC(); ROT();
    STEP(pA0,pA1,pB0,pB1,t+1,(t+4<NT),(t+2<NT),(t+2<NT));     ENDW(t+1); RESC(); ROT();
  }
  STEP(pB0,pB1,pA0,pA1,NT-1,false,false,false); RESC();
  { float sacc=pB0[0]+pB0[1]; _Pragma("unroll") for(int r=2;r<16;++r)sacc+=pB0[r]; _Pragma("unroll") for(int r=0;r<16;++r)sacc+=pB1[r]; l_reg+=sacc;
    pw0=(u32x4){PKW(pB0,0),PKW(pB0,2),PKW(pB0,4),PKW(pB0,6)};pw1=(u32x4){PKW(pB0,8),PKW(pB0,10),PKW(pB0,12),PKW(pB0,14)};pw2=(u32x4){PKW(pB1,0),PKW(pB1,2),PKW(pB1,4),PKW(pB1,6)};pw3=(u32x4){PKW(pB1,8),PKW(pB1,10),PKW(pB1,12),PKW(pB1,14)};
    SBAR(); pv(o,vb0+sl_cur,PAF(0),PAF(1),PAF(2),PAF(3)); }
  #undef PKW
  #undef PAF
  #undef VFR
  #undef PIN
  #undef MX3
  #undef GAPA
  #undef GAPB
  #undef EX
  #undef VRD
  #undef KRD
  #undef STEP
  #undef ENDW
  {auto rr=__builtin_amdgcn_permlane32_swap(__float_as_uint(l_reg),__float_as_uint(l_reg),false,false);l_reg=__uint_as_float(rr[0])+__uint_as_float(rr[1]);}
  if(hi==0)wsf[32+r32]=l_reg;asm volatile("s_waitcnt lgkmcnt(0)":::"memory");
  float rli[16];
  #pragma unroll
  for(int r=0;r<16;++r)rli[r]=__builtin_amdgcn_rcpf(wsf[32+crow(r,hi)]);
  bf16*Ow=O+(rowbase+q0+wid*QBLK)*QP+h*D;
  float*ssw=ssa+(rowbase+q0+wid*QBLK)*8+h;
  { bf16*stg=(bf16*)(shm+LDS_OST)+wid*2048;
    #pragma unroll
    for(int r=0;r<16;++r){const int orow=crow(r,hi);
      #pragma unroll
      for(int d0=0;d0<2;++d0)stg[orow*64+d0*32+r32]=__float2bfloat16(o[d0][r]*rli[r]);}
    asm volatile("s_waitcnt lgkmcnt(0)":::"memory");
    #pragma unroll
    for(int i=0;i<4;++i){const int row=i*8+(lane>>3),ch=lane&7; const u32x4 v=*(const u32x4*)(stg+row*64+ch*8); *(u32x4*)(Ow+(long)row*QP+ch*8)=v;
      float q=0.f;
      #pragma unroll
      for(int e=0;e<4;++e){const float lo=__uint_as_float(v[e]<<16),hi2=__uint_as_float(v[e]&0xffff0000u); q+=lo*lo+hi2*hi2;}
      q+=swz_xor<1>(q);q+=swz_xor<2>(q);q+=swz_xor<4>(q);
      if(ch==0)ssw[row*8]=q;} }
  asm volatile("s_waitcnt lgkmcnt(0)\n\ts_barrier":::"memory");
  #undef DMA_K
  #undef DMA_V
  #undef CMASK
  #undef ADDB
  #undef START
  #undef RESC
  #undef ROT
}
#undef SBAR
#undef WAIT_BAR

constexpr int CONV_W=31, CONV_C=512, CONV_TOK=32, CONV_ROWS=CONV_TOK+CONV_W-1, CONV_LDS_W=0, CONV_LDS_U=CONV_W*CONV_C*4;
__device__ __forceinline__ float wsum64(float v){ return wave_sum64(v); }
__device__ __forceinline__ void conv_stage_w(const float*cw,char*shm,const int tid){
  ATT_LAS u32x4*LW=(ATT_LAS u32x4*)(shm+CONV_LDS_W); const u32x4*src=(const u32x4*)cw;
  u32x4 v[8];
  #pragma unroll
  for(int i=0;i<8;++i){const int idx=tid+i*512; v[i]=(idx<CONV_W*CONV_C/4)?src[idx]:(u32x4){0u,0u,0u,0u};}
  #pragma unroll
  for(int i=0;i<8;++i){const int idx=tid+i*512; if(idx<CONV_W*CONV_C/4)LW[idx]=v[i];}
  __syncthreads();
}
__device__ __forceinline__ void conv_unit(int unit,const bf16*UB,const float*cbias,const float*lng,const float*lnb,bf16*Y,char*shm,const int tid){
  const int lane=tid&63,wid=tid>>6;
  const int b=unit>>6,t0=(unit&63)*CONV_TOK;
  ATT_LAS u32x4*L=(ATT_LAS u32x4*)(shm+CONV_LDS_U);
  const ATT_LAS f32x4_t*LW=(const ATT_LAS f32x4_t*)(shm+CONV_LDS_W);
  { u32x4 v[8];
    #pragma unroll
    for(int i=0;i<8;++i){const int idx=tid+i*512,row=idx>>6,ch=idx&63,t=t0-(CONV_W-1)+row;
      v[i]=(u32x4){0u,0u,0u,0u};
      if(idx<CONV_ROWS*64&&t>=0)v[i]=*(const u32x4*)(UB+((size_t)b*SEQ+t)*CONV_C+ch*8);}
    #pragma unroll
    for(int i=0;i<8;++i){const int idx=tid+i*512; if(idx<CONV_ROWS*64)L[idx]=v[i];} }
  __syncthreads();
  float acc[4][8];
  { const f32x4_t b0=*(const f32x4_t*)(cbias+8*lane),b1=*(const f32x4_t*)(cbias+8*lane+4);
    #pragma unroll
    for(int tt=0;tt<4;++tt){acc[tt][0]=b0[0];acc[tt][1]=b0[1];acc[tt][2]=b0[2];acc[tt][3]=b0[3];acc[tt][4]=b1[0];acc[tt][5]=b1[1];acc[tt][6]=b1[2];acc[tt][7]=b1[3];} }
  #pragma unroll 4
  for(int j=0;j<CONV_W;++j){
    const f32x4_t w0=LW[j*128+2*lane],w1=LW[j*128+2*lane+1];
    #pragma unroll
    for(int tt=0;tt<4;++tt){
      const u32x4 u=L[(wid*4+tt+j)*64+lane];
      acc[tt][0]+=w0[0]*__uint_as_float(u[0]<<16); acc[tt][1]+=w0[1]*__uint_as_float(u[0]&0xffff0000u);
      acc[tt][2]+=w0[2]*__uint_as_float(u[1]<<16); acc[tt][3]+=w0[3]*__uint_as_float(u[1]&0xffff0000u);
      acc[tt][4]+=w1[0]*__uint_as_float(u[2]<<16); acc[tt][5]+=w1[1]*__uint_as_float(u[2]&0xffff0000u);
      acc[tt][6]+=w1[2]*__uint_as_float(u[3]<<16); acc[tt][7]+=w1[3]*__uint_as_float(u[3]&0xffff0000u);
    }
  }
  const f32x4_t g0=*(const f32x4_t*)(lng+8*lane),g1=*(const f32x4_t*)(lng+8*lane+4),e0=*(const f32x4_t*)(lnb+8*lane),e1=*(const f32x4_t*)(lnb+8*lane+4);
  const float gg[8]={g0[0],g0[1],g0[2],g0[3],g1[0],g1[1],g1[2],g1[3]},bb[8]={e0[0],e0[1],e0[2],e0[3],e1[0],e1[1],e1[2],e1[3]};
  float mu[4],rstd[4],r2[4];
  #pragma unroll
  for(int tt=0;tt<4;++tt){ float s=0.f;
    #pragma unroll
    for(int e=0;e<8;++e)s+=acc[tt][e];
    mu[tt]=s; }
  #pragma unroll
  for(int tt=0;tt<4;++tt)mu[tt]=wsum64(mu[tt])*(1.0f/CONV_C);
  #pragma unroll
  for(int tt=0;tt<4;++tt){ float q=0.f;
    #pragma unroll
    for(int e=0;e<8;++e){acc[tt][e]-=mu[tt];q+=acc[tt][e]*acc[tt][e];}
    rstd[tt]=q; }
  #pragma unroll
  for(int tt=0;tt<4;++tt)rstd[tt]=__builtin_amdgcn_rsqf(wsum64(rstd[tt])*(1.0f/CONV_C)+1e-6f);
  #pragma unroll
  for(int tt=0;tt<4;++tt){ float q2=0.f;
    #pragma unroll
    for(int e=0;e<8;++e){float y=acc[tt][e]*rstd[tt]*gg[e]+bb[e]; y=y*__builtin_amdgcn_rcpf(1.0f+__builtin_amdgcn_exp2f(-y*1.4426950408889634f)); acc[tt][e]=y;q2+=y*y;}
    r2[tt]=q2; }
  #pragma unroll
  for(int tt=0;tt<4;++tt)r2[tt]=__builtin_amdgcn_rsqf(wsum64(r2[tt])*(1.0f/CONV_C)+1e-6f);
  #pragma unroll
  for(int tt=0;tt<4;++tt){
    u32x4 w; const float r=r2[tt];
    w[0]=cvtpk_s(acc[tt][0]*r,acc[tt][1]*r);w[1]=cvtpk_s(acc[tt][2]*r,acc[tt][3]*r);w[2]=cvtpk_s(acc[tt][4]*r,acc[tt][5]*r);w[3]=cvtpk_s(acc[tt][6]*r,acc[tt][7]*r);
    *(u32x4*)(Y+((size_t)b*SEQ+t0+wid*4+tt)*QP+CONV_C+8*lane)=w;
  }
  __syncthreads();
}
}
constexpr int NWAVES = 8;
constexpr int M = 16384, DM = 1024, DFF = 2816, SEQ = 2048, NBATCH = 8, NMEMROWS = 2048, NLAYER = 2;
constexpr size_t MiB = 1u << 20;
constexpr size_t WS_CTL = 0, CTL_ZERO_BYTES = 256 * 1024;
constexpr size_t WS_W = 2 * MiB;
constexpr size_t W_LAYER = 97 * MiB / 2;
constexpr size_t WO_1A = 0, WO_1B = 11 * MiB, WO_IN = WO_1B + 11 * MiB / 2, WO_OUT = WO_IN + 11 * MiB / 2, WO_XQ = WO_OUT + 2 * MiB, WO_XKV = WO_XQ + 2 * MiB, WO_XO = WO_XKV + 4 * MiB,
                 WO_2A = WO_XO + 2 * MiB, WO_2B = WO_2A + 11 * MiB;
static_assert(WO_2B + 11 * MiB / 2 == W_LAYER, "weight map");
constexpr size_t WS_XB = 100 * MiB;
constexpr size_t WS_MKV = 132 * MiB;
constexpr size_t WS_MEMB = 148 * MiB;
constexpr size_t WS_R1 = 152 * MiB;
constexpr size_t R1_H = 0;
constexpr size_t R1_Y = 0, R1_KB = 32 * MiB, R1_VB = 48 * MiB, R1_UB = 64 * MiB, R1_LOGF = 80 * MiB;
constexpr size_t R1_XP = 0, R1_WQK = 64 * MiB, R1_WVO = 80 * MiB;
constexpr size_t WS_SSP = 99 * MiB;
constexpr size_t WS_DUMMY = 248 * MiB, WS_SSA = 249 * MiB;
constexpr size_t WS_END = 250 * MiB;
constexpr int CW_BAR = 4096;
constexpr size_t CTL_SSM = 256 * 1024;
constexpr int RING_OFF = 0, RING_BYTES = 131072;
constexpr int EPI_SCR_OFF = RING_BYTES;
constexpr int LDSCTL_OFF = RING_BYTES + 8192, MISC_OFF = LDSCTL_OFF + 320;
constexpr int LDS_BYTES = 147456;
static_assert(MISC_OFF + 128 <= LDS_BYTES, "LDS map");

#define GAS __attribute__((address_space(1)))
#define LAS __attribute__((address_space(3)))
typedef unsigned short bf16;
typedef unsigned v4u __attribute__((ext_vector_type(4)));
typedef float f32x4 __attribute__((ext_vector_type(4)));
typedef GAS unsigned gu32;
#define RLX_AGENT __ATOMIC_RELAXED, __HIP_MEMORY_SCOPE_AGENT
#define LDS_WAIT() asm volatile("s_waitcnt lgkmcnt(0)" ::: "memory")
__device__ __forceinline__ unsigned f2bf(float f) { unsigned u = __builtin_bit_cast(unsigned, f); return (u + 0x7fffu + ((u >> 16) & 1u)) >> 16; }
__device__ __forceinline__ unsigned pk2(float lo, float hi) { return f2bf(lo) | (f2bf(hi) << 16); }

#define XB_TMO      128
#define XB_XCNT(j)  (256  + 64 * (j))
#define XB_XSUB(j)  (1280 + 64 * (j))
#define XB_XGEN(j)  (2304 + 64 * (j))
#define XB_TOP      3328
#define XB_TOPGEN   3392
#define XCD_BAR_WORDS 3456
#define XB_SPIN_CAP (1u << 18)
__device__ __forceinline__ unsigned xb_ld(unsigned* p)              { return __hip_atomic_load(p, __ATOMIC_RELAXED, __HIP_MEMORY_SCOPE_AGENT); }
__device__ __forceinline__ unsigned xb_add(unsigned* p, unsigned v) { return __hip_atomic_fetch_add(p, v, __ATOMIC_RELAXED, __HIP_MEMORY_SCOPE_AGENT); }
__device__ __forceinline__ unsigned xb_xcc_id() { return (unsigned)__builtin_amdgcn_s_getreg((3 << 11) | 20) & 0xFu; }
#define XB_SPIN(cond, bar) do { unsigned _sp = 0; while (cond) { __builtin_amdgcn_s_sleep(1); \
    if ((++_sp & 255u) == 0u) { if (xb_ld(&(bar)[XB_TMO])) break; if (_sp > XB_SPIN_CAP) { atomicAdd(&(bar)[XB_TMO], 1u); break; } } } } while (0)
struct XcdBarrier { unsigned* bar; unsigned x; volatile LAS unsigned* st; };
__device__ __forceinline__ XcdBarrier xcd_barrier_post(unsigned* bar, volatile LAS unsigned* st) {
    XcdBarrier b; b.bar = bar; b.x = xb_xcc_id(); b.st = st;
    if (threadIdx.x == 0) (void)xb_add(&bar[XB_XCNT(b.x)], 1u);
    return b;
}
__device__ __forceinline__ void xcd_barrier_complete(unsigned* bar, unsigned x, unsigned& nloc, unsigned& nx) {
    const unsigned G = gridDim.x * gridDim.y * gridDim.z;
    unsigned sum, cnt, mine, sp = 0u;
    for (;;) {
        sum = 0u; cnt = 0u; mine = 0u;
#pragma unroll
        for (unsigned j = 0; j < 16; ++j) { const unsigned c = xb_ld(&bar[XB_XCNT(j)]); sum += c; cnt += (c > 0u) ? 1u : 0u; mine = (j == x) ? c : mine; }
        if (sum == G) break;
        __builtin_amdgcn_s_sleep(1);
        if ((++sp & 255u) == 0u) { if (xb_ld(&bar[XB_TMO])) break; if (sp > XB_SPIN_CAP) { atomicAdd(&bar[XB_TMO], 1u); break; } }
    }
    nloc = mine > 0u ? mine : 1u; nx = cnt > 0u ? cnt : 1u;
}
__device__ __forceinline__ void xcd_barrier(const XcdBarrier& b) {
    asm volatile("s_waitcnt vmcnt(0)" ::: "memory");
    __syncthreads();
    if (threadIdx.x == 0) {
        unsigned* bar = b.bar;
        __builtin_amdgcn_s_waitcnt(0);
        unsigned nloc = b.st[0], nx = b.st[1];
        if (nloc == 0u) { xcd_barrier_complete(bar, b.x, nloc, nx); b.st[0] = nloc; b.st[1] = nx; }
        const unsigned old = xb_add(&bar[XB_XSUB(b.x)], 1u);
        const unsigned gen = old / nloc;
        if (old + 1u == (gen + 1u) * nloc) {
            __builtin_amdgcn_fence(__ATOMIC_RELEASE, "agent");
            asm volatile("s_waitcnt vmcnt(0)" ::: "memory");
            const unsigned og = xb_add(&bar[XB_TOP], 1u);
            const unsigned tg = og / nx;
            if (og + 1u == (tg + 1u) * nx) xb_add(&bar[XB_TOPGEN], 1u);
            else XB_SPIN(xb_ld(&bar[XB_TOPGEN]) == tg, bar);
            __builtin_amdgcn_fence(__ATOMIC_ACQUIRE, "agent");
            xb_add(&bar[XB_XGEN(b.x)], 1u);
            asm volatile("s_waitcnt vmcnt(0)" ::: "memory");
        } else {
            XB_SPIN(xb_ld(&bar[XB_XGEN(b.x)]) == gen, bar);
            __builtin_amdgcn_fence(__ATOMIC_ACQUIRE, "agent");
            asm volatile("s_waitcnt vmcnt(0)" ::: "memory");
        }
    }
    __syncthreads();
}

__device__ __forceinline__ float wave_sum(float v) { return wave_sum64(v); }
__device__ __forceinline__ void tr_item(const float* W, int ldw, int col0, int nvalid, int k0, const float* gain, int gsplit, const float* gain2, bf16* WT, int ldt, int drow0, LAS float* scr, int lane) {
#pragma unroll 8
    for (int i = 0; i < 32; ++i) { const int kk = 2 * i + (lane >> 5), n = lane & 31, k = k0 + kk;
        float v = (n < nvalid) ? W[(size_t)k * ldw + col0 + n] : 0.f;
        if (gain) v *= (k < gsplit ? gain[k] : gain2[k - gsplit]);
        scr[kk * 33 + n] = v; }
    LDS_WAIT(); asm volatile("" ::: "memory");
    const int c = lane & 7;
#pragma unroll
    for (int j = 0; j < 4; ++j) { const int n = (lane >> 3) + 8 * j; const LAS float* s = scr + (8 * c) * 33 + n;
        v4u o; o.x = pk2(s[0 * 33], s[1 * 33]); o.y = pk2(s[2 * 33], s[3 * 33]); o.z = pk2(s[4 * 33], s[5 * 33]); o.w = pk2(s[6 * 33], s[7 * 33]);
        *(GAS v4u*)(WT + (size_t)(drow0 + n) * ldt + k0 + 8 * c) = o; }
    LDS_WAIT(); asm volatile("" ::: "memory");
}
__device__ __forceinline__ void tr_item64(const float* W, int ldw, int col0, int nvalid, int k0, const float* gain, int gsplit, const float* gain2, bf16* WT, int ldt, int drow0, int lane) {
    float v[64];
    const float* src = W + (size_t)k0 * ldw + col0 + lane; const bool ok = lane < nvalid;
#pragma unroll
    for (int j = 0; j < 64; ++j) v[j] = ok ? src[(size_t)j * ldw] : 0.f;
    if (gain) {
#pragma unroll
        for (int j = 0; j < 64; ++j) { const int k = k0 + j; v[j] *= (k < gsplit ? gain[k] : gain2[k - gsplit]); }
    }
    bf16* dst = WT + (size_t)(drow0 + lane) * ldt + k0;
#pragma unroll
    for (int c = 0; c < 8; ++c) { v4u o; o.x = pk2(v[8 * c], v[8 * c + 1]); o.y = pk2(v[8 * c + 2], v[8 * c + 3]); o.z = pk2(v[8 * c + 4], v[8 * c + 5]); o.w = pk2(v[8 * c + 6], v[8 * c + 7]);
        *(GAS v4u*)(dst + 8 * c) = o; }
}
__device__ __forceinline__ void row_to_bf16(const float* xrow, bf16* orow, float* ssp, int lane) {
    const GAS f32x4* xr = (const GAS f32x4*)xrow + lane;
    f32x4 v[4]; float s = 0.f;
#pragma unroll
    for (int j = 0; j < 4; ++j) { v[j] = xr[64 * j]; s += (v[j].x * v[j].x + v[j].y * v[j].y) + (v[j].z * v[j].z + v[j].w * v[j].w); }
    s = wave_sum(s);
    GAS unsigned long long* o8 = (GAS unsigned long long*)orow + lane;
#pragma unroll
    for (int j = 0; j < 4; ++j) o8[64 * j] = (unsigned long long)pk2(v[j].x, v[j].y) | ((unsigned long long)pk2(v[j].z, v[j].w) << 32);
    if (lane == 0) *ssp = s;
}

struct Args { const float* in[26]; float* out; unsigned char* ws; int ph_lo, ph_hi, li, pad; };

enum { PH_PRO = 0, PH_L0 = 1, PH_PER_LAYER = 9, PH_FINAL = PH_L0 + 2 * PH_PER_LAYER, PH_COUNT = PH_FINAL + 1 };

#define WSP() ({ unsigned char* w_ = args.ws; asm volatile("" : "+s"(w_)); w_; })
#define INP(i) ({ int i_ = __builtin_amdgcn_readfirstlane(i); asm volatile("" : "+s"(i_)); args.in[i_]; })
#define XPTR() ({ float* x_ = args.out; asm volatile("" : "+s"(x_)); x_; })
#define TID() ({ int w_ = wid_s; asm volatile("" : "+s"(w_)); int t_ = (w_ << 6) | (int)__builtin_amdgcn_mbcnt_hi(~0u, __builtin_amdgcn_mbcnt_lo(~0u, 0u)); asm volatile("" : "+v"(t_)); t_; })

constexpr size_t T1K = (size_t)256 * 1024 * 2, TFF = (size_t)256 * 2816 * 2;
using G_1024 = pg8::Gemm<1024, 1024, 1024>; using G_down = pg8::Gemm<2816, 2816, 2816>; using G_qk = pg8::Gemm<2048, 1024, 256>; using G_vo = pg8::Gemm<1024, 2048, 256>;
using S_up = pg8::SchedT<0, 64, 22, T1K, T1K>; using S_mkv = pg8::SchedT<0, 8, 8, T1K, T1K>; using S_down = pg8::SchedT<0, 64, 4, TFF, TFF>; using S_win = pg8::SchedT<0, 64, 11, T1K, T1K>;
using S_sq = pg8::SchedT<0, 64, 4, T1K, T1K>; using S_xb = pg8::SchedT<1, 64, 4, T1K, T1K, (size_t)1024 * 1024 * 2>; using S_qk = pg8::SchedT<2, 128, 1, 0, 0>; using S_vo = pg8::SchedT<3, 128, 1, 0, 0>;

#ifndef PROBE_MASK
#define PROBE_MASK 0
#endif
#ifndef PROBE_REPS
#define PROBE_REPS 1
#endif
#ifndef PROBE_BARS
#define PROBE_BARS 0
#endif
#ifndef PROBE_NOATT
#define PROBE_NOATT 0
#endif
#ifndef PROBE_NOCONV
#define PROBE_NOCONV 0
#endif
#define NREP(k) (((PROBE_MASK >> (k)) & 1) ? (PROBE_REPS + 1) : 1)
#define REP_LOOP(k) _Pragma("unroll 1") for (int rep_ = 0; rep_ < NREP(k); ++rep_)
#define SHADOW(k) (NREP(k) > 1 && rep_ + 1 < NREP(k))
#define REP_SEAM(k) do { if (SHADOW(k)) GRIDBAR(); } while (0)

__global__ void __launch_bounds__(NWAVES * 64, 2) mega_fwd(Args args) {
    extern __shared__ __attribute__((aligned(16))) unsigned char lds[];
    LAS unsigned char* ldsp = (LAS unsigned char*)lds;
    volatile LAS unsigned* MISC = (volatile LAS unsigned*)(ldsp + MISC_OFF);
    constexpr int G = 256; const int bx = blockIdx.x;
    const int wid_s = __builtin_amdgcn_readfirstlane(threadIdx.x >> 6);
    for (int u = threadIdx.x; u < (LDS_BYTES - LDSCTL_OFF) / 4; u += NWAVES * 64) ((LAS unsigned*)(ldsp + LDSCTL_OFF))[u] = 0u;
    __syncthreads();
    (void)xcd_barrier_post((unsigned*)(args.ws + WS_CTL) + CW_BAR + args.li * XCD_BAR_WORDS, MISC + 8);
#define PHLO() ({ int i_ = 0; asm volatile("" : "+s"(i_)); (&args.ph_lo)[i_]; })
#define PHHI() ({ int i_ = 1; asm volatile("" : "+s"(i_)); (&args.ph_lo)[i_]; })
#define PHLI() ({ int i_ = 2; asm volatile("" : "+s"(i_)); (&args.ph_lo)[i_]; })
#define IN(k) (PHLO() <= (k) && (k) < PHHI())
#define GRIDBAR() do { XcdBarrier bar_; bar_.bar = (unsigned*)(WSP() + WS_CTL) + CW_BAR + PHLI() * XCD_BAR_WORDS; bar_.x = xb_xcc_id(); bar_.st = MISC + 8; xcd_barrier(bar_); } while (0)
#define SEAM(k) do { if (IN(k) && IN((k) + 1)) { XcdBarrier bar_; bar_.bar = (unsigned*)(WSP() + WS_CTL) + CW_BAR + PHLI() * XCD_BAR_WORDS; bar_.x = xb_xcc_id(); bar_.st = MISC + 8; xcd_barrier(bar_); } } while (0)
    constexpr float QSCALE = 0.125f * 1.4426950408889634f, XSCALE = 0.0625f * 1.4426950408889634f;

    if (IN(PH_PRO)) REP_LOOP(9) {
        unsigned char* ws = WSP(); const int tid = TID();
        const int lane = tid & 63, wave = __builtin_amdgcn_readfirstlane(tid >> 6);
        const int gw = bx * NWAVES + wave, NGW = G * NWAVES;
        constexpr int I_GU = 2 * 16 * 44, I_DN = 44 * 16, I_IN = 16 * 41, I_SQ = 16 * 16, I_KV = 16 * 32, I_WQ = 256;
        constexpr int L_ITEMS = 2 * (I_GU + I_DN) + I_IN + I_SQ + I_KV + I_SQ + I_WQ, W_ITEMS = NLAYER * L_ITEMS, X_ITEMS = M / 4, MEM_ITEMS = NMEMROWS / 4;
#pragma unroll 1
        for (int it = gw; it < W_ITEMS + X_ITEMS + MEM_ITEMS; it += NGW) {
            if (it < W_ITEMS) {
                const int l = it / L_ITEMS; int r = it % L_ITEMS;
                unsigned char* wl = ws + WS_W + (size_t)l * W_LAYER;
                if (r < 2 * (I_GU + I_DN)) {
                    const int f = r / (I_GU + I_DN); r %= (I_GU + I_DN);
                    if (r < I_GU) { const int which = r / (16 * 44), q = r % (16 * 44), kb = q / 44, nb = q % 44, j0 = nb * 64;
                        const float* w = INP(which ? (f ? 23 : 4) : (f ? 22 : 3)) + (size_t)l * DM * DFF; const float* gn = INP(f ? 21 : 2) + l * DM;
                        tr_item64(w, DFF, j0, 64, kb * 64, gn, 1 << 30, gn, (bf16*)(wl + (f ? WO_2A : WO_1A)), DM, 256 * (j0 / 128) + which * 128 + (j0 % 128), lane); }
                    else { r -= I_GU; const int kb = r / 16, nb = r % 16; const float* w = INP(f ? 24 : 5) + (size_t)l * DFF * DM;
                        tr_item64(w, DM, nb * 64, 64, kb * 64, nullptr, 0, w, (bf16*)(wl + (f ? WO_2B : WO_1B)), DFF, nb * 64, lane); }
                    continue;
                }
                r -= 2 * (I_GU + I_DN);
                if (r < I_IN) {
                    const int kb = r / 41, nb = r % 41; int col0, nvalid = 64, drow0;
                    if (nb < 24) { col0 = nb * 64; drow0 = col0; }
                    else if (nb == 24) { col0 = 1536; nvalid = 8; drow0 = 2560; }
                    else if (nb < 33) { const int ch = (nb - 25) * 64; col0 = 1544 + ch; drow0 = 1536 + 256 * (ch / 128) + (ch % 128); }
                    else { const int ch = (nb - 33) * 64; col0 = 2056 + ch; drow0 = 1536 + 256 * (ch / 128) + 128 + (ch % 128); }
                    const float* w = INP(7) + (size_t)l * DM * 2568; const float* gn = INP(6) + l * DM;
                    tr_item64(w, 2568, col0, nvalid, kb * 64, gn, 1 << 30, gn, (bf16*)(wl + WO_IN), DM, drow0, lane); continue; }
                r -= I_IN;
                if (r < I_SQ) { const int kb = r / 16, nb = r % 16; const float* w = INP(15) + (size_t)l * DM * DM;
                    tr_item64(w, DM, nb * 64, 64, kb * 64, INP(13) + l * 512, 512, INP(14) + l * 512, (bf16*)(wl + WO_OUT), DM, nb * 64, lane); continue; }
                r -= I_SQ;
                if (r < I_KV) { const int kb = r / 32, nb = r % 32; const float* w = INP(19) + (size_t)l * DM * 2048; const float* gn = INP(17) + l * DM;
                    tr_item64(w, 2048, nb * 64, 64, kb * 64, gn, 1 << 30, gn, (bf16*)(wl + WO_XKV), DM, nb * 64, lane); continue; }
                r -= I_KV;
                if (r < I_SQ) { const int kb = r / 16, nb = r % 16; const float* w = INP(20) + (size_t)l * DM * DM;
                    tr_item64(w, DM, nb * 64, 64, kb * 64, nullptr, 0, w, (bf16*)(wl + WO_XO), DM, nb * 64, lane); continue; }
                r -= I_SQ;
                { const float* w = INP(18) + (size_t)l * DM * DM; const float* gn = INP(16) + l * DM; bf16* WQ = (bf16*)(wl + WO_XQ);
                  f32x4 v[4][4];
#pragma unroll
                  for (int q = 0; q < 4; ++q)
#pragma unroll
                      for (int j = 0; j < 4; ++j) v[q][j] = *((const GAS f32x4*)(w + (size_t)(4 * r + q) * DM) + lane + 64 * j);
#pragma unroll
                  for (int q = 0; q < 4; ++q) { const float g = gn[4 * r + q] * XSCALE; GAS unsigned long long* o8 = (GAS unsigned long long*)(WQ + (size_t)(4 * r + q) * DM) + lane;
#pragma unroll
                      for (int j = 0; j < 4; ++j) { const f32x4 t = v[q][j] * g; o8[64 * j] = (unsigned long long)pk2(t.x, t.y) | ((unsigned long long)pk2(t.z, t.w) << 32); } } }
            } else {
                int r = it - W_ITEMS; const bool ismem = r >= X_ITEMS; if (ismem) r -= X_ITEMS;
                const float* src = INP(ismem ? 1 : 0) + (size_t)(4 * r) * DM; bf16* dst = (bf16*)(ws + (ismem ? WS_MEMB : WS_XB)) + (size_t)(4 * r) * DM; float* ssp = ismem ? (float*)(ws + CTL_SSM) + 4 * r : (float*)(ws + WS_SSP) + (size_t)(4 * r) * 16;
                f32x4 v[4][4]; float s[4];
#pragma unroll
                for (int q = 0; q < 4; ++q)
#pragma unroll
                    for (int j = 0; j < 4; ++j) v[q][j] = *((const GAS f32x4*)(src + (size_t)q * DM) + lane + 64 * j);
#pragma unroll
                for (int q = 0; q < 4; ++q) { s[q] = 0.f;
#pragma unroll
                    for (int j = 0; j < 4; ++j) s[q] += (v[q][j].x * v[q][j].x + v[q][j].y * v[q][j].y) + (v[q][j].z * v[q][j].z + v[q][j].w * v[q][j].w); }
#pragma unroll
                for (int q = 0; q < 4; ++q) { s[q] = wave_sum64(s[q]); GAS unsigned long long* o8 = (GAS unsigned long long*)(dst + (size_t)q * DM) + lane;
#pragma unroll
                    for (int j = 0; j < 4; ++j) o8[64 * j] = (unsigned long long)pk2(v[q][j].x, v[q][j].y) | ((unsigned long long)pk2(v[q][j].z, v[q][j].w) << 32);
                    if (ismem) { if (lane == 0) ssp[q] = s[q]; } else if (lane < 16) ssp[q * 16 + lane] = (lane == 0) ? s[q] : 0.f; }
            }
        }
        REP_SEAM(9);
    }
    SEAM(PH_PRO);

#pragma unroll 1
    for (int l = 0; l < NLAYER; ++l) {
        const int P = PH_L0 + l * PH_PER_LAYER;
#pragma unroll 1
        for (int f = 0; f < 2; ++f) {
            const int pu = P + (f ? 7 : 0), pd = pu + 1;
            if (IN(pu)) REP_LOOP(0) {
                unsigned char* ws = WSP(); unsigned char* wl = ws + WS_W + (size_t)l * W_LAYER;
                G_1024 g; S_up S; S.init(bx, ws + WS_XB, wl + (f ? WO_2A : WO_1A));
                pg8::EpiSwiGLU E{(bf16*)(ws + WS_R1 + R1_H), (float*)(ws + WS_SSP)};
                pg8::gemm_phase<pg8::EpiSwiGLU, decltype(S), decltype(g)>(ldsp + RING_OFF, g, S, E, TID());
                if (l == 0 && f == 0) {
#pragma unroll 1
                    for (int l2 = 0; l2 < NLAYER; ++l2) {
                        unsigned char* ws2 = WSP();
                        S_mkv S2; S2.init((bx + 128 - 64 * l2) % G, ws2 + WS_MEMB, ws2 + WS_W + (size_t)l2 * W_LAYER + WO_XKV);
                        pg8::EpiRowScale E2{(bf16*)(ws2 + WS_MKV) + (size_t)l2 * 2048 * 2048, (float*)(ws2 + CTL_SSM), 1.0f};
                        pg8::gemm_phase<pg8::EpiRowScale, decltype(S2), decltype(g)>(ldsp + RING_OFF, g, S2, E2, TID());
                    }
                }
                REP_SEAM(0);
            }
            SEAM(pu);
            if (IN(pd)) REP_LOOP(1) {
                unsigned char* ws = WSP(); unsigned char* wl = ws + WS_W + (size_t)l * W_LAYER; float* X = XPTR();
                G_down g; S_down S; S.init(bx, ws + WS_R1 + R1_H, wl + (f ? WO_2B : WO_1B));
                pg8::EpiResid<0> E{(l == 0 && f == 0) ? INP(0) : (const float*)nullptr, (l == NLAYER - 1 && f == 1 && !SHADOW(1)) ? X : (float*)nullptr, (bf16*)(ws + WS_XB), SHADOW(1) ? (float*)(ws + WS_DUMMY) : (float*)(ws + WS_SSP), nullptr, SHADOW(1) ? 0.f : 0.5f};
                E.shadow_skip = SHADOW(1);
                pg8::gemm_phase<pg8::EpiResid<0>, decltype(S), decltype(g)>(ldsp + RING_OFF, g, S, E, TID());
                REP_SEAM(1);
            }
            SEAM(pd);
            if (f == 1) break;
            if (IN(P + 2)) REP_LOOP(2) {
                unsigned char* ws = WSP(); unsigned char* wl = ws + WS_W + (size_t)l * W_LAYER; unsigned char* R1 = ws + WS_R1;
                G_1024 g; S_win S; S.init(bx, ws + WS_XB, wl + WO_IN);
                pg8::EpiWin E{(bf16*)(R1 + R1_Y), (bf16*)(R1 + R1_KB), (bf16*)(R1 + R1_VB), (bf16*)(R1 + R1_UB), (float*)(R1 + R1_LOGF), (float*)(ws + WS_SSP), INP(8) + l * 8, QSCALE};
                pg8::gemm_phase<pg8::EpiWin, decltype(S), decltype(g)>(ldsp + RING_OFF, g, S, E, TID());
                REP_SEAM(2);
            }
            SEAM(P + 2);
            if (IN(P + 3)) REP_LOOP(3) {
                unsigned char* ws = WSP(); unsigned char* R1 = ws + WS_R1;
                char* shm = (char*)lds + RING_OFF;
                const int vcu = (G % 8 == 0) ? (bx % 8) * (G / 8) + bx / 8 : bx;
                const int bh = vcu >> 2, s4 = vcu & 3;
                attn_body::bf16* YB = (attn_body::bf16*)(R1 + R1_Y); const attn_body::bf16* KB = (const attn_body::bf16*)(R1 + R1_KB); const attn_body::bf16* VB = (const attn_body::bf16*)(R1 + R1_VB);
                float* ssa = SHADOW(3) ? (float*)(ws + WS_DUMMY) : (float*)(ws + WS_SSA);
                attn_body::bf16* OB = SHADOW(3) ? YB + 512 : YB;
                if (!(SHADOW(3) && PROBE_NOATT)) {
                attn_body::scan_bias((const float*)(R1 + R1_LOGF), bh, shm, TID());
#pragma unroll 1
                for (int iu = 0; iu < 2; ++iu) attn_body::attn_unit<8>(bh >> 3, bh & 7, iu ? 7 - s4 : s4, YB, KB, VB, OB, ssa, shm, TID());
                __syncthreads();
                }
                if (!(SHADOW(3) && PROBE_NOCONV)) {
                    attn_body::conv_stage_w(INP(9) + (size_t)l * 31 * 512, shm, TID());
#pragma unroll 1
                    for (int iu = 0; iu < 2; ++iu) attn_body::conv_unit(2 * bx + iu, (const attn_body::bf16*)(R1 + R1_UB), INP(10) + l * 512, INP(11) + l * 512, INP(12) + l * 512, YB, shm, TID());
                }
                REP_SEAM(3);
            }
            SEAM(P + 3);
            if (IN(P + 4)) REP_LOOP(4) {
                { unsigned char* ws = WSP(); unsigned char* wl = ws + WS_W + (size_t)l * W_LAYER; float* X = XPTR();
                  G_1024 g; S_sq S; S.init(bx, ws + WS_R1 + R1_Y, wl + WO_OUT);
                  pg8::EpiResid<8> E{nullptr, nullptr, (bf16*)(ws + WS_XB), SHADOW(4) ? (float*)(ws + WS_DUMMY) : (float*)(ws + WS_SSP), (float*)(ws + WS_SSA), SHADOW(4) ? 0.f : 1.0f};
                  pg8::gemm_phase<pg8::EpiResid<8>, decltype(S), decltype(g)>(ldsp + RING_OFF, g, S, E, TID()); }
                { unsigned char* ws = WSP(); unsigned char* wl = ws + WS_W + (size_t)l * W_LAYER;
                  G_qk g; S_qk S; S.init(bx, (bf16*)(ws + WS_MKV) + (size_t)l * 2048 * 2048, wl + WO_XQ);
                  pg8::EpiAux E{(bf16*)(ws + WS_R1 + R1_WQK), 1.0f};
                  pg8::gemm_phase<pg8::EpiAux, decltype(S), decltype(g)>(ldsp + RING_OFF, g, S, E, TID()); }
                { unsigned char* ws = WSP(); unsigned char* wl = ws + WS_W + (size_t)l * W_LAYER;
                  G_vo g; S_vo S; S.init((bx + 128) % G, wl + WO_XO, (bf16*)(ws + WS_MKV) + (size_t)l * 2048 * 2048);
                  pg8::EpiAux E{(bf16*)(ws + WS_R1 + R1_WVO), 1.0f};
                  pg8::gemm_phase<pg8::EpiAux, decltype(S), decltype(g)>(ldsp + RING_OFF, g, S, E, TID()); }
                REP_SEAM(4);
            }
            SEAM(P + 4);
            if (IN(P + 5)) REP_LOOP(5) {
                unsigned char* ws = WSP();
                G_1024 g; S_xb S; S.init(bx, ws + WS_XB, ws + WS_R1 + R1_WQK);
                pg8::EpiSoftmax E{(bf16*)(ws + WS_R1 + R1_XP), (float*)(ws + WS_SSP), (LAS float*)(ldsp + EPI_SCR_OFF)};
                E.shadow_skip = SHADOW(5);
                pg8::gemm_phase<pg8::EpiSoftmax, decltype(S), decltype(g)>(ldsp + RING_OFF, g, S, E, TID());
                REP_SEAM(5);
            }
            SEAM(P + 5);
            if (IN(P + 6)) REP_LOOP(6) {
                unsigned char* ws = WSP(); float* X = XPTR();
                G_1024 g; S_xb S; S.init(bx, ws + WS_R1 + R1_XP, ws + WS_R1 + R1_WVO);
                pg8::EpiResid<0> E{nullptr, nullptr, (bf16*)(ws + WS_XB), SHADOW(6) ? (float*)(ws + WS_DUMMY) : (float*)(ws + WS_SSP), nullptr, SHADOW(6) ? 0.f : 1.0f};
                E.shadow_skip = SHADOW(6);
                pg8::gemm_phase<pg8::EpiResid<0>, decltype(S), decltype(g)>(ldsp + RING_OFF, g, S, E, TID());
                REP_SEAM(6);
            }
            SEAM(P + 6);
        }
    }
    for (int eb_ = 0; eb_ < PROBE_BARS; ++eb_) GRIDBAR();
    if (IN(PH_FINAL)) {
        unsigned char* ws = WSP(); float* X = XPTR(); const int tid = TID();
        const int lane = tid & 63, wave = __builtin_amdgcn_readfirstlane(tid >> 6);
        const int gw = bx * NWAVES + wave, NGW = G * NWAVES; const float* ssf = (float*)(ws + WS_SSP); const float* gn = INP(25);
        f32x4 gv[4];
#pragma unroll
        for (int j = 0; j < 4; ++j) gv[j] = *((const GAS f32x4*)gn + lane + 64 * j);
        for (int m = gw; m < M; m += NGW) { GAS f32x4* xr = (GAS f32x4*)(X + (size_t)m * DM) + lane; const float rs = pg8::rs_row(ssf, m);
#pragma unroll
            for (int j = 0; j < 4; ++j) xr[64 * j] = xr[64 * j] * rs * gv[j]; }
    }
#undef IN
#undef SEAM
}

static int g_grid = 0;
static bool mega_setup() {
    if (g_grid) return g_grid > 0;
    int dev = 0, cus = 0, per_cu = 0;
    if (hipGetDevice(&dev) != hipSuccess || hipDeviceGetAttribute(&cus, hipDeviceAttributeMultiprocessorCount, dev) != hipSuccess) { g_grid = -1; return false; }
    if (hipFuncSetAttribute((const void*)mega_fwd, hipFuncAttributeMaxDynamicSharedMemorySize, LDS_BYTES) != hipSuccess) { fprintf(stderr, "hipFuncSetAttribute failed\n"); g_grid = -1; return false; }
    if (hipOccupancyMaxActiveBlocksPerMultiprocessor(&per_cu, (const void*)mega_fwd, NWAVES * 64, LDS_BYTES) != hipSuccess || per_cu < 1) { fprintf(stderr, "occupancy query: %d blocks per CU\n", per_cu); (void)hipGetLastError(); g_grid = -1; return false; }
    g_grid = cus;
    if (g_grid != 256) { fprintf(stderr, "kernel_launch: %d CUs; the phase program is laid out for exactly 256: nothing launched\n", g_grid); g_grid = -1; return false; }
    return true;
}
static void mega_launch(void* const* d_in, void* d_out, void* d_ws, hipStream_t stream, int lo, int hi, int li) {
    Args a{};
    for (int i = 0; i < 26; ++i) a.in[i] = (const float*)d_in[i];
    a.out = (float*)d_out; a.ws = (unsigned char*)d_ws; a.ph_lo = lo; a.ph_hi = hi; a.li = li;
    hipLaunchKernelGGL(mega_fwd, dim3(g_grid), dim3(NWAVES * 64), LDS_BYTES, stream, a);
}
extern "C" void kernel_launch(void* const* d_in, const int* in_sizes, int n_in, void* d_out, int out_size, void* d_ws, size_t ws_size, hipStream_t stream) {
    if (!mega_setup()) return;
    if (ws_size < WS_END) { fprintf(stderr, "kernel_launch: workspace too small (%zu < %zu)\n", ws_size, (size_t)WS_END); return; }
    (void)hipMemsetAsync((char*)d_ws + WS_CTL, 0, CTL_ZERO_BYTES, stream);
    mega_launch(d_in, d_out, d_ws, stream, 0, PH_COUNT, 0);
}
```

```cpp
#include <hip/hip_runtime.h>
#include <cstdio>
#include <cstdint>
template <int X> __device__ __forceinline__ float swz_xor(float v) { return __int_as_float(__builtin_amdgcn_ds_swizzle(__float_as_int(v), (X << 10) | 0x1f)); }
__device__ __forceinline__ float sum_x32(float v) { auto rr = __builtin_amdgcn_permlane32_swap(__float_as_uint(v), __float_as_uint(v), false, false); return __uint_as_float(rr[0]) + __uint_as_float(rr[1]); }
__device__ __forceinline__ float max_x32(float v) { auto rr = __builtin_amdgcn_permlane32_swap(__float_as_uint(v), __float_as_uint(v), false, false); return fmaxf(__uint_as_float(rr[0]), __uint_as_float(rr[1])); }
__device__ __forceinline__ float wave_sum64(float v) { v += swz_xor<1>(v); v += swz_xor<2>(v); v += swz_xor<4>(v); v += swz_xor<8>(v); v += swz_xor<16>(v); return sum_x32(v); }
namespace pg8 {
#define PG8_LAS __attribute__((address_space(3)))
typedef unsigned short bf16_t;
typedef short bf16x8 __attribute__((ext_vector_type(8)));
typedef float f32x4 __attribute__((ext_vector_type(4)));
typedef float f32x2 __attribute__((ext_vector_type(2)));
typedef unsigned u32x4 __attribute__((ext_vector_type(4)));
constexpr int BM = 256, BK = 64, HALF = 128, HTB = HALF * BK * 2  , STAGE_BYTES = 8 * HTB, NXCD = 8, WGM = 8;

__host__ __device__ __forceinline__ int lds_byte(int r, int c) { const int st = (r >> 4) * 2 + (c >> 5), rr = r & 15, cc = c & 31, ob = rr * 64 + cc * 2; return st * 1024 + (ob ^ (((ob >> 9) & 1) << 5)); }
__host__ __device__ __forceinline__ void stage_rc(int b, int& R, int& C) { const int st = b / 1024, sb = b % 1024, swz = sb ^ (((sb >> 9) & 1) << 5); R = (st >> 1) * 16 + swz / 64; C = (st & 1) * 32 + (swz % 64) / 2; }
__host__ __device__ __forceinline__ int perm32(int rho) { const int n = rho >> 4, i = rho & 15; return 8 * (i >> 2) + 4 * n + (i & 3); }

struct Unit { int pm, pn; const char* a; const char* b; int aux; };
template <int LDA, int LDB, int K_> struct Gemm { static constexpr int lda = LDA, ldb = LDB, K = K_; };

__device__ __forceinline__ unsigned cvt_pk_bf16(float lo, float hi) { unsigned r; asm volatile("v_cvt_pk_bf16_f32 %0, %1, %2" : "=v"(r) : "v"(lo), "v"(hi)); return r; }


template <class Epi, class Sched, class Gemm, bool ALIGN_EPI = true, bool SP2 = true>
__device__ __forceinline__ void gemm_phase(PG8_LAS unsigned char* lds, const Gemm g, const Sched& S, const Epi& E, const int tid) {
    const int wid = __builtin_amdgcn_readfirstlane(tid >> 6), lane = tid & 63, wr = wid >> 2, wc = wid & 3, fr = lane & 15, fq = lane >> 4;
    constexpr int K = Gemm::K, nt = K / BK;
    unsigned voffA[2], voffB[2];
#pragma unroll
    for (int i = 0; i < 2; ++i) { int R, C; stage_rc(tid * 16 + i * 8192, R, C); const int Rb = Epi::PERM ? ((R & ~31) + perm32(R & 31)) : R;
        voffA[i] = (unsigned)(R * Gemm::lda + C) * 2u; voffB[i] = (unsigned)(Rb * Gemm::ldb + C) * 2u; }
    constexpr size_t kstep = (size_t)(BK * 2);
    constexpr size_t hstepA = (size_t)HALF * Gemm::lda * 2, hstepB = (size_t)HALF * Gemm::ldb * 2;
    const unsigned ldsw = (unsigned)wid * 1024u;
    const int aoff = lds_byte(wr * 64 + fr, fq * 8), boff = lds_byte(wc * 32 + fr, fq * 8);
#define PG8_SA(b, h) (((b) * 2 + (h)) * HTB)
#define PG8_SB(b, h) ((4 + (b) * 2 + (h)) * HTB)
#define PG8_STAGE(bufoff, gbase, voff) do { _Pragma("unroll") for (int _i = 0; _i < 2; ++_i) \
        __builtin_amdgcn_global_load_lds((const unsigned*)((const char*)(gbase) + (voff)[_i]), (PG8_LAS unsigned*)(lds + (bufoff) + ldsw + _i * 8192), 16, 0, 0); } while (0)
#define PG8_LDA(dst, b, h) do { _Pragma("unroll") for (int m = 0; m < 4; ++m) _Pragma("unroll") for (int k = 0; k < 2; ++k) dst[m][k] = *(const PG8_LAS bf16x8*)(lds + PG8_SA(b, h) + aoff + m * 2048 + k * 1024); } while (0)
#define PG8_LDB(dst, b, h) do { _Pragma("unroll") for (int n = 0; n < 2; ++n) _Pragma("unroll") for (int k = 0; k < 2; ++k) dst[n][k] = *(const PG8_LAS bf16x8*)(lds + PG8_SB(b, h) + boff + n * 2048 + k * 1024); } while (0)
#define PG8_MMA(ai, bj, At, Bt) do { __builtin_amdgcn_s_setprio(1); _Pragma("unroll") for (int m = 0; m < 4; ++m) _Pragma("unroll") for (int n = 0; n < 2; ++n) _Pragma("unroll") for (int k = 0; k < 2; ++k) \
        acc[ai][bj][m][n] = __builtin_amdgcn_mfma_f32_16x16x32_bf16(Bt[n][k], At[m][k], acc[ai][bj][m][n], 0, 0, 0); __builtin_amdgcn_s_setprio(0); } while (0)
#define PG8_WAIT_V(n) asm volatile("s_waitcnt vmcnt(" #n ")" ::: "memory")
#define PG8_WAIT_L(n) asm volatile("s_waitcnt lgkmcnt(" #n ")" ::: "memory")
#define PG8_BAR __builtin_amdgcn_s_barrier()
#define PG8_SCHED __builtin_amdgcn_sched_barrier(0)
    Unit cur, nxt; int ui = 0;
    if (!S.next(0, cur)) return;
    f32x4 acc[2][2][4][2];
#pragma unroll
    for (int a = 0; a < 2; ++a)
#pragma unroll
        for (int b = 0; b < 2; ++b)
#pragma unroll
            for (int m = 0; m < 4; ++m)
#pragma unroll
                for (int n = 0; n < 2; ++n) acc[a][b][m][n] = (f32x4){0.f, 0.f, 0.f, 0.f};
    bf16x8 At[4][2], B0[2][2], B1[2][2];
    const char* cA = cur.a; const char* cB = cur.b;
    if constexpr (SP2) {
        PG8_STAGE(PG8_SB(0, 0), cB, voffB); PG8_STAGE(PG8_SB(0, 1), cB + hstepB, voffB); PG8_STAGE(PG8_SA(0, 0), cA, voffA); PG8_STAGE(PG8_SA(0, 1), cA + hstepA, voffA);
        if (wr == 1) PG8_BAR;
        PG8_WAIT_V(2); PG8_BAR;
        PG8_STAGE(PG8_SB(1, 0), cB + kstep, voffB); PG8_STAGE(PG8_SA(1, 0), cA + kstep, voffA); PG8_STAGE(PG8_SB(1, 1), cB + hstepB + kstep, voffB);
        PG8_WAIT_V(6); PG8_BAR;
    } else {
        PG8_STAGE(PG8_SB(0, 0), cB, voffB); PG8_STAGE(PG8_SA(0, 0), cA, voffA); PG8_STAGE(PG8_SB(0, 1), cB + hstepB, voffB); PG8_STAGE(PG8_SA(0, 1), cA + hstepA, voffA);
        if (wr == 1) PG8_BAR;
        PG8_WAIT_V(4); PG8_BAR;
        PG8_STAGE(PG8_SB(1, 0), cB + kstep, voffB); PG8_STAGE(PG8_SA(1, 0), cA + kstep, voffA); PG8_STAGE(PG8_SB(1, 1), cB + hstepB + kstep, voffB);
        PG8_WAIT_V(6); PG8_BAR;
    }
    for (;;) {
        const bool has_next = S.next(ui + 1, nxt);
        const char* nA = has_next ? nxt.a : cA; const char* nB = has_next ? nxt.b : cB;
#pragma unroll 1
        for (int t = 0; t < nt; t += 2) {
            const bool last = (t == nt - 2);
            const char* a1 = cA + (size_t)(t + 1) * kstep;
            const char* a2 = last ? nA : cA + (size_t)(t + 2) * kstep; const char* b2 = last ? nB : cB + (size_t)(t + 2) * kstep;
            const char* a3 = a2 + kstep; const char* b3 = b2 + kstep;
            if constexpr (Epi::MIDK > 0) { if (t == Epi::MIDK) E.midk(acc, cur, wr, wc, fr, fq); }
            if constexpr (SP2) {
            PG8_LDB(B0, 0, 0); PG8_LDB(B1, 0, 1); PG8_SCHED; PG8_LDA(At, 0, 0); PG8_STAGE(PG8_SA(1, 1), a1 + hstepA, voffA);
            PG8_WAIT_V(8); PG8_WAIT_L(0); PG8_BAR; PG8_MMA(0, 0, At, B0); PG8_MMA(0, 1, At, B1); PG8_BAR; PG8_SCHED;
            PG8_LDA(At, 0, 1); PG8_STAGE(PG8_SB(0, 0), b2, voffB); PG8_STAGE(PG8_SB(0, 1), b2 + hstepB, voffB); PG8_STAGE(PG8_SA(0, 0), a2, voffA);
            PG8_WAIT_V(8); PG8_WAIT_L(0); PG8_BAR; PG8_MMA(1, 0, At, B0); PG8_MMA(1, 1, At, B1); PG8_BAR; PG8_SCHED;
            PG8_LDB(B0, 1, 0); PG8_LDB(B1, 1, 1); PG8_SCHED; PG8_LDA(At, 1, 0); PG8_STAGE(PG8_SA(0, 1), a2 + hstepA, voffA);
            PG8_WAIT_V(8); PG8_WAIT_L(0); PG8_BAR; PG8_MMA(0, 0, At, B0); PG8_MMA(0, 1, At, B1); PG8_BAR; PG8_SCHED;
            PG8_LDA(At, 1, 1); PG8_STAGE(PG8_SB(1, 0), b3, voffB); PG8_STAGE(PG8_SB(1, 1), b3 + hstepB, voffB); PG8_STAGE(PG8_SA(1, 0), a3, voffA);
            PG8_WAIT_V(8); PG8_WAIT_L(0); PG8_BAR; PG8_MMA(1, 0, At, B0); PG8_MMA(1, 1, At, B1); PG8_BAR; PG8_SCHED;
            } else {
            PG8_LDB(B0, 0, 0); PG8_SCHED; PG8_LDA(At, 0, 0); PG8_STAGE(PG8_SA(1, 1), a1 + hstepA, voffA);
            PG8_WAIT_L(8); PG8_BAR; PG8_WAIT_L(0); PG8_MMA(0, 0, At, B0); PG8_BAR; PG8_SCHED;
            PG8_LDB(B1, 0, 1); PG8_STAGE(PG8_SB(0, 0), b2, voffB);
            PG8_BAR; PG8_WAIT_L(0); PG8_MMA(0, 1, At, B1); PG8_BAR;
            PG8_LDA(At, 0, 1); PG8_STAGE(PG8_SA(0, 0), a2, voffA);
            PG8_BAR; PG8_WAIT_L(0); PG8_MMA(1, 0, At, B0); PG8_BAR; PG8_SCHED;
            PG8_STAGE(PG8_SB(0, 1), b2 + hstepB, voffB);
            PG8_WAIT_V(6); PG8_BAR; PG8_MMA(1, 1, At, B1); PG8_BAR;
            PG8_LDB(B0, 1, 0); PG8_SCHED; PG8_LDA(At, 1, 0); PG8_STAGE(PG8_SA(0, 1), a2 + hstepA, voffA);
            PG8_WAIT_L(8); PG8_BAR; PG8_WAIT_L(0); PG8_MMA(0, 0, At, B0); PG8_BAR; PG8_SCHED;
            PG8_LDB(B1, 1, 1); PG8_STAGE(PG8_SB(1, 0), b3, voffB);
            PG8_BAR; PG8_WAIT_L(0); PG8_MMA(0, 1, At, B1); PG8_BAR;
            PG8_LDA(At, 1, 1); PG8_STAGE(PG8_SA(1, 0), a3, voffA);
            PG8_BAR; PG8_WAIT_L(0); PG8_MMA(1, 0, At, B0); PG8_BAR; PG8_SCHED;
            PG8_STAGE(PG8_SB(1, 1), b3 + hstepB, voffB);
            PG8_WAIT_V(6); PG8_BAR; PG8_MMA(1, 1, At, B1); PG8_BAR;
            }
        }
        if constexpr (ALIGN_EPI) { if (wr == 0) PG8_BAR; }
        { int fr_ = fr, fq_ = fq; asm volatile("" : "+v"(fr_), "+v"(fq_));
#if defined(PROBE_NOEPI) && PROBE_NOEPI
        if (!E.shadow_skip) E(acc, cur, wr, wc, fr_, fq_);
#else
        E(acc, cur, wr, wc, fr_, fq_);
#endif
        }
        if (!has_next) break;
#pragma unroll
        for (int a = 0; a < 2; ++a)
#pragma unroll
            for (int b = 0; b < 2; ++b)
#pragma unroll
                for (int m = 0; m < 4; ++m)
#pragma unroll
                    for (int n = 0; n < 2; ++n) acc[a][b][m][n] = (f32x4){0.f, 0.f, 0.f, 0.f};
        cur = nxt; cA = nA; cB = nB; ++ui;
        if constexpr (ALIGN_EPI) { if (wr == 1) PG8_BAR; }
    }
    PG8_WAIT_V(0);
    if constexpr (!ALIGN_EPI) { if (wr == 0) PG8_BAR; }
    PG8_BAR;
#undef PG8_SA
#undef PG8_SB
#undef PG8_STAGE
#undef PG8_LDA
#undef PG8_LDB
#undef PG8_MMA
#undef PG8_WAIT_V
#undef PG8_WAIT_L
#undef PG8_BAR
#undef PG8_SCHED
}
}
namespace pg8 {
constexpr float LOG2E = 1.4426950408889634f;
constexpr float RMS_EPS = 1e-6f;
constexpr size_t TILE_BYTES = 1536 * 1024, T_Y = 0, T_K = 512 * 1024, T_V = 768 * 1024, T_U = 1024 * 1024, T_LOGF = 1280 * 1024;

template <int kind, int nM, int nN, size_t sA, size_t sB, size_t batchB = 0>
struct SchedT {
    static constexpr int nwg = nM * nN, G = 256;
    int c; const char* A; const char* B;
    __device__ __forceinline__ void init(int c_, const void* A_, const void* B_) { c = c_; A = (const char*)A_; B = (const char*)B_; }
    __device__ __forceinline__ bool next(int i, Unit& u) const {
        const int L = i * G + c; if ((unsigned)L >= (unsigned)nwg) return false;
        if constexpr (kind <= 1) {
            int wgid = L; { constexpr int q = nwg / NXCD, r = nwg % NXCD; const int xcd = wgid % NXCD, off = wgid / NXCD; wgid = (xcd < r ? xcd * (q + 1) : r * (q + 1) + (xcd - r) * q) + off; }
            constexpr int nig = WGM * nN; const int gid = wgid / nig, fm = gid * WGM, gsz = (nM - fm) < WGM ? (nM - fm) : WGM;
            u.pm = fm + ((wgid % nig) % gsz); u.pn = (wgid % nig) / gsz;
            u.a = A + (size_t)u.pm * sA; u.b = B + (size_t)u.pn * sB + (kind == 1 ? (size_t)(u.pm >> 3) * batchB : (size_t)0); u.aux = 0;
        } else if constexpr (kind == 2) {
            const int b_ = L & 7, h = (L >> 5) & 3, t4 = (L >> 3) & 3;
            u.pm = b_ * 4 + h; u.pn = t4;
            u.a = A + ((size_t)b_ * 256 * 2048 + (size_t)h * 256) * 2; u.b = B + ((size_t)t4 * 256 * 1024 + (size_t)h * 256) * 2;
            u.aux = b_ * 4194304 + (h * 256) * 1024 + t4 * 256;
        } else if constexpr (kind == 3) {
            const int b_ = L & 7, h = (L >> 5) & 3, t4 = (L >> 3) & 3;
            u.pm = t4; u.pn = b_ * 4 + h;
            u.a = A + ((size_t)t4 * 256 * 1024 + (size_t)h * 256) * 2; u.b = B + ((size_t)b_ * 256 * 2048 + 1024 + (size_t)h * 256) * 2;
            u.aux = b_ * 4194304 + (t4 * 256) * 1024 + h * 256;
        } else {
            u.pm = L & 7; u.pn = L >> 3; u.a = A + (size_t)u.pm * sA; u.b = B + (size_t)u.pn * sB; u.aux = 0;
        }
        return true;
    }
};

__device__ __forceinline__ void store8(bf16_t* p, const f32x4 v0, const f32x4 v1) {
    u32x4 w; w.x = cvt_pk_bf16(v0[0], v0[1]); w.y = cvt_pk_bf16(v0[2], v0[3]); w.z = cvt_pk_bf16(v1[0], v1[1]); w.w = cvt_pk_bf16(v1[2], v1[3]); *(u32x4*)p = w;
}
__device__ __forceinline__ float ss_sum16(const float* ssp, int row) {
    const f32x4* p = (const f32x4*)(ssp + (size_t)row * 16); const f32x4 a = p[0], b = p[1], c = p[2], d = p[3];
    return (((a[0] + a[1]) + (a[2] + a[3])) + ((b[0] + b[1]) + (b[2] + b[3]))) + (((c[0] + c[1]) + (c[2] + c[3])) + ((d[0] + d[1]) + (d[2] + d[3])));
}
__device__ __forceinline__ float rs_row(const float* ssp, int row) { return __builtin_amdgcn_rsqf(ss_sum16(ssp, row) * (1.0f / 1024.0f) + RMS_EPS); }
__device__ __forceinline__ float sigmoidf_fast(float z) { return __builtin_amdgcn_rcpf(1.0f + __builtin_amdgcn_exp2f(-z * LOG2E)); }
__device__ __forceinline__ f32x4 sig4(f32x4 z) { f32x4 r; r[0] = sigmoidf_fast(z[0]); r[1] = sigmoidf_fast(z[1]); r[2] = sigmoidf_fast(z[2]); r[3] = sigmoidf_fast(z[3]); return r; }

struct EpiSwiGLU {
    static constexpr bool PERM = true; static constexpr int MIDK = 0;
    bf16_t* H; const float* ss; static constexpr int ldh = 2816;
    bool shadow_skip = false;
    __device__ __forceinline__ void midk(f32x4 (&)[2][2][4][2], const Unit&, int, int, int, int) const {}
    __device__ __forceinline__ void operator()(f32x4 (&acc)[2][2][4][2], const Unit& u, int wr, int wc, int fr, int fq) const {
        const int rl0 = wr * 64 + fr, col0 = u.pn * HALF + wc * 32 + 8 * fq;
        bf16_t* Ht = (bf16_t*)((unsigned char*)H + (size_t)u.pm * TILE_BYTES);
#pragma unroll
        for (int ai = 0; ai < 2; ++ai)
#pragma unroll
            for (int m = 0; m < 4; ++m) {
                const int rl = rl0 + ai * HALF + m * 16;
                const float rs = rs_row(ss, u.pm * BM + rl);
                const f32x4 g0 = acc[ai][0][m][0] * rs, g1 = acc[ai][0][m][1] * rs, u0 = acc[ai][1][m][0] * rs, u1 = acc[ai][1][m][1] * rs;
                store8(Ht + (size_t)rl * ldh + col0, g0 * sig4(g0) * u0, g1 * sig4(g1) * u1);
            }
    }
};

template <int MIDK_>
struct EpiResid {
    static constexpr bool PERM = true; static constexpr int MIDK = MIDK_;
    const float* xin; float* xout; bf16_t* xb; float* ssn; const float* ssa; float alpha;
    bool shadow_skip = false;
    __device__ __forceinline__ void midk(f32x4 (&acc)[2][2][4][2], const Unit& u, int wr, int wc, int fr, int fq) const {
        const int row0 = u.pm * BM + wr * 64 + fr;
#pragma unroll
        for (int ai = 0; ai < 2; ++ai)
#pragma unroll
            for (int m = 0; m < 4; ++m) {
                const f32x4* pa = (const f32x4*)(ssa + (size_t)(row0 + ai * HALF + m * 16) * 8); const f32x4 sa = pa[0], sb = pa[1];
                const float rs = __builtin_amdgcn_rsqf((((sa[0] + sa[1]) + (sa[2] + sa[3])) + ((sb[0] + sb[1]) + (sb[2] + sb[3]))) * (1.0f / 512.0f) + RMS_EPS);
#pragma unroll
                for (int bj = 0; bj < 2; ++bj)
#pragma unroll
                    for (int n = 0; n < 2; ++n) acc[ai][bj][m][n] *= rs;
            }
    }
    __device__ __forceinline__ void operator()(f32x4 (&acc)[2][2][4][2], const Unit& u, int wr, int wc, int fr, int fq) const {
        const int row0 = u.pm * BM + wr * 64 + fr, col0 = u.pn * BM + wc * 32 + 8 * fq;
#pragma unroll
        for (int ai = 0; ai < 2; ++ai)
#pragma unroll
            for (int m = 0; m < 4; ++m) {
                const int row = row0 + ai * HALF + m * 16; float q = 0.f;
#pragma unroll
                for (int bj = 0; bj < 2; ++bj) {
                    const size_t off = (size_t)row * 1024 + col0 + bj * HALF;
                    f32x4 r0, r1;
                    if (xin) { r0 = *(const f32x4*)(xin + off); r1 = *(const f32x4*)(xin + off + 4); }
                    else { const u32x4 w = *(const u32x4*)(xb + off);
                        r0 = (f32x4){__uint_as_float(w.x << 16), __uint_as_float(w.x & 0xffff0000u), __uint_as_float(w.y << 16), __uint_as_float(w.y & 0xffff0000u)};
                        r1 = (f32x4){__uint_as_float(w.z << 16), __uint_as_float(w.z & 0xffff0000u), __uint_as_float(w.w << 16), __uint_as_float(w.w & 0xffff0000u)}; }
                    const f32x4 v0 = r0 + acc[ai][bj][m][0] * alpha, v1 = r1 + acc[ai][bj][m][1] * alpha;
                    if (xout) { *(f32x4*)(xout + off) = v0; *(f32x4*)(xout + off + 4) = v1; }
                    else store8(xb + off, v0, v1);
                    q += (v0[0] * v0[0] + v0[1] * v0[1]) + (v0[2] * v0[2] + v0[3] * v0[3]) + (v1[0] * v1[0] + v1[1] * v1[1]) + (v1[2] * v1[2] + v1[3] * v1[3]);
                }
                q += swz_xor<16>(q); q = sum_x32(q);
                if (fq == 0) ssn[(size_t)row * 16 + u.pn * 4 + wc] = q;
            }
    }
};

struct EpiWin {
    static constexpr bool PERM = true; static constexpr int MIDK = 0;
    unsigned char* R1; const float* ss; const float* bfp; float qscale;
    bool shadow_skip = false;
    __device__ __forceinline__ void midk(f32x4 (&)[2][2][4][2], const Unit&, int, int, int, int) const {}
    __device__ __forceinline__ void operator()(f32x4 (&acc)[2][2][4][2], const Unit& u, int wr, int wc, int fr, int fq) const {
        const int rl0 = wr * 64 + fr, cw = wc * 32 + 8 * fq; const int pn = u.pn;
        unsigned char* T = R1 + (size_t)u.pm * TILE_BYTES;
#pragma unroll
        for (int ai = 0; ai < 2; ++ai)
#pragma unroll
            for (int m = 0; m < 4; ++m) {
                const int rl = rl0 + ai * HALF + m * 16;
                const float rs = rs_row(ss, u.pm * BM + rl);
                if (pn < 6) {
                    bf16_t* base; int ld; float sc = rs;
                    if (pn < 2) { base = (bf16_t*)(T + T_Y) + pn * BM; ld = 1024; sc = rs * qscale; } else if (pn < 4) { base = (bf16_t*)(T + T_K) + (pn - 2) * BM; ld = 512; } else { base = (bf16_t*)(T + T_V) + (pn - 4) * BM; ld = 512; }
#pragma unroll
                    for (int bj = 0; bj < 2; ++bj) store8(base + (size_t)rl * ld + bj * HALF + cw, acc[ai][bj][m][0] * sc, acc[ai][bj][m][1] * sc);
                } else if (pn < 10) {
                    const f32x4 a0 = acc[ai][0][m][0] * rs, a1 = acc[ai][0][m][1] * rs, g0 = acc[ai][1][m][0] * rs, g1 = acc[ai][1][m][1] * rs;
                    store8((bf16_t*)(T + T_U) + (size_t)rl * 512 + (pn - 6) * HALF + cw, a0 * sig4(g0), a1 * sig4(g1));
                } else {
                    if (wc == 0 && fq == 0) {
                        float* LF = (float*)(T + T_LOGF);
#pragma unroll
                        for (int n = 0; n < 2; ++n)
#pragma unroll
                            for (int e = 0; e < 4; ++e) {
                                const int h = 4 * n + e; const float z = acc[ai][0][m][n][e] * rs + bfp[h];
                                LF[h * 256 + rl] = fminf(z, 0.f) - log1pf(expf(-fabsf(z)));
                            }
                    }
                }
            }
    }
};

struct EpiRowScale {
    static constexpr bool PERM = true; static constexpr int MIDK = 0;
    bf16_t* O; const float* ssr; float scale; static constexpr int ldc = 2048;
    bool shadow_skip = false;
    __device__ __forceinline__ void midk(f32x4 (&)[2][2][4][2], const Unit&, int, int, int, int) const {}
    __device__ __forceinline__ void operator()(f32x4 (&acc)[2][2][4][2], const Unit& u, int wr, int wc, int fr, int fq) const {
        const int row0 = u.pm * BM + wr * 64 + fr, col0 = u.pn * BM + wc * 32 + 8 * fq;
#pragma unroll
        for (int ai = 0; ai < 2; ++ai)
#pragma unroll
            for (int m = 0; m < 4; ++m) {
                const int row = row0 + ai * HALF + m * 16;
                const float rs = (ssr ? __builtin_amdgcn_rsqf(ssr[row] * (1.0f / 1024.0f) + RMS_EPS) : 1.0f) * scale;
#pragma unroll
                for (int bj = 0; bj < 2; ++bj) store8(O + (size_t)row * ldc + col0 + bj * HALF, acc[ai][bj][m][0] * rs, acc[ai][bj][m][1] * rs);
            }
    }
};

struct EpiAux {
    static constexpr bool PERM = true; static constexpr int MIDK = 0;
    bf16_t* O; float scale; static constexpr int ldc = 1024;
    bool shadow_skip = false;
    __device__ __forceinline__ void midk(f32x4 (&)[2][2][4][2], const Unit&, int, int, int, int) const {}
    __device__ __forceinline__ void operator()(f32x4 (&acc)[2][2][4][2], const Unit& u, int wr, int wc, int fr, int fq) const {
        bf16_t* base = O + u.aux + (size_t)(wr * 64 + fr) * ldc + wc * 32 + 8 * fq;
#pragma unroll
        for (int ai = 0; ai < 2; ++ai)
#pragma unroll
            for (int m = 0; m < 4; ++m)
#pragma unroll
                for (int bj = 0; bj < 2; ++bj) store8(base + (size_t)(ai * HALF + m * 16) * ldc + bj * HALF, acc[ai][bj][m][0] * scale, acc[ai][bj][m][1] * scale);
    }
};

struct EpiSoftmax {
    static constexpr bool PERM = true; static constexpr int MIDK = 0;
    unsigned char* R1; const float* ss; PG8_LAS float* scr;
    bool shadow_skip = false;
    __device__ __forceinline__ void midk(f32x4 (&)[2][2][4][2], const Unit&, int, int, int, int) const {}
    __device__ __forceinline__ void operator()(f32x4 (&acc)[2][2][4][2], const Unit& u, int wr, int wc, int fr, int fq) const {
        const int col0 = u.pn * BM + wc * 32 + 8 * fq;
        PG8_LAS float* TM = scr; PG8_LAS float* TS = scr + 1024;
        const float* ssr = ss + (size_t)(u.pm * BM + wr * 64 + fr) * 16;
#pragma unroll
        for (int ai = 0; ai < 2; ++ai)
#pragma unroll
            for (int m = 0; m < 4; ++m) {
                const int rl = ai * HALF + wr * 64 + m * 16 + fr;
                const float rs = rs_row(ssr, ai * HALF + m * 16);
                float v = -3.0e38f;
#pragma unroll
                for (int bj = 0; bj < 2; ++bj)
#pragma unroll
                    for (int n = 0; n < 2; ++n) { const f32x4 x = acc[ai][bj][m][n] * rs; acc[ai][bj][m][n] = x; v = fmaxf(v, fmaxf(fmaxf(x[0], x[1]), fmaxf(x[2], x[3]))); }
                v = fmaxf(v, swz_xor<16>(v)); v = max_x32(v);
                if (fq == 0) TM[rl * 4 + wc] = v;
            }
        asm volatile("s_waitcnt lgkmcnt(0)" ::: "memory"); __builtin_amdgcn_s_barrier(); asm volatile("" ::: "memory");
#pragma unroll
        for (int ai = 0; ai < 2; ++ai)
#pragma unroll
            for (int m = 0; m < 4; ++m) {
                const int rl = ai * HALF + wr * 64 + m * 16 + fr;
                const f32x4 t = *(const PG8_LAS f32x4*)(TM + rl * 4);
                const float mrow = fmaxf(fmaxf(t[0], t[1]), fmaxf(t[2], t[3]));
                float s = 0.f;
#pragma unroll
                for (int bj = 0; bj < 2; ++bj)
#pragma unroll
                    for (int n = 0; n < 2; ++n) { f32x4 x = acc[ai][bj][m][n] - mrow;
                        x[0] = __builtin_amdgcn_exp2f(x[0]); x[1] = __builtin_amdgcn_exp2f(x[1]); x[2] = __builtin_amdgcn_exp2f(x[2]); x[3] = __builtin_amdgcn_exp2f(x[3]);
                        acc[ai][bj][m][n] = x; s += (x[0] + x[1]) + (x[2] + x[3]); }
                s += swz_xor<16>(s); s = sum_x32(s);
                if (fq == 0) TS[rl * 4 + wc] = s;
            }
        asm volatile("s_waitcnt lgkmcnt(0)" ::: "memory"); __builtin_amdgcn_s_barrier(); asm volatile("" ::: "memory");
        bf16_t* xp = (bf16_t*)(R1 + (size_t)u.pm * TILE_BYTES + T_Y) + (size_t)(wr * 64 + fr) * 1024 + col0;
#pragma unroll
        for (int ai = 0; ai < 2; ++ai)
#pragma unroll
            for (int m = 0; m < 4; ++m) {
                const int rl = ai * HALF + wr * 64 + m * 16 + fr;
                const f32x4 t = *(const PG8_LAS f32x4*)(TS + rl * 4);
                const float inv = __builtin_amdgcn_rcpf((t[0] + t[1]) + (t[2] + t[3]));
#pragma unroll
                for (int bj = 0; bj < 2; ++bj) store8(xp + (size_t)(ai * HALF + m * 16) * 1024 + bj * HALF, acc[ai][bj][m][0] * inv, acc[ai][bj][m][1] * inv);
            }
    }
};
}
#include <hip/hip_bf16.h>
namespace attn_body {
using bf16=__hip_bfloat16;
using bf16x8=__attribute__((ext_vector_type(8)))short;
using s16x4=__attribute__((ext_vector_type(4)))short;
using f32x16=__attribute__((ext_vector_type(16)))float;
using f32x4_t=__attribute__((ext_vector_type(4)))float;
using u32x4=__attribute__((ext_vector_type(4)))unsigned;
#define ATT_LAS __attribute__((address_space(3)))
constexpr int BATCH=8,NHEAD=8,SEQ=2048,D=64,QP=1024,KP=512;
constexpr size_t TILE_BYTES=1536*1024,T_Y=0,T_K=512*1024,T_V=768*1024,T_U=1024*1024,T_LOGF=1280*1024;
constexpr int NW=8,QBLK=32,QB=QBLK*NW,KVBLK=64,NQB=SEQ/QB;
__device__ __forceinline__ int crow(int r,int hi){return (r&3)+8*(r>>2)+4*hi;}
#define SBAR() __builtin_amdgcn_sched_barrier(0)
__device__ __forceinline__ void cmask(f32x16&p0,f32x16&p1,int jb,int qrel,int hi){
  const float NEG=-INFINITY; int kb=64*jb+4*hi;
  #pragma unroll
  for(int r=0;r<16;++r){int kv=kb+(r&3)+8*(r>>2); if(kv>qrel)p0[r]=NEG; if(kv+32>qrel)p1[r]=NEG;}
}
constexpr int NSLOT=3, SLOTB=8192;
constexpr int LDS_K=0, LDS_V=NSLOT*SLOTB, LDS_WS=2*NSLOT*SLOTB, LDS_OST=LDS_WS+NW*64*4, LDS_CB=LDS_OST+NW*4096  , LDS_WT=LDS_CB+SEQ*4, LDS_BYTES=LDS_WT+64;
__device__ __forceinline__ void glds16(const void*gsrc,unsigned lds_dst){unsigned keep;
  asm volatile("s_mov_b32 %0, m0\n\ts_mov_b32 m0, %2\n\ts_nop 0\n\tglobal_load_lds_dwordx4 %1, off\n\ts_mov_b32 m0, %0":"=&s"(keep):"v"(gsrc),"s"(lds_dst):"memory");}
__device__ __forceinline__ float max3f(float a,float b,float c){float r;asm("v_max3_f32 %0, %1, %2, %3":"=v"(r):"v"(a),"v"(b),"v"(c));return r;}
__device__ __forceinline__ float max2f(float a,float b){float r;asm("v_max_f32_e32 %0, %1, %2":"=v"(r):"v"(a),"v"(b));return r;}
__device__ __forceinline__ float fadd_s(float a,float b){float r;asm("v_add_f32_e32 %0, %1, %2":"=v"(r):"v"(a),"v"(b));return r;}
__device__ __forceinline__ float fsub_s(float a,float b){float r;asm("v_sub_f32_e32 %0, %1, %2":"=v"(r):"v"(a),"v"(b));return r;}
typedef float f32x2_t __attribute__((ext_vector_type(2))); typedef __bf16 bf16x2_t __attribute__((ext_vector_type(2)));
__device__ __forceinline__ unsigned cvtpk_s(float lo,float hi){f32x2_t v={lo,hi};bf16x2_t b=__builtin_convertvector(v,bf16x2_t);return __builtin_bit_cast(unsigned,b);}
#define WAIT_BAR(N) asm volatile("s_waitcnt vmcnt(" #N ") lgkmcnt(0)\n\ts_barrier":::"memory")

__device__ __forceinline__ void qkt(f32x16&p0,f32x16&p1,const char*Kslot,const bf16x8*qr,const f32x16&negm,int r32,int hi){
  const char*kb=Kslot+hi*1024+r32*16;
  #pragma unroll
  for(int d0=0;d0<4;++d0){
    const bf16x8 b0=*reinterpret_cast<const bf16x8*>(kb+d0*2048);
    const bf16x8 b1=*reinterpret_cast<const bf16x8*>(kb+d0*2048+512);
    if(d0==0){p0=__builtin_amdgcn_mfma_f32_32x32x16_bf16(b0,qr[0],negm,0,0,0);p1=__builtin_amdgcn_mfma_f32_32x32x16_bf16(b1,qr[0],negm,0,0,0);}
    else{p0=__builtin_amdgcn_mfma_f32_32x32x16_bf16(b0,qr[d0],p0,0,0,0);p1=__builtin_amdgcn_mfma_f32_32x32x16_bf16(b1,qr[d0],p1,0,0,0);}}
}
typedef ATT_LAS const char* lds_cptr;
typedef short v4i16_t __attribute__((ext_vector_type(4)));
__device__ __forceinline__ void kload8(bf16x8*kf,lds_cptr kp){
  kf[0]=*(const ATT_LAS bf16x8*)(kp);      kf[1]=*(const ATT_LAS bf16x8*)(kp+512);
  kf[2]=*(const ATT_LAS bf16x8*)(kp+2048); kf[3]=*(const ATT_LAS bf16x8*)(kp+2560);
  kf[4]=*(const ATT_LAS bf16x8*)(kp+4096); kf[5]=*(const ATT_LAS bf16x8*)(kp+4608);
  kf[6]=*(const ATT_LAS bf16x8*)(kp+6144); kf[7]=*(const ATT_LAS bf16x8*)(kp+6656);
}
__device__ __forceinline__ void kload2(bf16x8*kf,lds_cptr kp,int j){ kf[2*j]=*(const ATT_LAS bf16x8*)(kp+j*2048); kf[2*j+1]=*(const ATT_LAS bf16x8*)(kp+j*2048+512); }
__device__ __forceinline__ s16x4 vtr(lds_cptr p){ return __builtin_bit_cast(s16x4,__builtin_amdgcn_ds_read_tr16_b64_v4i16((ATT_LAS v4i16_t*)p)); }
__device__ __forceinline__ float rowmax(const f32x16&p0,const f32x16&p1){
  float a=max3f(p0[0],p0[1],p1[0]),b=max3f(p0[2],p0[3],p1[1]);a=max3f(a,p1[2],p1[3]);
  #pragma unroll
  for(int r=4;r<16;r+=4){a=max3f(a,p0[r],p0[r+1]);b=max3f(b,p0[r+2],p0[r+3]);a=max3f(a,p1[r],p1[r+1]);b=max3f(b,p1[r+2],p1[r+3]);}
  const float m=max2f(a,b);
  auto rr=__builtin_amdgcn_permlane32_swap(__float_as_uint(m),__float_as_uint(m),false,false);
  return max2f(__uint_as_float(rr[0]),__uint_as_float(rr[1]));
}
__device__ __forceinline__ void pv(f32x16*o,int vb,bf16x8 pa0,bf16x8 pa1,bf16x8 pa2,bf16x8 pa3){
  #pragma unroll
  for(int d0=0;d0<2;++d0){s16x4 lo[4],hi[4];
    #pragma unroll
    for(int ks=0;ks<4;++ks){
      asm volatile("ds_read_b64_tr_b16 %0,%1 offset:%c2":"=&v"(lo[ks]):"v"(vb),"i"(d0*4096+ks*1024):"memory");
      asm volatile("ds_read_b64_tr_b16 %0,%1 offset:%c2":"=&v"(hi[ks]):"v"(vb),"i"(d0*4096+ks*1024+512):"memory");}
    asm volatile("s_waitcnt lgkmcnt(0)":::"memory");SBAR();
    #define PK(k) (bf16x8){lo[k][0],lo[k][1],lo[k][2],lo[k][3],hi[k][0],hi[k][1],hi[k][2],hi[k][3]}
    o[d0]=__builtin_amdgcn_mfma_f32_32x32x16_bf16(pa0,PK(0),o[d0],0,0,0);
    o[d0]=__builtin_amdgcn_mfma_f32_32x32x16_bf16(pa1,PK(1),o[d0],0,0,0);
    o[d0]=__builtin_amdgcn_mfma_f32_32x32x16_bf16(pa2,PK(2),o[d0],0,0,0);
    o[d0]=__builtin_amdgcn_mfma_f32_32x32x16_bf16(pa3,PK(3),o[d0],0,0,0);
    #undef PK
  }
}
__device__ __forceinline__ void scan_bias(const unsigned char*R1,int b,int h,char*shm,const int tid){
  const int lane=tid&63,wid=tid>>6;
  ATT_LAS float*cb=(ATT_LAS float*)(shm+LDS_CB); ATT_LAS float*wt=(ATT_LAS float*)(shm+LDS_WT);
  const f32x4_t v=*(const f32x4_t*)((const float*)(R1+(size_t)(8*b+wid)*TILE_BYTES+T_LOGF)+h*256+4*lane);
  const float s0=v[0],s1=s0+v[1],s2=s1+v[2],s3=s2+v[3];
  float incl=s3;
  #pragma unroll
  for(int o=1;o<64;o<<=1){const float n=__int_as_float(__builtin_amdgcn_ds_bpermute((lane-o)<<2,__float_as_int(incl))); if(lane>=o)incl+=n;}
  if(lane==63)wt[wid]=incl;
  asm volatile("s_waitcnt lgkmcnt(0)\n\ts_barrier":::"memory");
  float woff=0.f;
  #pragma unroll
  for(int w=0;w<8;++w){const float x=wt[w]; if(w<wid)woff+=x;}
  const float ex=woff+incl-s3; const float L2E=-1.4426950408889634f;
  f32x4_t o4; o4[0]=(ex+s0)*L2E;o4[1]=(ex+s1)*L2E;o4[2]=(ex+s2)*L2E;o4[3]=(ex+s3)*L2E;
  *(ATT_LAS f32x4_t*)(cb+4*tid)=o4;
  asm volatile("s_waitcnt lgkmcnt(0)\n\ts_barrier":::"memory");
}
template<int THRL> __device__ __forceinline__ void attn_unit(int b,int h,int qb,const unsigned char*R1,int ocol  ,float*ssa  ,char*shm,const int tid){
  const int lane=tid&63,r32=lane&31,hi=lane>>5; const int wid=__builtin_amdgcn_readfirstlane(tid>>6);
  const long rowbase=(long)b*SEQ; const int q0=qb*QB;
  const unsigned char*Tb=R1+(size_t)(8*b)*TILE_BYTES;
  const bf16*Qw=(const bf16*)(Tb+(size_t)qb*TILE_BYTES+T_Y)+(long)(wid*QBLK)*QP+h*D;
  const unsigned lds0=(unsigned)(uintptr_t)shm;
  float*wsf=(float*)(shm+LDS_WS)+wid*64;
  const ATT_LAS float*cbh=(const ATT_LAS float*)(shm+LDS_CB)+4*hi;
  const bf16*ksrc=(const bf16*)(Tb+T_K)+h*D+(long)lane*KP+wid*8;
  const bf16*vsrc=(const bf16*)(Tb+T_V)+h*D+(long)(16*(wid&3)+(lane>>2))*KP+(wid>>2)*32+(lane&3)*8;
  const unsigned kdst=lds0+LDS_K+wid*1024, vdst=lds0+LDS_V+wid*1024;
  #define KVOFF(t) ((size_t)((t)>>2)*(TILE_BYTES/2)+(size_t)((t)&3)*KVBLK*KP)
  #define DMA_K(t,slot) glds16(ksrc+KVOFF(t),(unsigned)__builtin_amdgcn_readfirstlane(kdst+(slot)))
  #define DMA_V(t,slot) glds16(vsrc+KVOFF(t),(unsigned)__builtin_amdgcn_readfirstlane(vdst+(slot)))
  const int vb0=(int)(lds0+LDS_V)+((lane>>4)&1)*32+(lane&3)*8+(4*hi+((lane&15)>>2))*64;
  const char*Kbase=shm+LDS_K; bf16x8 kf[8];
  const lds_cptr shm3=(lds_cptr)shm; const lds_cptr kp0=shm3+LDS_K+hi*1024+r32*16; const lds_cptr vp0=shm3+LDS_V+((lane>>4)&1)*32+(lane&3)*8+(4*hi+((lane&15)>>2))*64;
  const int NT=(q0+QB)/KVBLK;
  DMA_K(0,0);DMA_V(0,0);DMA_K(1,SLOTB);
  bf16x8 qr[4];
  #pragma unroll
  for(int d0=0;d0<4;++d0)qr[d0]=*reinterpret_cast<const bf16x8*>(&Qw[(long)r32*QP+d0*16+hi*8]);
  float mhat=0.f,l_reg=0.f;f32x16 o[2];o[0]=f32x16{};o[1]=f32x16{};f32x16 negm=f32x16{};asm volatile("":"+v"(negm));
  const int qrel=wid*QBLK+r32;
  #define CMASK(P0,P1,t) do{int jb_=(t)-(NT-4); if(jb_>=0)cmask(P0,P1,jb_,qrel,hi);}while(0)
  #define ADDB(P0,P1,t) do{ const ATT_LAS float*cbt_=cbh+64*(t); \
    _Pragma("unroll") for(int j_=0;j_<4;++j_){ const f32x4_t b0_=*(const ATT_LAS f32x4_t*)(cbt_+8*j_), b1_=*(const ATT_LAS f32x4_t*)(cbt_+32+8*j_); \
      _Pragma("unroll") for(int i_=0;i_<4;++i_){P0[4*j_+i_]+=b0_[i_];P1[4*j_+i_]+=b1_[i_];} } }while(0)
  bool resc=false;
  #define START(P0,P1) do{ const float rm=rowmax(P0,P1); resc=false; \
    { const float dl=rm; mhat=fadd_s(mhat,dl); \
      _Pragma("unroll") for(int r=0;r<16;++r){P0[r]=fsub_s(P0[r],dl);P1[r]=fsub_s(P1[r],dl);} \
      _Pragma("unroll") for(int r=0;r<16;++r)negm[r]=-mhat; asm volatile("":"+v"(negm)); } \
    _Pragma("unroll") for(int r=0;r<16;++r)P0[r]=__builtin_amdgcn_exp2f(P0[r]); }while(0)
  #define RESC() do{ if(resc){ asm volatile("s_waitcnt lgkmcnt(0)":::"memory"); \
      _Pragma("unroll") for(int d_=0;d_<2;++d_) _Pragma("unroll") for(int r=0;r<16;++r)o[d_][r]*=wsf[crow(r,hi)]; } }while(0)
  f32x16 pA0,pA1,pB0,pB1;
  int sl_prev=0,sl_cur=0,sl_next=SLOTB;
  #define ROT() do{sl_prev=sl_cur;sl_cur=sl_next;sl_next=(sl_next==(NSLOT-1)*SLOTB)?0:sl_next+SLOTB;}while(0)
  DMA_K(2,2*SLOTB);
  WAIT_BAR(3);
  qkt(pA0,pA1,Kbase,qr,negm,r32,hi);asm volatile("s_nop 15\n\ts_nop 7":"+v"(pA0),"+v"(pA1));ADDB(pA0,pA1,0);asm volatile("s_nop 3":"+v"(pA0),"+v"(pA1));CMASK(pA0,pA1,0);
  START(pA0,pA1);
  _Pragma("unroll") for(int r=0;r<16;++r)pA1[r]=__builtin_amdgcn_exp2f(pA1[r]);
  WAIT_BAR(0);
  DMA_K(3,0);DMA_V(1,SLOTB);
  ROT();
  kload8(kf,kp0+sl_cur);
  WAIT_BAR(2);
  s16x4 vlo[8],vhi[8]; u32x4 pw0,pw1,pw2,pw3;
  #define PKW(P,B) cvtpk_s(P[B],P[B+1])
  #define PAF(k) __builtin_bit_cast(bf16x8,pw##k)
  #define VFR(i) (bf16x8){vlo[i][0],vlo[i][1],vlo[i][2],vlo[i][3],vhi[i][0],vhi[i][1],vhi[i][2],vhi[i][3]}
  #define PIN(x) asm volatile("":"+v"(x))
  #define MX3(a,b,c) __builtin_fmaxf(__builtin_fmaxf((a),(b)),(c))
  #define GAPA(MF,A0,A1,A2,A3,W0,W1,PW) do{ MF; sacc+=A0; sacc+=A1; sacc+=A2; sacc+=A3; PIN(sacc); W0; W1; PIN(PW); SBAR(); }while(0)
  #define EX(v) __builtin_amdgcn_exp2f(v)
  #define GAPB(MF,X,B) do{ MF; X[B]=EX(X[B]); X[B+1]=EX(X[B+1]); X[B+2]=EX(X[B+2]); X[B+3]=EX(X[B+3]); PIN(X); SBAR(); }while(0)
  #define VRD(i) do{ vlo[i]=vtr(vp_+(((i)>>2)*4096+((i)&3)*1024)); vhi[i]=vtr(vp_+(((i)>>2)*4096+((i)&3)*1024+512)); }while(0)
  #define KRD(G,j) do{ if(G){ kload2(kf,kp0+sl_next,j); SBAR(); } }while(0)
  #define STEP(C0,C1,P0,P1,t,GK,GV,GL) do{ SBAR(); \
    const lds_cptr vp_=vp0+sl_prev; \
    VRD(0); SBAR(); float sacc=(P0[0]+P0[1]); \
    GAPA(C0=__builtin_amdgcn_mfma_f32_32x32x16_bf16(kf[0],qr[0],negm,0,0,0), P0[2],P0[3],P0[4],P0[5],     pw0[0]=PKW(P0,0), pw0[1]=PKW(P0,2), pw0); \
    VRD(4); SBAR(); GAPA(C1=__builtin_amdgcn_mfma_f32_32x32x16_bf16(kf[1],qr[0],negm,0,0,0), P0[6],P0[7],P0[8],P0[9],     pw0[2]=PKW(P0,4), pw0[3]=PKW(P0,6), pw0); \
    VRD(1); SBAR(); GAPA(C0=__builtin_amdgcn_mfma_f32_32x32x16_bf16(kf[2],qr[1],C0,0,0,0),   P0[10],P0[11],P0[12],P0[13], pw1[0]=PKW(P0,8), pw1[1]=PKW(P0,10), pw1); \
    VRD(5); SBAR(); GAPA(C1=__builtin_amdgcn_mfma_f32_32x32x16_bf16(kf[3],qr[1],C1,0,0,0),   P0[14],P0[15],P1[0],P1[1],   pw1[2]=PKW(P0,12),pw1[3]=PKW(P0,14), pw1); \
    VRD(2); SBAR(); GAPA(C0=__builtin_amdgcn_mfma_f32_32x32x16_bf16(kf[4],qr[2],C0,0,0,0),   P1[2],P1[3],P1[4],P1[5],     pw2[0]=PKW(P1,0), pw2[1]=PKW(P1,2), pw2); \
    VRD(6); SBAR(); GAPA(C1=__builtin_amdgcn_mfma_f32_32x32x16_bf16(kf[5],qr[2],C1,0,0,0),   P1[6],P1[7],P1[8],P1[9],     pw2[2]=PKW(P1,4), pw2[3]=PKW(P1,6), pw2); \
    VRD(3); SBAR(); GAPA(C0=__builtin_amdgcn_mfma_f32_32x32x16_bf16(kf[6],qr[3],C0,0,0,0),   P1[10],P1[11],P1[12],P1[13], pw3[0]=PKW(P1,8), pw3[1]=PKW(P1,10), pw3); \
    VRD(7); SBAR(); GAPA(C1=__builtin_amdgcn_mfma_f32_32x32x16_bf16(kf[7],qr[3],C1,0,0,0),   P1[14],P1[15],0.f,0.f,       pw3[2]=PKW(P1,12),pw3[3]=PKW(P1,14), pw3); \
    l_reg+=sacc; \
    if(GK){DMA_K((t)+3,sl_cur);} if(GV){DMA_V((t)+1,sl_next);} \
    ADDB(C0,C1,t); \
    CMASK(C0,C1,t); \
    { float a=MX3(C0[0],C0[1],C1[0]),b=MX3(C0[2],C0[3],C1[1]); a=MX3(a,C1[2],C1[3]); \
      _Pragma("unroll") for(int r=4;r<16;r+=4){a=MX3(a,C0[r],C0[r+1]);b=MX3(b,C0[r+2],C0[r+3]);a=MX3(a,C1[r],C1[r+1]);b=MX3(b,C1[r+2],C1[r+3]);} \
      float rm=__builtin_fmaxf(a,b); { auto rr=__builtin_amdgcn_permlane32_swap(__float_as_uint(rm),__float_as_uint(rm),false,false); rm=__builtin_fmaxf(__uint_as_float(rr[0]),__uint_as_float(rr[1])); } \
      resc=false; \
      if(__builtin_expect(__any(rm>(float)THRL),0)){ const float dl=__builtin_fmaxf(rm,0.f); mhat+=dl; \
        _Pragma("unroll") for(int r=0;r<16;++r){C0[r]-=dl;C1[r]-=dl;} \
        _Pragma("unroll") for(int r=0;r<16;++r)negm[r]=-mhat; asm volatile("":"+v"(negm)); \
        const float f=__builtin_amdgcn_exp2f(-dl); l_reg*=f; if(hi==0)wsf[r32]=f; resc=true; } } \
    SBAR(); \
    GAPB(o[0]=__builtin_amdgcn_mfma_f32_32x32x16_bf16(PAF(0),VFR(0),o[0],0,0,0), C0,0); \
    GAPB(o[1]=__builtin_amdgcn_mfma_f32_32x32x16_bf16(PAF(0),VFR(4),o[1],0,0,0), C0,4); \
    KRD(GL,0); GAPB(o[0]=__builtin_amdgcn_mfma_f32_32x32x16_bf16(PAF(1),VFR(1),o[0],0,0,0), C0,8); \
    KRD(GL,1); GAPB(o[1]=__builtin_amdgcn_mfma_f32_32x32x16_bf16(PAF(1),VFR(5),o[1],0,0,0), C0,12); \
    KRD(GL,2); GAPB(o[0]=__builtin_amdgcn_mfma_f32_32x32x16_bf16(PAF(2),VFR(2),o[0],0,0,0), C1,0); \
    KRD(GL,3); GAPB(o[1]=__builtin_amdgcn_mfma_f32_32x32x16_bf16(PAF(2),VFR(6),o[1],0,0,0), C1,4); \
    GAPB(o[0]=__builtin_amdgcn_mfma_f32_32x32x16_bf16(PAF(3),VFR(3),o[0],0,0,0), C1,8); \
    GAPB(o[1]=__builtin_amdgcn_mfma_f32_32x32x16_bf16(PAF(3),VFR(7),o[1],0,0,0), C1,12); \
    }while(0)
  int t=1;
  #undef CMASK
  #define CMASK(P0,P1,t) do{}while(0)
  for(;t+5<NT;t+=2){
    STEP(pB0,pB1,pA0,pA1,t,true,true,true);     WAIT_BAR(2); RESC(); ROT();
    STEP(pA0,pA1,pB0,pB1,t+1,true,true,true);   WAIT_BAR(2); RESC(); ROT();
  }
  #undef CMASK
  #define CMASK(P0,P1,t) do{int jb_=(t)-(NT-4); if(jb_>=0)cmask(P0,P1,jb_,qrel,hi);}while(0)
  #define ENDW(tt) do{ if((tt)+3<NT){WAIT_BAR(2);} else if((tt)+2<NT){WAIT_BAR(1);} else {WAIT_BAR(0);} }while(0)
  for(;t+1<NT;t+=2){
    STEP(pB0,pB1,pA0,pA1,t,(t+3<NT),(t+1<NT),(t+1<NT));       ENDW(t);   RESC(); ROT();
    STEP(pA0,pA1,pB0,pB1,t+1,(t+4<NT),(t+2<NT),(t+2<NT));     ENDW(t+1); RESC(); ROT();
  }
  STEP(pB0,pB1,pA0,pA1,NT-1,false,false,false); RESC();
  { float sacc=pB0[0]+pB0[1]; _Pragma("unroll") for(int r=2;r<16;++r)sacc+=pB0[r]; _Pragma("unroll") for(int r=0;r<16;++r)sacc+=pB1[r]; l_reg+=sacc;
    pw0=(u32x4){PKW(pB0,0),PKW(pB0,2),PKW(pB0,4),PKW(pB0,6)};pw1=(u32x4){PKW(pB0,8),PKW(pB0,10),PKW(pB0,12),PKW(pB0,14)};pw2=(u32x4){PKW(pB1,0),PKW(pB1,2),PKW(pB1,4),PKW(pB1,6)};pw3=(u32x4){PKW(pB1,8),PKW(pB1,10),PKW(pB1,12),PKW(pB1,14)};
    SBAR(); pv(o,vb0+sl_cur,PAF(0),PAF(1),PAF(2),PAF(3)); }
  #undef PKW
  #undef PAF
  #undef VFR
  #undef PIN
  #undef MX3
  #undef GAPA
  #undef GAPB
  #undef EX
  #undef VRD
  #undef KRD
  #undef STEP
  #undef ENDW
  {auto rr=__builtin_amdgcn_permlane32_swap(__float_as_uint(l_reg),__float_as_uint(l_reg),false,false);l_reg=__uint_as_float(rr[0])+__uint_as_float(rr[1]);}
  if(hi==0)wsf[32+r32]=l_reg;asm volatile("s_waitcnt lgkmcnt(0)":::"memory");
  float rli[16];
  #pragma unroll
  for(int r=0;r<16;++r)rli[r]=__builtin_amdgcn_rcpf(wsf[32+crow(r,hi)]);
  bf16*Ow=(bf16*)(Tb+(size_t)qb*TILE_BYTES+T_Y)+(long)(wid*QBLK)*QP+h*D+ocol;
  float*ssw=ssa+(rowbase+q0+wid*QBLK)*8+h;
  { bf16*stg=(bf16*)(shm+LDS_OST)+wid*2048;
    #pragma unroll
    for(int r=0;r<16;++r){const int orow=crow(r,hi);
      #pragma unroll
      for(int d0=0;d0<2;++d0)stg[orow*64+d0*32+r32]=__float2bfloat16(o[d0][r]*rli[r]);}
    asm volatile("s_waitcnt lgkmcnt(0)":::"memory");
    #pragma unroll
    for(int i=0;i<4;++i){const int row=i*8+(lane>>3),ch=lane&7; const u32x4 v=*(const u32x4*)(stg+row*64+ch*8); *(u32x4*)(Ow+(long)row*QP+ch*8)=v;
      float q=0.f;
      #pragma unroll
      for(int e=0;e<4;++e){const float lo=__uint_as_float(v[e]<<16),hi2=__uint_as_float(v[e]&0xffff0000u); q+=lo*lo+hi2*hi2;}
      q+=swz_xor<1>(q);q+=swz_xor<2>(q);q+=swz_xor<4>(q);
      if(ch==0)ssw[row*8]=q;} }
  asm volatile("s_waitcnt lgkmcnt(0)\n\ts_barrier":::"memory");
  #undef DMA_K
  #undef DMA_V
  #undef KVOFF
  #undef CMASK
  #undef ADDB
  #undef START
  #undef RESC
  #undef ROT
}
#undef SBAR
#undef WAIT_BAR

constexpr int CONV_W=31, CONV_C=512, CONV_TOK=32, CONV_ROWS=CONV_TOK+CONV_W-1, CONV_LDS_W=0, CONV_LDS_U=CONV_W*CONV_C*4;
__device__ __forceinline__ float wsum64(float v){ return wave_sum64(v); }
__device__ __forceinline__ void conv_stage_w(const float*cw,char*shm,const int tid){
  ATT_LAS u32x4*LW=(ATT_LAS u32x4*)(shm+CONV_LDS_W); const u32x4*src=(const u32x4*)cw;
  u32x4 v[8];
  #pragma unroll
  for(int i=0;i<8;++i){const int idx=tid+i*512; v[i]=(idx<CONV_W*CONV_C/4)?src[idx]:(u32x4){0u,0u,0u,0u};}
  #pragma unroll
  for(int i=0;i<8;++i){const int idx=tid+i*512; if(idx<CONV_W*CONV_C/4)LW[idx]=v[i];}
  __syncthreads();
}
__device__ __forceinline__ void conv_unit(int unit,const unsigned char*R1,const float*cbias,const float*lng,const float*lnb,char*shm,const int tid){
  const int lane=tid&63,wid=tid>>6;
  const int b=unit>>6,t0=(unit&63)*CONV_TOK;
  const unsigned char*Tb=R1+(size_t)(8*b)*TILE_BYTES;
  ATT_LAS u32x4*L=(ATT_LAS u32x4*)(shm+CONV_LDS_U);
  const ATT_LAS f32x4_t*LW=(const ATT_LAS f32x4_t*)(shm+CONV_LDS_W);
  { u32x4 v[8];
    #pragma unroll
    for(int i=0;i<8;++i){const int idx=tid+i*512,row=idx>>6,ch=idx&63,t=t0-(CONV_W-1)+row;
      v[i]=(u32x4){0u,0u,0u,0u};
      if(idx<CONV_ROWS*64&&t>=0)v[i]=*(const u32x4*)((const bf16*)(Tb+(size_t)(t>>8)*TILE_BYTES+T_U)+(size_t)(t&255)*CONV_C+ch*8);}
    #pragma unroll
    for(int i=0;i<8;++i){const int idx=tid+i*512; if(idx<CONV_ROWS*64)L[idx]=v[i];} }
  __syncthreads();
  float acc[4][8];
  { const f32x4_t b0=*(const f32x4_t*)(cbias+8*lane),b1=*(const f32x4_t*)(cbias+8*lane+4);
    #pragma unroll
    for(int tt=0;tt<4;++tt){acc[tt][0]=b0[0];acc[tt][1]=b0[1];acc[tt][2]=b0[2];acc[tt][3]=b0[3];acc[tt][4]=b1[0];acc[tt][5]=b1[1];acc[tt][6]=b1[2];acc[tt][7]=b1[3];} }
  #pragma unroll 4
  for(int j=0;j<CONV_W;++j){
    const f32x4_t w0=LW[j*128+2*lane],w1=LW[j*128+2*lane+1];
    #pragma unroll
    for(int tt=0;tt<4;++tt){
      const u32x4 u=L[(wid*4+tt+j)*64+lane];
      acc[tt][0]+=w0[0]*__uint_as_float(u[0]<<16); acc[tt][1]+=w0[1]*__uint_as_float(u[0]&0xffff0000u);
      acc[tt][2]+=w0[2]*__uint_as_float(u[1]<<16); acc[tt][3]+=w0[3]*__uint_as_float(u[1]&0xffff0000u);
      acc[tt][4]+=w1[0]*__uint_as_float(u[2]<<16); acc[tt][5]+=w1[1]*__uint_as_float(u[2]&0xffff0000u);
      acc[tt][6]+=w1[2]*__uint_as_float(u[3]<<16); acc[tt][7]+=w1[3]*__uint_as_float(u[3]&0xffff0000u);
    }
  }
  const f32x4_t g0=*(const f32x4_t*)(lng+8*lane),g1=*(const f32x4_t*)(lng+8*lane+4),e0=*(const f32x4_t*)(lnb+8*lane),e1=*(const f32x4_t*)(lnb+8*lane+4);
  const float gg[8]={g0[0],g0[1],g0[2],g0[3],g1[0],g1[1],g1[2],g1[3]},bb[8]={e0[0],e0[1],e0[2],e0[3],e1[0],e1[1],e1[2],e1[3]};
  float mu[4],rstd[4],r2[4];
  #pragma unroll
  for(int tt=0;tt<4;++tt){ float s=0.f;
    #pragma unroll
    for(int e=0;e<8;++e)s+=acc[tt][e];
    mu[tt]=s; }
  #pragma unroll
  for(int tt=0;tt<4;++tt)mu[tt]=wsum64(mu[tt])*(1.0f/CONV_C);
  #pragma unroll
  for(int tt=0;tt<4;++tt){ float q=0.f;
    #pragma unroll
    for(int e=0;e<8;++e){acc[tt][e]-=mu[tt];q+=acc[tt][e]*acc[tt][e];}
    rstd[tt]=q; }
  #pragma unroll
  for(int tt=0;tt<4;++tt)rstd[tt]=__builtin_amdgcn_rsqf(wsum64(rstd[tt])*(1.0f/CONV_C)+1e-6f);
  #pragma unroll
  for(int tt=0;tt<4;++tt){ float q2=0.f;
    #pragma unroll
    for(int e=0;e<8;++e){float y=acc[tt][e]*rstd[tt]*gg[e]+bb[e]; y=y*__builtin_amdgcn_rcpf(1.0f+__builtin_amdgcn_exp2f(-y*1.4426950408889634f)); acc[tt][e]=y;q2+=y*y;}
    r2[tt]=q2; }
  #pragma unroll
  for(int tt=0;tt<4;++tt)r2[tt]=__builtin_amdgcn_rsqf(wsum64(r2[tt])*(1.0f/CONV_C)+1e-6f);
  #pragma unroll
  for(int tt=0;tt<4;++tt){
    u32x4 w; const float r=r2[tt];
    w[0]=cvtpk_s(acc[tt][0]*r,acc[tt][1]*r);w[1]=cvtpk_s(acc[tt][2]*r,acc[tt][3]*r);w[2]=cvtpk_s(acc[tt][4]*r,acc[tt][5]*r);w[3]=cvtpk_s(acc[tt][6]*r,acc[tt][7]*r);
    { const int t=t0+wid*4+tt; *(u32x4*)((bf16*)(Tb+(size_t)(t>>8)*TILE_BYTES+T_Y)+(size_t)(t&255)*QP+CONV_C+8*lane)=w; }
  }
  __syncthreads();
}
}
constexpr int NWAVES = 8;
constexpr int M = 16384, DM = 1024, DFF = 2816, SEQ = 2048, NBATCH = 8, NMEMROWS = 2048, NLAYER = 2;
constexpr size_t MiB = 1u << 20;
constexpr size_t WS_CTL = 0, CTL_ZERO_BYTES = 256 * 1024;
constexpr size_t WS_W = 2 * MiB;
constexpr size_t W_LAYER = 97 * MiB / 2;
constexpr size_t WO_1A = 0, WO_1B = 11 * MiB, WO_IN = WO_1B + 11 * MiB / 2, WO_OUT = WO_IN + 11 * MiB / 2, WO_XQ = WO_OUT + 2 * MiB, WO_XKV = WO_XQ + 2 * MiB, WO_XO = WO_XKV + 4 * MiB,
                 WO_2A = WO_XO + 2 * MiB, WO_2B = WO_2A + 11 * MiB;
static_assert(WO_2B + 11 * MiB / 2 == W_LAYER, "weight map");
constexpr size_t WS_XB = 100 * MiB;
constexpr size_t WS_MKV = 132 * MiB;
constexpr size_t WS_MEMB = 148 * MiB;
constexpr size_t WS_R1 = 152 * MiB;
constexpr size_t DOUT_WQK = 0, DOUT_WVO = 2 * MiB, DOUT_BATCH = 8 * MiB;
constexpr size_t WS_SSP = 99 * MiB;
constexpr size_t WS_DUMMY = 248 * MiB, WS_SSA = 249 * MiB;
constexpr size_t WS_END = 250 * MiB;
constexpr int CW_BAR = 4096;
constexpr int CW_QUAD = 16384;
constexpr size_t CTL_SSM = 256 * 1024;
constexpr int RING_OFF = 0, RING_BYTES = 131072;
constexpr int EPI_SCR_OFF = RING_BYTES;
constexpr int LDSCTL_OFF = RING_BYTES + 8192, MISC_OFF = LDSCTL_OFF + 320;
constexpr int LDS_BYTES = 147456;
static_assert(MISC_OFF + 128 <= LDS_BYTES, "LDS map");

#define GAS __attribute__((address_space(1)))
#define LAS __attribute__((address_space(3)))
typedef unsigned short bf16;
typedef unsigned v4u __attribute__((ext_vector_type(4)));
typedef float f32x4 __attribute__((ext_vector_type(4)));
typedef GAS unsigned gu32;
#define RLX_AGENT __ATOMIC_RELAXED, __HIP_MEMORY_SCOPE_AGENT
#define LDS_WAIT() asm volatile("s_waitcnt lgkmcnt(0)" ::: "memory")
__device__ __forceinline__ unsigned f2bf(float f) { unsigned u = __builtin_bit_cast(unsigned, f); return (u + 0x7fffu + ((u >> 16) & 1u)) >> 16; }
__device__ __forceinline__ unsigned pk2(float lo, float hi) { return f2bf(lo) | (f2bf(hi) << 16); }

#define XB_TMO      128
#define XB_XCNT(j)  (256  + 64 * (j))
#define XB_XSUB(j)  (1280 + 64 * (j))
#define XB_XGEN(j)  (2304 + 64 * (j))
#define XB_TOP      3328
#define XB_TOPGEN   3392
#define XCD_BAR_WORDS 3456
#define XB_SPIN_CAP (1u << 18)
__device__ __forceinline__ unsigned xb_ld(unsigned* p)              { return __hip_atomic_load(p, __ATOMIC_RELAXED, __HIP_MEMORY_SCOPE_AGENT); }
__device__ __forceinline__ unsigned xb_add(unsigned* p, unsigned v) { return __hip_atomic_fetch_add(p, v, __ATOMIC_RELAXED, __HIP_MEMORY_SCOPE_AGENT); }
__device__ __forceinline__ unsigned xb_xcc_id() { return (unsigned)__builtin_amdgcn_s_getreg((3 << 11) | 20) & 0xFu; }
#define XB_SPIN(cond, bar) do { unsigned _sp = 0; while (cond) { __builtin_amdgcn_s_sleep(1); \
    if ((++_sp & 255u) == 0u) { if (xb_ld(&(bar)[XB_TMO])) break; if (_sp > XB_SPIN_CAP) { atomicAdd(&(bar)[XB_TMO], 1u); break; } } } } while (0)
struct XcdBarrier { unsigned* bar; unsigned x; volatile LAS unsigned* st; };
__device__ __forceinline__ XcdBarrier xcd_barrier_post(unsigned* bar, volatile LAS unsigned* st) {
    XcdBarrier b; b.bar = bar; b.x = xb_xcc_id(); b.st = st;
    if (threadIdx.x == 0) { const unsigned rank = xb_add(&bar[XB_XCNT(b.x)], 1u); st[2] = b.x; st[3] = rank; }
    return b;
}
__device__ __forceinline__ void xcd_barrier_complete(unsigned* bar, unsigned x, unsigned& nloc, unsigned& nx) {
    const unsigned G = gridDim.x * gridDim.y * gridDim.z;
    unsigned sum, cnt, mine, sp = 0u;
    for (;;) {
        sum = 0u; cnt = 0u; mine = 0u;
#pragma unroll
        for (unsigned j = 0; j < 16; ++j) { const unsigned c = xb_ld(&bar[XB_XCNT(j)]); sum += c; cnt += (c > 0u) ? 1u : 0u; mine = (j == x) ? c : mine; }
        if (sum == G) break;
        __builtin_amdgcn_s_sleep(1);
        if ((++sp & 255u) == 0u) { if (xb_ld(&bar[XB_TMO])) break; if (sp > XB_SPIN_CAP) { atomicAdd(&bar[XB_TMO], 1u); break; } }
    }
    nloc = mine > 0u ? mine : 1u; nx = cnt > 0u ? cnt : 1u;
}
__device__ __forceinline__ void xcd_barrier(const XcdBarrier& b) {
    asm volatile("s_waitcnt vmcnt(0)" ::: "memory");
    __syncthreads();
    if (threadIdx.x == 0) {
        unsigned* bar = b.bar;
        __builtin_amdgcn_s_waitcnt(0);
        unsigned nloc = b.st[0], nx = b.st[1];
        if (nloc == 0u) { xcd_barrier_complete(bar, b.x, nloc, nx); b.st[0] = nloc; b.st[1] = nx; }
        const unsigned old = xb_add(&bar[XB_XSUB(b.x)], 1u);
        const unsigned gen = old / nloc;
        if (old + 1u == (gen + 1u) * nloc) {
            __builtin_amdgcn_fence(__ATOMIC_RELEASE, "agent");
            asm volatile("s_waitcnt vmcnt(0)" ::: "memory");
            const unsigned og = xb_add(&bar[XB_TOP], 1u);
            const unsigned tg = og / nx;
            if (og + 1u == (tg + 1u) * nx) xb_add(&bar[XB_TOPGEN], 1u);
            else XB_SPIN(xb_ld(&bar[XB_TOPGEN]) == tg, bar);
            __builtin_amdgcn_fence(__ATOMIC_ACQUIRE, "agent");
            xb_add(&bar[XB_XGEN(b.x)], 1u);
            asm volatile("s_waitcnt vmcnt(0)" ::: "memory");
        } else {
            XB_SPIN(xb_ld(&bar[XB_XGEN(b.x)]) == gen, bar);
            __builtin_amdgcn_fence(__ATOMIC_ACQUIRE, "agent");
            asm volatile("s_waitcnt vmcnt(0)" ::: "memory");
        }
    }
    __syncthreads();
}

__device__ __forceinline__ void xcd_local_barrier(unsigned* bar, unsigned x) {
    asm volatile("s_waitcnt vmcnt(0)" ::: "memory");
    __syncthreads();
    if (threadIdx.x == 0) {
        __builtin_amdgcn_s_waitcnt(0);
        const unsigned old = xb_add(&bar[XB_XSUB(x)], 1u), gen = old / 32u;
        if (old + 1u == (gen + 1u) * 32u) xb_add(&bar[XB_XGEN(x)], 1u);
        else XB_SPIN(xb_ld(&bar[XB_XGEN(x)]) == gen, bar);
        __builtin_amdgcn_fence(__ATOMIC_ACQUIRE, "agent");
        asm volatile("s_waitcnt vmcnt(0)" ::: "memory");
    }
    __syncthreads();
}
__device__ __forceinline__ void quad_barrier(unsigned* bar, unsigned* qw) {
    asm volatile("s_waitcnt vmcnt(0)" ::: "memory");
    __syncthreads();
    if (threadIdx.x == 0) {
        __builtin_amdgcn_s_waitcnt(0);
        const unsigned old = xb_add(&qw[0], 1u), gen = old / 4u;
        if (old + 1u == (gen + 1u) * 4u) xb_add(&qw[64], 1u);
        else XB_SPIN(xb_ld(&qw[64]) == gen, bar);
        __builtin_amdgcn_fence(__ATOMIC_ACQUIRE, "agent");
        asm volatile("s_waitcnt vmcnt(0)" ::: "memory");
    }
    __syncthreads();
}

__device__ __forceinline__ float wave_sum(float v) { return wave_sum64(v); }
__device__ __forceinline__ void tr_item(const float* W, int ldw, int col0, int nvalid, int k0, const float* gain, int gsplit, const float* gain2, bf16* WT, int ldt, int drow0, LAS float* scr, int lane) {
#pragma unroll 8
    for (int i = 0; i < 32; ++i) { const int kk = 2 * i + (lane >> 5), n = lane & 31, k = k0 + kk;
        float v = (n < nvalid) ? W[(size_t)k * ldw + col0 + n] : 0.f;
        if (gain) v *= (k < gsplit ? gain[k] : gain2[k - gsplit]);
        scr[kk * 33 + n] = v; }
    LDS_WAIT(); asm volatile("" ::: "memory");
    const int c = lane & 7;
#pragma unroll
    for (int j = 0; j < 4; ++j) { const int n = (lane >> 3) + 8 * j; const LAS float* s = scr + (8 * c) * 33 + n;
        v4u o; o.x = pk2(s[0 * 33], s[1 * 33]); o.y = pk2(s[2 * 33], s[3 * 33]); o.z = pk2(s[4 * 33], s[5 * 33]); o.w = pk2(s[6 * 33], s[7 * 33]);
        *(GAS v4u*)(WT + (size_t)(drow0 + n) * ldt + k0 + 8 * c) = o; }
    LDS_WAIT(); asm volatile("" ::: "memory");
}
__device__ __forceinline__ void tr_item64(const float* W, int ldw, int col0, int nvalid, int k0, const float* gain, int gsplit, const float* gain2, bf16* WT, int ldt, int drow0, int lane) {
    float v[64];
    const float* src = W + (size_t)k0 * ldw + col0 + lane; const bool ok = lane < nvalid;
#pragma unroll
    for (int j = 0; j < 64; ++j) v[j] = ok ? src[(size_t)j * ldw] : 0.f;
    if (gain) {
#pragma unroll
        for (int j = 0; j < 64; ++j) { const int k = k0 + j; v[j] *= (k < gsplit ? gain[k] : gain2[k - gsplit]); }
    }
    bf16* dst = WT + (size_t)(drow0 + lane) * ldt + k0;
#pragma unroll
    for (int c = 0; c < 8; ++c) { v4u o; o.x = pk2(v[8 * c], v[8 * c + 1]); o.y = pk2(v[8 * c + 2], v[8 * c + 3]); o.z = pk2(v[8 * c + 4], v[8 * c + 5]); o.w = pk2(v[8 * c + 6], v[8 * c + 7]);
        *(GAS v4u*)(dst + 8 * c) = o; }
}
__device__ __forceinline__ void row_to_bf16(const float* xrow, bf16* orow, float* ssp, int lane) {
    const GAS f32x4* xr = (const GAS f32x4*)xrow + lane;
    f32x4 v[4]; float s = 0.f;
#pragma unroll
    for (int j = 0; j < 4; ++j) { v[j] = xr[64 * j]; s += (v[j].x * v[j].x + v[j].y * v[j].y) + (v[j].z * v[j].z + v[j].w * v[j].w); }
    s = wave_sum(s);
    GAS unsigned long long* o8 = (GAS unsigned long long*)orow + lane;
#pragma unroll
    for (int j = 0; j < 4; ++j) o8[64 * j] = (unsigned long long)pk2(v[j].x, v[j].y) | ((unsigned long long)pk2(v[j].z, v[j].w) << 32);
    if (lane == 0) *ssp = s;
}

struct Args { const float* in[26]; float* out; unsigned char* ws; };

enum { PH_PRO = 0, PH_L0 = 1, PH_PER_LAYER = 9, PH_FINAL = PH_L0 + 2 * PH_PER_LAYER, PH_COUNT = PH_FINAL + 1 };

#define WSP() ({ unsigned char* w_ = args.ws; asm volatile("" : "+s"(w_)); w_; })
#define INP(i) ({ int i_ = __builtin_amdgcn_readfirstlane(i); asm volatile("" : "+s"(i_)); args.in[i_]; })
#define XPTR() ({ float* x_ = args.out; asm volatile("" : "+s"(x_)); x_; })
#define TID() ({ int w_ = wid_s; asm volatile("" : "+s"(w_)); int t_ = (w_ << 6) | (int)__builtin_amdgcn_mbcnt_hi(~0u, __builtin_amdgcn_mbcnt_lo(~0u, 0u)); asm volatile("" : "+v"(t_)); t_; })

constexpr size_t T1K = (size_t)256 * 1024 * 2, TFF = (size_t)256 * 2816 * 2, TLB = pg8::TILE_BYTES;
using G_1024 = pg8::Gemm<1024, 1024, 1024>; using G_down = pg8::Gemm<2816, 2816, 2816>; using G_qk = pg8::Gemm<2048, 1024, 256>; using G_vo = pg8::Gemm<1024, 2048, 256>;
using S_up = pg8::SchedT<0, 64, 22, T1K, T1K>; using S_mkv = pg8::SchedT<4, 8, 8, T1K, T1K>; using S_down = pg8::SchedT<0, 64, 4, TLB, TFF>; using S_win = pg8::SchedT<0, 64, 11, T1K, T1K>;
using S_wout = pg8::SchedT<0, 64, 4, TLB, T1K>; using S_xs = pg8::SchedT<1, 64, 4, T1K, T1K, DOUT_BATCH>; using S_xpv = pg8::SchedT<1, 64, 4, TLB, T1K, DOUT_BATCH>;
using S_qk = pg8::SchedT<2, 128, 1, 0, 0>; using S_vo = pg8::SchedT<3, 128, 1, 0, 0>;

#ifndef PROBE_MASK
#define PROBE_MASK 0
#endif
#ifndef PROBE_REPS
#define PROBE_REPS 1
#endif
#ifndef PROBE_BARS
#define PROBE_BARS 0
#endif
#ifndef PROBE_NOATT
#define PROBE_NOATT 0
#endif
#ifndef PROBE_NOCONV
#define PROBE_NOCONV 0
#endif
#ifndef FORCE_GLOBAL
#define FORCE_GLOBAL 0
#endif
#define NREP(k) (((PROBE_MASK >> (k)) & 1) ? (PROBE_REPS + 1) : 1)
#define REP_LOOP(k) _Pragma("unroll 1") for (int rep_ = 0; rep_ < NREP(k); ++rep_)
#define SHADOW(k) (NREP(k) > 1 && rep_ + 1 < NREP(k))
#define REP_SEAM(k) do { if (SHADOW(k)) GRIDBAR(); } while (0)

#define WSP() ({ unsigned char* w_ = args.ws; asm volatile("" : "+s"(w_)); w_; })
#define INP(i) ({ int i_ = __builtin_amdgcn_readfirstlane(i); asm volatile("" : "+s"(i_)); args.in[i_]; })
#define XPTR() ({ float* x_ = args.out; asm volatile("" : "+s"(x_)); x_; })
#define TID() ({ int w_ = wid_s; asm volatile("" : "+s"(w_)); int t_ = (w_ << 6) | (int)__builtin_amdgcn_mbcnt_hi(~0u, __builtin_amdgcn_mbcnt_lo(~0u, 0u)); asm volatile("" : "+v"(t_)); t_; })
#define MISCW(k) (*({ unsigned o_ = MISC_OFF + 4 * (k); asm volatile("" : "+s"(o_)); (volatile LAS unsigned*)(ldsp + o_); }))
#define BXP() ((int)__builtin_amdgcn_readfirstlane((int)MISCW(13)))
#define BARW() ((unsigned*)(WSP() + WS_CTL) + CW_BAR)
#define GRIDBAR() do { XcdBarrier bar_; bar_.bar = BARW(); bar_.x = xb_xcc_id(); bar_.st = &MISCW(8); xcd_barrier(bar_); } while (0)
#define XCDBAR() do { if (MISCW(12)) xcd_local_barrier(BARW(), MISCW(10)); else GRIDBAR(); } while (0)
#define QUADBAR() do { if (MISCW(12)) { unsigned* bw_ = BARW(); quad_barrier(bw_, bw_ - CW_BAR + CW_QUAD + 128 * (MISCW(10) * 8 + (MISCW(11) & 7))); } else GRIDBAR(); } while (0)

__global__ void __launch_bounds__(NWAVES * 64, 2) mega_fwd(Args args) {
    extern __shared__ __attribute__((aligned(16))) unsigned char lds[];
    LAS unsigned char* ldsp = (LAS unsigned char*)lds;
    volatile LAS unsigned* MISC = (volatile LAS unsigned*)(ldsp + MISC_OFF);
    constexpr int G = 256; const int bx = blockIdx.x;
    const int wid_s = __builtin_amdgcn_readfirstlane(threadIdx.x >> 6);
    for (int u = threadIdx.x; u < (LDS_BYTES - LDSCTL_OFF) / 4; u += NWAVES * 64) ((LAS unsigned*)(ldsp + LDSCTL_OFF))[u] = 0u;
    __syncthreads();
    (void)xcd_barrier_post((unsigned*)(args.ws + WS_CTL) + CW_BAR, MISC + 8);
    constexpr float QSCALE = 0.125f * 1.4426950408889634f, XSCALE = 0.0625f * 1.4426950408889634f;

    REP_LOOP(9) {
        unsigned char* ws = WSP(); const int tid = TID();
        const int lane = tid & 63, wave = __builtin_amdgcn_readfirstlane(tid >> 6);
        const int gw = bx * NWAVES + wave, NGW = G * NWAVES;
        constexpr int I_GU = 2 * 16 * 44, I_DN = 44 * 16, I_IN = 16 * 41, I_SQ = 16 * 16, I_KV = 16 * 32, I_WQ = 256;
        constexpr int L_ITEMS = 2 * (I_GU + I_DN) + I_IN + I_SQ + I_KV + I_SQ + I_WQ, W_ITEMS = NLAYER * L_ITEMS, X_ITEMS = M / 4, MEM_ITEMS = NMEMROWS / 4;
#pragma unroll 1
        for (int it = gw; it < W_ITEMS + X_ITEMS + MEM_ITEMS; it += NGW) {
            if (it < W_ITEMS) {
                const int l = it / L_ITEMS; int r = it % L_ITEMS;
                unsigned char* wl = ws + WS_W + (size_t)l * W_LAYER;
                if (r < 2 * (I_GU + I_DN)) {
                    const int f = r / (I_GU + I_DN); r %= (I_GU + I_DN);
                    if (r < I_GU) { const int which = r / (16 * 44), q = r % (16 * 44), kb = q / 44, nb = q % 44, j0 = nb * 64;
                        const float* w = INP(which ? (f ? 23 : 4) : (f ? 22 : 3)) + (size_t)l * DM * DFF; const float* gn = INP(f ? 21 : 2) + l * DM;
                        tr_item64(w, DFF, j0, 64, kb * 64, gn, 1 << 30, gn, (bf16*)(wl + (f ? WO_2A : WO_1A)), DM, 256 * (j0 / 128) + which * 128 + (j0 % 128), lane); }
                    else { r -= I_GU; const int kb = r / 16, nb = r % 16; const float* w = INP(f ? 24 : 5) + (size_t)l * DFF * DM;
                        tr_item64(w, DM, nb * 64, 64, kb * 64, nullptr, 0, w, (bf16*)(wl + (f ? WO_2B : WO_1B)), DFF, nb * 64, lane); }
                    continue;
                }
                r -= 2 * (I_GU + I_DN);
                if (r < I_IN) {
                    const int kb = r / 41, nb = r % 41; int col0, nvalid = 64, drow0;
                    if (nb < 24) { col0 = nb * 64; drow0 = col0; }
                    else if (nb == 24) { col0 = 1536; nvalid = 8; drow0 = 2560; }
                    else if (nb < 33) { const int ch = (nb - 25) * 64; col0 = 1544 + ch; drow0 = 1536 + 256 * (ch / 128) + (ch % 128); }
                    else { const int ch = (nb - 33) * 64; col0 = 2056 + ch; drow0 = 1536 + 256 * (ch / 128) + 128 + (ch % 128); }
                    const float* w = INP(7) + (size_t)l * DM * 2568; const float* gn = INP(6) + l * DM;
                    tr_item64(w, 2568, col0, nvalid, kb * 64, gn, 1 << 30, gn, (bf16*)(wl + WO_IN), DM, drow0, lane); continue; }
                r -= I_IN;
                if (r < I_SQ) { const int kb = r / 16, nb = r % 16; const float* w = INP(15) + (size_t)l * DM * DM;
                    tr_item64(w, DM, nb * 64, 64, kb * 64, INP(13) + l * 512, 512, INP(14) + l * 512, (bf16*)(wl + WO_OUT), DM, nb * 64, lane); continue; }
                r -= I_SQ;
                if (r < I_KV) { const int kb = r / 32, nb = r % 32; const float* w = INP(19) + (size_t)l * DM * 2048; const float* gn = INP(17) + l * DM;
                    tr_item64(w, 2048, nb * 64, 64, kb * 64, gn, 1 << 30, gn, (bf16*)(wl + WO_XKV), DM, nb * 64, lane); continue; }
                r -= I_KV;
                if (r < I_SQ) { const int kb = r / 16, nb = r % 16; const float* w = INP(20) + (size_t)l * DM * DM;
                    tr_item64(w, DM, nb * 64, 64, kb * 64, nullptr, 0, w, (bf16*)(wl + WO_XO), DM, nb * 64, lane); continue; }
                r -= I_SQ;
                { const float* w = INP(18) + (size_t)l * DM * DM; const float* gn = INP(16) + l * DM; bf16* WQ = (bf16*)(wl + WO_XQ);
                  f32x4 v[4][4];
#pragma unroll
                  for (int q = 0; q < 4; ++q)
#pragma unroll
                      for (int j = 0; j < 4; ++j) v[q][j] = *((const GAS f32x4*)(w + (size_t)(4 * r + q) * DM) + lane + 64 * j);
#pragma unroll
                  for (int q = 0; q < 4; ++q) { const float g = gn[4 * r + q] * XSCALE; GAS unsigned long long* o8 = (GAS unsigned long long*)(WQ + (size_t)(4 * r + q) * DM) + lane;
#pragma unroll
                      for (int j = 0; j < 4; ++j) { const f32x4 t = v[q][j] * g; o8[64 * j] = (unsigned long long)pk2(t.x, t.y) | ((unsigned long long)pk2(t.z, t.w) << 32); } } }
            } else {
                int r = it - W_ITEMS; const bool ismem = r >= X_ITEMS; if (ismem) r -= X_ITEMS;
                const float* src = INP(ismem ? 1 : 0) + (size_t)(4 * r) * DM; bf16* dst = (bf16*)(ws + (ismem ? WS_MEMB : WS_XB)) + (size_t)(4 * r) * DM; float* ssp = ismem ? (float*)(ws + CTL_SSM) + 4 * r : (float*)(ws + WS_SSP) + (size_t)(4 * r) * 16;
                f32x4 v[4][4]; float s[4];
#pragma unroll
                for (int q = 0; q < 4; ++q)
#pragma unroll
                    for (int j = 0; j < 4; ++j) v[q][j] = *((const GAS f32x4*)(src + (size_t)q * DM) + lane + 64 * j);
#pragma unroll
                for (int q = 0; q < 4; ++q) { s[q] = 0.f;
#pragma unroll
                    for (int j = 0; j < 4; ++j) s[q] += (v[q][j].x * v[q][j].x + v[q][j].y * v[q][j].y) + (v[q][j].z * v[q][j].z + v[q][j].w * v[q][j].w); }
#pragma unroll
                for (int q = 0; q < 4; ++q) { s[q] = wave_sum64(s[q]); GAS unsigned long long* o8 = (GAS unsigned long long*)(dst + (size_t)q * DM) + lane;
#pragma unroll
                    for (int j = 0; j < 4; ++j) o8[64 * j] = (unsigned long long)pk2(v[q][j].x, v[q][j].y) | ((unsigned long long)pk2(v[q][j].z, v[q][j].w) << 32);
                    if (ismem) { if (lane == 0) ssp[q] = s[q]; } else if (lane < 16) ssp[q * 16 + lane] = (lane == 0) ? s[q] : 0.f; }
            }
        }
        REP_SEAM(9);
    }
    GRIDBAR();
    if (threadIdx.x == 0) {
        unsigned* bw = BARW(); bool ok = !FORCE_GLOBAL;
        for (int j = 0; j < 16; ++j) ok = ok && (xb_ld(&bw[XB_XCNT(j)]) == (j < 8 ? 32u : 0u));
        MISCW(12) = ok ? 1u : 0u; MISCW(13) = ok ? (MISCW(11) * 8u + MISCW(10)) : (unsigned)bx;
    }
    __syncthreads();

#pragma unroll 1
    for (int l = 0; l < NLAYER; ++l) {
#pragma unroll 1
        for (int f = 0; f < 2; ++f) {
            REP_LOOP(0) {
                unsigned char* ws = WSP(); unsigned char* wl = ws + WS_W + (size_t)l * W_LAYER; const int bxp = BXP();
                G_1024 g; S_up S; S.init(bxp, ws + WS_XB, wl + (f ? WO_2A : WO_1A));
                pg8::EpiSwiGLU E{(bf16*)(ws + WS_R1), (float*)(ws + WS_SSP)};
                pg8::gemm_phase<pg8::EpiSwiGLU, decltype(S), decltype(g)>(ldsp + RING_OFF, g, S, E, TID());
                if (l == 0 && f == 0) {
#pragma unroll 1
                    for (int l2 = 0; l2 < NLAYER; ++l2) {
                        unsigned char* ws2 = WSP();
                        S_mkv S2; S2.init(bxp - 128 - 64 * l2, ws2 + WS_MEMB, ws2 + WS_W + (size_t)l2 * W_LAYER + WO_XKV);
                        pg8::EpiRowScale E2{(bf16*)(ws2 + WS_MKV) + (size_t)l2 * 2048 * 2048, (float*)(ws2 + CTL_SSM), 1.0f};
                        pg8::gemm_phase<pg8::EpiRowScale, decltype(S2), decltype(g)>(ldsp + RING_OFF, g, S2, E2, TID());
                    }
                }
                REP_SEAM(0);
            }
            QUADBAR();
            REP_LOOP(1) {
                unsigned char* ws = WSP(); unsigned char* wl = ws + WS_W + (size_t)l * W_LAYER;
                G_down g; S_down S; S.init(BXP(), ws + WS_R1, wl + (f ? WO_2B : WO_1B));
                pg8::EpiResid<0> E{(l == 0 && f == 0) ? INP(0) : (const float*)nullptr, nullptr, (bf16*)(ws + WS_XB), SHADOW(1) ? (float*)(ws + WS_DUMMY) : (float*)(ws + WS_SSP), nullptr, SHADOW(1) ? 0.f : 0.5f};
                E.shadow_skip = SHADOW(1);
                pg8::gemm_phase<pg8::EpiResid<0>, decltype(S), decltype(g)>(ldsp + RING_OFF, g, S, E, TID());
                REP_SEAM(1);
            }
            if (f == 1) break;
            QUADBAR();
            REP_LOOP(2) {
                unsigned char* ws = WSP(); unsigned char* wl = ws + WS_W + (size_t)l * W_LAYER;
                G_1024 g; S_win S; S.init(BXP(), ws + WS_XB, wl + WO_IN);
                pg8::EpiWin E{ws + WS_R1, (float*)(ws + WS_SSP), INP(8) + l * 8, QSCALE};
                pg8::gemm_phase<pg8::EpiWin, decltype(S), decltype(g)>(ldsp + RING_OFF, g, S, E, TID());
                REP_SEAM(2);
            }
            XCDBAR();
            REP_LOOP(3) {
                unsigned char* ws = WSP(); unsigned char* R1 = ws + WS_R1; const int bxp = BXP();
                char* shm = (char*)lds + RING_OFF;
                const int vcu = (bxp & 7) * 32 + (bxp >> 3);
                const int bh = vcu >> 2, s4 = vcu & 3;
                float* ssa = SHADOW(3) ? (float*)(ws + WS_DUMMY) : (float*)(ws + WS_SSA);
                if (!(SHADOW(3) && PROBE_NOATT)) {
                attn_body::scan_bias(R1, bh >> 3, bh & 7, shm, TID());
#pragma unroll 1
                for (int iu = 0; iu < 2; ++iu) attn_body::attn_unit<8>(bh >> 3, bh & 7, iu ? 7 - s4 : s4, R1, SHADOW(3) ? 512 : 0, ssa, shm, TID());
                __syncthreads();
                }
                if (!(SHADOW(3) && PROBE_NOCONV)) {
                    attn_body::conv_stage_w(INP(9) + (size_t)l * 31 * 512, shm, TID());
#pragma unroll 1
                    for (int iu = 0; iu < 2; ++iu) attn_body::conv_unit(2 * vcu + iu, R1, INP(10) + l * 512, INP(11) + l * 512, INP(12) + l * 512, shm, TID());
                }
                { unsigned char* ws2 = WSP(); unsigned char* wl = ws2 + WS_W + (size_t)l * W_LAYER;
                  G_qk g; S_qk S; S.init(bxp, (bf16*)(ws2 + WS_MKV) + (size_t)l * 2048 * 2048, wl + WO_XQ);
                  pg8::EpiAux E{(bf16*)((unsigned char*)XPTR() + DOUT_WQK), 1.0f};
                  pg8::gemm_phase<pg8::EpiAux, decltype(S), decltype(g)>(ldsp + RING_OFF, g, S, E, TID()); }
                { unsigned char* ws2 = WSP(); unsigned char* wl = ws2 + WS_W + (size_t)l * W_LAYER;
                  G_vo g; S_vo S; S.init(bxp - 128, wl + WO_XO, (bf16*)(ws2 + WS_MKV) + (size_t)l * 2048 * 2048);
                  pg8::EpiAux E{(bf16*)((unsigned char*)XPTR() + DOUT_WVO), 1.0f};
                  pg8::gemm_phase<pg8::EpiAux, decltype(S), decltype(g)>(ldsp + RING_OFF, g, S, E, TID()); }
                REP_SEAM(3);
            }
            XCDBAR();
            REP_LOOP(4) {
                unsigned char* ws = WSP(); unsigned char* wl = ws + WS_W + (size_t)l * W_LAYER;
                G_1024 g; S_wout S; S.init(BXP(), ws + WS_R1 + pg8::T_Y, wl + WO_OUT);
                pg8::EpiResid<8> E{nullptr, nullptr, (bf16*)(ws + WS_XB), SHADOW(4) ? (float*)(ws + WS_DUMMY) : (float*)(ws + WS_SSP), (float*)(ws + WS_SSA), SHADOW(4) ? 0.f : 1.0f};
                pg8::gemm_phase<pg8::EpiResid<8>, decltype(S), decltype(g)>(ldsp + RING_OFF, g, S, E, TID());
                REP_SEAM(4);
            }
            QUADBAR();
            REP_LOOP(5) {
                unsigned char* ws = WSP();
                G_1024 g; S_xs S; S.init(BXP(), ws + WS_XB, (unsigned char*)XPTR() + DOUT_WQK);
                pg8::EpiSoftmax E{ws + WS_R1, (float*)(ws + WS_SSP), (LAS float*)(ldsp + EPI_SCR_OFF)};
                E.shadow_skip = SHADOW(5);
                pg8::gemm_phase<pg8::EpiSoftmax, decltype(S), decltype(g)>(ldsp + RING_OFF, g, S, E, TID());
                REP_SEAM(5);
            }
            QUADBAR();
            REP_LOOP(6) {
                unsigned char* ws = WSP();
                G_1024 g; S_xpv S; S.init(BXP(), ws + WS_R1 + pg8::T_Y, (unsigned char*)XPTR() + DOUT_WVO);
                pg8::EpiResid<0> E{nullptr, nullptr, (bf16*)(ws + WS_XB), SHADOW(6) ? (float*)(ws + WS_DUMMY) : (float*)(ws + WS_SSP), nullptr, SHADOW(6) ? 0.f : 1.0f};
                E.shadow_skip = SHADOW(6);
                pg8::gemm_phase<pg8::EpiResid<0>, decltype(S), decltype(g)>(ldsp + RING_OFF, g, S, E, TID());
                REP_SEAM(6);
            }
            QUADBAR();
        }
        if (l + 1 < NLAYER) QUADBAR();
    }
    XCDBAR();
    for (int eb_ = 0; eb_ < PROBE_BARS; ++eb_) GRIDBAR();
    {
        unsigned char* ws = WSP(); float* X = XPTR(); const int tid = TID(); const int bxp = BXP();
        const int lane = tid & 63, wave = __builtin_amdgcn_readfirstlane(tid >> 6);
        const int row0 = (8 * (bxp & 7) + ((bxp >> 3) & 7)) * 256 + (bxp >> 6) * 64 + wave * 8;
        const float* ssf = (float*)(ws + WS_SSP); const float* gn = INP(25); const bf16* XB = (const bf16*)(ws + WS_XB);
        f32x4 gv[4];
#pragma unroll
        for (int j = 0; j < 4; ++j) gv[j] = *((const GAS f32x4*)gn + lane + 64 * j);
#pragma unroll 2
        for (int r = 0; r < 8; ++r) { const int m = row0 + r; const float rs = pg8::rs_row(ssf, m);
            const GAS unsigned long long* xr = (const GAS unsigned long long*)(XB + (size_t)m * DM) + lane; GAS f32x4* orow = (GAS f32x4*)(X + (size_t)m * DM) + lane;
#pragma unroll
            for (int j = 0; j < 4; ++j) { const unsigned long long w = xr[64 * j]; const unsigned lo = (unsigned)w, hi = (unsigned)(w >> 32);
                f32x4 v = (f32x4){__uint_as_float(lo << 16), __uint_as_float(lo & 0xffff0000u), __uint_as_float(hi << 16), __uint_as_float(hi & 0xffff0000u)};
                orow[64 * j] = v * rs * gv[j]; } }
    }
}

static int g_grid = 0;
static bool mega_setup() {
    if (g_grid) return g_grid > 0;
    int dev = 0, cus = 0, per_cu = 0;
    if (hipGetDevice(&dev) != hipSuccess || hipDeviceGetAttribute(&cus, hipDeviceAttributeMultiprocessorCount, dev) != hipSuccess) { g_grid = -1; return false; }
    if (hipFuncSetAttribute((const void*)mega_fwd, hipFuncAttributeMaxDynamicSharedMemorySize, LDS_BYTES) != hipSuccess) { fprintf(stderr, "hipFuncSetAttribute failed\n"); g_grid = -1; return false; }
    if (hipOccupancyMaxActiveBlocksPerMultiprocessor(&per_cu, (const void*)mega_fwd, NWAVES * 64, LDS_BYTES) != hipSuccess || per_cu < 1) { fprintf(stderr, "occupancy query: %d blocks per CU\n", per_cu); (void)hipGetLastError(); g_grid = -1; return false; }
    g_grid = cus;
    if (g_grid != 256) { fprintf(stderr, "kernel_launch: %d CUs; the phase program is laid out for exactly 256: nothing launched\n", g_grid); g_grid = -1; return false; }
    return true;
}
static void mega_launch(void* const* d_in, void* d_out, void* d_ws, hipStream_t stream) {
    Args a{};
    for (int i = 0; i < 26; ++i) a.in[i] = (const float*)d_in[i];
    a.out = (float*)d_out; a.ws = (unsigned char*)d_ws;
    hipLaunchKernelGGL(mega_fwd, dim3(g_grid), dim3(NWAVES * 64), LDS_BYTES, stream, a);
}
extern "C" void kernel_launch(void* const* d_in, const int* in_sizes, int n_in, void* d_out, int out_size, void* d_ws, size_t ws_size, hipStream_t stream) {
    if (!mega_setup()) return;
    if (ws_size < WS_END) { fprintf(stderr, "kernel_launch: workspace too small (%zu < %zu)\n", ws_size, (size_t)WS_END); return; }
    (void)hipMemsetAsync((char*)d_ws + WS_CTL, 0, CTL_ZERO_BYTES, stream);
    mega_launch(d_in, d_out, d_ws, stream);
}
```

```cpp
#include <hip/hip_runtime.h>
#include <cstdio>
#include <cstdint>
template <int X> __device__ __forceinline__ float swz_xor(float v) { return __int_as_float(__builtin_amdgcn_ds_swizzle(__float_as_int(v), (X << 10) | 0x1f)); }
__device__ __forceinline__ float sum_x32(float v) { auto rr = __builtin_amdgcn_permlane32_swap(__float_as_uint(v), __float_as_uint(v), false, false); return __uint_as_float(rr[0]) + __uint_as_float(rr[1]); }
__device__ __forceinline__ float max_x32(float v) { auto rr = __builtin_amdgcn_permlane32_swap(__float_as_uint(v), __float_as_uint(v), false, false); return fmaxf(__uint_as_float(rr[0]), __uint_as_float(rr[1])); }
__device__ __forceinline__ float wave_sum64(float v) { v += swz_xor<1>(v); v += swz_xor<2>(v); v += swz_xor<4>(v); v += swz_xor<8>(v); v += swz_xor<16>(v); return sum_x32(v); }
namespace pg8 {
#define PG8_LAS __attribute__((address_space(3)))
typedef unsigned short bf16_t;
typedef short bf16x8 __attribute__((ext_vector_type(8)));
typedef float f32x4 __attribute__((ext_vector_type(4)));
typedef float f32x2 __attribute__((ext_vector_type(2)));
typedef unsigned u32x4 __attribute__((ext_vector_type(4)));
constexpr int BM = 256, BK = 64, HALF = 128, HTB = HALF * BK * 2  , STAGE_BYTES = 8 * HTB, NXCD = 8, WGM = 8;

__host__ __device__ __forceinline__ int lds_byte(int r, int c) { const int st = (r >> 4) * 2 + (c >> 5), rr = r & 15, cc = c & 31, ob = rr * 64 + cc * 2; return st * 1024 + (ob ^ (((ob >> 9) & 1) << 5)); }
__host__ __device__ __forceinline__ void stage_rc(int b, int& R, int& C) { const int st = b / 1024, sb = b % 1024, swz = sb ^ (((sb >> 9) & 1) << 5); R = (st >> 1) * 16 + swz / 64; C = (st & 1) * 32 + (swz % 64) / 2; }
__host__ __device__ __forceinline__ int perm32(int rho) { const int n = rho >> 4, i = rho & 15; return 8 * (i >> 2) + 4 * n + (i & 3); }

struct Unit { int pm, pn; const char* a; const char* b; int aux; };
template <int LDA, int LDB, int K_> struct Gemm { static constexpr int lda = LDA, ldb = LDB, K = K_; };

__device__ __forceinline__ unsigned cvt_pk_bf16(float lo, float hi) { unsigned r; asm volatile("v_cvt_pk_bf16_f32 %0, %1, %2" : "=v"(r) : "v"(lo), "v"(hi)); return r; }


template <class Epi, class Sched, class Gemm, bool ALIGN_EPI = true, bool SP2 = true>
__device__ __forceinline__ void gemm_phase(PG8_LAS unsigned char* lds, const Gemm g, const Sched& S, const Epi& E, const int tid) {
    const int wid = __builtin_amdgcn_readfirstlane(tid >> 6), lane = tid & 63, wr = wid >> 2, wc = wid & 3, fr = lane & 15, fq = lane >> 4;
    constexpr int K = Gemm::K, nt = K / BK;
    unsigned voffA[2], voffB[2];
#pragma unroll
    for (int i = 0; i < 2; ++i) { int R, C; stage_rc(tid * 16 + i * 8192, R, C); const int Rb = Epi::PERM ? ((R & ~31) + perm32(R & 31)) : R;
        voffA[i] = (unsigned)(R * Gemm::lda + C) * 2u; voffB[i] = (unsigned)(Rb * Gemm::ldb + C) * 2u; }
    constexpr size_t kstep = (size_t)(BK * 2);
    constexpr size_t hstepA = (size_t)HALF * Gemm::lda * 2, hstepB = (size_t)HALF * Gemm::ldb * 2;
    const unsigned ldsw = (unsigned)wid * 1024u;
    const int aoff = lds_byte(wr * 64 + fr, fq * 8), boff = lds_byte(wc * 32 + fr, fq * 8);
#define PG8_SA(b, h) (((b) * 2 + (h)) * HTB)
#define PG8_SB(b, h) ((4 + (b) * 2 + (h)) * HTB)
#define PG8_STAGE(bufoff, gbase, voff) do { _Pragma("unroll") for (int _i = 0; _i < 2; ++_i) \
        __builtin_amdgcn_global_load_lds((const unsigned*)((const char*)(gbase) + (voff)[_i]), (PG8_LAS unsigned*)(lds + (bufoff) + ldsw + _i * 8192), 16, 0, 0); } while (0)
#define PG8_LDA(dst, b, h) do { _Pragma("unroll") for (int m = 0; m < 4; ++m) _Pragma("unroll") for (int k = 0; k < 2; ++k) dst[m][k] = *(const PG8_LAS bf16x8*)(lds + PG8_SA(b, h) + aoff + m * 2048 + k * 1024); } while (0)
#define PG8_LDB(dst, b, h) do { _Pragma("unroll") for (int n = 0; n < 2; ++n) _Pragma("unroll") for (int k = 0; k < 2; ++k) dst[n][k] = *(const PG8_LAS bf16x8*)(lds + PG8_SB(b, h) + boff + n * 2048 + k * 1024); } while (0)
#define PG8_MMA(ai, bj, At, Bt) do { __builtin_amdgcn_s_setprio(1); _Pragma("unroll") for (int m = 0; m < 4; ++m) _Pragma("unroll") for (int n = 0; n < 2; ++n) _Pragma("unroll") for (int k = 0; k < 2; ++k) \
        acc[ai][bj][m][n] = __builtin_amdgcn_mfma_f32_16x16x32_bf16(Bt[n][k], At[m][k], acc[ai][bj][m][n], 0, 0, 0); __builtin_amdgcn_s_setprio(0); } while (0)
#define PG8_WAIT_V(n) asm volatile("s_waitcnt vmcnt(" #n ")" ::: "memory")
#define PG8_WAIT_L(n) asm volatile("s_waitcnt lgkmcnt(" #n ")" ::: "memory")
#define PG8_BAR __builtin_amdgcn_s_barrier()
#define PG8_SCHED __builtin_amdgcn_sched_barrier(0)
    Unit cur, nxt; int ui = 0;
    if (!S.next(0, cur)) return;
    f32x4 acc[2][2][4][2];
#pragma unroll
    for (int a = 0; a < 2; ++a)
#pragma unroll
        for (int b = 0; b < 2; ++b)
#pragma unroll
            for (int m = 0; m < 4; ++m)
#pragma unroll
                for (int n = 0; n < 2; ++n) acc[a][b][m][n] = (f32x4){0.f, 0.f, 0.f, 0.f};
    bf16x8 At[4][2], B0[2][2], B1[2][2];
    const char* cA = cur.a; const char* cB = cur.b;
    if constexpr (SP2) {
        PG8_STAGE(PG8_SB(0, 0), cB, voffB); PG8_STAGE(PG8_SB(0, 1), cB + hstepB, voffB); PG8_STAGE(PG8_SA(0, 0), cA, voffA); PG8_STAGE(PG8_SA(0, 1), cA + hstepA, voffA);
        if (wr == 1) PG8_BAR;
        PG8_WAIT_V(2); PG8_BAR;
        PG8_STAGE(PG8_SB(1, 0), cB + kstep, voffB); PG8_STAGE(PG8_SA(1, 0), cA + kstep, voffA); PG8_STAGE(PG8_SB(1, 1), cB + hstepB + kstep, voffB);
        PG8_WAIT_V(6); PG8_BAR;
    } else {
        PG8_STAGE(PG8_SB(0, 0), cB, voffB); PG8_STAGE(PG8_SA(0, 0), cA, voffA); PG8_STAGE(PG8_SB(0, 1), cB + hstepB, voffB); PG8_STAGE(PG8_SA(0, 1), cA + hstepA, voffA);
        if (wr == 1) PG8_BAR;
        PG8_WAIT_V(4); PG8_BAR;
        PG8_STAGE(PG8_SB(1, 0), cB + kstep, voffB); PG8_STAGE(PG8_SA(1, 0), cA + kstep, voffA); PG8_STAGE(PG8_SB(1, 1), cB + hstepB + kstep, voffB);
        PG8_WAIT_V(6); PG8_BAR;
    }
    for (;;) {
        const bool has_next = S.next(ui + 1, nxt);
        const char* nA = has_next ? nxt.a : cA; const char* nB = has_next ? nxt.b : cB;
#pragma unroll 1
        for (int t = 0; t < nt; t += 2) {
            const bool last = (t == nt - 2);
            const char* a1 = cA + (size_t)(t + 1) * kstep;
            const char* a2 = last ? nA : cA + (size_t)(t + 2) * kstep; const char* b2 = last ? nB : cB + (size_t)(t + 2) * kstep;
            const char* a3 = a2 + kstep; const char* b3 = b2 + kstep;
            if constexpr (Epi::MIDK > 0) { if (t == Epi::MIDK) E.midk(acc, cur, wr, wc, fr, fq); }
            if constexpr (SP2) {
            PG8_LDB(B0, 0, 0); PG8_LDB(B1, 0, 1); PG8_SCHED; PG8_LDA(At, 0, 0); PG8_STAGE(PG8_SA(1, 1), a1 + hstepA, voffA);
            PG8_WAIT_V(8); PG8_WAIT_L(0); PG8_BAR; PG8_MMA(0, 0, At, B0); PG8_MMA(0, 1, At, B1); PG8_BAR; PG8_SCHED;
            PG8_LDA(At, 0, 1); PG8_STAGE(PG8_SB(0, 0), b2, voffB); PG8_STAGE(PG8_SB(0, 1), b2 + hstepB, voffB); PG8_STAGE(PG8_SA(0, 0), a2, voffA);
            PG8_WAIT_V(8); PG8_WAIT_L(0); PG8_BAR; PG8_MMA(1, 0, At, B0); PG8_MMA(1, 1, At, B1); PG8_BAR; PG8_SCHED;
            PG8_LDB(B0, 1, 0); PG8_LDB(B1, 1, 1); PG8_SCHED; PG8_LDA(At, 1, 0); PG8_STAGE(PG8_SA(0, 1), a2 + hstepA, voffA);
            PG8_WAIT_V(8); PG8_WAIT_L(0); PG8_BAR; PG8_MMA(0, 0, At, B0); PG8_MMA(0, 1, At, B1); PG8_BAR; PG8_SCHED;
            PG8_LDA(At, 1, 1); PG8_STAGE(PG8_SB(1, 0), b3, voffB); PG8_STAGE(PG8_SB(1, 1), b3 + hstepB, voffB); PG8_STAGE(PG8_SA(1, 0), a3, voffA);
            PG8_WAIT_V(8); PG8_WAIT_L(0); PG8_BAR; PG8_MMA(1, 0, At, B0); PG8_MMA(1, 1, At, B1); PG8_BAR; PG8_SCHED;
            } else {
            PG8_LDB(B0, 0, 0); PG8_SCHED; PG8_LDA(At, 0, 0); PG8_STAGE(PG8_SA(1, 1), a1 + hstepA, voffA);
            PG8_WAIT_L(8); PG8_BAR; PG8_WAIT_L(0); PG8_MMA(0, 0, At, B0); PG8_BAR; PG8_SCHED;
            PG8_LDB(B1, 0, 1); PG8_STAGE(PG8_SB(0, 0), b2, voffB);
            PG8_BAR; PG8_WAIT_L(0); PG8_MMA(0, 1, At, B1); PG8_BAR;
            PG8_LDA(At, 0, 1); PG8_STAGE(PG8_SA(0, 0), a2, voffA);
            PG8_BAR; PG8_WAIT_L(0); PG8_MMA(1, 0, At, B0); PG8_BAR; PG8_SCHED;
            PG8_STAGE(PG8_SB(0, 1), b2 + hstepB, voffB);
            PG8_WAIT_V(6); PG8_BAR; PG8_MMA(1, 1, At, B1); PG8_BAR;
            PG8_LDB(B0, 1, 0); PG8_SCHED; PG8_LDA(At, 1, 0); PG8_STAGE(PG8_SA(0, 1), a2 + hstepA, voffA);
            PG8_WAIT_L(8); PG8_BAR; PG8_WAIT_L(0); PG8_MMA(0, 0, At, B0); PG8_BAR; PG8_SCHED;
            PG8_LDB(B1, 1, 1); PG8_STAGE(PG8_SB(1, 0), b3, voffB);
            PG8_BAR; PG8_WAIT_L(0); PG8_MMA(0, 1, At, B1); PG8_BAR;
            PG8_LDA(At, 1, 1); PG8_STAGE(PG8_SA(1, 0), a3, voffA);
            PG8_BAR; PG8_WAIT_L(0); PG8_MMA(1, 0, At, B0); PG8_BAR; PG8_SCHED;
            PG8_STAGE(PG8_SB(1, 1), b3 + hstepB, voffB);
            PG8_WAIT_V(6); PG8_BAR; PG8_MMA(1, 1, At, B1); PG8_BAR;
            }
        }
        if constexpr (ALIGN_EPI) { if (wr == 0) PG8_BAR; }
        { int fr_ = fr, fq_ = fq; asm volatile("" : "+v"(fr_), "+v"(fq_));
#if defined(PROBE_NOEPI) && PROBE_NOEPI
        if (!E.shadow_skip) E(acc, cur, wr, wc, fr_, fq_);
#else
        E(acc, cur, wr, wc, fr_, fq_);
#endif
        }
        if (!has_next) break;
#pragma unroll
        for (int a = 0; a < 2; ++a)
#pragma unroll
            for (int b = 0; b < 2; ++b)
#pragma unroll
                for (int m = 0; m < 4; ++m)
#pragma unroll
                    for (int n = 0; n < 2; ++n) acc[a][b][m][n] = (f32x4){0.f, 0.f, 0.f, 0.f};
        cur = nxt; cA = nA; cB = nB; ++ui;
        if constexpr (ALIGN_EPI) { if (wr == 1) PG8_BAR; }
    }
    PG8_WAIT_V(0);
    if constexpr (!ALIGN_EPI) { if (wr == 0) PG8_BAR; }
    PG8_BAR;
#undef PG8_SA
#undef PG8_SB
#undef PG8_STAGE
#undef PG8_LDA
#undef PG8_LDB
#undef PG8_MMA
#undef PG8_WAIT_V
#undef PG8_WAIT_L
#undef PG8_BAR
#undef PG8_SCHED
}
}
namespace pg8 {
constexpr float LOG2E = 1.4426950408889634f;
constexpr float RMS_EPS = 1e-6f;
constexpr size_t TILE_BYTES = 1536 * 1024, T_Y = 0, T_K = 512 * 1024, T_V = 768 * 1024, T_U = 1024 * 1024, T_LOGF = 1280 * 1024;

template <int kind, int nM, int nN, size_t sA, size_t sB, size_t batchB = 0>
struct SchedT {
    static constexpr int nwg = nM * nN, G = 256;
    int c; const char* A; const char* B;
    __device__ __forceinline__ void init(int c_, const void* A_, const void* B_) { c = c_; A = (const char*)A_; B = (const char*)B_; }
    __device__ __forceinline__ bool next(int i, Unit& u) const {
        const int L = i * G + c; if ((unsigned)L >= (unsigned)nwg) return false;
        if constexpr (kind <= 1) {
            int wgid = L; { constexpr int q = nwg / NXCD, r = nwg % NXCD; const int xcd = wgid % NXCD, off = wgid / NXCD; wgid = (xcd < r ? xcd * (q + 1) : r * (q + 1) + (xcd - r) * q) + off; }
            constexpr int nig = WGM * nN; const int gid = wgid / nig, fm = gid * WGM, gsz = (nM - fm) < WGM ? (nM - fm) : WGM;
            u.pm = fm + ((wgid % nig) % gsz); u.pn = (wgid % nig) / gsz;
            u.a = A + (size_t)u.pm * sA; u.b = B + (size_t)u.pn * sB + (kind == 1 ? (size_t)(u.pm >> 3) * batchB : (size_t)0); u.aux = 0;
        } else if constexpr (kind == 2) {
            const int b_ = L & 7, h = (L >> 5) & 3, t4 = (L >> 3) & 3;
            u.pm = b_ * 4 + h; u.pn = t4;
            u.a = A + ((size_t)b_ * 256 * 2048 + (size_t)h * 256) * 2; u.b = B + ((size_t)t4 * 256 * 1024 + (size_t)h * 256) * 2;
            u.aux = b_ * 4194304 + (h * 256) * 1024 + t4 * 256;
        } else if constexpr (kind == 3) {
            const int b_ = L & 7, h = (L >> 5) & 3, t4 = (L >> 3) & 3;
            u.pm = t4; u.pn = b_ * 4 + h;
            u.a = A + ((size_t)t4 * 256 * 1024 + (size_t)h * 256) * 2; u.b = B + ((size_t)b_ * 256 * 2048 + 1024 + (size_t)h * 256) * 2;
            u.aux = b_ * 4194304 + (t4 * 256) * 1024 + h * 256;
        } else {
            u.pm = L & 7; u.pn = L >> 3; u.a = A + (size_t)u.pm * sA; u.b = B + (size_t)u.pn * sB; u.aux = 0;
        }
        return true;
    }
};

__device__ __forceinline__ void store8(bf16_t* p, const f32x4 v0, const f32x4 v1) {
    u32x4 w; w.x = cvt_pk_bf16(v0[0], v0[1]); w.y = cvt_pk_bf16(v0[2], v0[3]); w.z = cvt_pk_bf16(v1[0], v1[1]); w.w = cvt_pk_bf16(v1[2], v1[3]); *(u32x4*)p = w;
}
__device__ __forceinline__ float ss_sum16(const float* ssp, int row) {
    const f32x4* p = (const f32x4*)(ssp + (size_t)row * 16); const f32x4 a = p[0], b = p[1], c = p[2], d = p[3];
    return (((a[0] + a[1]) + (a[2] + a[3])) + ((b[0] + b[1]) + (b[2] + b[3]))) + (((c[0] + c[1]) + (c[2] + c[3])) + ((d[0] + d[1]) + (d[2] + d[3])));
}
__device__ __forceinline__ float rs_row(const float* ssp, int row) { return __builtin_amdgcn_rsqf(ss_sum16(ssp, row) * (1.0f / 1024.0f) + RMS_EPS); }
__device__ __forceinline__ float sigmoidf_fast(float z) { return __builtin_amdgcn_rcpf(1.0f + __builtin_amdgcn_exp2f(-z * LOG2E)); }
__device__ __forceinline__ f32x4 sig4(f32x4 z) { f32x4 r; r[0] = sigmoidf_fast(z[0]); r[1] = sigmoidf_fast(z[1]); r[2] = sigmoidf_fast(z[2]); r[3] = sigmoidf_fast(z[3]); return r; }

struct EpiSwiGLU {
    static constexpr bool PERM = true; static constexpr int MIDK = 0;
    bf16_t* H; const float* ss; static constexpr int ldh = 2816;
    bool shadow_skip = false;
    __device__ __forceinline__ void midk(f32x4 (&)[2][2][4][2], const Unit&, int, int, int, int) const {}
    __device__ __forceinline__ void operator()(f32x4 (&acc)[2][2][4][2], const Unit& u, int wr, int wc, int fr, int fq) const {
        const int rl0 = wr * 64 + fr, col0 = u.pn * HALF + wc * 32 + 8 * fq;
        bf16_t* Ht = (bf16_t*)((unsigned char*)H + (size_t)u.pm * TILE_BYTES);
#pragma unroll
        for (int ai = 0; ai < 2; ++ai)
#pragma unroll
            for (int m = 0; m < 4; ++m) {
                const int rl = rl0 + ai * HALF + m * 16;
                const float rs = rs_row(ss, u.pm * BM + rl);
                const f32x4 g0 = acc[ai][0][m][0] * rs, g1 = acc[ai][0][m][1] * rs, u0 = acc[ai][1][m][0] * rs, u1 = acc[ai][1][m][1] * rs;
                store8(Ht + (size_t)rl * ldh + col0, g0 * sig4(g0) * u0, g1 * sig4(g1) * u1);
            }
    }
};

template <int MIDK_>
struct EpiResid {
    static constexpr bool PERM = true; static constexpr int MIDK = MIDK_;
    const float* xin; float* xout; bf16_t* xb; float* ssn; const float* ssa; float alpha;
    bool shadow_skip = false;
    __device__ __forceinline__ void midk(f32x4 (&acc)[2][2][4][2], const Unit& u, int wr, int wc, int fr, int fq) const {
        const int row0 = u.pm * BM + wr * 64 + fr;
#pragma unroll
        for (int ai = 0; ai < 2; ++ai)
#pragma unroll
            for (int m = 0; m < 4; ++m) {
                const f32x4* pa = (const f32x4*)(ssa + (size_t)(row0 + ai * HALF + m * 16) * 8); const f32x4 sa = pa[0], sb = pa[1];
                const float rs = __builtin_amdgcn_rsqf((((sa[0] + sa[1]) + (sa[2] + sa[3])) + ((sb[0] + sb[1]) + (sb[2] + sb[3]))) * (1.0f / 512.0f) + RMS_EPS);
#pragma unroll
                for (int bj = 0; bj < 2; ++bj)
#pragma unroll
                    for (int n = 0; n < 2; ++n) acc[ai][bj][m][n] *= rs;
            }
    }
    __device__ __forceinline__ void operator()(f32x4 (&acc)[2][2][4][2], const Unit& u, int wr, int wc, int fr, int fq) const {
        const int row0 = u.pm * BM + wr * 64 + fr, col0 = u.pn * BM + wc * 32 + 8 * fq;
#pragma unroll
        for (int ai = 0; ai < 2; ++ai)
#pragma unroll
            for (int m = 0; m < 4; ++m) {
                const int row = row0 + ai * HALF + m * 16; float q = 0.f;
#pragma unroll
                for (int bj = 0; bj < 2; ++bj) {
                    const size_t off = (size_t)row * 1024 + col0 + bj * HALF;
                    f32x4 r0, r1;
                    if (xin) { r0 = *(const f32x4*)(xin + off); r1 = *(const f32x4*)(xin + off + 4); }
                    else { const u32x4 w = *(const u32x4*)(xb + off);
                        r0 = (f32x4){__uint_as_float(w.x << 16), __uint_as_float(w.x & 0xffff0000u), __uint_as_float(w.y << 16), __uint_as_float(w.y & 0xffff0000u)};
                        r1 = (f32x4){__uint_as_float(w.z << 16), __uint_as_float(w.z & 0xffff0000u), __uint_as_float(w.w << 16), __uint_as_float(w.w & 0xffff0000u)}; }
                    const f32x4 v0 = r0 + acc[ai][bj][m][0] * alpha, v1 = r1 + acc[ai][bj][m][1] * alpha;
                    if (xout) { *(f32x4*)(xout + off) = v0; *(f32x4*)(xout + off + 4) = v1; }
                    else store8(xb + off, v0, v1);
                    q += (v0[0] * v0[0] + v0[1] * v0[1]) + (v0[2] * v0[2] + v0[3] * v0[3]) + (v1[0] * v1[0] + v1[1] * v1[1]) + (v1[2] * v1[2] + v1[3] * v1[3]);
                }
                q += swz_xor<16>(q); q = sum_x32(q);
                if (fq == 0) ssn[(size_t)row * 16 + u.pn * 4 + wc] = q;
            }
    }
};

struct EpiWin {
    static constexpr bool PERM = true; static constexpr int MIDK = 0;
    unsigned char* R1; const float* ss; const float* bfp; float qscale;
    bool shadow_skip = false;
    __device__ __forceinline__ void midk(f32x4 (&)[2][2][4][2], const Unit&, int, int, int, int) const {}
    __device__ __forceinline__ void operator()(f32x4 (&acc)[2][2][4][2], const Unit& u, int wr, int wc, int fr, int fq) const {
        const int rl0 = wr * 64 + fr, cw = wc * 32 + 8 * fq; const int pn = u.pn;
        unsigned char* T = R1 + (size_t)u.pm * TILE_BYTES;
#pragma unroll
        for (int ai = 0; ai < 2; ++ai)
#pragma unroll
            for (int m = 0; m < 4; ++m) {
                const int rl = rl0 + ai * HALF + m * 16;
                const float rs = rs_row(ss, u.pm * BM + rl);
                if (pn < 6) {
                    bf16_t* base; int ld; float sc = rs;
                    if (pn < 2) { base = (bf16_t*)(T + T_Y) + pn * BM; ld = 1024; sc = rs * qscale; } else if (pn < 4) { base = (bf16_t*)(T + T_K) + (pn - 2) * BM; ld = 512; } else { base = (bf16_t*)(T + T_V) + (pn - 4) * BM; ld = 512; }
#pragma unroll
                    for (int bj = 0; bj < 2; ++bj) store8(base + (size_t)rl * ld + bj * HALF + cw, acc[ai][bj][m][0] * sc, acc[ai][bj][m][1] * sc);
                } else if (pn < 10) {
                    const f32x4 a0 = acc[ai][0][m][0] * rs, a1 = acc[ai][0][m][1] * rs, g0 = acc[ai][1][m][0] * rs, g1 = acc[ai][1][m][1] * rs;
                    store8((bf16_t*)(T + T_U) + (size_t)rl * 512 + (pn - 6) * HALF + cw, a0 * sig4(g0), a1 * sig4(g1));
                } else {
                    if (wc == 0 && fq == 0) {
                        float* LF = (float*)(T + T_LOGF);
#pragma unroll
                        for (int n = 0; n < 2; ++n)
#pragma unroll
                            for (int e = 0; e < 4; ++e) {
                                const int h = 4 * n + e; const float z = acc[ai][0][m][n][e] * rs + bfp[h];
                                LF[h * 256 + rl] = fminf(z, 0.f) - log1pf(expf(-fabsf(z)));
                            }
                    }
                }
            }
    }
};

struct EpiRowScale {
    static constexpr bool PERM = true; static constexpr int MIDK = 0;
    bf16_t* O; const float* ssr; float scale; static constexpr int ldc = 2048;
    bool shadow_skip = false;
    __device__ __forceinline__ void midk(f32x4 (&)[2][2][4][2], const Unit&, int, int, int, int) const {}
    __device__ __forceinline__ void operator()(f32x4 (&acc)[2][2][4][2], const Unit& u, int wr, int wc, int fr, int fq) const {
        const int row0 = u.pm * BM + wr * 64 + fr, col0 = u.pn * BM + wc * 32 + 8 * fq;
#pragma unroll
        for (int ai = 0; ai < 2; ++ai)
#pragma unroll
            for (int m = 0; m < 4; ++m) {
                const int row = row0 + ai * HALF + m * 16;
                const float rs = (ssr ? __builtin_amdgcn_rsqf(ssr[row] * (1.0f / 1024.0f) + RMS_EPS) : 1.0f) * scale;
#pragma unroll
                for (int bj = 0; bj < 2; ++bj) store8(O + (size_t)row * ldc + col0 + bj * HALF, acc[ai][bj][m][0] * rs, acc[ai][bj][m][1] * rs);
            }
    }
};

struct EpiAux {
    static constexpr bool PERM = true; static constexpr int MIDK = 0;
    bf16_t* O; float scale; static constexpr int ldc = 1024;
    bool shadow_skip = false;
    __device__ __forceinline__ void midk(f32x4 (&)[2][2][4][2], const Unit&, int, int, int, int) const {}
    __device__ __forceinline__ void operator()(f32x4 (&acc)[2][2][4][2], const Unit& u, int wr, int wc, int fr, int fq) const {
        bf16_t* base = O + u.aux + (size_t)(wr * 64 + fr) * ldc + wc * 32 + 8 * fq;
#pragma unroll
        for (int ai = 0; ai < 2; ++ai)
#pragma unroll
            for (int m = 0; m < 4; ++m)
#pragma unroll
                for (int bj = 0; bj < 2; ++bj) store8(base + (size_t)(ai * HALF + m * 16) * ldc + bj * HALF, acc[ai][bj][m][0] * scale, acc[ai][bj][m][1] * scale);
    }
};

struct EpiSoftmax {
    static constexpr bool PERM = true; static constexpr int MIDK = 0;
    unsigned char* R1; const float* ss; PG8_LAS float* scr;
    bool shadow_skip = false;
    __device__ __forceinline__ void midk(f32x4 (&)[2][2][4][2], const Unit&, int, int, int, int) const {}
    __device__ __forceinline__ void operator()(f32x4 (&acc)[2][2][4][2], const Unit& u, int wr, int wc, int fr, int fq) const {
        const int col0 = u.pn * BM + wc * 32 + 8 * fq;
        PG8_LAS float* TM = scr; PG8_LAS float* TS = scr + 1024;
        const float* ssr = ss + (size_t)(u.pm * BM + wr * 64 + fr) * 16;
#pragma unroll
        for (int ai = 0; ai < 2; ++ai)
#pragma unroll
            for (int m = 0; m < 4; ++m) {
                const int rl = ai * HALF + wr * 64 + m * 16 + fr;
                const float rs = rs_row(ssr, ai * HALF + m * 16);
                float v = -3.0e38f;
#pragma unroll
                for (int bj = 0; bj < 2; ++bj)
#pragma unroll
                    for (int n = 0; n < 2; ++n) { const f32x4 x = acc[ai][bj][m][n] * rs; acc[ai][bj][m][n] = x; v = fmaxf(v, fmaxf(fmaxf(x[0], x[1]), fmaxf(x[2], x[3]))); }
                v = fmaxf(v, swz_xor<16>(v)); v = max_x32(v);
                if (fq == 0) TM[rl * 4 + wc] = v;
            }
        asm volatile("s_waitcnt lgkmcnt(0)" ::: "memory"); __builtin_amdgcn_s_barrier(); asm volatile("" ::: "memory");
#pragma unroll
        for (int ai = 0; ai < 2; ++ai)
#pragma unroll
            for (int m = 0; m < 4; ++m) {
                const int rl = ai * HALF + wr * 64 + m * 16 + fr;
                const f32x4 t = *(const PG8_LAS f32x4*)(TM + rl * 4);
                const float mrow = fmaxf(fmaxf(t[0], t[1]), fmaxf(t[2], t[3]));
                float s = 0.f;
#pragma unroll
                for (int bj = 0; bj < 2; ++bj)
#pragma unroll
                    for (int n = 0; n < 2; ++n) { f32x4 x = acc[ai][bj][m][n] - mrow;
                        x[0] = __builtin_amdgcn_exp2f(x[0]); x[1] = __builtin_amdgcn_exp2f(x[1]); x[2] = __builtin_amdgcn_exp2f(x[2]); x[3] = __builtin_amdgcn_exp2f(x[3]);
                        acc[ai][bj][m][n] = x; s += (x[0] + x[1]) + (x[2] + x[3]); }
                s += swz_xor<16>(s); s = sum_x32(s);
                if (fq == 0) TS[rl * 4 + wc] = s;
            }
        asm volatile("s_waitcnt lgkmcnt(0)" ::: "memory"); __builtin_amdgcn_s_barrier(); asm volatile("" ::: "memory");
        bf16_t* xp = (bf16_t*)(R1 + (size_t)u.pm * TILE_BYTES + T_Y) + (size_t)(wr * 64 + fr) * 1024 + col0;
#pragma unroll
        for (int ai = 0; ai < 2; ++ai)
#pragma unroll
            for (int m = 0; m < 4; ++m) {
                const int rl = ai * HALF + wr * 64 + m * 16 + fr;
                const f32x4 t = *(const PG8_LAS f32x4*)(TS + rl * 4);
                const float inv = __builtin_amdgcn_rcpf((t[0] + t[1]) + (t[2] + t[3]));
#pragma unroll
                for (int bj = 0; bj < 2; ++bj) store8(xp + (size_t)(ai * HALF + m * 16) * 1024 + bj * HALF, acc[ai][bj][m][0] * inv, acc[ai][bj][m][1] * inv);
            }
    }
};
}
#include <hip/hip_bf16.h>
namespace attn_body {
using bf16=__hip_bfloat16;
using bf16x8=__attribute__((ext_vector_type(8)))short;
using s16x4=__attribute__((ext_vector_type(4)))short;
using f32x16=__attribute__((ext_vector_type(16)))float;
using f32x4_t=__attribute__((ext_vector_type(4)))float;
using u32x4=__attribute__((ext_vector_type(4)))unsigned;
#define ATT_LAS __attribute__((address_space(3)))
constexpr int BATCH=8,NHEAD=8,SEQ=2048,D=64,QP=1024,KP=512;
constexpr size_t TILE_BYTES=1536*1024,T_Y=0,T_K=512*1024,T_V=768*1024,T_U=1024*1024,T_LOGF=1280*1024;
constexpr int NW=8,QBLK=32,QB=QBLK*NW,KVBLK=64,NQB=SEQ/QB;
__device__ __forceinline__ int crow(int r,int hi){return (r&3)+8*(r>>2)+4*hi;}
#define SBAR() __builtin_amdgcn_sched_barrier(0)
__device__ __forceinline__ void cmask(f32x16&p0,f32x16&p1,int jb,int qrel,int hi){
  const float NEG=-INFINITY; int kb=64*jb+4*hi;
  #pragma unroll
  for(int r=0;r<16;++r){int kv=kb+(r&3)+8*(r>>2); if(kv>qrel)p0[r]=NEG; if(kv+32>qrel)p1[r]=NEG;}
}
constexpr int NSLOT=3, SLOTB=8192;
constexpr int LDS_K=0, LDS_V=NSLOT*SLOTB, LDS_WS=2*NSLOT*SLOTB, LDS_OST=LDS_WS+NW*64*4, LDS_CB=LDS_OST+NW*4096  , LDS_WT=LDS_CB+SEQ*4, LDS_BYTES=LDS_WT+64;
__device__ __forceinline__ void glds16(const void*gsrc,unsigned lds_dst){unsigned keep;
  asm volatile("s_mov_b32 %0, m0\n\ts_mov_b32 m0, %2\n\ts_nop 0\n\tglobal_load_lds_dwordx4 %1, off\n\ts_mov_b32 m0, %0":"=&s"(keep):"v"(gsrc),"s"(lds_dst):"memory");}
__device__ __forceinline__ float max3f(float a,float b,float c){float r;asm("v_max3_f32 %0, %1, %2, %3":"=v"(r):"v"(a),"v"(b),"v"(c));return r;}
__device__ __forceinline__ float max2f(float a,float b){float r;asm("v_max_f32_e32 %0, %1, %2":"=v"(r):"v"(a),"v"(b));return r;}
__device__ __forceinline__ float fadd_s(float a,float b){float r;asm("v_add_f32_e32 %0, %1, %2":"=v"(r):"v"(a),"v"(b));return r;}
__device__ __forceinline__ float fsub_s(float a,float b){float r;asm("v_sub_f32_e32 %0, %1, %2":"=v"(r):"v"(a),"v"(b));return r;}
typedef float f32x2_t __attribute__((ext_vector_type(2))); typedef __bf16 bf16x2_t __attribute__((ext_vector_type(2)));
__device__ __forceinline__ unsigned cvtpk_s(float lo,float hi){f32x2_t v={lo,hi};bf16x2_t b=__builtin_convertvector(v,bf16x2_t);return __builtin_bit_cast(unsigned,b);}
#define WAIT_BAR(N) asm volatile("s_waitcnt vmcnt(" #N ") lgkmcnt(0)\n\ts_barrier":::"memory")

__device__ __forceinline__ void qkt(f32x16&p0,f32x16&p1,const char*Kslot,const bf16x8*qr,const f32x16&negm,int r32,int hi){
  const char*kb=Kslot+hi*1024+r32*16;
  #pragma unroll
  for(int d0=0;d0<4;++d0){
    const bf16x8 b0=*reinterpret_cast<const bf16x8*>(kb+d0*2048);
    const bf16x8 b1=*reinterpret_cast<const bf16x8*>(kb+d0*2048+512);
    if(d0==0){p0=__builtin_amdgcn_mfma_f32_32x32x16_bf16(b0,qr[0],negm,0,0,0);p1=__builtin_amdgcn_mfma_f32_32x32x16_bf16(b1,qr[0],negm,0,0,0);}
    else{p0=__builtin_amdgcn_mfma_f32_32x32x16_bf16(b0,qr[d0],p0,0,0,0);p1=__builtin_amdgcn_mfma_f32_32x32x16_bf16(b1,qr[d0],p1,0,0,0);}}
}
typedef ATT_LAS const char* lds_cptr;
typedef short v4i16_t __attribute__((ext_vector_type(4)));
__device__ __forceinline__ void kload8(bf16x8*kf,lds_cptr kp){
  kf[0]=*(const ATT_LAS bf16x8*)(kp);      kf[1]=*(const ATT_LAS bf16x8*)(kp+512);
  kf[2]=*(const ATT_LAS bf16x8*)(kp+2048); kf[3]=*(const ATT_LAS bf16x8*)(kp+2560);
  kf[4]=*(const ATT_LAS bf16x8*)(kp+4096); kf[5]=*(const ATT_LAS bf16x8*)(kp+4608);
  kf[6]=*(const ATT_LAS bf16x8*)(kp+6144); kf[7]=*(const ATT_LAS bf16x8*)(kp+6656);
}
__device__ __forceinline__ void kload2(bf16x8*kf,lds_cptr kp,int j){ kf[2*j]=*(const ATT_LAS bf16x8*)(kp+j*2048); kf[2*j+1]=*(const ATT_LAS bf16x8*)(kp+j*2048+512); }
__device__ __forceinline__ s16x4 vtr(lds_cptr p){ return __builtin_bit_cast(s16x4,__builtin_amdgcn_ds_read_tr16_b64_v4i16((ATT_LAS v4i16_t*)p)); }
__device__ __forceinline__ float rowmax(const f32x16&p0,const f32x16&p1){
  float a=max3f(p0[0],p0[1],p1[0]),b=max3f(p0[2],p0[3],p1[1]);a=max3f(a,p1[2],p1[3]);
  #pragma unroll
  for(int r=4;r<16;r+=4){a=max3f(a,p0[r],p0[r+1]);b=max3f(b,p0[r+2],p0[r+3]);a=max3f(a,p1[r],p1[r+1]);b=max3f(b,p1[r+2],p1[r+3]);}
  const float m=max2f(a,b);
  auto rr=__builtin_amdgcn_permlane32_swap(__float_as_uint(m),__float_as_uint(m),false,false);
  return max2f(__uint_as_float(rr[0]),__uint_as_float(rr[1]));
}
__device__ __forceinline__ void pv(f32x16*o,int vb,bf16x8 pa0,bf16x8 pa1,bf16x8 pa2,bf16x8 pa3){
  #pragma unroll
  for(int d0=0;d0<2;++d0){s16x4 lo[4],hi[4];
    #pragma unroll
    for(int ks=0;ks<4;++ks){
      asm volatile("ds_read_b64_tr_b16 %0,%1 offset:%c2":"=&v"(lo[ks]):"v"(vb),"i"(d0*4096+ks*1024):"memory");
      asm volatile("ds_read_b64_tr_b16 %0,%1 offset:%c2":"=&v"(hi[ks]):"v"(vb),"i"(d0*4096+ks*1024+512):"memory");}
    asm volatile("s_waitcnt lgkmcnt(0)":::"memory");SBAR();
    #define PK(k) (bf16x8){lo[k][0],lo[k][1],lo[k][2],lo[k][3],hi[k][0],hi[k][1],hi[k][2],hi[k][3]}
    o[d0]=__builtin_amdgcn_mfma_f32_32x32x16_bf16(pa0,PK(0),o[d0],0,0,0);
    o[d0]=__builtin_amdgcn_mfma_f32_32x32x16_bf16(pa1,PK(1),o[d0],0,0,0);
    o[d0]=__builtin_amdgcn_mfma_f32_32x32x16_bf16(pa2,PK(2),o[d0],0,0,0);
    o[d0]=__builtin_amdgcn_mfma_f32_32x32x16_bf16(pa3,PK(3),o[d0],0,0,0);
    #undef PK
  }
}
__device__ __forceinline__ void scan_bias(const unsigned char*R1,int b,int h,char*shm,const int tid){
  const int lane=tid&63,wid=tid>>6;
  ATT_LAS float*cb=(ATT_LAS float*)(shm+LDS_CB); ATT_LAS float*wt=(ATT_LAS float*)(shm+LDS_WT);
  const f32x4_t v=*(const f32x4_t*)((const float*)(R1+(size_t)(8*b+wid)*TILE_BYTES+T_LOGF)+h*256+4*lane);
  const float s0=v[0],s1=s0+v[1],s2=s1+v[2],s3=s2+v[3];
  float incl=s3;
  #pragma unroll
  for(int o=1;o<64;o<<=1){const float n=__int_as_float(__builtin_amdgcn_ds_bpermute((lane-o)<<2,__float_as_int(incl))); if(lane>=o)incl+=n;}
  if(lane==63)wt[wid]=incl;
  asm volatile("s_waitcnt lgkmcnt(0)\n\ts_barrier":::"memory");
  float woff=0.f;
  #pragma unroll
  for(int w=0;w<8;++w){const float x=wt[w]; if(w<wid)woff+=x;}
  const float ex=woff+incl-s3; const float L2E=-1.4426950408889634f;
  f32x4_t o4; o4[0]=(ex+s0)*L2E;o4[1]=(ex+s1)*L2E;o4[2]=(ex+s2)*L2E;o4[3]=(ex+s3)*L2E;
  *(ATT_LAS f32x4_t*)(cb+4*tid)=o4;
  asm volatile("s_waitcnt lgkmcnt(0)\n\ts_barrier":::"memory");
}
template<int THRL> __device__ __forceinline__ void attn_unit(int b,int h,int qb,const unsigned char*R1,int ocol  ,float*ssa  ,char*shm,const int tid){
  const int lane=tid&63,r32=lane&31,hi=lane>>5; const int wid=__builtin_amdgcn_readfirstlane(tid>>6);
  const long rowbase=(long)b*SEQ; const int q0=qb*QB;
  const unsigned char*Tb=R1+(size_t)(8*b)*TILE_BYTES;
  const bf16*Qw=(const bf16*)(Tb+(size_t)qb*TILE_BYTES+T_Y)+(long)(wid*QBLK)*QP+h*D;
  const unsigned lds0=(unsigned)(uintptr_t)shm;
  float*wsf=(float*)(shm+LDS_WS)+wid*64;
  const ATT_LAS float*cbh=(const ATT_LAS float*)(shm+LDS_CB)+4*hi;
  const bf16*ksrc=(const bf16*)(Tb+T_K)+h*D+(long)lane*KP+wid*8;
  const bf16*vsrc=(const bf16*)(Tb+T_V)+h*D+(long)(16*(wid&3)+(lane>>2))*KP+(wid>>2)*32+(lane&3)*8;
  const unsigned kdst=lds0+LDS_K+wid*1024, vdst=lds0+LDS_V+wid*1024;
  #define KVOFF(t) ((size_t)((t)>>2)*(TILE_BYTES/2)+(size_t)((t)&3)*KVBLK*KP)
  #define DMA_K(t,slot) glds16(ksrc+KVOFF(t),(unsigned)__builtin_amdgcn_readfirstlane(kdst+(slot)))
  #define DMA_V(t,slot) glds16(vsrc+KVOFF(t),(unsigned)__builtin_amdgcn_readfirstlane(vdst+(slot)))
  const int vb0=(int)(lds0+LDS_V)+((lane>>4)&1)*32+(lane&3)*8+(4*hi+((lane&15)>>2))*64;
  const char*Kbase=shm+LDS_K; bf16x8 kf[8];
  const lds_cptr shm3=(lds_cptr)shm; const lds_cptr kp0=shm3+LDS_K+hi*1024+r32*16; const lds_cptr vp0=shm3+LDS_V+((lane>>4)&1)*32+(lane&3)*8+(4*hi+((lane&15)>>2))*64;
  const int NT=(q0+QB)/KVBLK;
  DMA_K(0,0);DMA_V(0,0);DMA_K(1,SLOTB);
  bf16x8 qr[4];
  #pragma unroll
  for(int d0=0;d0<4;++d0)qr[d0]=*reinterpret_cast<const bf16x8*>(&Qw[(long)r32*QP+d0*16+hi*8]);
  float mhat=0.f,l_reg=0.f;f32x16 o[2];o[0]=f32x16{};o[1]=f32x16{};f32x16 negm=f32x16{};asm volatile("":"+v"(negm));
  const int qrel=wid*QBLK+r32;
  #define CMASK(P0,P1,t) do{int jb_=(t)-(NT-4); if(jb_>=0)cmask(P0,P1,jb_,qrel,hi);}while(0)
  #define ADDB(P0,P1,t) do{ const ATT_LAS float*cbt_=cbh+64*(t); \
    _Pragma("unroll") for(int j_=0;j_<4;++j_){ const f32x4_t b0_=*(const ATT_LAS f32x4_t*)(cbt_+8*j_), b1_=*(const ATT_LAS f32x4_t*)(cbt_+32+8*j_); \
      _Pragma("unroll") for(int i_=0;i_<4;++i_){P0[4*j_+i_]+=b0_[i_];P1[4*j_+i_]+=b1_[i_];} } }while(0)
  bool resc=false;
  #define START(P0,P1) do{ const float rm=rowmax(P0,P1); resc=false; \
    { const float dl=rm; mhat=fadd_s(mhat,dl); \
      _Pragma("unroll") for(int r=0;r<16;++r){P0[r]=fsub_s(P0[r],dl);P1[r]=fsub_s(P1[r],dl);} \
      _Pragma("unroll") for(int r=0;r<16;++r)negm[r]=-mhat; asm volatile("":"+v"(negm)); } \
    _Pragma("unroll") for(int r=0;r<16;++r)P0[r]=__builtin_amdgcn_exp2f(P0[r]); }while(0)
  #define RESC() do{ if(resc){ asm volatile("s_waitcnt lgkmcnt(0)":::"memory"); \
      _Pragma("unroll") for(int d_=0;d_<2;++d_) _Pragma("unroll") for(int r=0;r<16;++r)o[d_][r]*=wsf[crow(r,hi)]; } }while(0)
  f32x16 pA0,pA1,pB0,pB1;
  int sl_prev=0,sl_cur=0,sl_next=SLOTB;
  #define ROT() do{sl_prev=sl_cur;sl_cur=sl_next;sl_next=(sl_next==(NSLOT-1)*SLOTB)?0:sl_next+SLOTB;}while(0)
  DMA_K(2,2*SLOTB);
  WAIT_BAR(3);
  qkt(pA0,pA1,Kbase,qr,negm,r32,hi);asm volatile("s_nop 15\n\ts_nop 7":"+v"(pA0),"+v"(pA1));ADDB(pA0,pA1,0);asm volatile("s_nop 3":"+v"(pA0),"+v"(pA1));CMASK(pA0,pA1,0);
  START(pA0,pA1);
  _Pragma("unroll") for(int r=0;r<16;++r)pA1[r]=__builtin_amdgcn_exp2f(pA1[r]);
  WAIT_BAR(0);
  DMA_K(3,0);DMA_V(1,SLOTB);
  ROT();
  kload8(kf,kp0+sl_cur);
  WAIT_BAR(2);
  s16x4 vlo[8],vhi[8]; u32x4 pw0,pw1,pw2,pw3;
  #define PKW(P,B) cvtpk_s(P[B],P[B+1])
  #define PAF(k) __builtin_bit_cast(bf16x8,pw##k)
  #define VFR(i) (bf16x8){vlo[i][0],vlo[i][1],vlo[i][2],vlo[i][3],vhi[i][0],vhi[i][1],vhi[i][2],vhi[i][3]}
  #define PIN(x) asm volatile("":"+v"(x))
  #define MX3(a,b,c) __builtin_fmaxf(__builtin_fmaxf((a),(b)),(c))
  #define GAPA(MF,A0,A1,A2,A3,W0,W1,PW) do{ MF; sacc+=A0; sacc+=A1; sacc+=A2; sacc+=A3; PIN(sacc); W0; W1; PIN(PW); SBAR(); }while(0)
  #define EX(v) __builtin_amdgcn_exp2f(v)
  #define GAPB(MF,X,B) do{ MF; X[B]=EX(X[B]); X[B+1]=EX(X[B+1]); X[B+2]=EX(X[B+2]); X[B+3]=EX(X[B+3]); PIN(X); SBAR(); }while(0)
  #define VRD(i) do{ vlo[i]=vtr(vp_+(((i)>>2)*4096+((i)&3)*1024)); vhi[i]=vtr(vp_+(((i)>>2)*4096+((i)&3)*1024+512)); }while(0)
  #define KRD(G,j) do{ if(G){ kload2(kf,kp0+sl_next,j); SBAR(); } }while(0)
  #define STEP(C0,C1,P0,P1,t,GK,GV,GL) do{ SBAR(); \
    const lds_cptr vp_=vp0+sl_prev; \
    VRD(0); SBAR(); float sacc=(P0[0]+P0[1]); \
    GAPA(C0=__builtin_amdgcn_mfma_f32_32x32x16_bf16(kf[0],qr[0],negm,0,0,0), P0[2],P0[3],P0[4],P0[5],     pw0[0]=PKW(P0,0), pw0[1]=PKW(P0,2), pw0); \
    VRD(4); SBAR(); GAPA(C1=__builtin_amdgcn_mfma_f32_32x32x16_bf16(kf[1],qr[0],negm,0,0,0), P0[6],P0[7],P0[8],P0[9],     pw0[2]=PKW(P0,4), pw0[3]=PKW(P0,6), pw0); \
    VRD(1); SBAR(); GAPA(C0=__builtin_amdgcn_mfma_f32_32x32x16_bf16(kf[2],qr[1],C0,0,0,0),   P0[10],P0[11],P0[12],P0[13], pw1[0]=PKW(P0,8), pw1[1]=PKW(P0,10), pw1); \
    VRD(5); SBAR(); GAPA(C1=__builtin_amdgcn_mfma_f32_32x32x16_bf16(kf[3],qr[1],C1,0,0,0),   P0[14],P0[15],P1[0],P1[1],   pw1[2]=PKW(P0,12),pw1[3]=PKW(P0,14), pw1); \
    VRD(2); SBAR(); GAPA(C0=__builtin_amdgcn_mfma_f32_32x32x16_bf16(kf[4],qr[2],C0,0,0,0),   P1[2],P1[3],P1[4],P1[5],     pw2[0]=PKW(P1,0), pw2[1]=PKW(P1,2), pw2); \
    VRD(6); SBAR(); GAPA(C1=__builtin_amdgcn_mfma_f32_32x32x16_bf16(kf[5],qr[2],C1,0,0,0),   P1[6],P1[7],P1[8],P1[9],     pw2[2]=PKW(P1,4), pw2[3]=PKW(P1,6), pw2); \
    VRD(3); SBAR(); GAPA(C0=__builtin_amdgcn_mfma_f32_32x32x16_bf16(kf[6],qr[3],C0,0,0,0),   P1[10],P1[11],P1[12],P1[13], pw3[0]=PKW(P1,8), pw3[1]=PKW(P1,10), pw3); \
    VRD(7); SBAR(); GAPA(C1=__builtin_amdgcn_mfma_f32_32x32x16_bf16(kf[7],qr[3],C1,0,0,0),   P1[14],P1[15],0.f,0.f,       pw3[2]=PKW(P1,12),pw3[3]=PKW(P1,14), pw3); \
    l_reg+=sacc; \
    if(GK){DMA_K((t)+3,sl_cur);} if(GV){DMA_V((t)+1,sl_next);} \
    ADDB(C0,C1,t); \
    CMASK(C0,C1,t); \
    { float a=MX3(C0[0],C0[1],C1[0]),b=MX3(C0[2],C0[3],C1[1]); a=MX3(a,C1[2],C1[3]); \
      _Pragma("unroll") for(int r=4;r<16;r+=4){a=MX3(a,C0[r],C0[r+1]);b=MX3(b,C0[r+2],C0[r+3]);a=MX3(a,C1[r],C1[r+1]);b=MX3(b,C1[r+2],C1[r+3]);} \
      float rm=__builtin_fmaxf(a,b); { auto rr=__builtin_amdgcn_permlane32_swap(__float_as_uint(rm),__float_as_uint(rm),false,false); rm=__builtin_fmaxf(__uint_as_float(rr[0]),__uint_as_float(rr[1])); } \
      resc=false; \
      if(__builtin_expect(__any(rm>(float)THRL),0)){ const float dl=__builtin_fmaxf(rm,0.f); mhat+=dl; \
        _Pragma("unroll") for(int r=0;r<16;++r){C0[r]-=dl;C1[r]-=dl;} \
        _Pragma("unroll") for(int r=0;r<16;++r)negm[r]=-mhat; asm volatile("":"+v"(negm)); \
        const float f=__builtin_amdgcn_exp2f(-dl); l_reg*=f; if(hi==0)wsf[r32]=f; resc=true; } } \
    SBAR(); \
    GAPB(o[0]=__builtin_amdgcn_mfma_f32_32x32x16_bf16(PAF(0),VFR(0),o[0],0,0,0), C0,0); \
    GAPB(o[1]=__builtin_amdgcn_mfma_f32_32x32x16_bf16(PAF(0),VFR(4),o[1],0,0,0), C0,4); \
    KRD(GL,0); GAPB(o[0]=__builtin_amdgcn_mfma_f32_32x32x16_bf16(PAF(1),VFR(1),o[0],0,0,0), C0,8); \
    KRD(GL,1); GAPB(o[1]=__builtin_amdgcn_mfma_f32_32x32x16_bf16(PAF(1),VFR(5),o[1],0,0,0), C0,12); \
    KRD(GL,2); GAPB(o[0]=__builtin_amdgcn_mfma_f32_32x32x16_bf16(PAF(2),VFR(2),o[0],0,0,0), C1,0); \
    KRD(GL,3); GAPB(o[1]=__builtin_amdgcn_mfma_f32_32x32x16_bf16(PAF(2),VFR(6),o[1],0,0,0), C1,4); \
    GAPB(o[0]=__builtin_amdgcn_mfma_f32_32x32x16_bf16(PAF(3),VFR(3),o[0],0,0,0), C1,8); \
    GAPB(o[1]=__builtin_amdgcn_mfma_f32_32x32x16_bf16(PAF(3),VFR(7),o[1],0,0,0), C1,12); \
    }while(0)
  int t=1;
  #undef CMASK
  #define CMASK(P0,P1,t) do{}while(0)
  for(;t+5<NT;t+=2){
    STEP(pB0,pB1,pA0,pA1,t,true,true,true);     WAIT_BAR(2); RESC(); ROT();
    STEP(pA0,pA1,pB0,pB1,t+1,true,true,true);   WAIT_BAR(2); RESC(); ROT();
  }
  #undef CMASK
  #define CMASK(P0,P1,t) do{int jb_=(t)-(NT-4); if(jb_>=0)cmask(P0,P1,jb_,qrel,hi);}while(0)
  #define ENDW(tt) do{ if((tt)+3<NT){WAIT_BAR(2);} else if((tt)+2<NT){WAIT_BAR(1);} else {WAIT_BAR(0);} }while(0)
  for(;t+1<NT;t+=2){
    STEP(pB0,pB1,pA0,pA1,t,(t+3<NT),(t+1<NT),(t+1<NT));       ENDW(t);   RESC(); ROT();
    STEP(pA0,pA1,pB0,pB1,t+1,(t+4<NT),(t+2<NT),(t+2<NT));     ENDW(t+1); RESC(); ROT();
  }
  STEP(pB0,pB1,pA0,pA1,NT-1,false,false,false); RESC();
  { float sacc=pB0[0]+pB0[1]; _Pragma("unroll") for(int r=2;r<16;++r)sacc+=pB0[r]; _Pragma("unroll") for(int r=0;r<16;++r)sacc+=pB1[r]; l_reg+=sacc;
    pw0=(u32x4){PKW(pB0,0),PKW(pB0,2),PKW(pB0,4),PKW(pB0,6)};pw1=(u32x4){PKW(pB0,8),PKW(pB0,10),PKW(pB0,12),PKW(pB0,14)};pw2=(u32x4){PKW(pB1,0),PKW(pB1,2),PKW(pB1,4),PKW(pB1,6)};pw3=(u32x4){PKW(pB1,8),PKW(pB1,10),PKW(pB1,12),PKW(pB1,14)};
    SBAR(); pv(o,vb0+sl_cur,PAF(0),PAF(1),PAF(2),PAF(3)); }
  #undef PKW
  #undef PAF
  #undef VFR
  #undef PIN
  #undef MX3
  #undef GAPA
  #undef GAPB
  #undef EX
  #undef VRD
  #undef KRD
  #undef STEP
  #undef ENDW
  {auto rr=__builtin_amdgcn_permlane32_swap(__float_as_uint(l_reg),__float_as_uint(l_reg),false,false);l_reg=__uint_as_float(rr[0])+__uint_as_float(rr[1]);}
  if(hi==0)wsf[32+r32]=l_reg;asm volatile("s_waitcnt lgkmcnt(0)":::"memory");
  float rli[16];
  #pragma unroll
  for(int r=0;r<16;++r)rli[r]=__builtin_amdgcn_rcpf(wsf[32+crow(r,hi)]);
  bf16*Ow=(bf16*)(Tb+(size_t)qb*TILE_BYTES+T_Y)+(long)(wid*QBLK)*QP+h*D+ocol;
  float*ssw=ssa+(rowbase+q0+wid*QBLK)*8+h;
  { bf16*stg=(bf16*)(shm+LDS_OST)+wid*2048;
    #pragma unroll
    for(int r=0;r<16;++r){const int orow=crow(r,hi);
      #pragma unroll
      for(int d0=0;d0<2;++d0)stg[orow*64+d0*32+r32]=__float2bfloat16(o[d0][r]*rli[r]);}
    asm volatile("s_waitcnt lgkmcnt(0)":::"memory");
    #pragma unroll
    for(int i=0;i<4;++i){const int row=i*8+(lane>>3),ch=lane&7; const u32x4 v=*(const u32x4*)(stg+row*64+ch*8); *(u32x4*)(Ow+(long)row*QP+ch*8)=v;
      float q=0.f;
      #pragma unroll
      for(int e=0;e<4;++e){const float lo=__uint_as_float(v[e]<<16),hi2=__uint_as_float(v[e]&0xffff0000u); q+=lo*lo+hi2*hi2;}
      q+=swz_xor<1>(q);q+=swz_xor<2>(q);q+=swz_xor<4>(q);
      if(ch==0)ssw[row*8]=q;} }
  asm volatile("s_waitcnt lgkmcnt(0)\n\ts_barrier":::"memory");
  #undef DMA_K
  #undef DMA_V
  #undef KVOFF
  #undef CMASK
  #undef ADDB
  #undef START
  #undef RESC
  #undef ROT
}
#undef SBAR
#undef WAIT_BAR

constexpr int CONV_W=31, CONV_C=512, CONV_TOK=32, CONV_ROWS=CONV_TOK+CONV_W-1, CONV_LDS_W=0, CONV_LDS_U=CONV_W*CONV_C*4;
__device__ __forceinline__ float wsum64(float v){ return wave_sum64(v); }
__device__ __forceinline__ void conv_stage_w(const float*cw,char*shm,const int tid){
  ATT_LAS u32x4*LW=(ATT_LAS u32x4*)(shm+CONV_LDS_W); const u32x4*src=(const u32x4*)cw;
  u32x4 v[8];
  #pragma unroll
  for(int i=0;i<8;++i){const int idx=tid+i*512; v[i]=(idx<CONV_W*CONV_C/4)?src[idx]:(u32x4){0u,0u,0u,0u};}
  #pragma unroll
  for(int i=0;i<8;++i){const int idx=tid+i*512; if(idx<CONV_W*CONV_C/4)LW[idx]=v[i];}
  __syncthreads();
}
__device__ __forceinline__ void conv_unit(int unit,const unsigned char*R1,const float*cbias,const float*lng,const float*lnb,char*shm,const int tid){
  const int lane=tid&63,wid=tid>>6;
  const int b=unit>>6,t0=(unit&63)*CONV_TOK;
  const unsigned char*Tb=R1+(size_t)(8*b)*TILE_BYTES;
  ATT_LAS u32x4*L=(ATT_LAS u32x4*)(shm+CONV_LDS_U);
  const ATT_LAS f32x4_t*LW=(const ATT_LAS f32x4_t*)(shm+CONV_LDS_W);
  { u32x4 v[8];
    #pragma unroll
    for(int i=0;i<8;++i){const int idx=tid+i*512,row=idx>>6,ch=idx&63,t=t0-(CONV_W-1)+row;
      v[i]=(u32x4){0u,0u,0u,0u};
      if(idx<CONV_ROWS*64&&t>=0)v[i]=*(const u32x4*)((const bf16*)(Tb+(size_t)(t>>8)*TILE_BYTES+T_U)+(size_t)(t&255)*CONV_C+ch*8);}
    #pragma unroll
    for(int i=0;i<8;++i){const int idx=tid+i*512; if(idx<CONV_ROWS*64)L[idx]=v[i];} }
  __syncthreads();
  float acc[4][8];
  { const f32x4_t b0=*(const f32x4_t*)(cbias+8*lane),b1=*(const f32x4_t*)(cbias+8*lane+4);
    #pragma unroll
    for(int tt=0;tt<4;++tt){acc[tt][0]=b0[0];acc[tt][1]=b0[1];acc[tt][2]=b0[2];acc[tt][3]=b0[3];acc[tt][4]=b1[0];acc[tt][5]=b1[1];acc[tt][6]=b1[2];acc[tt][7]=b1[3];} }
  #pragma unroll 4
  for(int j=0;j<CONV_W;++j){
    const f32x4_t w0=LW[j*128+2*lane],w1=LW[j*128+2*lane+1];
    #pragma unroll
    for(int tt=0;tt<4;++tt){
      const u32x4 u=L[(wid*4+tt+j)*64+lane];
      acc[tt][0]+=w0[0]*__uint_as_float(u[0]<<16); acc[tt][1]+=w0[1]*__uint_as_float(u[0]&0xffff0000u);
      acc[tt][2]+=w0[2]*__uint_as_float(u[1]<<16); acc[tt][3]+=w0[3]*__uint_as_float(u[1]&0xffff0000u);
      acc[tt][4]+=w1[0]*__uint_as_float(u[2]<<16); acc[tt][5]+=w1[1]*__uint_as_float(u[2]&0xffff0000u);
      acc[tt][6]+=w1[2]*__uint_as_float(u[3]<<16); acc[tt][7]+=w1[3]*__uint_as_float(u[3]&0xffff0000u);
    }
  }
  const f32x4_t g0=*(const f32x4_t*)(lng+8*lane),g1=*(const f32x4_t*)(lng+8*lane+4),e0=*(const f32x4_t*)(lnb+8*lane),e1=*(const f32x4_t*)(lnb+8*lane+4);
  const float gg[8]={g0[0],g0[1],g0[2],g0[3],g1[0],g1[1],g1[2],g1[3]},bb[8]={e0[0],e0[1],e0[2],e0[3],e1[0],e1[1],e1[2],e1[3]};
  float mu[4],rstd[4],r2[4];
  #pragma unroll
  for(int tt=0;tt<4;++tt){ float s=0.f;
    #pragma unroll
    for(int e=0;e<8;++e)s+=acc[tt][e];
    mu[tt]=s; }
  #pragma unroll
  for(int tt=0;tt<4;++tt)mu[tt]=wsum64(mu[tt])*(1.0f/CONV_C);
  #pragma unroll
  for(int tt=0;tt<4;++tt){ float q=0.f;
    #pragma unroll
    for(int e=0;e<8;++e){acc[tt][e]-=mu[tt];q+=acc[tt][e]*acc[tt][e];}
    rstd[tt]=q; }
  #pragma unroll
  for(int tt=0;tt<4;++tt)rstd[tt]=__builtin_amdgcn_rsqf(wsum64(rstd[tt])*(1.0f/CONV_C)+1e-6f);
  #pragma unroll
  for(int tt=0;tt<4;++tt){ float q2=0.f;
    #pragma unroll
    for(int e=0;e<8;++e){float y=acc[tt][e]*rstd[tt]*gg[e]+bb[e]; y=y*__builtin_amdgcn_rcpf(1.0f+__builtin_amdgcn_exp2f(-y*1.4426950408889634f)); acc[tt][e]=y;q2+=y*y;}
    r2[tt]=q2; }
  #pragma unroll
  for(int tt=0;tt<4;++tt)r2[tt]=__builtin_amdgcn_rsqf(wsum64(r2[tt])*(1.0f/CONV_C)+1e-6f);
  #pragma unroll
  for(int tt=0;tt<4;++tt){
    u32x4 w; const float r=r2[tt];
    w[0]=cvtpk_s(acc[tt][0]*r,acc[tt][1]*r);w[1]=cvtpk_s(acc[tt][2]*r,acc[tt][3]*r);w[2]=cvtpk_s(acc[tt][4]*r,acc[tt][5]*r);w[3]=cvtpk_s(acc[tt][6]*r,acc[tt][7]*r);
    { const int t=t0+wid*4+tt; *(u32x4*)((bf16*)(Tb+(size_t)(t>>8)*TILE_BYTES+T_Y)+(size_t)(t&255)*QP+CONV_C+8*lane)=w; }
  }
  __syncthreads();
}
}
constexpr int NWAVES = 8;
constexpr int M = 16384, DM = 1024, DFF = 2816, SEQ = 2048, NBATCH = 8, NMEMROWS = 2048, NLAYER = 2;
constexpr size_t MiB = 1u << 20;
constexpr size_t WS_CTL = 0, CTL_ZERO_BYTES = 256 * 1024;
constexpr size_t WS_W = 2 * MiB;
constexpr size_t W_LAYER = 97 * MiB / 2;
constexpr size_t WO_1A = 0, WO_1B = 11 * MiB, WO_IN = WO_1B + 11 * MiB / 2, WO_OUT = WO_IN + 11 * MiB / 2, WO_XQ = WO_OUT + 2 * MiB, WO_XKV = WO_XQ + 2 * MiB, WO_XO = WO_XKV + 4 * MiB,
                 WO_2A = WO_XO + 2 * MiB, WO_2B = WO_2A + 11 * MiB;
static_assert(WO_2B + 11 * MiB / 2 == W_LAYER, "weight map");
constexpr size_t WS_XB = 100 * MiB;
constexpr size_t WS_MKV = 132 * MiB;
constexpr size_t WS_MEMB = 148 * MiB;
constexpr size_t WS_R1 = 152 * MiB;
constexpr size_t DOUT_WQK = 0, DOUT_WVO = 2 * MiB, DOUT_BATCH = 8 * MiB;
constexpr size_t WS_SSP = 99 * MiB;
constexpr size_t WS_DUMMY = 248 * MiB, WS_SSA = 249 * MiB;
constexpr size_t WS_END = 250 * MiB;
constexpr int CW_BAR = 4096;
constexpr int CW_QUAD = 16384;
constexpr size_t CTL_SSM = 256 * 1024;
constexpr int RING_OFF = 0, RING_BYTES = 131072;
constexpr int EPI_SCR_OFF = RING_BYTES;
constexpr int LDSCTL_OFF = RING_BYTES + 8192, MISC_OFF = LDSCTL_OFF + 320;
constexpr int LDS_BYTES = 147456;
static_assert(MISC_OFF + 128 <= LDS_BYTES, "LDS map");

#define GAS __attribute__((address_space(1)))
#define LAS __attribute__((address_space(3)))
typedef unsigned short bf16;
typedef unsigned v4u __attribute__((ext_vector_type(4)));
typedef float f32x4 __attribute__((ext_vector_type(4)));
typedef GAS unsigned gu32;
#define RLX_AGENT __ATOMIC_RELAXED, __HIP_MEMORY_SCOPE_AGENT
#define LDS_WAIT() asm volatile("s_waitcnt lgkmcnt(0)" ::: "memory")
__device__ __forceinline__ unsigned f2bf(float f) { unsigned u = __builtin_bit_cast(unsigned, f); return (u + 0x7fffu + ((u >> 16) & 1u)) >> 16; }
__device__ __forceinline__ unsigned pk2(float lo, float hi) { return f2bf(lo) | (f2bf(hi) << 16); }

#define XB_TMO      128
#define XB_XCNT(j)  (256  + 64 * (j))
#define XB_XSUB(j)  (1280 + 64 * (j))
#define XB_XGEN(j)  (2304 + 64 * (j))
#define XB_TOP      3328
#define XB_TOPGEN   3392
#define XCD_BAR_WORDS 3456
#define XB_SPIN_CAP (1u << 18)
__device__ __forceinline__ unsigned xb_ld(unsigned* p)              { return __hip_atomic_load(p, __ATOMIC_RELAXED, __HIP_MEMORY_SCOPE_AGENT); }
__device__ __forceinline__ unsigned xb_add(unsigned* p, unsigned v) { return __hip_atomic_fetch_add(p, v, __ATOMIC_RELAXED, __HIP_MEMORY_SCOPE_AGENT); }
__device__ __forceinline__ unsigned xb_xcc_id() { return (unsigned)__builtin_amdgcn_s_getreg((3 << 11) | 20) & 0xFu; }
#define XB_SPIN(cond, bar) do { unsigned _sp = 0; while (cond) { __builtin_amdgcn_s_sleep(1); \
    if ((++_sp & 255u) == 0u) { if (xb_ld(&(bar)[XB_TMO])) break; if (_sp > XB_SPIN_CAP) { atomicAdd(&(bar)[XB_TMO], 1u); break; } } } } while (0)
struct XcdBarrier { unsigned* bar; unsigned x; volatile LAS unsigned* st; };
__device__ __forceinline__ XcdBarrier xcd_barrier_post(unsigned* bar, volatile LAS unsigned* st) {
    XcdBarrier b; b.bar = bar; b.x = xb_xcc_id(); b.st = st;
    if (threadIdx.x == 0) { const unsigned rank = xb_add(&bar[XB_XCNT(b.x)], 1u); st[2] = b.x; st[3] = rank; }
    return b;
}
__device__ __forceinline__ void xcd_barrier_complete(unsigned* bar, unsigned x, unsigned& nloc, unsigned& nx) {
    const unsigned G = gridDim.x * gridDim.y * gridDim.z;
    unsigned sum, cnt, mine, sp = 0u;
    for (;;) {
        sum = 0u; cnt = 0u; mine = 0u;
#pragma unroll
        for (unsigned j = 0; j < 16; ++j) { const unsigned c = xb_ld(&bar[XB_XCNT(j)]); sum += c; cnt += (c > 0u) ? 1u : 0u; mine = (j == x) ? c : mine; }
        if (sum == G) break;
        __builtin_amdgcn_s_sleep(1);
        if ((++sp & 255u) == 0u) { if (xb_ld(&bar[XB_TMO])) break; if (sp > XB_SPIN_CAP) { atomicAdd(&bar[XB_TMO], 1u); break; } }
    }
    nloc = mine > 0u ? mine : 1u; nx = cnt > 0u ? cnt : 1u;
}
__device__ __forceinline__ void xcd_barrier(const XcdBarrier& b) {
    asm volatile("s_waitcnt vmcnt(0)" ::: "memory");
    __syncthreads();
    if (threadIdx.x == 0) {
        unsigned* bar = b.bar;
        __builtin_amdgcn_s_waitcnt(0);
        unsigned nloc = b.st[0], nx = b.st[1];
        if (nloc == 0u) { xcd_barrier_complete(bar, b.x, nloc, nx); b.st[0] = nloc; b.st[1] = nx; }
        const unsigned old = xb_add(&bar[XB_XSUB(b.x)], 1u);
        const unsigned gen = old / nloc;
        if (old + 1u == (gen + 1u) * nloc) {
            __builtin_amdgcn_fence(__ATOMIC_RELEASE, "agent");
            asm volatile("s_waitcnt vmcnt(0)" ::: "memory");
            const unsigned og = xb_add(&bar[XB_TOP], 1u);
            const unsigned tg = og / nx;
            if (og + 1u == (tg + 1u) * nx) xb_add(&bar[XB_TOPGEN], 1u);
            else XB_SPIN(xb_ld(&bar[XB_TOPGEN]) == tg, bar);
            __builtin_amdgcn_fence(__ATOMIC_ACQUIRE, "agent");
            xb_add(&bar[XB_XGEN(b.x)], 1u);
            asm volatile("s_waitcnt vmcnt(0)" ::: "memory");
        } else {
            XB_SPIN(xb_ld(&bar[XB_XGEN(b.x)]) == gen, bar);
            __builtin_amdgcn_fence(__ATOMIC_ACQUIRE, "agent");
            asm volatile("s_waitcnt vmcnt(0)" ::: "memory");
        }
    }
    __syncthreads();
}

__device__ __forceinline__ void xcd_local_barrier(unsigned* bar, unsigned x) {
    asm volatile("s_waitcnt vmcnt(0)" ::: "memory");
    __syncthreads();
    if (threadIdx.x == 0) {
        __builtin_amdgcn_s_waitcnt(0);
        const unsigned old = xb_add(&bar[XB_XSUB(x)], 1u), gen = old / 32u;
        if (old + 1u == (gen + 1u) * 32u) xb_add(&bar[XB_XGEN(x)], 1u);
        else XB_SPIN(xb_ld(&bar[XB_XGEN(x)]) == gen, bar);
        __builtin_amdgcn_fence(__ATOMIC_ACQUIRE, "agent");
        asm volatile("s_waitcnt vmcnt(0)" ::: "memory");
    }
    __syncthreads();
}
__device__ __forceinline__ void quad_barrier(unsigned* bar, unsigned* qw) {
    asm volatile("s_waitcnt vmcnt(0)" ::: "memory");
    __syncthreads();
    if (threadIdx.x == 0) {
        __builtin_amdgcn_s_waitcnt(0);
        const unsigned old = xb_add(&qw[0], 1u), gen = old / 4u;
        if (old + 1u == (gen + 1u) * 4u) xb_add(&qw[64], 1u);
        else XB_SPIN(xb_ld(&qw[64]) == gen, bar);
        __builtin_amdgcn_fence(__ATOMIC_ACQUIRE, "agent");
        asm volatile("s_waitcnt vmcnt(0)" ::: "memory");
    }
    __syncthreads();
}

__device__ __forceinline__ float wave_sum(float v) { return wave_sum64(v); }
__device__ __forceinline__ void tr_item(const float* W, int ldw, int col0, int nvalid, int k0, const float* gain, int gsplit, const float* gain2, bf16* WT, int ldt, int drow0, LAS float* scr, int lane) {
#pragma unroll 8
    for (int i = 0; i < 32; ++i) { const int kk = 2 * i + (lane >> 5), n = lane & 31, k = k0 + kk;
        float v = (n < nvalid) ? W[(size_t)k * ldw + col0 + n] : 0.f;
        if (gain) v *= (k < gsplit ? gain[k] : gain2[k - gsplit]);
        scr[kk * 33 + n] = v; }
    LDS_WAIT(); asm volatile("" ::: "memory");
    const int c = lane & 7;
#pragma unroll
    for (int j = 0; j < 4; ++j) { const int n = (lane >> 3) + 8 * j; const LAS float* s = scr + (8 * c) * 33 + n;
        v4u o; o.x = pk2(s[0 * 33], s[1 * 33]); o.y = pk2(s[2 * 33], s[3 * 33]); o.z = pk2(s[4 * 33], s[5 * 33]); o.w = pk2(s[6 * 33], s[7 * 33]);
        *(GAS v4u*)(WT + (size_t)(drow0 + n) * ldt + k0 + 8 * c) = o; }
    LDS_WAIT(); asm volatile("" ::: "memory");
}
__device__ __forceinline__ void tr_item64(const float* W, int ldw, int col0, int nvalid, int k0, const float* gain, int gsplit, const float* gain2, bf16* WT, int ldt, int drow0, int lane) {
    float v[64];
    const float* src = W + (size_t)k0 * ldw + col0 + lane; const bool ok = lane < nvalid;
#pragma unroll
    for (int j = 0; j < 64; ++j) v[j] = ok ? src[(size_t)j * ldw] : 0.f;
    if (gain) {
#pragma unroll
        for (int j = 0; j < 64; ++j) { const int k = k0 + j; v[j] *= (k < gsplit ? gain[k] : gain2[k - gsplit]); }
    }
    bf16* dst = WT + (size_t)(drow0 + lane) * ldt + k0;
#pragma unroll
    for (int c = 0; c < 8; ++c) { v4u o; o.x = pk2(v[8 * c], v[8 * c + 1]); o.y = pk2(v[8 * c + 2], v[8 * c + 3]); o.z = pk2(v[8 * c + 4], v[8 * c + 5]); o.w = pk2(v[8 * c + 6], v[8 * c + 7]);
        *(GAS v4u*)(dst + 8 * c) = o; }
}
__device__ __forceinline__ void row_to_bf16(const float* xrow, bf16* orow, float* ssp, int lane) {
    const GAS f32x4* xr = (const GAS f32x4*)xrow + lane;
    f32x4 v[4]; float s = 0.f;
#pragma unroll
    for (int j = 0; j < 4; ++j) { v[j] = xr[64 * j]; s += (v[j].x * v[j].x + v[j].y * v[j].y) + (v[j].z * v[j].z + v[j].w * v[j].w); }
    s = wave_sum(s);
    GAS unsigned long long* o8 = (GAS unsigned long long*)orow + lane;
#pragma unroll
    for (int j = 0; j < 4; ++j) o8[64 * j] = (unsigned long long)pk2(v[j].x, v[j].y) | ((unsigned long long)pk2(v[j].z, v[j].w) << 32);
    if (lane == 0) *ssp = s;
}

struct Args { const float* in[26]; float* out; unsigned char* ws; };

enum { PH_PRO = 0, PH_L0 = 1, PH_PER_LAYER = 9, PH_FINAL = PH_L0 + 2 * PH_PER_LAYER, PH_COUNT = PH_FINAL + 1 };

#define WSP() ({ unsigned char* w_ = args.ws; asm volatile("" : "+s"(w_)); w_; })
#define INP(i) ({ int i_ = __builtin_amdgcn_readfirstlane(i); asm volatile("" : "+s"(i_)); args.in[i_]; })
#define XPTR() ({ float* x_ = args.out; asm volatile("" : "+s"(x_)); x_; })
#define TID() ({ int w_ = wid_s; asm volatile("" : "+s"(w_)); int t_ = (w_ << 6) | (int)__builtin_amdgcn_mbcnt_hi(~0u, __builtin_amdgcn_mbcnt_lo(~0u, 0u)); asm volatile("" : "+v"(t_)); t_; })

constexpr size_t T1K = (size_t)256 * 1024 * 2, TFF = (size_t)256 * 2816 * 2, TLB = pg8::TILE_BYTES;
using G_1024 = pg8::Gemm<1024, 1024, 1024>; using G_down = pg8::Gemm<2816, 2816, 2816>; using G_qk = pg8::Gemm<2048, 1024, 256>; using G_vo = pg8::Gemm<1024, 2048, 256>;
using S_up = pg8::SchedT<0, 64, 22, T1K, T1K>; using S_mkv = pg8::SchedT<4, 8, 8, T1K, T1K>; using S_down = pg8::SchedT<0, 64, 4, TLB, TFF>; using S_win = pg8::SchedT<0, 64, 11, T1K, T1K>;
using S_wout = pg8::SchedT<0, 64, 4, TLB, T1K>; using S_xs = pg8::SchedT<1, 64, 4, T1K, T1K, DOUT_BATCH>; using S_xpv = pg8::SchedT<1, 64, 4, TLB, T1K, DOUT_BATCH>;
using S_qk = pg8::SchedT<2, 128, 1, 0, 0>; using S_vo = pg8::SchedT<3, 128, 1, 0, 0>;

#ifndef PROBE_MASK
#define PROBE_MASK 0
#endif
#ifndef PROBE_REPS
#define PROBE_REPS 1
#endif
#ifndef PROBE_BARS
#define PROBE_BARS 0
#endif
#ifndef PROBE_NOATT
#define PROBE_NOATT 0
#endif
#ifndef PROBE_NOCONV
#define PROBE_NOCONV 0
#endif
#ifndef FORCE_GLOBAL
#define FORCE_GLOBAL 0
#endif
#define NREP(k) (((PROBE_MASK >> (k)) & 1) ? (PROBE_REPS + 1) : 1)
#define REP_LOOP(k) _Pragma("unroll 1") for (int rep_ = 0; rep_ < NREP(k); ++rep_)
#define SHADOW(k) (NREP(k) > 1 && rep_ + 1 < NREP(k))
#define REP_SEAM(k) do { if (SHADOW(k)) GRIDBAR(); } while (0)

#define WSP() ({ unsigned char* w_ = args.ws; asm volatile("" : "+s"(w_)); w_; })
#define INP(i) ({ int i_ = __builtin_amdgcn_readfirstlane(i); asm volatile("" : "+s"(i_)); args.in[i_]; })
#define XPTR() ({ float* x_ = args.out; asm volatile("" : "+s"(x_)); x_; })
#define TID() ({ int w_ = wid_s; asm volatile("" : "+s"(w_)); int t_ = (w_ << 6) | (int)__builtin_amdgcn_mbcnt_hi(~0u, __builtin_amdgcn_mbcnt_lo(~0u, 0u)); asm volatile("" : "+v"(t_)); t_; })
#define MISCW(k) (*({ unsigned o_ = MISC_OFF + 4 * (k); asm volatile("" : "+s"(o_)); (volatile LAS unsigned*)(ldsp + o_); }))
#define BXP() ((int)__builtin_amdgcn_readfirstlane((int)MISCW(13)))
#define BARW() ((unsigned*)(WSP() + WS_CTL) + CW_BAR)
#define GRIDBAR() do { XcdBarrier bar_; bar_.bar = BARW(); bar_.x = xb_xcc_id(); bar_.st = &MISCW(8); xcd_barrier(bar_); } while (0)
#define XCDBAR() do { if (MISCW(12)) xcd_local_barrier(BARW(), MISCW(10)); else GRIDBAR(); } while (0)
#define QUADBAR() do { if (MISCW(12)) { unsigned* bw_ = BARW(); quad_barrier(bw_, bw_ - CW_BAR + CW_QUAD + 128 * (MISCW(10) * 8 + (MISCW(11) & 7))); } else GRIDBAR(); } while (0)

__global__ void __launch_bounds__(NWAVES * 64, 2) mega_fwd(Args args) {
    extern __shared__ __attribute__((aligned(16))) unsigned char lds[];
    LAS unsigned char* ldsp = (LAS unsigned char*)lds;
    volatile LAS unsigned* MISC = (volatile LAS unsigned*)(ldsp + MISC_OFF);
    constexpr int G = 256; const int bx = blockIdx.x;
    const int wid_s = __builtin_amdgcn_readfirstlane(threadIdx.x >> 6);
    for (int u = threadIdx.x; u < (LDS_BYTES - LDSCTL_OFF) / 4; u += NWAVES * 64) ((LAS unsigned*)(ldsp + LDSCTL_OFF))[u] = 0u;
    __syncthreads();
    (void)xcd_barrier_post((unsigned*)(args.ws + WS_CTL) + CW_BAR, MISC + 8);
    constexpr float QSCALE = 0.125f * 1.4426950408889634f, XSCALE = 0.0625f * 1.4426950408889634f;

    REP_LOOP(9) {
        unsigned char* ws = WSP(); const int tid = TID();
        const int lane = tid & 63, wave = __builtin_amdgcn_readfirstlane(tid >> 6);
        const int gw = bx * NWAVES + wave, NGW = G * NWAVES;
        constexpr int I_GU = 2 * 16 * 44, I_DN = 44 * 16, I_IN = 16 * 41, I_SQ = 16 * 16, I_KV = 16 * 32, I_WQ = 256;
        constexpr int L_ITEMS = 2 * (I_GU + I_DN) + I_IN + I_SQ + I_KV + I_SQ + I_WQ, W_ITEMS = NLAYER * L_ITEMS, X_ITEMS = M / 4, MEM_ITEMS = NMEMROWS / 4;
#pragma unroll 1
        for (int it = gw; it < W_ITEMS + X_ITEMS + MEM_ITEMS; it += NGW) {
            if (it < W_ITEMS) {
                const int l = it / L_ITEMS; int r = it % L_ITEMS;
                unsigned char* wl = ws + WS_W + (size_t)l * W_LAYER;
                if (r < 2 * (I_GU + I_DN)) {
                    const int f = r / (I_GU + I_DN); r %= (I_GU + I_DN);
                    if (r < I_GU) { const int which = r / (16 * 44), q = r % (16 * 44), kb = q / 44, nb = q % 44, j0 = nb * 64;
                        const float* w = INP(which ? (f ? 23 : 4) : (f ? 22 : 3)) + (size_t)l * DM * DFF; const float* gn = INP(f ? 21 : 2) + l * DM;
                        tr_item64(w, DFF, j0, 64, kb * 64, gn, 1 << 30, gn, (bf16*)(wl + (f ? WO_2A : WO_1A)), DM, 256 * (j0 / 128) + which * 128 + (j0 % 128), lane); }
                    else { r -= I_GU; const int kb = r / 16, nb = r % 16; const float* w = INP(f ? 24 : 5) + (size_t)l * DFF * DM;
                        tr_item64(w, DM, nb * 64, 64, kb * 64, nullptr, 0, w, (bf16*)(wl + (f ? WO_2B : WO_1B)), DFF, nb * 64, lane); }
                    continue;
                }
                r -= 2 * (I_GU + I_DN);
                if (r < I_IN) {
                    const int kb = r / 41, nb = r % 41; int col0, nvalid = 64, drow0;
                    if (nb < 24) { col0 = nb * 64; drow0 = col0; }
                    else if (nb == 24) { col0 = 1536; nvalid = 8; drow0 = 2560; }
                    else if (nb < 33) { const int ch = (nb - 25) * 64; col0 = 1544 + ch; drow0 = 1536 + 256 * (ch / 128) + (ch % 128); }
                    else { const int ch = (nb - 33) * 64; col0 = 2056 + ch; drow0 = 1536 + 256 * (ch / 128) + 128 + (ch % 128); }
                    const float* w = INP(7) + (size_t)l * DM * 2568; const float* gn = INP(6) + l * DM;
                    tr_item64(w, 2568, col0, nvalid, kb * 64, gn, 1 << 30, gn, (bf16*)(wl + WO_IN), DM, drow0, lane); continue; }
                r -= I_IN;
                if (r < I_SQ) { const int kb = r / 16, nb = r % 16; const float* w = INP(15) + (size_t)l * DM * DM;
                    tr_item64(w, DM, nb * 64, 64, kb * 64, INP(13) + l * 512, 512, INP(14) + l * 512, (bf16*)(wl + WO_OUT), DM, nb * 64, lane); continue; }
                r -= I_SQ;
                if (r < I_KV) { const int kb = r / 32, nb = r % 32; const float* w = INP(19) + (size_t)l * DM * 2048; const float* gn = INP(17) + l * DM;
                    tr_item64(w, 2048, nb * 64, 64, kb * 64, gn, 1 << 30, gn, (bf16*)(wl + WO_XKV), DM, nb * 64, lane); continue; }
                r -= I_KV;
                if (r < I_SQ) { const int kb = r / 16, nb = r % 16; const float* w = INP(20) + (size_t)l * DM * DM;
                    tr_item64(w, DM, nb * 64, 64, kb * 64, nullptr, 0, w, (bf16*)(wl + WO_XO), DM, nb * 64, lane); continue; }
                r -= I_SQ;
                { const float* w = INP(18) + (size_t)l * DM * DM; const float* gn = INP(16) + l * DM; bf16* WQ = (bf16*)(wl + WO_XQ);
                  f32x4 v[4][4];
#pragma unroll
                  for (int q = 0; q < 4; ++q)
#pragma unroll
                      for (int j = 0; j < 4; ++j) v[q][j] = *((const GAS f32x4*)(w + (size_t)(4 * r + q) * DM) + lane + 64 * j);
#pragma unroll
                  for (int q = 0; q < 4; ++q) { const float g = gn[4 * r + q] * XSCALE; GAS unsigned long long* o8 = (GAS unsigned long long*)(WQ + (size_t)(4 * r + q) * DM) + lane;
#pragma unroll
                      for (int j = 0; j < 4; ++j) { const f32x4 t = v[q][j] * g; o8[64 * j] = (unsigned long long)pk2(t.x, t.y) | ((unsigned long long)pk2(t.z, t.w) << 32); } } }
            } else {
                int r = it - W_ITEMS; const bool ismem = r >= X_ITEMS; if (ismem) r -= X_ITEMS;
                const float* src = INP(ismem ? 1 : 0) + (size_t)(4 * r) * DM; bf16* dst = (bf16*)(ws + (ismem ? WS_MEMB : WS_XB)) + (size_t)(4 * r) * DM; float* ssp = ismem ? (float*)(ws + CTL_SSM) + 4 * r : (float*)(ws + WS_SSP) + (size_t)(4 * r) * 16;
                f32x4 v[4][4]; float s[4];
#pragma unroll
                for (int q = 0; q < 4; ++q)
#pragma unroll
                    for (int j = 0; j < 4; ++j) v[q][j] = *((const GAS f32x4*)(src + (size_t)q * DM) + lane + 64 * j);
#pragma unroll
                for (int q = 0; q < 4; ++q) { s[q] = 0.f;
#pragma unroll
                    for (int j = 0; j < 4; ++j) s[q] += (v[q][j].x * v[q][j].x + v[q][j].y * v[q][j].y) + (v[q][j].z * v[q][j].z + v[q][j].w * v[q][j].w); }
#pragma unroll
                for (int q = 0; q < 4; ++q) { s[q] = wave_sum64(s[q]); GAS unsigned long long* o8 = (GAS unsigned long long*)(dst + (size_t)q * DM) + lane;
#pragma unroll
                    for (int j = 0; j < 4; ++j) o8[64 * j] = (unsigned long long)pk2(v[q][j].x, v[q][j].y) | ((unsigned long long)pk2(v[q][j].z, v[q][j].w) << 32);
                    if (ismem) { if (lane == 0) ssp[q] = s[q]; } else if (lane < 16) ssp[q * 16 + lane] = (lane == 0) ? s[q] : 0.f; }
            }
        }
        REP_SEAM(9);
    }
    GRIDBAR();
    if (threadIdx.x == 0) {
        unsigned* bw = BARW(); bool ok = !FORCE_GLOBAL;
        for (int j = 0; j < 16; ++j) ok = ok && (xb_ld(&bw[XB_XCNT(j)]) == (j < 8 ? 32u : 0u));
        MISCW(12) = ok ? 1u : 0u; MISCW(13) = ok ? (MISCW(11) * 8u + MISCW(10)) : (unsigned)bx;
    }
    __syncthreads();

#pragma unroll 1
    for (int l = 0; l < NLAYER; ++l) {
#pragma unroll 1
        for (int f = 0; f < 2; ++f) {
            REP_LOOP(0) {
                unsigned char* ws = WSP(); unsigned char* wl = ws + WS_W + (size_t)l * W_LAYER; const int bxp = BXP();
                G_1024 g; S_up S; S.init(bxp, ws + WS_XB, wl + (f ? WO_2A : WO_1A));
                pg8::EpiSwiGLU E{(bf16*)(ws + WS_R1), (float*)(ws + WS_SSP)};
                pg8::gemm_phase<pg8::EpiSwiGLU, decltype(S), decltype(g)>(ldsp + RING_OFF, g, S, E, TID());
                if (l == 0 && f == 0) {
#pragma unroll 1
                    for (int l2 = 0; l2 < NLAYER; ++l2) {
                        unsigned char* ws2 = WSP();
                        S_mkv S2; S2.init(bxp - 128 - 64 * l2, ws2 + WS_MEMB, ws2 + WS_W + (size_t)l2 * W_LAYER + WO_XKV);
                        pg8::EpiRowScale E2{(bf16*)(ws2 + WS_MKV) + (size_t)l2 * 2048 * 2048, (float*)(ws2 + CTL_SSM), 1.0f};
                        pg8::gemm_phase<pg8::EpiRowScale, decltype(S2), decltype(g)>(ldsp + RING_OFF, g, S2, E2, TID());
                    }
                }
                REP_SEAM(0);
            }
            QUADBAR();
            REP_LOOP(1) {
                unsigned char* ws = WSP(); unsigned char* wl = ws + WS_W + (size_t)l * W_LAYER;
                G_down g; S_down S; S.init(BXP(), ws + WS_R1, wl + (f ? WO_2B : WO_1B));
                pg8::EpiResid<0> E{(l == 0 && f == 0) ? INP(0) : (const float*)nullptr, nullptr, (bf16*)(ws + WS_XB), SHADOW(1) ? (float*)(ws + WS_DUMMY) : (float*)(ws + WS_SSP), nullptr, SHADOW(1) ? 0.f : 0.5f};
                E.shadow_skip = SHADOW(1);
                pg8::gemm_phase<pg8::EpiResid<0>, decltype(S), decltype(g)>(ldsp + RING_OFF, g, S, E, TID());
                REP_SEAM(1);
            }
            if (f == 1) break;
            QUADBAR();
            REP_LOOP(2) {
                unsigned char* ws = WSP(); unsigned char* wl = ws + WS_W + (size_t)l * W_LAYER;
                G_1024 g; S_win S; S.init(BXP(), ws + WS_XB, wl + WO_IN);
                pg8::EpiWin E{ws + WS_R1, (float*)(ws + WS_SSP), INP(8) + l * 8, QSCALE};
                pg8::gemm_phase<pg8::EpiWin, decltype(S), decltype(g)>(ldsp + RING_OFF, g, S, E, TID());
                REP_SEAM(2);
            }
            XCDBAR();
            REP_LOOP(3) {
                unsigned char* ws = WSP(); unsigned char* R1 = ws + WS_R1; const int bxp = BXP();
                char* shm = (char*)lds + RING_OFF;
                const int vcu = (bxp & 7) * 32 + (bxp >> 3);
                const int bh = vcu >> 2, s4 = vcu & 3;
                float* ssa = SHADOW(3) ? (float*)(ws + WS_DUMMY) : (float*)(ws + WS_SSA);
                if (!(SHADOW(3) && PROBE_NOATT)) {
                attn_body::scan_bias(R1, bh >> 3, bh & 7, shm, TID());
#pragma unroll 1
                for (int iu = 0; iu < 2; ++iu) attn_body::attn_unit<60>(bh >> 3, bh & 7, iu ? 7 - s4 : s4, R1, SHADOW(3) ? 512 : 0, ssa, shm, TID());
                __syncthreads();
                }
                if (!(SHADOW(3) && PROBE_NOCONV)) {
                    attn_body::conv_stage_w(INP(9) + (size_t)l * 31 * 512, shm, TID());
#pragma unroll 1
                    for (int iu = 0; iu < 2; ++iu) attn_body::conv_unit(2 * vcu + iu, R1, INP(10) + l * 512, INP(11) + l * 512, INP(12) + l * 512, shm, TID());
                }
                { unsigned char* ws2 = WSP(); unsigned char* wl = ws2 + WS_W + (size_t)l * W_LAYER;
                  G_qk g; S_qk S; S.init(bxp, (bf16*)(ws2 + WS_MKV) + (size_t)l * 2048 * 2048, wl + WO_XQ);
                  pg8::EpiAux E{(bf16*)((unsigned char*)XPTR() + DOUT_WQK), 1.0f};
                  pg8::gemm_phase<pg8::EpiAux, decltype(S), decltype(g)>(ldsp + RING_OFF, g, S, E, TID()); }
                { unsigned char* ws2 = WSP(); unsigned char* wl = ws2 + WS_W + (size_t)l * W_LAYER;
                  G_vo g; S_vo S; S.init(bxp - 128, wl + WO_XO, (bf16*)(ws2 + WS_MKV) + (size_t)l * 2048 * 2048);
                  pg8::EpiAux E{(bf16*)((unsigned char*)XPTR() + DOUT_WVO), 1.0f};
                  pg8::gemm_phase<pg8::EpiAux, decltype(S), decltype(g)>(ldsp + RING_OFF, g, S, E, TID()); }
                REP_SEAM(3);
            }
            XCDBAR();
            REP_LOOP(4) {
                unsigned char* ws = WSP(); unsigned char* wl = ws + WS_W + (size_t)l * W_LAYER;
                G_1024 g; S_wout S; S.init(BXP(), ws + WS_R1 + pg8::T_Y, wl + WO_OUT);
                pg8::EpiResid<8> E{nullptr, nullptr, (bf16*)(ws + WS_XB), SHADOW(4) ? (float*)(ws + WS_DUMMY) : (float*)(ws + WS_SSP), (float*)(ws + WS_SSA), SHADOW(4) ? 0.f : 1.0f};
                pg8::gemm_phase<pg8::EpiResid<8>, decltype(S), decltype(g)>(ldsp + RING_OFF, g, S, E, TID());
                REP_SEAM(4);
            }
            QUADBAR();
            REP_LOOP(5) {
                unsigned char* ws = WSP();
                G_1024 g; S_xs S; S.init(BXP(), ws + WS_XB, (unsigned char*)XPTR() + DOUT_WQK);
                pg8::EpiSoftmax E{ws + WS_R1, (float*)(ws + WS_SSP), (LAS float*)(ldsp + EPI_SCR_OFF)};
                E.shadow_skip = SHADOW(5);
                pg8::gemm_phase<pg8::EpiSoftmax, decltype(S), decltype(g)>(ldsp + RING_OFF, g, S, E, TID());
                REP_SEAM(5);
            }
            QUADBAR();
            REP_LOOP(6) {
                unsigned char* ws = WSP();
                G_1024 g; S_xpv S; S.init(BXP(), ws + WS_R1 + pg8::T_Y, (unsigned char*)XPTR() + DOUT_WVO);
                pg8::EpiResid<0> E{nullptr, nullptr, (bf16*)(ws + WS_XB), SHADOW(6) ? (float*)(ws + WS_DUMMY) : (float*)(ws + WS_SSP), nullptr, SHADOW(6) ? 0.f : 1.0f};
                E.shadow_skip = SHADOW(6);
                pg8::gemm_phase<pg8::EpiResid<0>, decltype(S), decltype(g)>(ldsp + RING_OFF, g, S, E, TID());
                REP_SEAM(6);
            }
            QUADBAR();
        }
        if (l + 1 < NLAYER) QUADBAR();
    }
    XCDBAR();
    for (int eb_ = 0; eb_ < PROBE_BARS; ++eb_) GRIDBAR();
    {
        unsigned char* ws = WSP(); float* X = XPTR(); const int tid = TID(); const int bxp = BXP();
        const int lane = tid & 63, wave = __builtin_amdgcn_readfirstlane(tid >> 6);
        const int row0 = (8 * (bxp & 7) + ((bxp >> 3) & 7)) * 256 + (bxp >> 6) * 64 + wave * 8;
        const float* ssf = (float*)(ws + WS_SSP); const float* gn = INP(25); const bf16* XB = (const bf16*)(ws + WS_XB);
        f32x4 gv[4];
#pragma unroll
        for (int j = 0; j < 4; ++j) gv[j] = *((const GAS f32x4*)gn + lane + 64 * j);
#pragma unroll 2
        for (int r = 0; r < 8; ++r) { const int m = row0 + r; const float rs = pg8::rs_row(ssf, m);
            const GAS unsigned long long* xr = (const GAS unsigned long long*)(XB + (size_t)m * DM) + lane; GAS f32x4* orow = (GAS f32x4*)(X + (size_t)m * DM) + lane;
#pragma unroll
            for (int j = 0; j < 4; ++j) { const unsigned long long w = xr[64 * j]; const unsigned lo = (unsigned)w, hi = (unsigned)(w >> 32);
                f32x4 v = (f32x4){__uint_as_float(lo << 16), __uint_as_float(lo & 0xffff0000u), __uint_as_float(hi << 16), __uint_as_float(hi & 0xffff0000u)};
                orow[64 * j] = v * rs * gv[j]; } }
    }
}

static int g_grid = 0;
static bool mega_setup() {
    if (g_grid) return g_grid > 0;
    int dev = 0, cus = 0, per_cu = 0;
    if (hipGetDevice(&dev) != hipSuccess || hipDeviceGetAttribute(&cus, hipDeviceAttributeMultiprocessorCount, dev) != hipSuccess) { g_grid = -1; return false; }
    if (hipFuncSetAttribute((const void*)mega_fwd, hipFuncAttributeMaxDynamicSharedMemorySize, LDS_BYTES) != hipSuccess) { fprintf(stderr, "hipFuncSetAttribute failed\n"); g_grid = -1; return false; }
    if (hipOccupancyMaxActiveBlocksPerMultiprocessor(&per_cu, (const void*)mega_fwd, NWAVES * 64, LDS_BYTES) != hipSuccess || per_cu < 1) { fprintf(stderr, "occupancy query: %d blocks per CU\n", per_cu); (void)hipGetLastError(); g_grid = -1; return false; }
    g_grid = cus;
    if (g_grid != 256) { fprintf(stderr, "kernel_launch: %d CUs; the phase program is laid out for exactly 256: nothing launched\n", g_grid); g_grid = -1; return false; }
    return true;
}
static void mega_launch(void* const* d_in, void* d_out, void* d_ws, hipStream_t stream) {
    Args a{};
    for (int i = 0; i < 26; ++i) a.in[i] = (const float*)d_in[i];
    a.out = (float*)d_out; a.ws = (unsigned char*)d_ws;
    hipLaunchKernelGGL(mega_fwd, dim3(g_grid), dim3(NWAVES * 64), LDS_BYTES, stream, a);
}
extern "C" void kernel_launch(void* const* d_in, const int* in_sizes, int n_in, void* d_out, int out_size, void* d_ws, size_t ws_size, hipStream_t stream) {
    if (!mega_setup()) return;
    if (ws_size < WS_END) { fprintf(stderr, "kernel_launch: workspace too small (%zu < %zu)\n", ws_size, (size_t)WS_END); return; }
    (void)hipMemsetAsync((char*)d_ws + WS_CTL, 0, CTL_ZERO_BYTES, stream);
    mega_launch(d_in, d_out, d_ws, stream);
}
```

```cpp
#include <hip/hip_runtime.h>
#include <cstdio>
#include <cstdint>
template <int X> __device__ __forceinline__ float swz_xor(float v) { return __int_as_float(__builtin_amdgcn_ds_swizzle(__float_as_int(v), (X << 10) | 0x1f)); }
__device__ __forceinline__ float sum_x32(float v) { auto rr = __builtin_amdgcn_permlane32_swap(__float_as_uint(v), __float_as_uint(v), false, false); return __uint_as_float(rr[0]) + __uint_as_float(rr[1]); }
__device__ __forceinline__ float max_x32(float v) { auto rr = __builtin_amdgcn_permlane32_swap(__float_as_uint(v), __float_as_uint(v), false, false); return fmaxf(__uint_as_float(rr[0]), __uint_as_float(rr[1])); }
__device__ __forceinline__ float wave_sum64(float v) { v += swz_xor<1>(v); v += swz_xor<2>(v); v += swz_xor<4>(v); v += swz_xor<8>(v); v += swz_xor<16>(v); return sum_x32(v); }
namespace pg8 {
#define PG8_LAS __attribute__((address_space(3)))
typedef unsigned short bf16_t;
typedef short bf16x8 __attribute__((ext_vector_type(8)));
typedef float f32x4 __attribute__((ext_vector_type(4)));
typedef float f32x2 __attribute__((ext_vector_type(2)));
typedef unsigned u32x4 __attribute__((ext_vector_type(4)));
constexpr int BM = 256, BK = 64, HALF = 128, HTB = HALF * BK * 2  , STAGE_BYTES = 8 * HTB, NXCD = 8, WGM = 8;

__host__ __device__ __forceinline__ int lds_byte(int r, int c) { const int st = (r >> 4) * 2 + (c >> 5), rr = r & 15, cc = c & 31, ob = rr * 64 + cc * 2; return st * 1024 + (ob ^ (((ob >> 9) & 1) << 5)); }
__host__ __device__ __forceinline__ void stage_rc(int b, int& R, int& C) { const int st = b / 1024, sb = b % 1024, swz = sb ^ (((sb >> 9) & 1) << 5); R = (st >> 1) * 16 + swz / 64; C = (st & 1) * 32 + (swz % 64) / 2; }
__host__ __device__ __forceinline__ int perm32(int rho) { const int n = rho >> 4, i = rho & 15; return 8 * (i >> 2) + 4 * n + (i & 3); }

struct Unit { int pm, pn; const char* a; const char* b; int aux; };
template <int LDA, int LDB, int K_> struct Gemm { static constexpr int lda = LDA, ldb = LDB, K = K_; };

__device__ __forceinline__ unsigned cvt_pk_bf16(float lo, float hi) { unsigned r; asm volatile("v_cvt_pk_bf16_f32 %0, %1, %2" : "=v"(r) : "v"(lo), "v"(hi)); return r; }


template <class Epi, class Sched, class Gemm, bool ALIGN_EPI = true, bool SP2 = true>
__device__ __forceinline__ void gemm_phase(PG8_LAS unsigned char* lds, const Gemm g, const Sched& S, const Epi& E, const int tid) {
    const int wid = __builtin_amdgcn_readfirstlane(tid >> 6), lane = tid & 63, wr = wid >> 2, wc = wid & 3, fr = lane & 15, fq = lane >> 4;
    constexpr int K = Gemm::K, nt = K / BK;
    unsigned voffA[2], voffB[2];
#pragma unroll
    for (int i = 0; i < 2; ++i) { int R, C; stage_rc(tid * 16 + i * 8192, R, C); const int Rb = Epi::PERM ? ((R & ~31) + perm32(R & 31)) : R;
        voffA[i] = (unsigned)(R * Gemm::lda + C) * 2u; voffB[i] = (unsigned)(Rb * Gemm::ldb + C) * 2u; }
    constexpr size_t kstep = (size_t)(BK * 2);
    constexpr size_t hstepA = (size_t)HALF * Gemm::lda * 2, hstepB = (size_t)HALF * Gemm::ldb * 2;
    const unsigned ldsw = (unsigned)wid * 1024u;
    const int aoff = lds_byte(wr * 64 + fr, fq * 8), boff = lds_byte(wc * 32 + fr, fq * 8);
#define PG8_SA(b, h) (((b) * 2 + (h)) * HTB)
#define PG8_SB(b, h) ((4 + (b) * 2 + (h)) * HTB)
#define PG8_STAGE(bufoff, gbase, voff) do { _Pragma("unroll") for (int _i = 0; _i < 2; ++_i) \
        __builtin_amdgcn_global_load_lds((const unsigned*)((const char*)(gbase) + (voff)[_i]), (PG8_LAS unsigned*)(lds + (bufoff) + ldsw + _i * 8192), 16, 0, 0); } while (0)
#define PG8_LDA(dst, b, h) do { _Pragma("unroll") for (int m = 0; m < 4; ++m) _Pragma("unroll") for (int k = 0; k < 2; ++k) dst[m][k] = *(const PG8_LAS bf16x8*)(lds + PG8_SA(b, h) + aoff + m * 2048 + k * 1024); } while (0)
#define PG8_LDB(dst, b, h) do { _Pragma("unroll") for (int n = 0; n < 2; ++n) _Pragma("unroll") for (int k = 0; k < 2; ++k) dst[n][k] = *(const PG8_LAS bf16x8*)(lds + PG8_SB(b, h) + boff + n * 2048 + k * 1024); } while (0)
#define PG8_MMA(ai, bj, At, Bt) do { __builtin_amdgcn_s_setprio(1); _Pragma("unroll") for (int m = 0; m < 4; ++m) _Pragma("unroll") for (int n = 0; n < 2; ++n) _Pragma("unroll") for (int k = 0; k < 2; ++k) \
        acc[ai][bj][m][n] = __builtin_amdgcn_mfma_f32_16x16x32_bf16(Bt[n][k], At[m][k], acc[ai][bj][m][n], 0, 0, 0); __builtin_amdgcn_s_setprio(0); } while (0)
#define PG8_WAIT_V(n) asm volatile("s_waitcnt vmcnt(" #n ")" ::: "memory")
#define PG8_WAIT_L(n) asm volatile("s_waitcnt lgkmcnt(" #n ")" ::: "memory")
#define PG8_BAR __builtin_amdgcn_s_barrier()
#define PG8_SCHED __builtin_amdgcn_sched_barrier(0)
    Unit cur, nxt; int ui = 0;
    if (!S.next(0, cur)) return;
    f32x4 acc[2][2][4][2];
#pragma unroll
    for (int a = 0; a < 2; ++a)
#pragma unroll
        for (int b = 0; b < 2; ++b)
#pragma unroll
            for (int m = 0; m < 4; ++m)
#pragma unroll
                for (int n = 0; n < 2; ++n) acc[a][b][m][n] = (f32x4){0.f, 0.f, 0.f, 0.f};
    bf16x8 At[4][2], B0[2][2], B1[2][2];
    const char* cA = cur.a; const char* cB = cur.b;
    if constexpr (SP2) {
        PG8_STAGE(PG8_SB(0, 0), cB, voffB); PG8_STAGE(PG8_SB(0, 1), cB + hstepB, voffB); PG8_STAGE(PG8_SA(0, 0), cA, voffA); PG8_STAGE(PG8_SA(0, 1), cA + hstepA, voffA);
        if (wr == 1) PG8_BAR;
        PG8_WAIT_V(2); PG8_BAR;
        PG8_STAGE(PG8_SB(1, 0), cB + kstep, voffB); PG8_STAGE(PG8_SA(1, 0), cA + kstep, voffA); PG8_STAGE(PG8_SB(1, 1), cB + hstepB + kstep, voffB);
        PG8_WAIT_V(6); PG8_BAR;
    } else {
        PG8_STAGE(PG8_SB(0, 0), cB, voffB); PG8_STAGE(PG8_SA(0, 0), cA, voffA); PG8_STAGE(PG8_SB(0, 1), cB + hstepB, voffB); PG8_STAGE(PG8_SA(0, 1), cA + hstepA, voffA);
        if (wr == 1) PG8_BAR;
        PG8_WAIT_V(4); PG8_BAR;
        PG8_STAGE(PG8_SB(1, 0), cB + kstep, voffB); PG8_STAGE(PG8_SA(1, 0), cA + kstep, voffA); PG8_STAGE(PG8_SB(1, 1), cB + hstepB + kstep, voffB);
        PG8_WAIT_V(6); PG8_BAR;
    }
    for (;;) {
        const bool has_next = S.next(ui + 1, nxt);
        const char* nA = has_next ? nxt.a : cA; const char* nB = has_next ? nxt.b : cB;
#pragma unroll 1
        for (int t = 0; t < nt; t += 2) {
            const bool last = (t == nt - 2);
            const char* a1 = cA + (size_t)(t + 1) * kstep;
            const char* a2 = last ? nA : cA + (size_t)(t + 2) * kstep; const char* b2 = last ? nB : cB + (size_t)(t + 2) * kstep;
            const char* a3 = a2 + kstep; const char* b3 = b2 + kstep;
            if constexpr (Epi::MIDK > 0) { if (t == Epi::MIDK) E.midk(acc, cur, wr, wc, fr, fq); }
            if constexpr (SP2) {
            PG8_LDB(B0, 0, 0); PG8_LDB(B1, 0, 1); PG8_SCHED; PG8_LDA(At, 0, 0); PG8_STAGE(PG8_SA(1, 1), a1 + hstepA, voffA);
            PG8_WAIT_V(8); PG8_WAIT_L(0); PG8_BAR; PG8_MMA(0, 0, At, B0); PG8_MMA(0, 1, At, B1); PG8_BAR; PG8_SCHED;
            PG8_LDA(At, 0, 1); PG8_STAGE(PG8_SB(0, 0), b2, voffB); PG8_STAGE(PG8_SB(0, 1), b2 + hstepB, voffB); PG8_STAGE(PG8_SA(0, 0), a2, voffA);
            PG8_WAIT_V(8); PG8_WAIT_L(0); PG8_BAR; PG8_MMA(1, 0, At, B0); PG8_MMA(1, 1, At, B1); PG8_BAR; PG8_SCHED;
            PG8_LDB(B0, 1, 0); PG8_LDB(B1, 1, 1); PG8_SCHED; PG8_LDA(At, 1, 0); PG8_STAGE(PG8_SA(0, 1), a2 + hstepA, voffA);
            PG8_WAIT_V(8); PG8_WAIT_L(0); PG8_BAR; PG8_MMA(0, 0, At, B0); PG8_MMA(0, 1, At, B1); PG8_BAR; PG8_SCHED;
            PG8_LDA(At, 1, 1); PG8_STAGE(PG8_SB(1, 0), b3, voffB); PG8_STAGE(PG8_SB(1, 1), b3 + hstepB, voffB); PG8_STAGE(PG8_SA(1, 0), a3, voffA);
            PG8_WAIT_V(8); PG8_WAIT_L(0); PG8_BAR; PG8_MMA(1, 0, At, B0); PG8_MMA(1, 1, At, B1); PG8_BAR; PG8_SCHED;
            } else {
            PG8_LDB(B0, 0, 0); PG8_SCHED; PG8_LDA(At, 0, 0); PG8_STAGE(PG8_SA(1, 1), a1 + hstepA, voffA);
            PG8_WAIT_L(8); PG8_BAR; PG8_WAIT_L(0); PG8_MMA(0, 0, At, B0); PG8_BAR; PG8_SCHED;
            PG8_LDB(B1, 0, 1); PG8_STAGE(PG8_SB(0, 0), b2, voffB);
            PG8_BAR; PG8_WAIT_L(0); PG8_MMA(0, 1, At, B1); PG8_BAR;
            PG8_LDA(At, 0, 1); PG8_STAGE(PG8_SA(0, 0), a2, voffA);
            PG8_BAR; PG8_WAIT_L(0); PG8_MMA(1, 0, At, B0); PG8_BAR; PG8_SCHED;
            PG8_STAGE(PG8_SB(0, 1), b2 + hstepB, voffB);
            PG8_WAIT_V(6); PG8_BAR; PG8_MMA(1, 1, At, B1); PG8_BAR;
            PG8_LDB(B0, 1, 0); PG8_SCHED; PG8_LDA(At, 1, 0); PG8_STAGE(PG8_SA(0, 1), a2 + hstepA, voffA);
            PG8_WAIT_L(8); PG8_BAR; PG8_WAIT_L(0); PG8_MMA(0, 0, At, B0); PG8_BAR; PG8_SCHED;
            PG8_LDB(B1, 1, 1); PG8_STAGE(PG8_SB(1, 0), b3, voffB);
            PG8_BAR; PG8_WAIT_L(0); PG8_MMA(0, 1, At, B1); PG8_BAR;
            PG8_LDA(At, 1, 1); PG8_STAGE(PG8_SA(1, 0), a3, voffA);
            PG8_BAR; PG8_WAIT_L(0); PG8_MMA(1, 0, At, B0); PG8_BAR; PG8_SCHED;
            PG8_STAGE(PG8_SB(1, 1), b3 + hstepB, voffB);
            PG8_WAIT_V(6); PG8_BAR; PG8_MMA(1, 1, At, B1); PG8_BAR;
            }
        }
        if constexpr (ALIGN_EPI) { if (wr == 0) PG8_BAR; }
        { int fr_ = fr, fq_ = fq; asm volatile("" : "+v"(fr_), "+v"(fq_));
#if defined(PROBE_NOEPI) && PROBE_NOEPI
        if (!E.shadow_skip) E(acc, cur, wr, wc, fr_, fq_);
#else
        E(acc, cur, wr, wc, fr_, fq_);
#endif
        }
        if (!has_next) break;
#pragma unroll
        for (int a = 0; a < 2; ++a)
#pragma unroll
            for (int b = 0; b < 2; ++b)
#pragma unroll
                for (int m = 0; m < 4; ++m)
#pragma unroll
                    for (int n = 0; n < 2; ++n) acc[a][b][m][n] = (f32x4){0.f, 0.f, 0.f, 0.f};
        cur = nxt; cA = nA; cB = nB; ++ui;
        if constexpr (ALIGN_EPI) { if (wr == 1) PG8_BAR; }
    }
    PG8_WAIT_V(0);
    if constexpr (!ALIGN_EPI) { if (wr == 0) PG8_BAR; }
    PG8_BAR;
#undef PG8_SA
#undef PG8_SB
#undef PG8_STAGE
#undef PG8_LDA
#undef PG8_LDB
#undef PG8_MMA
#undef PG8_WAIT_V
#undef PG8_WAIT_L
#undef PG8_BAR
#undef PG8_SCHED
}
}
namespace pg8 {
constexpr float LOG2E = 1.4426950408889634f;
constexpr float RMS_EPS = 1e-6f;
constexpr size_t TILE_BYTES = 1536 * 1024, T_Y = 0, T_K = 512 * 1024, T_V = 768 * 1024, T_U = 1024 * 1024, T_LOGF = 1280 * 1024;

template <int kind, int nM, int nN, size_t sA, size_t sB, size_t batchB = 0>
struct SchedT {
    static constexpr int nwg = nM * nN, G = 256;
    int c; const char* A; const char* B;
    __device__ __forceinline__ void init(int c_, const void* A_, const void* B_) { c = c_; A = (const char*)A_; B = (const char*)B_; }
    __device__ __forceinline__ bool next(int i, Unit& u) const {
        const int L = i * G + c; if ((unsigned)L >= (unsigned)nwg) return false;
        if constexpr (kind <= 1) {
            int wgid = L; { constexpr int q = nwg / NXCD, r = nwg % NXCD; const int xcd = wgid % NXCD, off = wgid / NXCD; wgid = (xcd < r ? xcd * (q + 1) : r * (q + 1) + (xcd - r) * q) + off; }
            constexpr int nig = WGM * nN; const int gid = wgid / nig, fm = gid * WGM, gsz = (nM - fm) < WGM ? (nM - fm) : WGM;
            u.pm = fm + ((wgid % nig) % gsz); u.pn = (wgid % nig) / gsz;
            u.a = A + (size_t)u.pm * sA; u.b = B + (size_t)u.pn * sB + (kind == 1 ? (size_t)(u.pm >> 3) * batchB : (size_t)0); u.aux = 0;
        } else if constexpr (kind == 2) {
            const int b_ = L & 7, h = (L >> 5) & 3, t4 = (L >> 3) & 3;
            u.pm = b_ * 4 + h; u.pn = t4;
            u.a = A + ((size_t)b_ * 256 * 2048 + (size_t)h * 256) * 2; u.b = B + ((size_t)t4 * 256 * 1024 + (size_t)h * 256) * 2;
            u.aux = b_ * 4194304 + (h * 256) * 1024 + t4 * 256;
        } else if constexpr (kind == 3) {
            const int b_ = L & 7, h = (L >> 5) & 3, t4 = (L >> 3) & 3;
            u.pm = t4; u.pn = b_ * 4 + h;
            u.a = A + ((size_t)t4 * 256 * 1024 + (size_t)h * 256) * 2; u.b = B + ((size_t)b_ * 256 * 2048 + 1024 + (size_t)h * 256) * 2;
            u.aux = b_ * 4194304 + (t4 * 256) * 1024 + h * 256;
        } else {
            u.pm = L & 7; u.pn = L >> 3; u.a = A + (size_t)u.pm * sA; u.b = B + (size_t)u.pn * sB; u.aux = 0;
        }
        return true;
    }
};

__device__ __forceinline__ void store8(bf16_t* p, const f32x4 v0, const f32x4 v1) {
    u32x4 w; w.x = cvt_pk_bf16(v0[0], v0[1]); w.y = cvt_pk_bf16(v0[2], v0[3]); w.z = cvt_pk_bf16(v1[0], v1[1]); w.w = cvt_pk_bf16(v1[2], v1[3]); *(u32x4*)p = w;
}
__device__ __forceinline__ float ss_sum16(const float* ssp, int row) {
    const f32x4* p = (const f32x4*)(ssp + (size_t)row * 16); const f32x4 a = p[0], b = p[1], c = p[2], d = p[3];
    return (((a[0] + a[1]) + (a[2] + a[3])) + ((b[0] + b[1]) + (b[2] + b[3]))) + (((c[0] + c[1]) + (c[2] + c[3])) + ((d[0] + d[1]) + (d[2] + d[3])));
}
__device__ __forceinline__ float rs_row(const float* ssp, int row) { return __builtin_amdgcn_rsqf(ss_sum16(ssp, row) * (1.0f / 1024.0f) + RMS_EPS); }
__device__ __forceinline__ float sigmoidf_fast(float z) { return __builtin_amdgcn_rcpf(1.0f + __builtin_amdgcn_exp2f(-z * LOG2E)); }
__device__ __forceinline__ f32x4 sig4(f32x4 z) { f32x4 r; r[0] = sigmoidf_fast(z[0]); r[1] = sigmoidf_fast(z[1]); r[2] = sigmoidf_fast(z[2]); r[3] = sigmoidf_fast(z[3]); return r; }

struct EpiSwiGLU {
    static constexpr bool PERM = true; static constexpr int MIDK = 0;
    bf16_t* H; const float* ss; static constexpr int ldh = 2816;
    bool shadow_skip = false;
    __device__ __forceinline__ void midk(f32x4 (&)[2][2][4][2], const Unit&, int, int, int, int) const {}
    __device__ __forceinline__ void operator()(f32x4 (&acc)[2][2][4][2], const Unit& u, int wr, int wc, int fr, int fq) const {
        const int rl0 = wr * 64 + fr, col0 = u.pn * HALF + wc * 32 + 8 * fq;
        bf16_t* Ht = (bf16_t*)((unsigned char*)H + (size_t)u.pm * TILE_BYTES);
#pragma unroll
        for (int ai = 0; ai < 2; ++ai)
#pragma unroll
            for (int m = 0; m < 4; ++m) {
                const int rl = rl0 + ai * HALF + m * 16;
                const float rs = rs_row(ss, u.pm * BM + rl);
                const f32x4 g0 = acc[ai][0][m][0] * rs, g1 = acc[ai][0][m][1] * rs, u0 = acc[ai][1][m][0] * rs, u1 = acc[ai][1][m][1] * rs;
                store8(Ht + (size_t)rl * ldh + col0, g0 * sig4(g0) * u0, g1 * sig4(g1) * u1);
            }
    }
};

template <int MIDK_>
struct EpiResid {
    static constexpr bool PERM = true; static constexpr int MIDK = MIDK_;
    const float* xin; float* xout; bf16_t* xb; float* ssn; const float* ssa; float alpha;
    bool shadow_skip = false;
    __device__ __forceinline__ void midk(f32x4 (&acc)[2][2][4][2], const Unit& u, int wr, int wc, int fr, int fq) const {
        const int row0 = u.pm * BM + wr * 64 + fr;
#pragma unroll
        for (int ai = 0; ai < 2; ++ai)
#pragma unroll
            for (int m = 0; m < 4; ++m) {
                const f32x4* pa = (const f32x4*)(ssa + (size_t)(row0 + ai * HALF + m * 16) * 8); const f32x4 sa = pa[0], sb = pa[1];
                const float rs = __builtin_amdgcn_rsqf((((sa[0] + sa[1]) + (sa[2] + sa[3])) + ((sb[0] + sb[1]) + (sb[2] + sb[3]))) * (1.0f / 512.0f) + RMS_EPS);
#pragma unroll
                for (int bj = 0; bj < 2; ++bj)
#pragma unroll
                    for (int n = 0; n < 2; ++n) acc[ai][bj][m][n] *= rs;
            }
    }
    __device__ __forceinline__ void operator()(f32x4 (&acc)[2][2][4][2], const Unit& u, int wr, int wc, int fr, int fq) const {
        const int row0 = u.pm * BM + wr * 64 + fr, col0 = u.pn * BM + wc * 32 + 8 * fq;
#pragma unroll
        for (int ai = 0; ai < 2; ++ai)
#pragma unroll
            for (int m = 0; m < 4; ++m) {
                const int row = row0 + ai * HALF + m * 16; float q = 0.f;
#pragma unroll
                for (int bj = 0; bj < 2; ++bj) {
                    const size_t off = (size_t)row * 1024 + col0 + bj * HALF;
                    f32x4 r0, r1;
                    if (xin) { r0 = *(const f32x4*)(xin + off); r1 = *(const f32x4*)(xin + off + 4); }
                    else { const u32x4 w = *(const u32x4*)(xb + off);
                        r0 = (f32x4){__uint_as_float(w.x << 16), __uint_as_float(w.x & 0xffff0000u), __uint_as_float(w.y << 16), __uint_as_float(w.y & 0xffff0000u)};
                        r1 = (f32x4){__uint_as_float(w.z << 16), __uint_as_float(w.z & 0xffff0000u), __uint_as_float(w.w << 16), __uint_as_float(w.w & 0xffff0000u)}; }
                    const f32x4 v0 = r0 + acc[ai][bj][m][0] * alpha, v1 = r1 + acc[ai][bj][m][1] * alpha;
                    if (xout) { *(f32x4*)(xout + off) = v0; *(f32x4*)(xout + off + 4) = v1; }
                    else store8(xb + off, v0, v1);
                    q += (v0[0] * v0[0] + v0[1] * v0[1]) + (v0[2] * v0[2] + v0[3] * v0[3]) + (v1[0] * v1[0] + v1[1] * v1[1]) + (v1[2] * v1[2] + v1[3] * v1[3]);
                }
                q += swz_xor<16>(q); q = sum_x32(q);
                if (fq == 0) ssn[(size_t)row * 16 + u.pn * 4 + wc] = q;
            }
    }
};

struct EpiWin {
    static constexpr bool PERM = true; static constexpr int MIDK = 0;
    unsigned char* R1; const float* ss; const float* bfp; float qscale;
    bool shadow_skip = false;
    __device__ __forceinline__ void midk(f32x4 (&)[2][2][4][2], const Unit&, int, int, int, int) const {}
    __device__ __forceinline__ void operator()(f32x4 (&acc)[2][2][4][2], const Unit& u, int wr, int wc, int fr, int fq) const {
        const int rl0 = wr * 64 + fr, cw = wc * 32 + 8 * fq; const int pn = u.pn;
        unsigned char* T = R1 + (size_t)u.pm * TILE_BYTES;
#pragma unroll
        for (int ai = 0; ai < 2; ++ai)
#pragma unroll
            for (int m = 0; m < 4; ++m) {
                const int rl = rl0 + ai * HALF + m * 16;
                const float rs = rs_row(ss, u.pm * BM + rl);
                if (pn < 6) {
                    bf16_t* base; int ld; float sc = rs;
                    if (pn < 2) { base = (bf16_t*)(T + T_Y) + pn * BM; ld = 1024; sc = rs * qscale; } else if (pn < 4) { base = (bf16_t*)(T + T_K) + (pn - 2) * BM; ld = 512; } else { base = (bf16_t*)(T + T_V) + (pn - 4) * BM; ld = 512; }
#pragma unroll
                    for (int bj = 0; bj < 2; ++bj) store8(base + (size_t)rl * ld + bj * HALF + cw, acc[ai][bj][m][0] * sc, acc[ai][bj][m][1] * sc);
                } else if (pn < 10) {
                    const f32x4 a0 = acc[ai][0][m][0] * rs, a1 = acc[ai][0][m][1] * rs, g0 = acc[ai][1][m][0] * rs, g1 = acc[ai][1][m][1] * rs;
                    store8((bf16_t*)(T + T_U) + (size_t)rl * 512 + (pn - 6) * HALF + cw, a0 * sig4(g0), a1 * sig4(g1));
                } else {
                    if (wc == 0 && fq == 0) {
                        float* LF = (float*)(T + T_LOGF);
#pragma unroll
                        for (int n = 0; n < 2; ++n)
#pragma unroll
                            for (int e = 0; e < 4; ++e) {
                                const int h = 4 * n + e; const float z = acc[ai][0][m][n][e] * rs + bfp[h];
                                LF[h * 256 + rl] = fminf(z, 0.f) - log1pf(expf(-fabsf(z)));
                            }
                    }
                }
            }
    }
};

struct EpiRowScale {
    static constexpr bool PERM = true; static constexpr int MIDK = 0;
    bf16_t* O; const float* ssr; float scale; static constexpr int ldc = 2048;
    bool shadow_skip = false;
    __device__ __forceinline__ void midk(f32x4 (&)[2][2][4][2], const Unit&, int, int, int, int) const {}
    __device__ __forceinline__ void operator()(f32x4 (&acc)[2][2][4][2], const Unit& u, int wr, int wc, int fr, int fq) const {
        const int row0 = u.pm * BM + wr * 64 + fr, col0 = u.pn * BM + wc * 32 + 8 * fq;
#pragma unroll
        for (int ai = 0; ai < 2; ++ai)
#pragma unroll
            for (int m = 0; m < 4; ++m) {
                const int row = row0 + ai * HALF + m * 16;
                const float rs = (ssr ? __builtin_amdgcn_rsqf(ssr[row] * (1.0f / 1024.0f) + RMS_EPS) : 1.0f) * scale;
#pragma unroll
                for (int bj = 0; bj < 2; ++bj) store8(O + (size_t)row * ldc + col0 + bj * HALF, acc[ai][bj][m][0] * rs, acc[ai][bj][m][1] * rs);
            }
    }
};

struct EpiAux {
    static constexpr bool PERM = true; static constexpr int MIDK = 0;
    bf16_t* O; float scale; static constexpr int ldc = 1024;
    bool shadow_skip = false;
    __device__ __forceinline__ void midk(f32x4 (&)[2][2][4][2], const Unit&, int, int, int, int) const {}
    __device__ __forceinline__ void operator()(f32x4 (&acc)[2][2][4][2], const Unit& u, int wr, int wc, int fr, int fq) const {
        bf16_t* base = O + u.aux + (size_t)(wr * 64 + fr) * ldc + wc * 32 + 8 * fq;
#pragma unroll
        for (int ai = 0; ai < 2; ++ai)
#pragma unroll
            for (int m = 0; m < 4; ++m)
#pragma unroll
                for (int bj = 0; bj < 2; ++bj) store8(base + (size_t)(ai * HALF + m * 16) * ldc + bj * HALF, acc[ai][bj][m][0] * scale, acc[ai][bj][m][1] * scale);
    }
};

struct EpiSoftmax {
    static constexpr bool PERM = true; static constexpr int MIDK = 0;
    unsigned char* R1; const float* ss; PG8_LAS float* scr;
    bool shadow_skip = false;
    __device__ __forceinline__ void midk(f32x4 (&)[2][2][4][2], const Unit&, int, int, int, int) const {}
    __device__ __forceinline__ void operator()(f32x4 (&acc)[2][2][4][2], const Unit& u, int wr, int wc, int fr, int fq) const {
        const int col0 = u.pn * BM + wc * 32 + 8 * fq;
        PG8_LAS float* TM = scr; PG8_LAS float* TS = scr + 1024;
        const float* ssr = ss + (size_t)(u.pm * BM + wr * 64 + fr) * 16;
#pragma unroll
        for (int ai = 0; ai < 2; ++ai)
#pragma unroll
            for (int m = 0; m < 4; ++m) {
                const int rl = ai * HALF + wr * 64 + m * 16 + fr;
                const float rs = rs_row(ssr, ai * HALF + m * 16);
                float v = -3.0e38f;
#pragma unroll
                for (int bj = 0; bj < 2; ++bj)
#pragma unroll
                    for (int n = 0; n < 2; ++n) { const f32x4 x = acc[ai][bj][m][n] * rs; acc[ai][bj][m][n] = x; v = fmaxf(v, fmaxf(fmaxf(x[0], x[1]), fmaxf(x[2], x[3]))); }
                v = fmaxf(v, swz_xor<16>(v)); v = max_x32(v);
                if (fq == 0) TM[rl * 4 + wc] = v;
            }
        asm volatile("s_waitcnt lgkmcnt(0)" ::: "memory"); __builtin_amdgcn_s_barrier(); asm volatile("" ::: "memory");
#pragma unroll
        for (int ai = 0; ai < 2; ++ai)
#pragma unroll
            for (int m = 0; m < 4; ++m) {
                const int rl = ai * HALF + wr * 64 + m * 16 + fr;
                const f32x4 t = *(const PG8_LAS f32x4*)(TM + rl * 4);
                const float mrow = fmaxf(fmaxf(t[0], t[1]), fmaxf(t[2], t[3]));
                float s = 0.f;
#pragma unroll
                for (int bj = 0; bj < 2; ++bj)
#pragma unroll
                    for (int n = 0; n < 2; ++n) { f32x4 x = acc[ai][bj][m][n] - mrow;
                        x[0] = __builtin_amdgcn_exp2f(x[0]); x[1] = __builtin_amdgcn_exp2f(x[1]); x[2] = __builtin_amdgcn_exp2f(x[2]); x[3] = __builtin_amdgcn_exp2f(x[3]);
                        acc[ai][bj][m][n] = x; s += (x[0] + x[1]) + (x[2] + x[3]); }
                s += swz_xor<16>(s); s = sum_x32(s);
                if (fq == 0) TS[rl * 4 + wc] = s;
            }
        asm volatile("s_waitcnt lgkmcnt(0)" ::: "memory"); __builtin_amdgcn_s_barrier(); asm volatile("" ::: "memory");
        bf16_t* xp = (bf16_t*)(R1 + (size_t)u.pm * TILE_BYTES + T_Y) + (size_t)(wr * 64 + fr) * 1024 + col0;
#pragma unroll
        for (int ai = 0; ai < 2; ++ai)
#pragma unroll
            for (int m = 0; m < 4; ++m) {
                const int rl = ai * HALF + wr * 64 + m * 16 + fr;
                const f32x4 t = *(const PG8_LAS f32x4*)(TS + rl * 4);
                const float inv = __builtin_amdgcn_rcpf((t[0] + t[1]) + (t[2] + t[3]));
#pragma unroll
                for (int bj = 0; bj < 2; ++bj) store8(xp + (size_t)(ai * HALF + m * 16) * 1024 + bj * HALF, acc[ai][bj][m][0] * inv, acc[ai][bj][m][1] * inv);
            }
    }
};
}
#include <hip/hip_bf16.h>
namespace attn_body {
using bf16=__hip_bfloat16;
using bf16x8=__attribute__((ext_vector_type(8)))short;
using s16x4=__attribute__((ext_vector_type(4)))short;
using f32x16=__attribute__((ext_vector_type(16)))float;
using f32x4_t=__attribute__((ext_vector_type(4)))float;
using u32x4=__attribute__((ext_vector_type(4)))unsigned;
#define ATT_LAS __attribute__((address_space(3)))
constexpr int BATCH=8,NHEAD=8,SEQ=2048,D=64,QP=1024,KP=512;
constexpr size_t TILE_BYTES=1536*1024,T_Y=0,T_K=512*1024,T_V=768*1024,T_U=1024*1024,T_LOGF=1280*1024;
constexpr int NW=8,QBLK=32,QB=QBLK*NW,KVBLK=64,NQB=SEQ/QB;
__device__ __forceinline__ int crow(int r,int hi){return (r&3)+8*(r>>2)+4*hi;}
#define SBAR() __builtin_amdgcn_sched_barrier(0)
__device__ __forceinline__ void cmask(f32x16&p0,f32x16&p1,int jb,int qrel,int hi){
  const float NEG=-INFINITY; int kb=64*jb+4*hi;
  #pragma unroll
  for(int r=0;r<16;++r){int kv=kb+(r&3)+8*(r>>2); if(kv>qrel)p0[r]=NEG; if(kv+32>qrel)p1[r]=NEG;}
}
constexpr int NSLOT=3, SLOTB=8192;
constexpr int LDS_K=0, LDS_V=NSLOT*SLOTB, LDS_WS=2*NSLOT*SLOTB, LDS_OST=LDS_WS+NW*64*4, LDS_CB=LDS_OST+NW*4096  , LDS_WT=LDS_CB+SEQ*4, LDS_BYTES=LDS_WT+64;
__device__ __forceinline__ void glds16(const void*gsrc,unsigned lds_dst){unsigned keep;
  asm volatile("s_mov_b32 %0, m0\n\ts_mov_b32 m0, %2\n\ts_nop 0\n\tglobal_load_lds_dwordx4 %1, off\n\ts_mov_b32 m0, %0":"=&s"(keep):"v"(gsrc),"s"(lds_dst):"memory");}
__device__ __forceinline__ float max3f(float a,float b,float c){float r;asm("v_max3_f32 %0, %1, %2, %3":"=v"(r):"v"(a),"v"(b),"v"(c));return r;}
__device__ __forceinline__ float max2f(float a,float b){float r;asm("v_max_f32_e32 %0, %1, %2":"=v"(r):"v"(a),"v"(b));return r;}
__device__ __forceinline__ float fadd_s(float a,float b){float r;asm("v_add_f32_e32 %0, %1, %2":"=v"(r):"v"(a),"v"(b));return r;}
__device__ __forceinline__ float fsub_s(float a,float b){float r;asm("v_sub_f32_e32 %0, %1, %2":"=v"(r):"v"(a),"v"(b));return r;}
typedef float f32x2_t __attribute__((ext_vector_type(2))); typedef __bf16 bf16x2_t __attribute__((ext_vector_type(2)));
__device__ __forceinline__ unsigned cvtpk_s(float lo,float hi){f32x2_t v={lo,hi};bf16x2_t b=__builtin_convertvector(v,bf16x2_t);return __builtin_bit_cast(unsigned,b);}
#define WAIT_BAR(N) asm volatile("s_waitcnt vmcnt(" #N ") lgkmcnt(0)\n\ts_barrier":::"memory")

__device__ __forceinline__ void qkt(f32x16&p0,f32x16&p1,const char*Kslot,const bf16x8*qr,const f32x16&negm,int r32,int hi){
  const char*kb=Kslot+hi*1024+r32*16;
  #pragma unroll
  for(int d0=0;d0<4;++d0){
    const bf16x8 b0=*reinterpret_cast<const bf16x8*>(kb+d0*2048);
    const bf16x8 b1=*reinterpret_cast<const bf16x8*>(kb+d0*2048+512);
    if(d0==0){p0=__builtin_amdgcn_mfma_f32_32x32x16_bf16(b0,qr[0],negm,0,0,0);p1=__builtin_amdgcn_mfma_f32_32x32x16_bf16(b1,qr[0],negm,0,0,0);}
    else{p0=__builtin_amdgcn_mfma_f32_32x32x16_bf16(b0,qr[d0],p0,0,0,0);p1=__builtin_amdgcn_mfma_f32_32x32x16_bf16(b1,qr[d0],p1,0,0,0);}}
}
typedef ATT_LAS const char* lds_cptr;
typedef short v4i16_t __attribute__((ext_vector_type(4)));
__device__ __forceinline__ void kload8(bf16x8*kf,lds_cptr kp){
  kf[0]=*(const ATT_LAS bf16x8*)(kp);      kf[1]=*(const ATT_LAS bf16x8*)(kp+512);
  kf[2]=*(const ATT_LAS bf16x8*)(kp+2048); kf[3]=*(const ATT_LAS bf16x8*)(kp+2560);
  kf[4]=*(const ATT_LAS bf16x8*)(kp+4096); kf[5]=*(const ATT_LAS bf16x8*)(kp+4608);
  kf[6]=*(const ATT_LAS bf16x8*)(kp+6144); kf[7]=*(const ATT_LAS bf16x8*)(kp+6656);
}
__device__ __forceinline__ void kload2(bf16x8*kf,lds_cptr kp,int j){ kf[2*j]=*(const ATT_LAS bf16x8*)(kp+j*2048); kf[2*j+1]=*(const ATT_LAS bf16x8*)(kp+j*2048+512); }
__device__ __forceinline__ s16x4 vtr(lds_cptr p){ return __builtin_bit_cast(s16x4,__builtin_amdgcn_ds_read_tr16_b64_v4i16((ATT_LAS v4i16_t*)p)); }
__device__ __forceinline__ float rowmax(const f32x16&p0,const f32x16&p1){
  float a=max3f(p0[0],p0[1],p1[0]),b=max3f(p0[2],p0[3],p1[1]);a=max3f(a,p1[2],p1[3]);
  #pragma unroll
  for(int r=4;r<16;r+=4){a=max3f(a,p0[r],p0[r+1]);b=max3f(b,p0[r+2],p0[r+3]);a=max3f(a,p1[r],p1[r+1]);b=max3f(b,p1[r+2],p1[r+3]);}
  const float m=max2f(a,b);
  auto rr=__builtin_amdgcn_permlane32_swap(__float_as_uint(m),__float_as_uint(m),false,false);
  return max2f(__uint_as_float(rr[0]),__uint_as_float(rr[1]));
}
__device__ __forceinline__ void pv(f32x16*o,int vb,bf16x8 pa0,bf16x8 pa1,bf16x8 pa2,bf16x8 pa3){
  #pragma unroll
  for(int d0=0;d0<2;++d0){s16x4 lo[4],hi[4];
    #pragma unroll
    for(int ks=0;ks<4;++ks){
      asm volatile("ds_read_b64_tr_b16 %0,%1 offset:%c2":"=&v"(lo[ks]):"v"(vb),"i"(d0*4096+ks*1024):"memory");
      asm volatile("ds_read_b64_tr_b16 %0,%1 offset:%c2":"=&v"(hi[ks]):"v"(vb),"i"(d0*4096+ks*1024+512):"memory");}
    asm volatile("s_waitcnt lgkmcnt(0)":::"memory");SBAR();
    #define PK(k) (bf16x8){lo[k][0],lo[k][1],lo[k][2],lo[k][3],hi[k][0],hi[k][1],hi[k][2],hi[k][3]}
    o[d0]=__builtin_amdgcn_mfma_f32_32x32x16_bf16(pa0,PK(0),o[d0],0,0,0);
    o[d0]=__builtin_amdgcn_mfma_f32_32x32x16_bf16(pa1,PK(1),o[d0],0,0,0);
    o[d0]=__builtin_amdgcn_mfma_f32_32x32x16_bf16(pa2,PK(2),o[d0],0,0,0);
    o[d0]=__builtin_amdgcn_mfma_f32_32x32x16_bf16(pa3,PK(3),o[d0],0,0,0);
    #undef PK
  }
}
__device__ __forceinline__ void scan_bias(const unsigned char*R1,int b,int h,char*shm,const int tid){
  const int lane=tid&63,wid=tid>>6;
  ATT_LAS float*cb=(ATT_LAS float*)(shm+LDS_CB); ATT_LAS float*wt=(ATT_LAS float*)(shm+LDS_WT);
  const f32x4_t v=*(const f32x4_t*)((const float*)(R1+(size_t)(8*b+wid)*TILE_BYTES+T_LOGF)+h*256+4*lane);
  const float s0=v[0],s1=s0+v[1],s2=s1+v[2],s3=s2+v[3];
  float incl=s3;
  #pragma unroll
  for(int o=1;o<64;o<<=1){const float n=__int_as_float(__builtin_amdgcn_ds_bpermute((lane-o)<<2,__float_as_int(incl))); if(lane>=o)incl+=n;}
  if(lane==63)wt[wid]=incl;
  asm volatile("s_waitcnt lgkmcnt(0)\n\ts_barrier":::"memory");
  float woff=0.f;
  #pragma unroll
  for(int w=0;w<8;++w){const float x=wt[w]; if(w<wid)woff+=x;}
  const float ex=woff+incl-s3; const float L2E=-1.4426950408889634f;
  f32x4_t o4; o4[0]=(ex+s0)*L2E;o4[1]=(ex+s1)*L2E;o4[2]=(ex+s2)*L2E;o4[3]=(ex+s3)*L2E;
  *(ATT_LAS f32x4_t*)(cb+4*tid)=o4;
  asm volatile("s_waitcnt lgkmcnt(0)\n\ts_barrier":::"memory");
}
template<int THRL> __device__ __forceinline__ void attn_unit(int b,int h,int qb,const unsigned char*R1,int ocol  ,float*ssa  ,char*shm,const int tid){
  const int lane=tid&63,r32=lane&31,hi=lane>>5; const int wid=__builtin_amdgcn_readfirstlane(tid>>6);
  const long rowbase=(long)b*SEQ; const int q0=qb*QB;
  const unsigned char*Tb=R1+(size_t)(8*b)*TILE_BYTES;
  const bf16*Qw=(const bf16*)(Tb+(size_t)qb*TILE_BYTES+T_Y)+(long)(wid*QBLK)*QP+h*D;
  const unsigned lds0=(unsigned)(uintptr_t)shm;
  float*wsf=(float*)(shm+LDS_WS)+wid*64;
  const ATT_LAS float*cbh=(const ATT_LAS float*)(shm+LDS_CB)+4*hi;
  const bf16*ksrc=(const bf16*)(Tb+T_K)+h*D+(long)lane*KP+wid*8;
  const bf16*vsrc=(const bf16*)(Tb+T_V)+h*D+(long)(16*(wid&3)+(lane>>2))*KP+(wid>>2)*32+(lane&3)*8;
  const unsigned kdst=lds0+LDS_K+wid*1024, vdst=lds0+LDS_V+wid*1024;
  #define KVOFF(t) ((size_t)((t)>>2)*(TILE_BYTES/2)+(size_t)((t)&3)*KVBLK*KP)
  #define DMA_K(t,slot) glds16(ksrc+KVOFF(t),(unsigned)__builtin_amdgcn_readfirstlane(kdst+(slot)))
  #define DMA_V(t,slot) glds16(vsrc+KVOFF(t),(unsigned)__builtin_amdgcn_readfirstlane(vdst+(slot)))
  const int vb0=(int)(lds0+LDS_V)+((lane>>4)&1)*32+(lane&3)*8+(4*hi+((lane&15)>>2))*64;
  const char*Kbase=shm+LDS_K; bf16x8 kf[8];
  const lds_cptr shm3=(lds_cptr)shm; const lds_cptr kp0=shm3+LDS_K+hi*1024+r32*16; const lds_cptr vp0=shm3+LDS_V+((lane>>4)&1)*32+(lane&3)*8+(4*hi+((lane&15)>>2))*64;
  const int NT=(q0+QB)/KVBLK;
  DMA_K(0,0);DMA_V(0,0);DMA_K(1,SLOTB);
  bf16x8 qr[4];
  #pragma unroll
  for(int d0=0;d0<4;++d0)qr[d0]=*reinterpret_cast<const bf16x8*>(&Qw[(long)r32*QP+d0*16+hi*8]);
  float mhat=0.f,l_reg=0.f;f32x16 o[2];o[0]=f32x16{};o[1]=f32x16{};f32x16 negm=f32x16{};asm volatile("":"+v"(negm));
  const int qrel=wid*QBLK+r32;
  #define CMASK(P0,P1,t) do{int jb_=(t)-(NT-4); if(jb_>=0)cmask(P0,P1,jb_,qrel,hi);}while(0)
  #define ADDB(P0,P1,t) do{ const ATT_LAS float*cbt_=cbh+64*(t); \
    _Pragma("unroll") for(int j_=0;j_<4;++j_){ const f32x4_t b0_=*(const ATT_LAS f32x4_t*)(cbt_+8*j_), b1_=*(const ATT_LAS f32x4_t*)(cbt_+32+8*j_); \
      _Pragma("unroll") for(int i_=0;i_<4;++i_){P0[4*j_+i_]+=b0_[i_];P1[4*j_+i_]+=b1_[i_];} } }while(0)
  bool resc=false;
  #define START(P0,P1) do{ const float rm=rowmax(P0,P1); resc=false; \
    { const float dl=rm; mhat=fadd_s(mhat,dl); \
      _Pragma("unroll") for(int r=0;r<16;++r){P0[r]=fsub_s(P0[r],dl);P1[r]=fsub_s(P1[r],dl);} \
      _Pragma("unroll") for(int r=0;r<16;++r)negm[r]=-mhat; asm volatile("":"+v"(negm)); } \
    _Pragma("unroll") for(int r=0;r<16;++r)P0[r]=__builtin_amdgcn_exp2f(P0[r]); }while(0)
  #define RESC() do{ if(resc){ asm volatile("s_waitcnt lgkmcnt(0)":::"memory"); \
      _Pragma("unroll") for(int d_=0;d_<2;++d_) _Pragma("unroll") for(int r=0;r<16;++r)o[d_][r]*=wsf[crow(r,hi)]; } }while(0)
  f32x16 pA0,pA1,pB0,pB1;
  int sl_prev=0,sl_cur=0,sl_next=SLOTB;
  #define ROT() do{sl_prev=sl_cur;sl_cur=sl_next;sl_next=(sl_next==(NSLOT-1)*SLOTB)?0:sl_next+SLOTB;}while(0)
  DMA_K(2,2*SLOTB);
  WAIT_BAR(3);
  qkt(pA0,pA1,Kbase,qr,negm,r32,hi);asm volatile("s_nop 15\n\ts_nop 7":"+v"(pA0),"+v"(pA1));ADDB(pA0,pA1,0);asm volatile("s_nop 3":"+v"(pA0),"+v"(pA1));CMASK(pA0,pA1,0);
  START(pA0,pA1);
  _Pragma("unroll") for(int r=0;r<16;++r)pA1[r]=__builtin_amdgcn_exp2f(pA1[r]);
  WAIT_BAR(0);
  DMA_K(3,0);DMA_V(1,SLOTB);
  ROT();
  kload8(kf,kp0+sl_cur);
  WAIT_BAR(2);
  s16x4 vlo[8],vhi[8]; u32x4 pw0,pw1,pw2,pw3;
  #define PKW(P,B) cvtpk_s(P[B],P[B+1])
  #define PAF(k) __builtin_bit_cast(bf16x8,pw##k)
  #define VFR(i) (bf16x8){vlo[i][0],vlo[i][1],vlo[i][2],vlo[i][3],vhi[i][0],vhi[i][1],vhi[i][2],vhi[i][3]}
  #define PIN(x) asm volatile("":"+v"(x))
  #define MX3(a,b,c) __builtin_fmaxf(__builtin_fmaxf((a),(b)),(c))
  #define GAPA(MF,A0,A1,A2,A3,W0,W1,PW) do{ MF; sacc+=A0; sacc+=A1; sacc+=A2; sacc+=A3; PIN(sacc); W0; W1; PIN(PW); SBAR(); }while(0)
  #define EX(v) __builtin_amdgcn_exp2f(v)
  #define GAPB(MF,X,B) do{ MF; X[B]=EX(X[B]); X[B+1]=EX(X[B+1]); X[B+2]=EX(X[B+2]); X[B+3]=EX(X[B+3]); PIN(X); SBAR(); }while(0)
  #define VRD(i) do{ vlo[i]=vtr(vp_+(((i)>>2)*4096+((i)&3)*1024)); vhi[i]=vtr(vp_+(((i)>>2)*4096+((i)&3)*1024+512)); }while(0)
  #define KRD(G,j) do{ if(G){ kload2(kf,kp0+sl_next,j); SBAR(); } }while(0)
  #define STEP(C0,C1,P0,P1,t,GK,GV,GL) do{ SBAR(); \
    const lds_cptr vp_=vp0+sl_prev; \
    VRD(0); SBAR(); float sacc=(P0[0]+P0[1]); \
    GAPA(C0=__builtin_amdgcn_mfma_f32_32x32x16_bf16(kf[0],qr[0],negm,0,0,0), P0[2],P0[3],P0[4],P0[5],     pw0[0]=PKW(P0,0), pw0[1]=PKW(P0,2), pw0); \
    VRD(4); SBAR(); GAPA(C1=__builtin_amdgcn_mfma_f32_32x32x16_bf16(kf[1],qr[0],negm,0,0,0), P0[6],P0[7],P0[8],P0[9],     pw0[2]=PKW(P0,4), pw0[3]=PKW(P0,6), pw0); \
    VRD(1); SBAR(); GAPA(C0=__builtin_amdgcn_mfma_f32_32x32x16_bf16(kf[2],qr[1],C0,0,0,0),   P0[10],P0[11],P0[12],P0[13], pw1[0]=PKW(P0,8), pw1[1]=PKW(P0,10), pw1); \
    VRD(5); SBAR(); GAPA(C1=__builtin_amdgcn_mfma_f32_32x32x16_bf16(kf[3],qr[1],C1,0,0,0),   P0[14],P0[15],P1[0],P1[1],   pw1[2]=PKW(P0,12),pw1[3]=PKW(P0,14), pw1); \
    VRD(2); SBAR(); GAPA(C0=__builtin_amdgcn_mfma_f32_32x32x16_bf16(kf[4],qr[2],C0,0,0,0),   P1[2],P1[3],P1[4],P1[5],     pw2[0]=PKW(P1,0), pw2[1]=PKW(P1,2), pw2); \
    VRD(6); SBAR(); GAPA(C1=__builtin_amdgcn_mfma_f32_32x32x16_bf16(kf[5],qr[2],C1,0,0,0),   P1[6],P1[7],P1[8],P1[9],     pw2[2]=PKW(P1,4), pw2[3]=PKW(P1,6), pw2); \
    VRD(3); SBAR(); GAPA(C0=__builtin_amdgcn_mfma_f32_32x32x16_bf16(kf[6],qr[3],C0,0,0,0),   P1[10],P1[11],P1[12],P1[13], pw3[0]=PKW(P1,8), pw3[1]=PKW(P1,10), pw3); \
    VRD(7); SBAR(); GAPA(C1=__builtin_amdgcn_mfma_f32_32x32x16_bf16(kf[7],qr[3],C1,0,0,0),   P1[14],P1[15],0.f,0.f,       pw3[2]=PKW(P1,12),pw3[3]=PKW(P1,14), pw3); \
    l_reg+=sacc; \
    if(GK){DMA_K((t)+3,sl_cur);} if(GV){DMA_V((t)+1,sl_next);} \
    ADDB(C0,C1,t); \
    CMASK(C0,C1,t); \
    { float a=MX3(C0[0],C0[1],C1[0]),b=MX3(C0[2],C0[3],C1[1]); a=MX3(a,C1[2],C1[3]); \
      _Pragma("unroll") for(int r=4;r<16;r+=4){a=MX3(a,C0[r],C0[r+1]);b=MX3(b,C0[r+2],C0[r+3]);a=MX3(a,C1[r],C1[r+1]);b=MX3(b,C1[r+2],C1[r+3]);} \
      float rm=__builtin_fmaxf(a,b); { auto rr=__builtin_amdgcn_permlane32_swap(__float_as_uint(rm),__float_as_uint(rm),false,false); rm=__builtin_fmaxf(__uint_as_float(rr[0]),__uint_as_float(rr[1])); } \
      resc=false; \
      if(__builtin_expect(__any(rm>(float)THRL),0)){ const float dl=__builtin_fmaxf(rm,0.f); mhat+=dl; \
        _Pragma("unroll") for(int r=0;r<16;++r){C0[r]-=dl;C1[r]-=dl;} \
        _Pragma("unroll") for(int r=0;r<16;++r)negm[r]=-mhat; asm volatile("":"+v"(negm)); \
        const float f=__builtin_amdgcn_exp2f(-dl); l_reg*=f; if(hi==0)wsf[r32]=f; resc=true; } } \
    SBAR(); \
    GAPB(o[0]=__builtin_amdgcn_mfma_f32_32x32x16_bf16(PAF(0),VFR(0),o[0],0,0,0), C0,0); \
    GAPB(o[1]=__builtin_amdgcn_mfma_f32_32x32x16_bf16(PAF(0),VFR(4),o[1],0,0,0), C0,4); \
    KRD(GL,0); GAPB(o[0]=__builtin_amdgcn_mfma_f32_32x32x16_bf16(PAF(1),VFR(1),o[0],0,0,0), C0,8); \
    KRD(GL,1); GAPB(o[1]=__builtin_amdgcn_mfma_f32_32x32x16_bf16(PAF(1),VFR(5),o[1],0,0,0), C0,12); \
    KRD(GL,2); GAPB(o[0]=__builtin_amdgcn_mfma_f32_32x32x16_bf16(PAF(2),VFR(2),o[0],0,0,0), C1,0); \
    KRD(GL,3); GAPB(o[1]=__builtin_amdgcn_mfma_f32_32x32x16_bf16(PAF(2),VFR(6),o[1],0,0,0), C1,4); \
    GAPB(o[0]=__builtin_amdgcn_mfma_f32_32x32x16_bf16(PAF(3),VFR(3),o[0],0,0,0), C1,8); \
    GAPB(o[1]=__builtin_amdgcn_mfma_f32_32x32x16_bf16(PAF(3),VFR(7),o[1],0,0,0), C1,12); \
    }while(0)
  int t=1;
  #undef CMASK
  #define CMASK(P0,P1,t) do{}while(0)
  for(;t+5<NT;t+=2){
    STEP(pB0,pB1,pA0,pA1,t,true,true,true);     WAIT_BAR(2); RESC(); ROT();
    STEP(pA0,pA1,pB0,pB1,t+1,true,true,true);   WAIT_BAR(2); RESC(); ROT();
  }
  #undef CMASK
  #define CMASK(P0,P1,t) do{int jb_=(t)-(NT-4); if(jb_>=0)cmask(P0,P1,jb_,qrel,hi);}while(0)
  #define ENDW(tt) do{ if((tt)+3<NT){WAIT_BAR(2);} else if((tt)+2<NT){WAIT_BAR(1);} else {WAIT_BAR(0);} }while(0)
  for(;t+1<NT;t+=2){
    STEP(pB0,pB1,pA0,pA1,t,(t+3<NT),(t+1<NT),(t+1<NT));       ENDW(t);   RESC(); ROT();
    STEP(pA0,pA1,pB0,pB1,t+1,(t+4<NT),(t+2<NT),(t+2<NT));     ENDW(t+1); RESC(); ROT();
  }
  STEP(pB0,pB1,pA0,pA1,NT-1,false,false,false); RESC();
  { float sacc=pB0[0]+pB0[1]; _Pragma("unroll") for(int r=2;r<16;++r)sacc+=pB0[r]; _Pragma("unroll") for(int r=0;r<16;++r)sacc+=pB1[r]; l_reg+=sacc;
    pw0=(u32x4){PKW(pB0,0),PKW(pB0,2),PKW(pB0,4),PKW(pB0,6)};pw1=(u32x4){PKW(pB0,8),PKW(pB0,10),PKW(pB0,12),PKW(pB0,14)};pw2=(u32x4){PKW(pB1,0),PKW(pB1,2),PKW(pB1,4),PKW(pB1,6)};pw3=(u32x4){PKW(pB1,8),PKW(pB1,10),PKW(pB1,12),PKW(pB1,14)};
    SBAR(); pv(o,vb0+sl_cur,PAF(0),PAF(1),PAF(2),PAF(3)); }
  #undef PKW
  #undef PAF
  #undef VFR
  #undef PIN
  #undef MX3
  #undef GAPA
  #undef GAPB
  #undef EX
  #undef VRD
  #undef KRD
  #undef STEP
  #undef ENDW
  {auto rr=__builtin_amdgcn_permlane32_swap(__float_as_uint(l_reg),__float_as_uint(l_reg),false,false);l_reg=__uint_as_float(rr[0])+__uint_as_float(rr[1]);}
  if(hi==0)wsf[32+r32]=l_reg;asm volatile("s_waitcnt lgkmcnt(0)":::"memory");
  float rli[16];
  #pragma unroll
  for(int r=0;r<16;++r)rli[r]=__builtin_amdgcn_rcpf(wsf[32+crow(r,hi)]);
  bf16*Ow=(bf16*)(Tb+(size_t)qb*TILE_BYTES+T_Y)+(long)(wid*QBLK)*QP+h*D+ocol;
  float*ssw=ssa+(rowbase+q0+wid*QBLK)*8+h;
  { bf16*stg=(bf16*)(shm+LDS_OST)+wid*2048;
    #pragma unroll
    for(int r=0;r<16;++r){const int orow=crow(r,hi);
      #pragma unroll
      for(int d0=0;d0<2;++d0)stg[orow*64+d0*32+r32]=__float2bfloat16(o[d0][r]*rli[r]);}
    asm volatile("s_waitcnt lgkmcnt(0)":::"memory");
    #pragma unroll
    for(int i=0;i<4;++i){const int row=i*8+(lane>>3),ch=lane&7; const u32x4 v=*(const u32x4*)(stg+row*64+ch*8); *(u32x4*)(Ow+(long)row*QP+ch*8)=v;
      float q=0.f;
      #pragma unroll
      for(int e=0;e<4;++e){const float lo=__uint_as_float(v[e]<<16),hi2=__uint_as_float(v[e]&0xffff0000u); q+=lo*lo+hi2*hi2;}
      q+=swz_xor<1>(q);q+=swz_xor<2>(q);q+=swz_xor<4>(q);
      if(ch==0)ssw[row*8]=q;} }
  asm volatile("s_waitcnt lgkmcnt(0)\n\ts_barrier":::"memory");
  #undef DMA_K
  #undef DMA_V
  #undef KVOFF
  #undef CMASK
  #undef ADDB
  #undef START
  #undef RESC
  #undef ROT
}
#undef SBAR
#undef WAIT_BAR

constexpr int CONV_W=31, CONV_C=512, CONV_TOK=32, CONV_ROWS=CONV_TOK+CONV_W-1, CONV_LDS_W=0, CONV_LDS_U=CONV_W*CONV_C*4;
__device__ __forceinline__ float wsum64(float v){ return wave_sum64(v); }
__device__ __forceinline__ void conv_stage_w(const float*cw,char*shm,const int tid){
  ATT_LAS u32x4*LW=(ATT_LAS u32x4*)(shm+CONV_LDS_W); const u32x4*src=(const u32x4*)cw;
  u32x4 v[8];
  #pragma unroll
  for(int i=0;i<8;++i){const int idx=tid+i*512; v[i]=(idx<CONV_W*CONV_C/4)?src[idx]:(u32x4){0u,0u,0u,0u};}
  #pragma unroll
  for(int i=0;i<8;++i){const int idx=tid+i*512; if(idx<CONV_W*CONV_C/4)LW[idx]=v[i];}
  __syncthreads();
}
__device__ __forceinline__ void conv_unit(int unit,const unsigned char*R1,const float*cbias,const float*lng,const float*lnb,char*shm,const int tid){
  const int lane=tid&63,wid=tid>>6;
  const int b=unit>>6,t0=(unit&63)*CONV_TOK;
  const unsigned char*Tb=R1+(size_t)(8*b)*TILE_BYTES;
  ATT_LAS u32x4*L=(ATT_LAS u32x4*)(shm+CONV_LDS_U);
  const ATT_LAS f32x4_t*LW=(const ATT_LAS f32x4_t*)(shm+CONV_LDS_W);
  { u32x4 v[8];
    #pragma unroll
    for(int i=0;i<8;++i){const int idx=tid+i*512,row=idx>>6,ch=idx&63,t=t0-(CONV_W-1)+row;
      v[i]=(u32x4){0u,0u,0u,0u};
      if(idx<CONV_ROWS*64&&t>=0)v[i]=*(const u32x4*)((const bf16*)(Tb+(size_t)(t>>8)*TILE_BYTES+T_U)+(size_t)(t&255)*CONV_C+ch*8);}
    #pragma unroll
    for(int i=0;i<8;++i){const int idx=tid+i*512; if(idx<CONV_ROWS*64)L[idx]=v[i];} }
  __syncthreads();
  float acc[4][8];
  { const f32x4_t b0=*(const f32x4_t*)(cbias+8*lane),b1=*(const f32x4_t*)(cbias+8*lane+4);
    #pragma unroll
    for(int tt=0;tt<4;++tt){acc[tt][0]=b0[0];acc[tt][1]=b0[1];acc[tt][2]=b0[2];acc[tt][3]=b0[3];acc[tt][4]=b1[0];acc[tt][5]=b1[1];acc[tt][6]=b1[2];acc[tt][7]=b1[3];} }
  #pragma unroll 4
  for(int j=0;j<CONV_W;++j){
    const f32x4_t w0=LW[j*128+2*lane],w1=LW[j*128+2*lane+1];
    #pragma unroll
    for(int tt=0;tt<4;++tt){
      const u32x4 u=L[(wid*4+tt+j)*64+lane];
      acc[tt][0]+=w0[0]*__uint_as_float(u[0]<<16); acc[tt][1]+=w0[1]*__uint_as_float(u[0]&0xffff0000u);
      acc[tt][2]+=w0[2]*__uint_as_float(u[1]<<16); acc[tt][3]+=w0[3]*__uint_as_float(u[1]&0xffff0000u);
      acc[tt][4]+=w1[0]*__uint_as_float(u[2]<<16); acc[tt][5]+=w1[1]*__uint_as_float(u[2]&0xffff0000u);
      acc[tt][6]+=w1[2]*__uint_as_float(u[3]<<16); acc[tt][7]+=w1[3]*__uint_as_float(u[3]&0xffff0000u);
    }
  }
  const f32x4_t g0=*(const f32x4_t*)(lng+8*lane),g1=*(const f32x4_t*)(lng+8*lane+4),e0=*(const f32x4_t*)(lnb+8*lane),e1=*(const f32x4_t*)(lnb+8*lane+4);
  const float gg[8]={g0[0],g0[1],g0[2],g0[3],g1[0],g1[1],g1[2],g1[3]},bb[8]={e0[0],e0[1],e0[2],e0[3],e1[0],e1[1],e1[2],e1[3]};
  float mu[4],rstd[4],r2[4];
  #pragma unroll
  for(int tt=0;tt<4;++tt){ float s=0.f;
    #pragma unroll
    for(int e=0;e<8;++e)s+=acc[tt][e];
    mu[tt]=s; }
  #pragma unroll
  for(int tt=0;tt<4;++tt)mu[tt]=wsum64(mu[tt])*(1.0f/CONV_C);
  #pragma unroll
  for(int tt=0;tt<4;++tt){ float q=0.f;
    #pragma unroll
    for(int e=0;e<8;++e){acc[tt][e]-=mu[tt];q+=acc[tt][e]*acc[tt][e];}
    rstd[tt]=q; }
  #pragma unroll
  for(int tt=0;tt<4;++tt)rstd[tt]=__builtin_amdgcn_rsqf(wsum64(rstd[tt])*(1.0f/CONV_C)+1e-6f);
  #pragma unroll
  for(int tt=0;tt<4;++tt){ float q2=0.f;
    #pragma unroll
    for(int e=0;e<8;++e){float y=acc[tt][e]*rstd[tt]*gg[e]+bb[e]; y=y*__builtin_amdgcn_rcpf(1.0f+__builtin_amdgcn_exp2f(-y*1.4426950408889634f)); acc[tt][e]=y;q2+=y*y;}
    r2[tt]=q2; }
  #pragma unroll
  for(int tt=0;tt<4;++tt)r2[tt]=__builtin_amdgcn_rsqf(wsum64(r2[tt])*(1.0f/CONV_C)+1e-6f);
  #pragma unroll
  for(int tt=0;tt<4;++tt){
    u32x4 w; const float r=r2[tt];
    w[0]=cvtpk_s(acc[tt][0]*r,acc[tt][1]*r);w[1]=cvtpk_s(acc[tt][2]*r,acc[tt][3]*r);w[2]=cvtpk_s(acc[tt][4]*r,acc[tt][5]*r);w[3]=cvtpk_s(acc[tt][6]*r,acc[tt][7]*r);
    { const int t=t0+wid*4+tt; *(u32x4*)((bf16*)(Tb+(size_t)(t>>8)*TILE_BYTES+T_Y)+(size_t)(t&255)*QP+CONV_C+8*lane)=w; }
  }
  __syncthreads();
}
}
constexpr int NWAVES = 8;
constexpr int M = 16384, DM = 1024, DFF = 2816, SEQ = 2048, NBATCH = 8, NMEMROWS = 2048, NLAYER = 2;
constexpr size_t MiB = 1u << 20;
constexpr size_t WS_CTL = 0, CTL_ZERO_BYTES = 256 * 1024;
constexpr size_t WS_W = 2 * MiB;
constexpr size_t W_LAYER = 97 * MiB / 2;
constexpr size_t WO_1A = 0, WO_1B = 11 * MiB, WO_IN = WO_1B + 11 * MiB / 2, WO_OUT = WO_IN + 11 * MiB / 2, WO_XQ = WO_OUT + 2 * MiB, WO_XKV = WO_XQ + 2 * MiB, WO_XO = WO_XKV + 4 * MiB,
                 WO_2A = WO_XO + 2 * MiB, WO_2B = WO_2A + 11 * MiB;
static_assert(WO_2B + 11 * MiB / 2 == W_LAYER, "weight map");
constexpr size_t WS_XB = 100 * MiB;
constexpr size_t WS_MKV = 132 * MiB;
constexpr size_t WS_MEMB = 148 * MiB;
constexpr size_t WS_R1 = 152 * MiB;
constexpr size_t DOUT_WQK = 0, DOUT_WVO = 2 * MiB, DOUT_BATCH = 8 * MiB;
constexpr size_t WS_SSP = 99 * MiB;
constexpr size_t WS_DUMMY = 248 * MiB, WS_SSA = 249 * MiB;
constexpr size_t WS_END = 250 * MiB;
constexpr int CW_BAR = 4096;
constexpr int CW_QUAD = 16384;
constexpr size_t CTL_SSM = 256 * 1024;
constexpr int RING_OFF = 0, RING_BYTES = 131072;
constexpr int EPI_SCR_OFF = RING_BYTES;
constexpr int LDSCTL_OFF = RING_BYTES + 8192, MISC_OFF = LDSCTL_OFF + 320;
constexpr int LDS_BYTES = 147456;
static_assert(MISC_OFF + 128 <= LDS_BYTES, "LDS map");

#define GAS __attribute__((address_space(1)))
#define LAS __attribute__((address_space(3)))
typedef unsigned short bf16;
typedef unsigned v4u __attribute__((ext_vector_type(4)));
typedef float f32x4 __attribute__((ext_vector_type(4)));
typedef GAS unsigned gu32;
#define RLX_AGENT __ATOMIC_RELAXED, __HIP_MEMORY_SCOPE_AGENT
#define LDS_WAIT() asm volatile("s_waitcnt lgkmcnt(0)" ::: "memory")
__device__ __forceinline__ unsigned f2bf(float f) { unsigned u = __builtin_bit_cast(unsigned, f); return (u + 0x7fffu + ((u >> 16) & 1u)) >> 16; }
__device__ __forceinline__ unsigned pk2(float lo, float hi) { return f2bf(lo) | (f2bf(hi) << 16); }

#define XB_TMO      128
#define XB_XCNT(j)  (256  + 64 * (j))
#define XB_XSUB(j)  (1280 + 64 * (j))
#define XB_XGEN(j)  (2304 + 64 * (j))
#define XB_TOP      3328
#define XB_TOPGEN   3392
#define XCD_BAR_WORDS 3456
#define XB_SPIN_CAP (1u << 18)
__device__ __forceinline__ unsigned xb_ld(unsigned* p)              { return __hip_atomic_load(p, __ATOMIC_RELAXED, __HIP_MEMORY_SCOPE_AGENT); }
__device__ __forceinline__ unsigned xb_add(unsigned* p, unsigned v) { return __hip_atomic_fetch_add(p, v, __ATOMIC_RELAXED, __HIP_MEMORY_SCOPE_AGENT); }
__device__ __forceinline__ unsigned xb_xcc_id() { return (unsigned)__builtin_amdgcn_s_getreg((3 << 11) | 20) & 0xFu; }
#define XB_SPIN(cond, bar) do { unsigned _sp = 0; while (cond) { __builtin_amdgcn_s_sleep(1); \
    if ((++_sp & 255u) == 0u) { if (xb_ld(&(bar)[XB_TMO])) break; if (_sp > XB_SPIN_CAP) { atomicAdd(&(bar)[XB_TMO], 1u); break; } } } } while (0)
struct XcdBarrier { unsigned* bar; unsigned x; volatile LAS unsigned* st; };
__device__ __forceinline__ XcdBarrier xcd_barrier_post(unsigned* bar, volatile LAS unsigned* st) {
    XcdBarrier b; b.bar = bar; b.x = xb_xcc_id(); b.st = st;
    if (threadIdx.x == 0) { const unsigned rank = xb_add(&bar[XB_XCNT(b.x)], 1u); st[2] = b.x; st[3] = rank; }
    return b;
}
__device__ __forceinline__ void xcd_barrier_complete(unsigned* bar, unsigned x, unsigned& nloc, unsigned& nx) {
    const unsigned G = gridDim.x * gridDim.y * gridDim.z;
    unsigned sum, cnt, mine, sp = 0u;
    for (;;) {
        sum = 0u; cnt = 0u; mine = 0u;
#pragma unroll
        for (unsigned j = 0; j < 16; ++j) { const unsigned c = xb_ld(&bar[XB_XCNT(j)]); sum += c; cnt += (c > 0u) ? 1u : 0u; mine = (j == x) ? c : mine; }
        if (sum == G) break;
        __builtin_amdgcn_s_sleep(1);
        if ((++sp & 255u) == 0u) { if (xb_ld(&bar[XB_TMO])) break; if (sp > XB_SPIN_CAP) { atomicAdd(&bar[XB_TMO], 1u); break; } }
    }
    nloc = mine > 0u ? mine : 1u; nx = cnt > 0u ? cnt : 1u;
}
__device__ __forceinline__ void xcd_barrier(const XcdBarrier& b) {
    asm volatile("s_waitcnt vmcnt(0)" ::: "memory");
    __syncthreads();
    if (threadIdx.x == 0) {
        unsigned* bar = b.bar;
        __builtin_amdgcn_s_waitcnt(0);
        unsigned nloc = b.st[0], nx = b.st[1];
        if (nloc == 0u) { xcd_barrier_complete(bar, b.x, nloc, nx); b.st[0] = nloc; b.st[1] = nx; }
        const unsigned old = xb_add(&bar[XB_XSUB(b.x)], 1u);
        const unsigned gen = old / nloc;
        if (old + 1u == (gen + 1u) * nloc) {
            __builtin_amdgcn_fence(__ATOMIC_RELEASE, "agent");
            asm volatile("s_waitcnt vmcnt(0)" ::: "memory");
            const unsigned og = xb_add(&bar[XB_TOP], 1u);
            const unsigned tg = og / nx;
            if (og + 1u == (tg + 1u) * nx) xb_add(&bar[XB_TOPGEN], 1u);
            else XB_SPIN(xb_ld(&bar[XB_TOPGEN]) == tg, bar);
            __builtin_amdgcn_fence(__ATOMIC_ACQUIRE, "agent");
            xb_add(&bar[XB_XGEN(b.x)], 1u);
            asm volatile("s_waitcnt vmcnt(0)" ::: "memory");
        } else {
            XB_SPIN(xb_ld(&bar[XB_XGEN(b.x)]) == gen, bar);
            __builtin_amdgcn_fence(__ATOMIC_ACQUIRE, "agent");
            asm volatile("s_waitcnt vmcnt(0)" ::: "memory");
        }
    }
    __syncthreads();
}

__device__ __forceinline__ void xcd_local_barrier(unsigned* bar, unsigned x) {
    asm volatile("s_waitcnt vmcnt(0)" ::: "memory");
    __syncthreads();
    if (threadIdx.x == 0) {
        __builtin_amdgcn_s_waitcnt(0);
        const unsigned old = xb_add(&bar[XB_XSUB(x)], 1u), gen = old / 32u;
        if (old + 1u == (gen + 1u) * 32u) xb_add(&bar[XB_XGEN(x)], 1u);
        else XB_SPIN(xb_ld(&bar[XB_XGEN(x)]) == gen, bar);
        __builtin_amdgcn_fence(__ATOMIC_ACQUIRE, "agent");
        asm volatile("s_waitcnt vmcnt(0)" ::: "memory");
    }
    __syncthreads();
}
__device__ __forceinline__ void quad_barrier(unsigned* bar, unsigned* qw) {
    asm volatile("s_waitcnt vmcnt(0)" ::: "memory");
    __syncthreads();
    if (threadIdx.x == 0) {
        __builtin_amdgcn_s_waitcnt(0);
        const unsigned old = xb_add(&qw[0], 1u), gen = old / 4u;
        if (old + 1u == (gen + 1u) * 4u) xb_add(&qw[64], 1u);
        else XB_SPIN(xb_ld(&qw[64]) == gen, bar);
        __builtin_amdgcn_fence(__ATOMIC_ACQUIRE, "agent");
        asm volatile("s_waitcnt vmcnt(0)" ::: "memory");
    }
    __syncthreads();
}

__device__ __forceinline__ float wave_sum(float v) { return wave_sum64(v); }
__device__ __forceinline__ void tr_item(const float* W, int ldw, int col0, int nvalid, int k0, const float* gain, int gsplit, const float* gain2, bf16* WT, int ldt, int drow0, LAS float* scr, int lane) {
#pragma unroll 8
    for (int i = 0; i < 32; ++i) { const int kk = 2 * i + (lane >> 5), n = lane & 31, k = k0 + kk;
        float v = (n < nvalid) ? W[(size_t)k * ldw + col0 + n] : 0.f;
        if (gain) v *= (k < gsplit ? gain[k] : gain2[k - gsplit]);
        scr[kk * 33 + n] = v; }
    LDS_WAIT(); asm volatile("" ::: "memory");
    const int c = lane & 7;
#pragma unroll
    for (int j = 0; j < 4; ++j) { const int n = (lane >> 3) + 8 * j; const LAS float* s = scr + (8 * c) * 33 + n;
        v4u o; o.x = pk2(s[0 * 33], s[1 * 33]); o.y = pk2(s[2 * 33], s[3 * 33]); o.z = pk2(s[4 * 33], s[5 * 33]); o.w = pk2(s[6 * 33], s[7 * 33]);
        *(GAS v4u*)(WT + (size_t)(drow0 + n) * ldt + k0 + 8 * c) = o; }
    LDS_WAIT(); asm volatile("" ::: "memory");
}
__device__ __forceinline__ void tr_item64(const float* W, int ldw, int col0, int nvalid, int k0, const float* gain, int gsplit, const float* gain2, bf16* WT, int ldt, int drow0, int lane) {
    float v[64];
    const float* src = W + (size_t)k0 * ldw + col0 + lane; const bool ok = lane < nvalid;
#pragma unroll
    for (int j = 0; j < 64; ++j) v[j] = ok ? __builtin_nontemporal_load(src + (size_t)j * ldw) : 0.f;
    if (gain) {
#pragma unroll
        for (int j = 0; j < 64; ++j) { const int k = k0 + j; v[j] *= (k < gsplit ? gain[k] : gain2[k - gsplit]); }
    }
    bf16* dst = WT + (size_t)(drow0 + lane) * ldt + k0;
#pragma unroll
    for (int c = 0; c < 8; ++c) { v4u o; o.x = pk2(v[8 * c], v[8 * c + 1]); o.y = pk2(v[8 * c + 2], v[8 * c + 3]); o.z = pk2(v[8 * c + 4], v[8 * c + 5]); o.w = pk2(v[8 * c + 6], v[8 * c + 7]);
        *(GAS v4u*)(dst + 8 * c) = o; }
}
__device__ __forceinline__ void row_to_bf16(const float* xrow, bf16* orow, float* ssp, int lane) {
    const GAS f32x4* xr = (const GAS f32x4*)xrow + lane;
    f32x4 v[4]; float s = 0.f;
#pragma unroll
    for (int j = 0; j < 4; ++j) { v[j] = xr[64 * j]; s += (v[j].x * v[j].x + v[j].y * v[j].y) + (v[j].z * v[j].z + v[j].w * v[j].w); }
    s = wave_sum(s);
    GAS unsigned long long* o8 = (GAS unsigned long long*)orow + lane;
#pragma unroll
    for (int j = 0; j < 4; ++j) o8[64 * j] = (unsigned long long)pk2(v[j].x, v[j].y) | ((unsigned long long)pk2(v[j].z, v[j].w) << 32);
    if (lane == 0) *ssp = s;
}

struct Args { const float* in[26]; float* out; unsigned char* ws; };

enum { PH_PRO = 0, PH_L0 = 1, PH_PER_LAYER = 9, PH_FINAL = PH_L0 + 2 * PH_PER_LAYER, PH_COUNT = PH_FINAL + 1 };

#define WSP() ({ unsigned char* w_ = args.ws; asm volatile("" : "+s"(w_)); w_; })
#define INP(i) ({ int i_ = __builtin_amdgcn_readfirstlane(i); asm volatile("" : "+s"(i_)); args.in[i_]; })
#define XPTR() ({ float* x_ = args.out; asm volatile("" : "+s"(x_)); x_; })
#define TID() ({ int w_ = wid_s; asm volatile("" : "+s"(w_)); int t_ = (w_ << 6) | (int)__builtin_amdgcn_mbcnt_hi(~0u, __builtin_amdgcn_mbcnt_lo(~0u, 0u)); asm volatile("" : "+v"(t_)); t_; })

constexpr size_t T1K = (size_t)256 * 1024 * 2, TFF = (size_t)256 * 2816 * 2, TLB = pg8::TILE_BYTES;
using G_1024 = pg8::Gemm<1024, 1024, 1024>; using G_down = pg8::Gemm<2816, 2816, 2816>; using G_qk = pg8::Gemm<2048, 1024, 256>; using G_vo = pg8::Gemm<1024, 2048, 256>;
using S_up = pg8::SchedT<0, 64, 22, T1K, T1K>; using S_mkv = pg8::SchedT<4, 8, 8, T1K, T1K>; using S_down = pg8::SchedT<0, 64, 4, TLB, TFF>; using S_win = pg8::SchedT<0, 64, 11, T1K, T1K>;
using S_wout = pg8::SchedT<0, 64, 4, TLB, T1K>; using S_xs = pg8::SchedT<1, 64, 4, T1K, T1K, DOUT_BATCH>; using S_xpv = pg8::SchedT<1, 64, 4, TLB, T1K, DOUT_BATCH>;
using S_qk = pg8::SchedT<2, 128, 1, 0, 0>; using S_vo = pg8::SchedT<3, 128, 1, 0, 0>;

#ifndef PROBE_MASK
#define PROBE_MASK 0
#endif
#ifndef PROBE_REPS
#define PROBE_REPS 1
#endif
#ifndef PROBE_BARS
#define PROBE_BARS 0
#endif
#ifndef PROBE_NOATT
#define PROBE_NOATT 0
#endif
#ifndef PROBE_NOCONV
#define PROBE_NOCONV 0
#endif
#ifndef FORCE_GLOBAL
#define FORCE_GLOBAL 0
#endif
#define NREP(k) (((PROBE_MASK >> (k)) & 1) ? (PROBE_REPS + 1) : 1)
#define REP_LOOP(k) _Pragma("unroll 1") for (int rep_ = 0; rep_ < NREP(k); ++rep_)
#define SHADOW(k) (NREP(k) > 1 && rep_ + 1 < NREP(k))
#define REP_SEAM(k) do { if (SHADOW(k)) GRIDBAR(); } while (0)

#define WSP() ({ unsigned char* w_ = args.ws; asm volatile("" : "+s"(w_)); w_; })
#define INP(i) ({ int i_ = __builtin_amdgcn_readfirstlane(i); asm volatile("" : "+s"(i_)); args.in[i_]; })
#define XPTR() ({ float* x_ = args.out; asm volatile("" : "+s"(x_)); x_; })
#define TID() ({ int w_ = wid_s; asm volatile("" : "+s"(w_)); int t_ = (w_ << 6) | (int)__builtin_amdgcn_mbcnt_hi(~0u, __builtin_amdgcn_mbcnt_lo(~0u, 0u)); asm volatile("" : "+v"(t_)); t_; })
#define MISCW(k) (*({ unsigned o_ = MISC_OFF + 4 * (k); asm volatile("" : "+s"(o_)); (volatile LAS unsigned*)(ldsp + o_); }))
#define BXP() ((int)__builtin_amdgcn_readfirstlane((int)MISCW(13)))
#define BARW() ((unsigned*)(WSP() + WS_CTL) + CW_BAR)
#define GRIDBAR() do { XcdBarrier bar_; bar_.bar = BARW(); bar_.x = xb_xcc_id(); bar_.st = &MISCW(8); xcd_barrier(bar_); } while (0)
#define XCDBAR() do { if (MISCW(12)) xcd_local_barrier(BARW(), MISCW(10)); else GRIDBAR(); } while (0)
#define QUADBAR() do { if (MISCW(12)) { unsigned* bw_ = BARW(); quad_barrier(bw_, bw_ - CW_BAR + CW_QUAD + 128 * (MISCW(10) * 8 + (MISCW(11) & 7))); } else GRIDBAR(); } while (0)

__global__ void __launch_bounds__(NWAVES * 64, 2) mega_fwd(Args args) {
    extern __shared__ __attribute__((aligned(16))) unsigned char lds[];
    LAS unsigned char* ldsp = (LAS unsigned char*)lds;
    volatile LAS unsigned* MISC = (volatile LAS unsigned*)(ldsp + MISC_OFF);
    constexpr int G = 256; const int bx = blockIdx.x;
    const int wid_s = __builtin_amdgcn_readfirstlane(threadIdx.x >> 6);
    for (int u = threadIdx.x; u < (LDS_BYTES - LDSCTL_OFF) / 4; u += NWAVES * 64) ((LAS unsigned*)(ldsp + LDSCTL_OFF))[u] = 0u;
    __syncthreads();
    (void)xcd_barrier_post((unsigned*)(args.ws + WS_CTL) + CW_BAR, MISC + 8);
    constexpr float QSCALE = 0.125f * 1.4426950408889634f, XSCALE = 0.0625f * 1.4426950408889634f;

    REP_LOOP(9) {
        unsigned char* ws = WSP(); const int tid = TID();
        const int lane = tid & 63, wave = __builtin_amdgcn_readfirstlane(tid >> 6);
        const int gw = bx * NWAVES + wave, NGW = G * NWAVES;
        constexpr int I_GU = 2 * 16 * 44, I_DN = 44 * 16, I_IN = 16 * 41, I_SQ = 16 * 16, I_KV = 16 * 32, I_WQ = 256;
        constexpr int L_ITEMS = 2 * (I_GU + I_DN) + I_IN + I_SQ + I_KV + I_SQ + I_WQ, W_ITEMS = NLAYER * L_ITEMS, X_ITEMS = M / 4, MEM_ITEMS = NMEMROWS / 4;
#pragma unroll 1
        for (int it = gw; it < W_ITEMS + X_ITEMS + MEM_ITEMS; it += NGW) {
            if (it < W_ITEMS) {
                const int l = it / L_ITEMS; int r = it % L_ITEMS;
                unsigned char* wl = ws + WS_W + (size_t)l * W_LAYER;
                if (r < 2 * (I_GU + I_DN)) {
                    const int f = r / (I_GU + I_DN); r %= (I_GU + I_DN);
                    if (r < I_GU) { const int which = r / (16 * 44), q = r % (16 * 44), kb = q / 44, nb = q % 44, j0 = nb * 64;
                        const float* w = INP(which ? (f ? 23 : 4) : (f ? 22 : 3)) + (size_t)l * DM * DFF; const float* gn = INP(f ? 21 : 2) + l * DM;
                        tr_item64(w, DFF, j0, 64, kb * 64, gn, 1 << 30, gn, (bf16*)(wl + (f ? WO_2A : WO_1A)), DM, 256 * (j0 / 128) + which * 128 + (j0 % 128), lane); }
                    else { r -= I_GU; const int kb = r / 16, nb = r % 16; const float* w = INP(f ? 24 : 5) + (size_t)l * DFF * DM;
                        tr_item64(w, DM, nb * 64, 64, kb * 64, nullptr, 0, w, (bf16*)(wl + (f ? WO_2B : WO_1B)), DFF, nb * 64, lane); }
                    continue;
                }
                r -= 2 * (I_GU + I_DN);
                if (r < I_IN) {
                    const int kb = r / 41, nb = r % 41; int col0, nvalid = 64, drow0;
                    if (nb < 24) { col0 = nb * 64; drow0 = col0; }
                    else if (nb == 24) { col0 = 1536; nvalid = 8; drow0 = 2560; }
                    else if (nb < 33) { const int ch = (nb - 25) * 64; col0 = 1544 + ch; drow0 = 1536 + 256 * (ch / 128) + (ch % 128); }
                    else { const int ch = (nb - 33) * 64; col0 = 2056 + ch; drow0 = 1536 + 256 * (ch / 128) + 128 + (ch % 128); }
                    const float* w = INP(7) + (size_t)l * DM * 2568; const float* gn = INP(6) + l * DM;
                    tr_item64(w, 2568, col0, nvalid, kb * 64, gn, 1 << 30, gn, (bf16*)(wl + WO_IN), DM, drow0, lane); continue; }
                r -= I_IN;
                if (r < I_SQ) { const int kb = r / 16, nb = r % 16; const float* w = INP(15) + (size_t)l * DM * DM;
                    tr_item64(w, DM, nb * 64, 64, kb * 64, INP(13) + l * 512, 512, INP(14) + l * 512, (bf16*)(wl + WO_OUT), DM, nb * 64, lane); continue; }
                r -= I_SQ;
                if (r < I_KV) { const int kb = r / 32, nb = r % 32; const float* w = INP(19) + (size_t)l * DM * 2048; const float* gn = INP(17) + l * DM;
                    tr_item64(w, 2048, nb * 64, 64, kb * 64, gn, 1 << 30, gn, (bf16*)(wl + WO_XKV), DM, nb * 64, lane); continue; }
                r -= I_KV;
                if (r < I_SQ) { const int kb = r / 16, nb = r % 16; const float* w = INP(20) + (size_t)l * DM * DM;
                    tr_item64(w, DM, nb * 64, 64, kb * 64, nullptr, 0, w, (bf16*)(wl + WO_XO), DM, nb * 64, lane); continue; }
                r -= I_SQ;
                { const float* w = INP(18) + (size_t)l * DM * DM; const float* gn = INP(16) + l * DM; bf16* WQ = (bf16*)(wl + WO_XQ);
                  f32x4 v[4][4];
#pragma unroll
                  for (int q = 0; q < 4; ++q)
#pragma unroll
                      for (int j = 0; j < 4; ++j) v[q][j] = __builtin_nontemporal_load((const GAS f32x4*)(w + (size_t)(4 * r + q) * DM) + lane + 64 * j);
#pragma unroll
                  for (int q = 0; q < 4; ++q) { const float g = gn[4 * r + q] * XSCALE; GAS unsigned long long* o8 = (GAS unsigned long long*)(WQ + (size_t)(4 * r + q) * DM) + lane;
#pragma unroll
                      for (int j = 0; j < 4; ++j) { const f32x4 t = v[q][j] * g; o8[64 * j] = (unsigned long long)pk2(t.x, t.y) | ((unsigned long long)pk2(t.z, t.w) << 32); } } }
            } else {
                int r = it - W_ITEMS; const bool ismem = r >= X_ITEMS; if (ismem) r -= X_ITEMS;
                const float* src = INP(ismem ? 1 : 0) + (size_t)(4 * r) * DM; bf16* dst = (bf16*)(ws + (ismem ? WS_MEMB : WS_XB)) + (size_t)(4 * r) * DM; float* ssp = ismem ? (float*)(ws + CTL_SSM) + 4 * r : (float*)(ws + WS_SSP) + (size_t)(4 * r) * 16;
                f32x4 v[4][4]; float s[4];
#pragma unroll
                for (int q = 0; q < 4; ++q)
#pragma unroll
                    for (int j = 0; j < 4; ++j) v[q][j] = __builtin_nontemporal_load((const GAS f32x4*)(src + (size_t)q * DM) + lane + 64 * j);
#pragma unroll
                for (int q = 0; q < 4; ++q) { s[q] = 0.f;
#pragma unroll
                    for (int j = 0; j < 4; ++j) s[q] += (v[q][j].x * v[q][j].x + v[q][j].y * v[q][j].y) + (v[q][j].z * v[q][j].z + v[q][j].w * v[q][j].w); }
#pragma unroll
                for (int q = 0; q < 4; ++q) { s[q] = wave_sum64(s[q]); GAS unsigned long long* o8 = (GAS unsigned long long*)(dst + (size_t)q * DM) + lane;
#pragma unroll
                    for (int j = 0; j < 4; ++j) o8[64 * j] = (unsigned long long)pk2(v[q][j].x, v[q][j].y) | ((unsigned long long)pk2(v[q][j].z, v[q][j].w) << 32);
                    if (ismem) { if (lane == 0) ssp[q] = s[q]; } else if (lane < 16) ssp[q * 16 + lane] = (lane == 0) ? s[q] : 0.f; }
            }
        }
        REP_SEAM(9);
    }
    GRIDBAR();
    if (threadIdx.x == 0) {
        unsigned* bw = BARW(); bool ok = !FORCE_GLOBAL;
        for (int j = 0; j < 16; ++j) ok = ok && (xb_ld(&bw[XB_XCNT(j)]) == (j < 8 ? 32u : 0u));
        MISCW(12) = ok ? 1u : 0u; MISCW(13) = ok ? (MISCW(11) * 8u + MISCW(10)) : (unsigned)bx;
    }
    __syncthreads();

#pragma unroll 1
    for (int l = 0; l < NLAYER; ++l) {
#pragma unroll 1
        for (int f = 0; f < 2; ++f) {
            REP_LOOP(0) {
                unsigned char* ws = WSP(); unsigned char* wl = ws + WS_W + (size_t)l * W_LAYER; const int bxp = BXP();
                G_1024 g; S_up S; S.init(bxp, ws + WS_XB, wl + (f ? WO_2A : WO_1A));
                pg8::EpiSwiGLU E{(bf16*)(ws + WS_R1), (float*)(ws + WS_SSP)};
                pg8::gemm_phase<pg8::EpiSwiGLU, decltype(S), decltype(g)>(ldsp + RING_OFF, g, S, E, TID());
                if (l == 0 && f == 0) {
#pragma unroll 1
                    for (int l2 = 0; l2 < NLAYER; ++l2) {
                        unsigned char* ws2 = WSP();
                        S_mkv S2; S2.init(bxp - 128 - 64 * l2, ws2 + WS_MEMB, ws2 + WS_W + (size_t)l2 * W_LAYER + WO_XKV);
                        pg8::EpiRowScale E2{(bf16*)(ws2 + WS_MKV) + (size_t)l2 * 2048 * 2048, (float*)(ws2 + CTL_SSM), 1.0f};
                        pg8::gemm_phase<pg8::EpiRowScale, decltype(S2), decltype(g)>(ldsp + RING_OFF, g, S2, E2, TID());
                    }
                }
                REP_SEAM(0);
            }
            QUADBAR();
            REP_LOOP(1) {
                unsigned char* ws = WSP(); unsigned char* wl = ws + WS_W + (size_t)l * W_LAYER;
                G_down g; S_down S; S.init(BXP(), ws + WS_R1, wl + (f ? WO_2B : WO_1B));
                pg8::EpiResid<0> E{(l == 0 && f == 0) ? INP(0) : (const float*)nullptr, nullptr, (bf16*)(ws + WS_XB), SHADOW(1) ? (float*)(ws + WS_DUMMY) : (float*)(ws + WS_SSP), nullptr, SHADOW(1) ? 0.f : 0.5f};
                E.shadow_skip = SHADOW(1);
                pg8::gemm_phase<pg8::EpiResid<0>, decltype(S), decltype(g)>(ldsp + RING_OFF, g, S, E, TID());
                REP_SEAM(1);
            }
            if (f == 1) break;
            QUADBAR();
            REP_LOOP(2) {
                unsigned char* ws = WSP(); unsigned char* wl = ws + WS_W + (size_t)l * W_LAYER;
                G_1024 g; S_win S; S.init(BXP(), ws + WS_XB, wl + WO_IN);
                pg8::EpiWin E{ws + WS_R1, (float*)(ws + WS_SSP), INP(8) + l * 8, QSCALE};
                pg8::gemm_phase<pg8::EpiWin, decltype(S), decltype(g)>(ldsp + RING_OFF, g, S, E, TID());
                REP_SEAM(2);
            }
            XCDBAR();
            REP_LOOP(3) {
                unsigned char* ws = WSP(); unsigned char* R1 = ws + WS_R1; const int bxp = BXP();
                char* shm = (char*)lds + RING_OFF;
                const int vcu = (bxp & 7) * 32 + (bxp >> 3);
                const int bh = vcu >> 2, s4 = vcu & 3;
                float* ssa = SHADOW(3) ? (float*)(ws + WS_DUMMY) : (float*)(ws + WS_SSA);
                if (!(SHADOW(3) && PROBE_NOATT)) {
                attn_body::scan_bias(R1, bh >> 3, bh & 7, shm, TID());
#pragma unroll 1
                for (int iu = 0; iu < 2; ++iu) attn_body::attn_unit<60>(bh >> 3, bh & 7, iu ? 7 - s4 : s4, R1, SHADOW(3) ? 512 : 0, ssa, shm, TID());
                __syncthreads();
                }
                if (!(SHADOW(3) && PROBE_NOCONV)) {
                    attn_body::conv_stage_w(INP(9) + (size_t)l * 31 * 512, shm, TID());
#pragma unroll 1
                    for (int iu = 0; iu < 2; ++iu) attn_body::conv_unit(2 * vcu + iu, R1, INP(10) + l * 512, INP(11) + l * 512, INP(12) + l * 512, shm, TID());
                }
                { unsigned char* ws2 = WSP(); unsigned char* wl = ws2 + WS_W + (size_t)l * W_LAYER;
                  G_qk g; S_qk S; S.init(bxp, (bf16*)(ws2 + WS_MKV) + (size_t)l * 2048 * 2048, wl + WO_XQ);
                  pg8::EpiAux E{(bf16*)((unsigned char*)XPTR() + DOUT_WQK), 1.0f};
                  pg8::gemm_phase<pg8::EpiAux, decltype(S), decltype(g)>(ldsp + RING_OFF, g, S, E, TID()); }
                { unsigned char* ws2 = WSP(); unsigned char* wl = ws2 + WS_W + (size_t)l * W_LAYER;
                  G_vo g; S_vo S; S.init(bxp - 128, wl + WO_XO, (bf16*)(ws2 + WS_MKV) + (size_t)l * 2048 * 2048);
                  pg8::EpiAux E{(bf16*)((unsigned char*)XPTR() + DOUT_WVO), 1.0f};
                  pg8::gemm_phase<pg8::EpiAux, decltype(S), decltype(g)>(ldsp + RING_OFF, g, S, E, TID()); }
                REP_SEAM(3);
            }
            XCDBAR();
            REP_LOOP(4) {
                unsigned char* ws = WSP(); unsigned char* wl = ws + WS_W + (size_t)l * W_LAYER;
                G_1024 g; S_wout S; S.init(BXP(), ws + WS_R1 + pg8::T_Y, wl + WO_OUT);
                pg8::EpiResid<8> E{nullptr, nullptr, (bf16*)(ws + WS_XB), SHADOW(4) ? (float*)(ws + WS_DUMMY) : (float*)(ws + WS_SSP), (float*)(ws + WS_SSA), SHADOW(4) ? 0.f : 1.0f};
                pg8::gemm_phase<pg8::EpiResid<8>, decltype(S), decltype(g)>(ldsp + RING_OFF, g, S, E, TID());
                REP_SEAM(4);
            }
            QUADBAR();
            REP_LOOP(5) {
                unsigned char* ws = WSP();
                G_1024 g; S_xs S; S.init(BXP(), ws + WS_XB, (unsigned char*)XPTR() + DOUT_WQK);
                pg8::EpiSoftmax E{ws + WS_R1, (float*)(ws + WS_SSP), (LAS float*)(ldsp + EPI_SCR_OFF)};
                E.shadow_skip = SHADOW(5);
                pg8::gemm_phase<pg8::EpiSoftmax, decltype(S), decltype(g)>(ldsp + RING_OFF, g, S, E, TID());
                REP_SEAM(5);
            }
            QUADBAR();
            REP_LOOP(6) {
                unsigned char* ws = WSP();
                G_1024 g; S_xpv S; S.init(BXP(), ws + WS_R1 + pg8::T_Y, (unsigned char*)XPTR() + DOUT_WVO);
                pg8::EpiResid<0> E{nullptr, nullptr, (bf16*)(ws + WS_XB), SHADOW(6) ? (float*)(ws + WS_DUMMY) : (float*)(ws + WS_SSP), nullptr, SHADOW(6) ? 0.f : 1.0f};
                E.shadow_skip = SHADOW(6);
                pg8::gemm_phase<pg8::EpiResid<0>, decltype(S), decltype(g)>(ldsp + RING_OFF, g, S, E, TID());
                REP_SEAM(6);
            }
            QUADBAR();
        }
        if (l + 1 < NLAYER) QUADBAR();
    }
    XCDBAR();
    for (int eb_ = 0; eb_ < PROBE_BARS; ++eb_) GRIDBAR();
    {
        unsigned char* ws = WSP(); float* X = XPTR(); const int tid = TID(); const int bxp = BXP();
        const int lane = tid & 63, wave = __builtin_amdgcn_readfirstlane(tid >> 6);
        const int row0 = (8 * (bxp & 7) + ((bxp >> 3) & 7)) * 256 + (bxp >> 6) * 64 + wave * 8;
        const float* ssf = (float*)(ws + WS_SSP); const float* gn = INP(25); const bf16* XB = (const bf16*)(ws + WS_XB);
        f32x4 gv[4];
#pragma unroll
        for (int j = 0; j < 4; ++j) gv[j] = *((const GAS f32x4*)gn + lane + 64 * j);
#pragma unroll 2
        for (int r = 0; r < 8; ++r) { const int m = row0 + r; const float rs = pg8::rs_row(ssf, m);
            const GAS unsigned long long* xr = (const GAS unsigned long long*)(XB + (size_t)m * DM) + lane; GAS f32x4* orow = (GAS f32x4*)(X + (size_t)m * DM) + lane;
#pragma unroll
            for (int j = 0; j < 4; ++j) { const unsigned long long w = xr[64 * j]; const unsigned lo = (unsigned)w, hi = (unsigned)(w >> 32);
                f32x4 v = (f32x4){__uint_as_float(lo << 16), __uint_as_float(lo & 0xffff0000u), __uint_as_float(hi << 16), __uint_as_float(hi & 0xffff0000u)};
                orow[64 * j] = v * rs * gv[j]; } }
    }
}

static int g_grid = 0;
static bool mega_setup() {
    if (g_grid) return g_grid > 0;
    int dev = 0, cus = 0, per_cu = 0;
    if (hipGetDevice(&dev) != hipSuccess || hipDeviceGetAttribute(&cus, hipDeviceAttributeMultiprocessorCount, dev) != hipSuccess) { g_grid = -1; return false; }
    if (hipFuncSetAttribute((const void*)mega_fwd, hipFuncAttributeMaxDynamicSharedMemorySize, LDS_BYTES) != hipSuccess) { fprintf(stderr, "hipFuncSetAttribute failed\n"); g_grid = -1; return false; }
    if (hipOccupancyMaxActiveBlocksPerMultiprocessor(&per_cu, (const void*)mega_fwd, NWAVES * 64, LDS_BYTES) != hipSuccess || per_cu < 1) { fprintf(stderr, "occupancy query: %d blocks per CU\n", per_cu); (void)hipGetLastError(); g_grid = -1; return false; }
    g_grid = cus;
    if (g_grid != 256) { fprintf(stderr, "kernel_launch: %d CUs; the phase program is laid out for exactly 256: nothing launched\n", g_grid); g_grid = -1; return false; }
    return true;
}
static void mega_launch(void* const* d_in, void* d_out, void* d_ws, hipStream_t stream) {
    Args a{};
    for (int i = 0; i < 26; ++i) a.in[i] = (const float*)d_in[i];
    a.out = (float*)d_out; a.ws = (unsigned char*)d_ws;
    hipLaunchKernelGGL(mega_fwd, dim3(g_grid), dim3(NWAVES * 64), LDS_BYTES, stream, a);
}
extern "C" void kernel_launch(void* const* d_in, const int* in_sizes, int n_in, void* d_out, int out_size, void* d_ws, size_t ws_size, hipStream_t stream) {
    if (!mega_setup()) return;
    if (ws_size < WS_END) { fprintf(stderr, "kernel_launch: workspace too small (%zu < %zu)\n", ws_size, (size_t)WS_END); return; }
    (void)hipMemsetAsync((char*)d_ws + WS_CTL, 0, CTL_ZERO_BYTES, stream);
    mega_launch(d_in, d_out, d_ws, stream);
}
```

```cpp
#include <hip/hip_runtime.h>
#include <cstdio>
#include <cstdint>
template <int X> __device__ __forceinline__ float swz_xor(float v) { return __int_as_float(__builtin_amdgcn_ds_swizzle(__float_as_int(v), (X << 10) | 0x1f)); }
__device__ __forceinline__ float sum_x32(float v) { auto rr = __builtin_amdgcn_permlane32_swap(__float_as_uint(v), __float_as_uint(v), false, false); return __uint_as_float(rr[0]) + __uint_as_float(rr[1]); }
__device__ __forceinline__ float max_x32(float v) { auto rr = __builtin_amdgcn_permlane32_swap(__float_as_uint(v), __float_as_uint(v), false, false); return fmaxf(__uint_as_float(rr[0]), __uint_as_float(rr[1])); }
__device__ __forceinline__ float wave_sum64(float v) { v += swz_xor<1>(v); v += swz_xor<2>(v); v += swz_xor<4>(v); v += swz_xor<8>(v); v += swz_xor<16>(v); return sum_x32(v); }
namespace pg8 {
#define PG8_LAS __attribute__((address_space(3)))
typedef unsigned short bf16_t;
typedef short bf16x8 __attribute__((ext_vector_type(8)));
typedef float f32x4 __attribute__((ext_vector_type(4)));
typedef float f32x2 __attribute__((ext_vector_type(2)));
typedef unsigned u32x4 __attribute__((ext_vector_type(4)));
constexpr int BM = 256, BK = 64, HALF = 128, HTB = HALF * BK * 2  , STAGE_BYTES = 8 * HTB, NXCD = 8, WGM = 8;

__host__ __device__ __forceinline__ int lds_byte(int r, int c) { const int st = (r >> 4) * 2 + (c >> 5), rr = r & 15, cc = c & 31, ob = rr * 64 + cc * 2; return st * 1024 + (ob ^ (((ob >> 9) & 1) << 5)); }
__host__ __device__ __forceinline__ void stage_rc(int b, int& R, int& C) { const int st = b / 1024, sb = b % 1024, swz = sb ^ (((sb >> 9) & 1) << 5); R = (st >> 1) * 16 + swz / 64; C = (st & 1) * 32 + (swz % 64) / 2; }
__host__ __device__ __forceinline__ int perm32(int rho) { const int n = rho >> 4, i = rho & 15; return 8 * (i >> 2) + 4 * n + (i & 3); }

struct Unit { int pm, pn; const char* a; const char* b; int aux; };
template <int LDA, int LDB, int K_> struct Gemm { static constexpr int lda = LDA, ldb = LDB, K = K_; };

__device__ __forceinline__ unsigned cvt_pk_bf16(float lo, float hi) { unsigned r; asm volatile("v_cvt_pk_bf16_f32 %0, %1, %2" : "=v"(r) : "v"(lo), "v"(hi)); return r; }


template <class Epi, class Sched, class Gemm, bool ALIGN_EPI = true, bool SP2 = true>
__device__ __forceinline__ void gemm_phase(PG8_LAS unsigned char* lds, const Gemm g, const Sched& S, const Epi& E, const int tid) {
    const int wid = __builtin_amdgcn_readfirstlane(tid >> 6), lane = tid & 63, wr = wid >> 2, wc = wid & 3, fr = lane & 15, fq = lane >> 4;
    constexpr int K = Gemm::K, nt = K / BK;
    unsigned voffA[2], voffB[2];
#pragma unroll
    for (int i = 0; i < 2; ++i) { int R, C; stage_rc(tid * 16 + i * 8192, R, C); const int Rb = Epi::PERM ? ((R & ~31) + perm32(R & 31)) : R;
        voffA[i] = (unsigned)(R * Gemm::lda + C) * 2u; voffB[i] = (unsigned)(Rb * Gemm::ldb + C) * 2u; }
    constexpr size_t kstep = (size_t)(BK * 2);
    constexpr size_t hstepA = (size_t)HALF * Gemm::lda * 2, hstepB = (size_t)HALF * Gemm::ldb * 2;
    const unsigned ldsw = (unsigned)wid * 1024u;
    const int aoff = lds_byte(wr * 64 + fr, fq * 8), boff = lds_byte(wc * 32 + fr, fq * 8);
#define PG8_SA(b, h) (((b) * 2 + (h)) * HTB)
#define PG8_SB(b, h) ((4 + (b) * 2 + (h)) * HTB)
#define PG8_STAGE(bufoff, gbase, voff) do { _Pragma("unroll") for (int _i = 0; _i < 2; ++_i) \
        __builtin_amdgcn_global_load_lds((const unsigned*)((const char*)(gbase) + (voff)[_i]), (PG8_LAS unsigned*)(lds + (bufoff) + ldsw + _i * 8192), 16, 0, 0); } while (0)
#define PG8_LDA(dst, b, h) do { _Pragma("unroll") for (int m = 0; m < 4; ++m) _Pragma("unroll") for (int k = 0; k < 2; ++k) dst[m][k] = *(const PG8_LAS bf16x8*)(lds + PG8_SA(b, h) + aoff + m * 2048 + k * 1024); } while (0)
#define PG8_LDB(dst, b, h) do { _Pragma("unroll") for (int n = 0; n < 2; ++n) _Pragma("unroll") for (int k = 0; k < 2; ++k) dst[n][k] = *(const PG8_LAS bf16x8*)(lds + PG8_SB(b, h) + boff + n * 2048 + k * 1024); } while (0)
#define PG8_MMA(ai, bj, At, Bt) do { __builtin_amdgcn_s_setprio(1); _Pragma("unroll") for (int m = 0; m < 4; ++m) _Pragma("unroll") for (int n = 0; n < 2; ++n) _Pragma("unroll") for (int k = 0; k < 2; ++k) \
        acc[ai][bj][m][n] = __builtin_amdgcn_mfma_f32_16x16x32_bf16(Bt[n][k], At[m][k], acc[ai][bj][m][n], 0, 0, 0); __builtin_amdgcn_s_setprio(0); } while (0)
#define PG8_WAIT_V(n) asm volatile("s_waitcnt vmcnt(" #n ")" ::: "memory")
#define PG8_WAIT_L(n) asm volatile("s_waitcnt lgkmcnt(" #n ")" ::: "memory")
#define PG8_BAR __builtin_amdgcn_s_barrier()
#define PG8_SCHED __builtin_amdgcn_sched_barrier(0)
    Unit cur, nxt; int ui = 0;
    if (!S.next(0, cur)) return;
    f32x4 acc[2][2][4][2];
#pragma unroll
    for (int a = 0; a < 2; ++a)
#pragma unroll
        for (int b = 0; b < 2; ++b)
#pragma unroll
            for (int m = 0; m < 4; ++m)
#pragma unroll
                for (int n = 0; n < 2; ++n) acc[a][b][m][n] = (f32x4){0.f, 0.f, 0.f, 0.f};
    bf16x8 At[4][2], B0[2][2], B1[2][2];
    const char* cA = cur.a; const char* cB = cur.b;
    if constexpr (SP2) {
        PG8_STAGE(PG8_SB(0, 0), cB, voffB); PG8_STAGE(PG8_SB(0, 1), cB + hstepB, voffB); PG8_STAGE(PG8_SA(0, 0), cA, voffA); PG8_STAGE(PG8_SA(0, 1), cA + hstepA, voffA);
        if (wr == 1) PG8_BAR;
        PG8_WAIT_V(2); PG8_BAR;
        PG8_STAGE(PG8_SB(1, 0), cB + kstep, voffB); PG8_STAGE(PG8_SA(1, 0), cA + kstep, voffA); PG8_STAGE(PG8_SB(1, 1), cB + hstepB + kstep, voffB);
        PG8_WAIT_V(6); PG8_BAR;
    } else {
        PG8_STAGE(PG8_SB(0, 0), cB, voffB); PG8_STAGE(PG8_SA(0, 0), cA, voffA); PG8_STAGE(PG8_SB(0, 1), cB + hstepB, voffB); PG8_STAGE(PG8_SA(0, 1), cA + hstepA, voffA);
        if (wr == 1) PG8_BAR;
        PG8_WAIT_V(4); PG8_BAR;
        PG8_STAGE(PG8_SB(1, 0), cB + kstep, voffB); PG8_STAGE(PG8_SA(1, 0), cA + kstep, voffA); PG8_STAGE(PG8_SB(1, 1), cB + hstepB + kstep, voffB);
        PG8_WAIT_V(6); PG8_BAR;
    }
    for (;;) {
        const bool has_next = S.next(ui + 1, nxt);
        const char* nA = has_next ? nxt.a : cA; const char* nB = has_next ? nxt.b : cB;
#pragma unroll 1
        for (int t = 0; t < nt; t += 2) {
            const bool last = (t == nt - 2);
            const char* a1 = cA + (size_t)(t + 1) * kstep;
            const char* a2 = last ? nA : cA + (size_t)(t + 2) * kstep; const char* b2 = last ? nB : cB + (size_t)(t + 2) * kstep;
            const char* a3 = a2 + kstep; const char* b3 = b2 + kstep;
            if constexpr (Epi::MIDK > 0) { if (t == Epi::MIDK) E.midk(acc, cur, wr, wc, fr, fq); }
            if constexpr (SP2) {
            PG8_LDB(B0, 0, 0); PG8_LDB(B1, 0, 1); PG8_SCHED; PG8_LDA(At, 0, 0); PG8_STAGE(PG8_SA(1, 1), a1 + hstepA, voffA);
            PG8_WAIT_V(8); PG8_WAIT_L(0); PG8_BAR; PG8_MMA(0, 0, At, B0); PG8_MMA(0, 1, At, B1); PG8_BAR; PG8_SCHED;
            PG8_LDA(At, 0, 1); PG8_STAGE(PG8_SB(0, 0), b2, voffB); PG8_STAGE(PG8_SB(0, 1), b2 + hstepB, voffB); PG8_STAGE(PG8_SA(0, 0), a2, voffA);
            PG8_WAIT_V(8); PG8_WAIT_L(0); PG8_BAR; PG8_MMA(1, 0, At, B0); PG8_MMA(1, 1, At, B1); PG8_BAR; PG8_SCHED;
            PG8_LDB(B0, 1, 0); PG8_LDB(B1, 1, 1); PG8_SCHED; PG8_LDA(At, 1, 0); PG8_STAGE(PG8_SA(0, 1), a2 + hstepA, voffA);
            PG8_WAIT_V(8); PG8_WAIT_L(0); PG8_BAR; PG8_MMA(0, 0, At, B0); PG8_MMA(0, 1, At, B1); PG8_BAR; PG8_SCHED;
            PG8_LDA(At, 1, 1); PG8_STAGE(PG8_SB(1, 0), b3, voffB); PG8_STAGE(PG8_SB(1, 1), b3 + hstepB, voffB); PG8_STAGE(PG8_SA(1, 0), a3, voffA);
            PG8_WAIT_V(8); PG8_WAIT_L(0); PG8_BAR; PG8_MMA(1, 0, At, B0); PG8_MMA(1, 1, At, B1); PG8_BAR; PG8_SCHED;
            } else {
            PG8_LDB(B0, 0, 0); PG8_SCHED; PG8_LDA(At, 0, 0); PG8_STAGE(PG8_SA(1, 1), a1 + hstepA, voffA);
            PG8_WAIT_L(8); PG8_BAR; PG8_WAIT_L(0); PG8_MMA(0, 0, At, B0); PG8_BAR; PG8_SCHED;
            PG8_LDB(B1, 0, 1); PG8_STAGE(PG8_SB(0, 0), b2, voffB);
            PG8_BAR; PG8_WAIT_L(0); PG8_MMA(0, 1, At, B1); PG8_BAR;
            PG8_LDA(At, 0, 1); PG8_STAGE(PG8_SA(0, 0), a2, voffA);
            PG8_BAR; PG8_WAIT_L(0); PG8_MMA(1, 0, At, B0); PG8_BAR; PG8_SCHED;
            PG8_STAGE(PG8_SB(0, 1), b2 + hstepB, voffB);
            PG8_WAIT_V(6); PG8_BAR; PG8_MMA(1, 1, At, B1); PG8_BAR;
            PG8_LDB(B0, 1, 0); PG8_SCHED; PG8_LDA(At, 1, 0); PG8_STAGE(PG8_SA(0, 1), a2 + hstepA, voffA);
            PG8_WAIT_L(8); PG8_BAR; PG8_WAIT_L(0); PG8_MMA(0, 0, At, B0); PG8_BAR; PG8_SCHED;
            PG8_LDB(B1, 1, 1); PG8_STAGE(PG8_SB(1, 0), b3, voffB);
            PG8_BAR; PG8_WAIT_L(0); PG8_MMA(0, 1, At, B1); PG8_BAR;
            PG8_LDA(At, 1, 1); PG8_STAGE(PG8_SA(1, 0), a3, voffA);
            PG8_BAR; PG8_WAIT_L(0); PG8_MMA(1, 0, At, B0); PG8_BAR; PG8_SCHED;
            PG8_STAGE(PG8_SB(1, 1), b3 + hstepB, voffB);
            PG8_WAIT_V(6); PG8_BAR; PG8_MMA(1, 1, At, B1); PG8_BAR;
            }
        }
        if constexpr (ALIGN_EPI) { if (wr == 0) PG8_BAR; }
        { int fr_ = fr, fq_ = fq; asm volatile("" : "+v"(fr_), "+v"(fq_));
#if defined(PROBE_NOEPI) && PROBE_NOEPI
        if (!E.shadow_skip) E(acc, cur, wr, wc, fr_, fq_);
#else
        E(acc, cur, wr, wc, fr_, fq_);
#endif
        }
        if (!has_next) break;
#pragma unroll
        for (int a = 0; a < 2; ++a)
#pragma unroll
            for (int b = 0; b < 2; ++b)
#pragma unroll
                for (int m = 0; m < 4; ++m)
#pragma unroll
                    for (int n = 0; n < 2; ++n) acc[a][b][m][n] = (f32x4){0.f, 0.f, 0.f, 0.f};
        cur = nxt; cA = nA; cB = nB; ++ui;
        if constexpr (ALIGN_EPI) { if (wr == 1) PG8_BAR; }
    }
    PG8_WAIT_V(0);
    if constexpr (!ALIGN_EPI) { if (wr == 0) PG8_BAR; }
    PG8_BAR;
#undef PG8_SA
#undef PG8_SB
#undef PG8_STAGE
#undef PG8_LDA
#undef PG8_LDB
#undef PG8_MMA
#undef PG8_WAIT_V
#undef PG8_WAIT_L
#undef PG8_BAR
#undef PG8_SCHED
}
}
namespace pg8 {
constexpr float LOG2E = 1.4426950408889634f;
constexpr float RMS_EPS = 1e-6f;
constexpr size_t TILE_BYTES = 1536 * 1024, T_Y = 0, T_K = 512 * 1024, T_V = 768 * 1024, T_U = 1024 * 1024, T_LOGF = 1280 * 1024;

template <int kind, int nM, int nN, size_t sA, size_t sB, size_t batchB = 0>
struct SchedT {
    static constexpr int nwg = nM * nN, G = 256;
    int c; const char* A; const char* B;
    __device__ __forceinline__ void init(int c_, const void* A_, const void* B_) { c = c_; A = (const char*)A_; B = (const char*)B_; }
    __device__ __forceinline__ bool next(int i, Unit& u) const {
        const int L = i * G + c; if ((unsigned)L >= (unsigned)nwg) return false;
        if constexpr (kind <= 1) {
            int wgid = L; { constexpr int q = nwg / NXCD, r = nwg % NXCD; const int xcd = wgid % NXCD, off = wgid / NXCD; wgid = (xcd < r ? xcd * (q + 1) : r * (q + 1) + (xcd - r) * q) + off; }
            constexpr int nig = WGM * nN; const int gid = wgid / nig, fm = gid * WGM, gsz = (nM - fm) < WGM ? (nM - fm) : WGM;
            u.pm = fm + ((wgid % nig) % gsz); u.pn = (wgid % nig) / gsz;
            u.a = A + (size_t)u.pm * sA; u.b = B + (size_t)u.pn * sB + (kind == 1 ? (size_t)(u.pm >> 3) * batchB : (size_t)0); u.aux = 0;
        } else if constexpr (kind == 2) {
            const int b_ = L & 7, h = (L >> 5) & 3, t4 = (L >> 3) & 3;
            u.pm = b_ * 4 + h; u.pn = t4;
            u.a = A + ((size_t)b_ * 256 * 2048 + (size_t)h * 256) * 2; u.b = B + ((size_t)t4 * 256 * 1024 + (size_t)h * 256) * 2;
            u.aux = b_ * 4194304 + (h * 256) * 1024 + t4 * 256;
        } else if constexpr (kind == 3) {
            const int b_ = L & 7, h = (L >> 5) & 3, t4 = (L >> 3) & 3;
            u.pm = t4; u.pn = b_ * 4 + h;
            u.a = A + ((size_t)t4 * 256 * 1024 + (size_t)h * 256) * 2; u.b = B + ((size_t)b_ * 256 * 2048 + 1024 + (size_t)h * 256) * 2;
            u.aux = b_ * 4194304 + (t4 * 256) * 1024 + h * 256;
        } else {
            u.pm = L & 7; u.pn = L >> 3; u.a = A + (size_t)u.pm * sA; u.b = B + (size_t)u.pn * sB; u.aux = 0;
        }
        return true;
    }
};

__device__ __forceinline__ void store8(bf16_t* p, const f32x4 v0, const f32x4 v1) {
    u32x4 w; w.x = cvt_pk_bf16(v0[0], v0[1]); w.y = cvt_pk_bf16(v0[2], v0[3]); w.z = cvt_pk_bf16(v1[0], v1[1]); w.w = cvt_pk_bf16(v1[2], v1[3]); *(u32x4*)p = w;
}
__device__ __forceinline__ float ss_sum16(const float* ssp, int row) {
    const f32x4* p = (const f32x4*)(ssp + (size_t)row * 16); const f32x4 a = p[0], b = p[1], c = p[2], d = p[3];
    return (((a[0] + a[1]) + (a[2] + a[3])) + ((b[0] + b[1]) + (b[2] + b[3]))) + (((c[0] + c[1]) + (c[2] + c[3])) + ((d[0] + d[1]) + (d[2] + d[3])));
}
__device__ __forceinline__ float rs_row(const float* ssp, int row) { return __builtin_amdgcn_rsqf(ss_sum16(ssp, row) * (1.0f / 1024.0f) + RMS_EPS); }
__device__ __forceinline__ float sigmoidf_fast(float z) { return __builtin_amdgcn_rcpf(1.0f + __builtin_amdgcn_exp2f(-z * LOG2E)); }
__device__ __forceinline__ f32x4 sig4(f32x4 z) { f32x4 r; r[0] = sigmoidf_fast(z[0]); r[1] = sigmoidf_fast(z[1]); r[2] = sigmoidf_fast(z[2]); r[3] = sigmoidf_fast(z[3]); return r; }

struct EpiSwiGLU {
    static constexpr bool PERM = true; static constexpr int MIDK = 0;
    bf16_t* H; const float* ss; static constexpr int ldh = 2816;
    bool shadow_skip = false;
    __device__ __forceinline__ void midk(f32x4 (&)[2][2][4][2], const Unit&, int, int, int, int) const {}
    __device__ __forceinline__ void operator()(f32x4 (&acc)[2][2][4][2], const Unit& u, int wr, int wc, int fr, int fq) const {
        const int rl0 = wr * 64 + fr, col0 = u.pn * HALF + wc * 32 + 8 * fq;
        bf16_t* Ht = (bf16_t*)((unsigned char*)H + (size_t)u.pm * TILE_BYTES);
#pragma unroll
        for (int ai = 0; ai < 2; ++ai)
#pragma unroll
            for (int m = 0; m < 4; ++m) {
                const int rl = rl0 + ai * HALF + m * 16;
                const float rs = rs_row(ss, u.pm * BM + rl);
                const f32x4 g0 = acc[ai][0][m][0] * rs, g1 = acc[ai][0][m][1] * rs, u0 = acc[ai][1][m][0] * rs, u1 = acc[ai][1][m][1] * rs;
                store8(Ht + (size_t)rl * ldh + col0, g0 * sig4(g0) * u0, g1 * sig4(g1) * u1);
            }
    }
};

template <int MIDK_>
struct EpiResid {
    static constexpr bool PERM = true; static constexpr int MIDK = MIDK_;
    const float* xin; float* xout; bf16_t* xb; float* ssn; const float* ssa; float alpha;
    bool shadow_skip = false;
    __device__ __forceinline__ void midk(f32x4 (&acc)[2][2][4][2], const Unit& u, int wr, int wc, int fr, int fq) const {
        const int row0 = u.pm * BM + wr * 64 + fr;
#pragma unroll
        for (int ai = 0; ai < 2; ++ai)
#pragma unroll
            for (int m = 0; m < 4; ++m) {
                const f32x4* pa = (const f32x4*)(ssa + (size_t)(row0 + ai * HALF + m * 16) * 8); const f32x4 sa = pa[0], sb = pa[1];
                const float rs = __builtin_amdgcn_rsqf((((sa[0] + sa[1]) + (sa[2] + sa[3])) + ((sb[0] + sb[1]) + (sb[2] + sb[3]))) * (1.0f / 512.0f) + RMS_EPS);
#pragma unroll
                for (int bj = 0; bj < 2; ++bj)
#pragma unroll
                    for (int n = 0; n < 2; ++n) acc[ai][bj][m][n] *= rs;
            }
    }
    __device__ __forceinline__ void operator()(f32x4 (&acc)[2][2][4][2], const Unit& u, int wr, int wc, int fr, int fq) const {
        const int row0 = u.pm * BM + wr * 64 + fr, col0 = u.pn * BM + wc * 32 + 8 * fq;
#pragma unroll
        for (int ai = 0; ai < 2; ++ai)
#pragma unroll
            for (int m = 0; m < 4; ++m) {
                const int row = row0 + ai * HALF + m * 16; float q = 0.f;
#pragma unroll
                for (int bj = 0; bj < 2; ++bj) {
                    const size_t off = (size_t)row * 1024 + col0 + bj * HALF;
                    f32x4 r0, r1;
                    if (xin) { r0 = __builtin_nontemporal_load((const f32x4*)(xin + off)); r1 = __builtin_nontemporal_load((const f32x4*)(xin + off + 4)); }
                    else { const u32x4 w = *(const u32x4*)(xb + off);
                        r0 = (f32x4){__uint_as_float(w.x << 16), __uint_as_float(w.x & 0xffff0000u), __uint_as_float(w.y << 16), __uint_as_float(w.y & 0xffff0000u)};
                        r1 = (f32x4){__uint_as_float(w.z << 16), __uint_as_float(w.z & 0xffff0000u), __uint_as_float(w.w << 16), __uint_as_float(w.w & 0xffff0000u)}; }
                    const f32x4 v0 = r0 + acc[ai][bj][m][0] * alpha, v1 = r1 + acc[ai][bj][m][1] * alpha;
                    if (xout) { *(f32x4*)(xout + off) = v0; *(f32x4*)(xout + off + 4) = v1; }
                    else store8(xb + off, v0, v1);
                    q += (v0[0] * v0[0] + v0[1] * v0[1]) + (v0[2] * v0[2] + v0[3] * v0[3]) + (v1[0] * v1[0] + v1[1] * v1[1]) + (v1[2] * v1[2] + v1[3] * v1[3]);
                }
                q += swz_xor<16>(q); q = sum_x32(q);
                if (fq == 0) ssn[(size_t)row * 16 + u.pn * 4 + wc] = q;
            }
    }
};

struct EpiWin {
    static constexpr bool PERM = true; static constexpr int MIDK = 0;
    unsigned char* R1; const float* ss; const float* bfp; float qscale;
    bool shadow_skip = false;
    __device__ __forceinline__ void midk(f32x4 (&)[2][2][4][2], const Unit&, int, int, int, int) const {}
    __device__ __forceinline__ void operator()(f32x4 (&acc)[2][2][4][2], const Unit& u, int wr, int wc, int fr, int fq) const {
        const int rl0 = wr * 64 + fr, cw = wc * 32 + 8 * fq; const int pn = u.pn;
        unsigned char* T = R1 + (size_t)u.pm * TILE_BYTES;
#pragma unroll
        for (int ai = 0; ai < 2; ++ai)
#pragma unroll
            for (int m = 0; m < 4; ++m) {
                const int rl = rl0 + ai * HALF + m * 16;
                const float rs = rs_row(ss, u.pm * BM + rl);
                if (pn < 6) {
                    bf16_t* base; int ld; float sc = rs;
                    if (pn < 2) { base = (bf16_t*)(T + T_Y) + pn * BM; ld = 1024; sc = rs * qscale; } else if (pn < 4) { base = (bf16_t*)(T + T_K) + (pn - 2) * BM; ld = 512; } else { base = (bf16_t*)(T + T_V) + (pn - 4) * BM; ld = 512; }
#pragma unroll
                    for (int bj = 0; bj < 2; ++bj) store8(base + (size_t)rl * ld + bj * HALF + cw, acc[ai][bj][m][0] * sc, acc[ai][bj][m][1] * sc);
                } else if (pn < 10) {
                    const f32x4 a0 = acc[ai][0][m][0] * rs, a1 = acc[ai][0][m][1] * rs, g0 = acc[ai][1][m][0] * rs, g1 = acc[ai][1][m][1] * rs;
                    store8((bf16_t*)(T + T_U) + (size_t)rl * 512 + (pn - 6) * HALF + cw, a0 * sig4(g0), a1 * sig4(g1));
                } else {
                    if (wc == 0 && fq == 0) {
                        float* LF = (float*)(T + T_LOGF);
#pragma unroll
                        for (int n = 0; n < 2; ++n)
#pragma unroll
                            for (int e = 0; e < 4; ++e) {
                                const int h = 4 * n + e; const float z = acc[ai][0][m][n][e] * rs + bfp[h];
                                LF[h * 256 + rl] = fminf(z, 0.f) - log1pf(expf(-fabsf(z)));
                            }
                    }
                }
            }
    }
};

struct EpiRowScale {
    static constexpr bool PERM = true; static constexpr int MIDK = 0;
    bf16_t* O; const float* ssr; float scale; static constexpr int ldc = 2048;
    bool shadow_skip = false;
    __device__ __forceinline__ void midk(f32x4 (&)[2][2][4][2], const Unit&, int, int, int, int) const {}
    __device__ __forceinline__ void operator()(f32x4 (&acc)[2][2][4][2], const Unit& u, int wr, int wc, int fr, int fq) const {
        const int row0 = u.pm * BM + wr * 64 + fr, col0 = u.pn * BM + wc * 32 + 8 * fq;
#pragma unroll
        for (int ai = 0; ai < 2; ++ai)
#pragma unroll
            for (int m = 0; m < 4; ++m) {
                const int row = row0 + ai * HALF + m * 16;
                const float rs = (ssr ? __builtin_amdgcn_rsqf(ssr[row] * (1.0f / 1024.0f) + RMS_EPS) : 1.0f) * scale;
#pragma unroll
                for (int bj = 0; bj < 2; ++bj) store8(O + (size_t)row * ldc + col0 + bj * HALF, acc[ai][bj][m][0] * rs, acc[ai][bj][m][1] * rs);
            }
    }
};

struct EpiAux {
    static constexpr bool PERM = true; static constexpr int MIDK = 0;
    bf16_t* O; float scale; static constexpr int ldc = 1024;
    bool shadow_skip = false;
    __device__ __forceinline__ void midk(f32x4 (&)[2][2][4][2], const Unit&, int, int, int, int) const {}
    __device__ __forceinline__ void operator()(f32x4 (&acc)[2][2][4][2], const Unit& u, int wr, int wc, int fr, int fq) const {
        bf16_t* base = O + u.aux + (size_t)(wr * 64 + fr) * ldc + wc * 32 + 8 * fq;
#pragma unroll
        for (int ai = 0; ai < 2; ++ai)
#pragma unroll
            for (int m = 0; m < 4; ++m)
#pragma unroll
                for (int bj = 0; bj < 2; ++bj) store8(base + (size_t)(ai * HALF + m * 16) * ldc + bj * HALF, acc[ai][bj][m][0] * scale, acc[ai][bj][m][1] * scale);
    }
};

struct EpiSoftmax {
    static constexpr bool PERM = true; static constexpr int MIDK = 0;
    unsigned char* R1; const float* ss; PG8_LAS float* scr;
    bool shadow_skip = false;
    __device__ __forceinline__ void midk(f32x4 (&)[2][2][4][2], const Unit&, int, int, int, int) const {}
    __device__ __forceinline__ void operator()(f32x4 (&acc)[2][2][4][2], const Unit& u, int wr, int wc, int fr, int fq) const {
        const int col0 = u.pn * BM + wc * 32 + 8 * fq;
        PG8_LAS float* TM = scr; PG8_LAS float* TS = scr + 1024;
        const float* ssr = ss + (size_t)(u.pm * BM + wr * 64 + fr) * 16;
#pragma unroll
        for (int ai = 0; ai < 2; ++ai)
#pragma unroll
            for (int m = 0; m < 4; ++m) {
                const int rl = ai * HALF + wr * 64 + m * 16 + fr;
                const float rs = rs_row(ssr, ai * HALF + m * 16);
                float v = -3.0e38f;
#pragma unroll
                for (int bj = 0; bj < 2; ++bj)
#pragma unroll
                    for (int n = 0; n < 2; ++n) { const f32x4 x = acc[ai][bj][m][n] * rs; acc[ai][bj][m][n] = x; v = fmaxf(v, fmaxf(fmaxf(x[0], x[1]), fmaxf(x[2], x[3]))); }
                v = fmaxf(v, swz_xor<16>(v)); v = max_x32(v);
                if (fq == 0) TM[rl * 4 + wc] = v;
            }
        asm volatile("s_waitcnt lgkmcnt(0)" ::: "memory"); __builtin_amdgcn_s_barrier(); asm volatile("" ::: "memory");
#pragma unroll
        for (int ai = 0; ai < 2; ++ai)
#pragma unroll
            for (int m = 0; m < 4; ++m) {
                const int rl = ai * HALF + wr * 64 + m * 16 + fr;
                const f32x4 t = *(const PG8_LAS f32x4*)(TM + rl * 4);
                const float mrow = fmaxf(fmaxf(t[0], t[1]), fmaxf(t[2], t[3]));
                float s = 0.f;
#pragma unroll
                for (int bj = 0; bj < 2; ++bj)
#pragma unroll
                    for (int n = 0; n < 2; ++n) { f32x4 x = acc[ai][bj][m][n] - mrow;
                        x[0] = __builtin_amdgcn_exp2f(x[0]); x[1] = __builtin_amdgcn_exp2f(x[1]); x[2] = __builtin_amdgcn_exp2f(x[2]); x[3] = __builtin_amdgcn_exp2f(x[3]);
                        acc[ai][bj][m][n] = x; s += (x[0] + x[1]) + (x[2] + x[3]); }
                s += swz_xor<16>(s); s = sum_x32(s);
                if (fq == 0) TS[rl * 4 + wc] = s;
            }
        asm volatile("s_waitcnt lgkmcnt(0)" ::: "memory"); __builtin_amdgcn_s_barrier(); asm volatile("" ::: "memory");
        bf16_t* xp = (bf16_t*)(R1 + (size_t)u.pm * TILE_BYTES + T_Y) + (size_t)(wr * 64 + fr) * 1024 + col0;
#pragma unroll
        for (int ai = 0; ai < 2; ++ai)
#pragma unroll
            for (int m = 0; m < 4; ++m) {
                const int rl = ai * HALF + wr * 64 + m * 16 + fr;
                const f32x4 t = *(const PG8_LAS f32x4*)(TS + rl * 4);
                const float inv = __builtin_amdgcn_rcpf((t[0] + t[1]) + (t[2] + t[3]));
#pragma unroll
                for (int bj = 0; bj < 2; ++bj) store8(xp + (size_t)(ai * HALF + m * 16) * 1024 + bj * HALF, acc[ai][bj][m][0] * inv, acc[ai][bj][m][1] * inv);
            }
    }
};
}
#include <hip/hip_bf16.h>
namespace attn_body {
using bf16=__hip_bfloat16;
using bf16x8=__attribute__((ext_vector_type(8)))short;
using s16x4=__attribute__((ext_vector_type(4)))short;
using f32x16=__attribute__((ext_vector_type(16)))float;
using f32x4_t=__attribute__((ext_vector_type(4)))float;
using u32x4=__attribute__((ext_vector_type(4)))unsigned;
#define ATT_LAS __attribute__((address_space(3)))
constexpr int BATCH=8,NHEAD=8,SEQ=2048,D=64,QP=1024,KP=512;
constexpr size_t TILE_BYTES=1536*1024,T_Y=0,T_K=512*1024,T_V=768*1024,T_U=1024*1024,T_LOGF=1280*1024;
constexpr int NW=8,QBLK=32,QB=QBLK*NW,KVBLK=64,NQB=SEQ/QB;
__device__ __forceinline__ int crow(int r,int hi){return (r&3)+8*(r>>2)+4*hi;}
#define SBAR() __builtin_amdgcn_sched_barrier(0)
__device__ __forceinline__ void cmask(f32x16&p0,f32x16&p1,int jb,int qrel,int hi){
  const float NEG=-INFINITY; int kb=64*jb+4*hi;
  #pragma unroll
  for(int r=0;r<16;++r){int kv=kb+(r&3)+8*(r>>2); if(kv>qrel)p0[r]=NEG; if(kv+32>qrel)p1[r]=NEG;}
}
constexpr int NSLOT=3, SLOTB=8192;
constexpr int LDS_K=0, LDS_V=NSLOT*SLOTB, LDS_WS=2*NSLOT*SLOTB, LDS_OST=LDS_WS+NW*64*4, LDS_CB=LDS_OST+NW*4096  , LDS_WT=LDS_CB+SEQ*4, LDS_BYTES=LDS_WT+64;
__device__ __forceinline__ void glds16(const void*gsrc,unsigned lds_dst){unsigned keep;
  asm volatile("s_mov_b32 %0, m0\n\ts_mov_b32 m0, %2\n\ts_nop 0\n\tglobal_load_lds_dwordx4 %1, off\n\ts_mov_b32 m0, %0":"=&s"(keep):"v"(gsrc),"s"(lds_dst):"memory");}
__device__ __forceinline__ float max3f(float a,float b,float c){float r;asm("v_max3_f32 %0, %1, %2, %3":"=v"(r):"v"(a),"v"(b),"v"(c));return r;}
__device__ __forceinline__ float max2f(float a,float b){float r;asm("v_max_f32_e32 %0, %1, %2":"=v"(r):"v"(a),"v"(b));return r;}
__device__ __forceinline__ float fadd_s(float a,float b){float r;asm("v_add_f32_e32 %0, %1, %2":"=v"(r):"v"(a),"v"(b));return r;}
__device__ __forceinline__ float fsub_s(float a,float b){float r;asm("v_sub_f32_e32 %0, %1, %2":"=v"(r):"v"(a),"v"(b));return r;}
typedef float f32x2_t __attribute__((ext_vector_type(2))); typedef __bf16 bf16x2_t __attribute__((ext_vector_type(2)));
__device__ __forceinline__ unsigned cvtpk_s(float lo,float hi){f32x2_t v={lo,hi};bf16x2_t b=__builtin_convertvector(v,bf16x2_t);return __builtin_bit_cast(unsigned,b);}
#define WAIT_BAR(N) asm volatile("s_waitcnt vmcnt(" #N ") lgkmcnt(0)\n\ts_barrier":::"memory")

__device__ __forceinline__ void qkt(f32x16&p0,f32x16&p1,const char*Kslot,const bf16x8*qr,const f32x16&negm,int r32,int hi){
  const char*kb=Kslot+hi*1024+r32*16;
  #pragma unroll
  for(int d0=0;d0<4;++d0){
    const bf16x8 b0=*reinterpret_cast<const bf16x8*>(kb+d0*2048);
    const bf16x8 b1=*reinterpret_cast<const bf16x8*>(kb+d0*2048+512);
    if(d0==0){p0=__builtin_amdgcn_mfma_f32_32x32x16_bf16(b0,qr[0],negm,0,0,0);p1=__builtin_amdgcn_mfma_f32_32x32x16_bf16(b1,qr[0],negm,0,0,0);}
    else{p0=__builtin_amdgcn_mfma_f32_32x32x16_bf16(b0,qr[d0],p0,0,0,0);p1=__builtin_amdgcn_mfma_f32_32x32x16_bf16(b1,qr[d0],p1,0,0,0);}}
}
typedef ATT_LAS const char* lds_cptr;
typedef short v4i16_t __attribute__((ext_vector_type(4)));
__device__ __forceinline__ void kload8(bf16x8*kf,lds_cptr kp){
  kf[0]=*(const ATT_LAS bf16x8*)(kp);      kf[1]=*(const ATT_LAS bf16x8*)(kp+512);
  kf[2]=*(const ATT_LAS bf16x8*)(kp+2048); kf[3]=*(const ATT_LAS bf16x8*)(kp+2560);
  kf[4]=*(const ATT_LAS bf16x8*)(kp+4096); kf[5]=*(const ATT_LAS bf16x8*)(kp+4608);
  kf[6]=*(const ATT_LAS bf16x8*)(kp+6144); kf[7]=*(const ATT_LAS bf16x8*)(kp+6656);
}
__device__ __forceinline__ void kload2(bf16x8*kf,lds_cptr kp,int j){ kf[2*j]=*(const ATT_LAS bf16x8*)(kp+j*2048); kf[2*j+1]=*(const ATT_LAS bf16x8*)(kp+j*2048+512); }
__device__ __forceinline__ s16x4 vtr(lds_cptr p){ return __builtin_bit_cast(s16x4,__builtin_amdgcn_ds_read_tr16_b64_v4i16((ATT_LAS v4i16_t*)p)); }
__device__ __forceinline__ float rowmax(const f32x16&p0,const f32x16&p1){
  float a=max3f(p0[0],p0[1],p1[0]),b=max3f(p0[2],p0[3],p1[1]);a=max3f(a,p1[2],p1[3]);
  #pragma unroll
  for(int r=4;r<16;r+=4){a=max3f(a,p0[r],p0[r+1]);b=max3f(b,p0[r+2],p0[r+3]);a=max3f(a,p1[r],p1[r+1]);b=max3f(b,p1[r+2],p1[r+3]);}
  const float m=max2f(a,b);
  auto rr=__builtin_amdgcn_permlane32_swap(__float_as_uint(m),__float_as_uint(m),false,false);
  return max2f(__uint_as_float(rr[0]),__uint_as_float(rr[1]));
}
__device__ __forceinline__ void pv(f32x16*o,int vb,bf16x8 pa0,bf16x8 pa1,bf16x8 pa2,bf16x8 pa3){
  #pragma unroll
  for(int d0=0;d0<2;++d0){s16x4 lo[4],hi[4];
    #pragma unroll
    for(int ks=0;ks<4;++ks){
      asm volatile("ds_read_b64_tr_b16 %0,%1 offset:%c2":"=&v"(lo[ks]):"v"(vb),"i"(d0*4096+ks*1024):"memory");
      asm volatile("ds_read_b64_tr_b16 %0,%1 offset:%c2":"=&v"(hi[ks]):"v"(vb),"i"(d0*4096+ks*1024+512):"memory");}
    asm volatile("s_waitcnt lgkmcnt(0)":::"memory");SBAR();
    #define PK(k) (bf16x8){lo[k][0],lo[k][1],lo[k][2],lo[k][3],hi[k][0],hi[k][1],hi[k][2],hi[k][3]}
    o[d0]=__builtin_amdgcn_mfma_f32_32x32x16_bf16(pa0,PK(0),o[d0],0,0,0);
    o[d0]=__builtin_amdgcn_mfma_f32_32x32x16_bf16(pa1,PK(1),o[d0],0,0,0);
    o[d0]=__builtin_amdgcn_mfma_f32_32x32x16_bf16(pa2,PK(2),o[d0],0,0,0);
    o[d0]=__builtin_amdgcn_mfma_f32_32x32x16_bf16(pa3,PK(3),o[d0],0,0,0);
    #undef PK
  }
}
__device__ __forceinline__ void scan_bias(const unsigned char*R1,int b,int h,char*shm,const int tid){
  const int lane=tid&63,wid=tid>>6;
  ATT_LAS float*cb=(ATT_LAS float*)(shm+LDS_CB); ATT_LAS float*wt=(ATT_LAS float*)(shm+LDS_WT);
  const f32x4_t v=*(const f32x4_t*)((const float*)(R1+(size_t)(8*b+wid)*TILE_BYTES+T_LOGF)+h*256+4*lane);
  const float s0=v[0],s1=s0+v[1],s2=s1+v[2],s3=s2+v[3];
  float incl=s3;
  #pragma unroll
  for(int o=1;o<64;o<<=1){const float n=__int_as_float(__builtin_amdgcn_ds_bpermute((lane-o)<<2,__float_as_int(incl))); if(lane>=o)incl+=n;}
  if(lane==63)wt[wid]=incl;
  asm volatile("s_waitcnt lgkmcnt(0)\n\ts_barrier":::"memory");
  float woff=0.f;
  #pragma unroll
  for(int w=0;w<8;++w){const float x=wt[w]; if(w<wid)woff+=x;}
  const float ex=woff+incl-s3; const float L2E=-1.4426950408889634f;
  f32x4_t o4; o4[0]=(ex+s0)*L2E;o4[1]=(ex+s1)*L2E;o4[2]=(ex+s2)*L2E;o4[3]=(ex+s3)*L2E;
  *(ATT_LAS f32x4_t*)(cb+4*tid)=o4;
  asm volatile("s_waitcnt lgkmcnt(0)\n\ts_barrier":::"memory");
}
template<int THRL> __device__ __forceinline__ void attn_unit(int b,int h,int qb,const unsigned char*R1,int ocol  ,float*ssa  ,char*shm,const int tid){
  const int lane=tid&63,r32=lane&31,hi=lane>>5; const int wid=__builtin_amdgcn_readfirstlane(tid>>6);
  const long rowbase=(long)b*SEQ; const int q0=qb*QB;
  const unsigned char*Tb=R1+(size_t)(8*b)*TILE_BYTES;
  const bf16*Qw=(const bf16*)(Tb+(size_t)qb*TILE_BYTES+T_Y)+(long)(wid*QBLK)*QP+h*D;
  const unsigned lds0=(unsigned)(uintptr_t)shm;
  float*wsf=(float*)(shm+LDS_WS)+wid*64;
  const ATT_LAS float*cbh=(const ATT_LAS float*)(shm+LDS_CB)+4*hi;
  const bf16*ksrc=(const bf16*)(Tb+T_K)+h*D+(long)lane*KP+wid*8;
  const bf16*vsrc=(const bf16*)(Tb+T_V)+h*D+(long)(16*(wid&3)+(lane>>2))*KP+(wid>>2)*32+(lane&3)*8;
  const unsigned kdst=lds0+LDS_K+wid*1024, vdst=lds0+LDS_V+wid*1024;
  #define KVOFF(t) ((size_t)((t)>>2)*(TILE_BYTES/2)+(size_t)((t)&3)*KVBLK*KP)
  #define DMA_K(t,slot) glds16(ksrc+KVOFF(t),(unsigned)__builtin_amdgcn_readfirstlane(kdst+(slot)))
  #define DMA_V(t,slot) glds16(vsrc+KVOFF(t),(unsigned)__builtin_amdgcn_readfirstlane(vdst+(slot)))
  const int vb0=(int)(lds0+LDS_V)+((lane>>4)&1)*32+(lane&3)*8+(4*hi+((lane&15)>>2))*64;
  const char*Kbase=shm+LDS_K; bf16x8 kf[8];
  const lds_cptr shm3=(lds_cptr)shm; const lds_cptr kp0=shm3+LDS_K+hi*1024+r32*16; const lds_cptr vp0=shm3+LDS_V+((lane>>4)&1)*32+(lane&3)*8+(4*hi+((lane&15)>>2))*64;
  const int NT=(q0+QB)/KVBLK;
  DMA_K(0,0);DMA_V(0,0);DMA_K(1,SLOTB);
  bf16x8 qr[4];
  #pragma unroll
  for(int d0=0;d0<4;++d0)qr[d0]=*reinterpret_cast<const bf16x8*>(&Qw[(long)r32*QP+d0*16+hi*8]);
  float mhat=0.f,l_reg=0.f;f32x16 o[2];o[0]=f32x16{};o[1]=f32x16{};f32x16 negm=f32x16{};asm volatile("":"+v"(negm));
  const int qrel=wid*QBLK+r32;
  #define CMASK(P0,P1,t) do{int jb_=(t)-(NT-4); if(jb_>=0)cmask(P0,P1,jb_,qrel,hi);}while(0)
  #define ADDB(P0,P1,t) do{ const ATT_LAS float*cbt_=cbh+64*(t); \
    _Pragma("unroll") for(int j_=0;j_<4;++j_){ const f32x4_t b0_=*(const ATT_LAS f32x4_t*)(cbt_+8*j_), b1_=*(const ATT_LAS f32x4_t*)(cbt_+32+8*j_); \
      _Pragma("unroll") for(int i_=0;i_<4;++i_){P0[4*j_+i_]+=b0_[i_];P1[4*j_+i_]+=b1_[i_];} } }while(0)
  bool resc=false;
  #define START(P0,P1) do{ const float rm=rowmax(P0,P1); resc=false; \
    { const float dl=rm; mhat=fadd_s(mhat,dl); \
      _Pragma("unroll") for(int r=0;r<16;++r){P0[r]=fsub_s(P0[r],dl);P1[r]=fsub_s(P1[r],dl);} \
      _Pragma("unroll") for(int r=0;r<16;++r)negm[r]=-mhat; asm volatile("":"+v"(negm)); } \
    _Pragma("unroll") for(int r=0;r<16;++r)P0[r]=__builtin_amdgcn_exp2f(P0[r]); }while(0)
  #define RESC() do{ if(resc){ asm volatile("s_waitcnt lgkmcnt(0)":::"memory"); \
      _Pragma("unroll") for(int d_=0;d_<2;++d_) _Pragma("unroll") for(int r=0;r<16;++r)o[d_][r]*=wsf[crow(r,hi)]; } }while(0)
  f32x16 pA0,pA1,pB0,pB1;
  int sl_prev=0,sl_cur=0,sl_next=SLOTB;
  #define ROT() do{sl_prev=sl_cur;sl_cur=sl_next;sl_next=(sl_next==(NSLOT-1)*SLOTB)?0:sl_next+SLOTB;}while(0)
  DMA_K(2,2*SLOTB);
  WAIT_BAR(3);
  qkt(pA0,pA1,Kbase,qr,negm,r32,hi);asm volatile("s_nop 15\n\ts_nop 7":"+v"(pA0),"+v"(pA1));ADDB(pA0,pA1,0);asm volatile("s_nop 3":"+v"(pA0),"+v"(pA1));CMASK(pA0,pA1,0);
  START(pA0,pA1);
  _Pragma("unroll") for(int r=0;r<16;++r)pA1[r]=__builtin_amdgcn_exp2f(pA1[r]);
  WAIT_BAR(0);
  DMA_K(3,0);DMA_V(1,SLOTB);
  ROT();
  kload8(kf,kp0+sl_cur);
  WAIT_BAR(2);
  s16x4 vlo[8],vhi[8]; u32x4 pw0,pw1,pw2,pw3;
  #define PKW(P,B) cvtpk_s(P[B],P[B+1])
  #define PAF(k) __builtin_bit_cast(bf16x8,pw##k)
  #define VFR(i) (bf16x8){vlo[i][0],vlo[i][1],vlo[i][2],vlo[i][3],vhi[i][0],vhi[i][1],vhi[i][2],vhi[i][3]}
  #define PIN(x) asm volatile("":"+v"(x))
  #define MX3(a,b,c) __builtin_fmaxf(__builtin_fmaxf((a),(b)),(c))
  #define GAPA(MF,A0,A1,A2,A3,W0,W1,PW) do{ MF; sacc+=A0; sacc+=A1; sacc+=A2; sacc+=A3; PIN(sacc); W0; W1; PIN(PW); SBAR(); }while(0)
  #define EX(v) __builtin_amdgcn_exp2f(v)
  #define GAPB(MF,X,B) do{ MF; X[B]=EX(X[B]); X[B+1]=EX(X[B+1]); X[B+2]=EX(X[B+2]); X[B+3]=EX(X[B+3]); PIN(X); SBAR(); }while(0)
  #define VRD(i) do{ vlo[i]=vtr(vp_+(((i)>>2)*4096+((i)&3)*1024)); vhi[i]=vtr(vp_+(((i)>>2)*4096+((i)&3)*1024+512)); }while(0)
  #define KRD(G,j) do{ if(G){ kload2(kf,kp0+sl_next,j); SBAR(); } }while(0)
  #define STEP(C0,C1,P0,P1,t,GK,GV,GL) do{ SBAR(); \
    const lds_cptr vp_=vp0+sl_prev; \
    VRD(0); SBAR(); float sacc=(P0[0]+P0[1]); \
    GAPA(C0=__builtin_amdgcn_mfma_f32_32x32x16_bf16(kf[0],qr[0],negm,0,0,0), P0[2],P0[3],P0[4],P0[5],     pw0[0]=PKW(P0,0), pw0[1]=PKW(P0,2), pw0); \
    VRD(4); SBAR(); GAPA(C1=__builtin_amdgcn_mfma_f32_32x32x16_bf16(kf[1],qr[0],negm,0,0,0), P0[6],P0[7],P0[8],P0[9],     pw0[2]=PKW(P0,4), pw0[3]=PKW(P0,6), pw0); \
    VRD(1); SBAR(); GAPA(C0=__builtin_amdgcn_mfma_f32_32x32x16_bf16(kf[2],qr[1],C0,0,0,0),   P0[10],P0[11],P0[12],P0[13], pw1[0]=PKW(P0,8), pw1[1]=PKW(P0,10), pw1); \
    VRD(5); SBAR(); GAPA(C1=__builtin_amdgcn_mfma_f32_32x32x16_bf16(kf[3],qr[1],C1,0,0,0),   P0[14],P0[15],P1[0],P1[1],   pw1[2]=PKW(P0,12),pw1[3]=PKW(P0,14), pw1); \
    VRD(2); SBAR(); GAPA(C0=__builtin_amdgcn_mfma_f32_32x32x16_bf16(kf[4],qr[2],C0,0,0,0),   P1[2],P1[3],P1[4],P1[5],     pw2[0]=PKW(P1,0), pw2[1]=PKW(P1,2), pw2); \
    VRD(6); SBAR(); GAPA(C1=__builtin_amdgcn_mfma_f32_32x32x16_bf16(kf[5],qr[2],C1,0,0,0),   P1[6],P1[7],P1[8],P1[9],     pw2[2]=PKW(P1,4), pw2[3]=PKW(P1,6), pw2); \
    VRD(3); SBAR(); GAPA(C0=__builtin_amdgcn_mfma_f32_32x32x16_bf16(kf[6],qr[3],C0,0,0,0),   P1[10],P1[11],P1[12],P1[13], pw3[0]=PKW(P1,8), pw3[1]=PKW(P1,10), pw3); \
    VRD(7); SBAR(); GAPA(C1=__builtin_amdgcn_mfma_f32_32x32x16_bf16(kf[7],qr[3],C1,0,0,0),   P1[14],P1[15],0.f,0.f,       pw3[2]=PKW(P1,12),pw3[3]=PKW(P1,14), pw3); \
    l_reg+=sacc; \
    if(GK){DMA_K((t)+3,sl_cur);} if(GV){DMA_V((t)+1,sl_next);} \
    ADDB(C0,C1,t); \
    CMASK(C0,C1,t); \
    { float a=MX3(C0[0],C0[1],C1[0]),b=MX3(C0[2],C0[3],C1[1]); a=MX3(a,C1[2],C1[3]); \
      _Pragma("unroll") for(int r=4;r<16;r+=4){a=MX3(a,C0[r],C0[r+1]);b=MX3(b,C0[r+2],C0[r+3]);a=MX3(a,C1[r],C1[r+1]);b=MX3(b,C1[r+2],C1[r+3]);} \
      float rm=__builtin_fmaxf(a,b); { auto rr=__builtin_amdgcn_permlane32_swap(__float_as_uint(rm),__float_as_uint(rm),false,false); rm=__builtin_fmaxf(__uint_as_float(rr[0]),__uint_as_float(rr[1])); } \
      resc=false; \
      if(__builtin_expect(__any(rm>(float)THRL),0)){ const float dl=__builtin_fmaxf(rm,0.f); mhat+=dl; \
        _Pragma("unroll") for(int r=0;r<16;++r){C0[r]-=dl;C1[r]-=dl;} \
        _Pragma("unroll") for(int r=0;r<16;++r)negm[r]=-mhat; asm volatile("":"+v"(negm)); \
        const float f=__builtin_amdgcn_exp2f(-dl); l_reg*=f; if(hi==0)wsf[r32]=f; resc=true; } } \
    SBAR(); \
    GAPB(o[0]=__builtin_amdgcn_mfma_f32_32x32x16_bf16(PAF(0),VFR(0),o[0],0,0,0), C0,0); \
    GAPB(o[1]=__builtin_amdgcn_mfma_f32_32x32x16_bf16(PAF(0),VFR(4),o[1],0,0,0), C0,4); \
    KRD(GL,0); GAPB(o[0]=__builtin_amdgcn_mfma_f32_32x32x16_bf16(PAF(1),VFR(1),o[0],0,0,0), C0,8); \
    KRD(GL,1); GAPB(o[1]=__builtin_amdgcn_mfma_f32_32x32x16_bf16(PAF(1),VFR(5),o[1],0,0,0), C0,12); \
    KRD(GL,2); GAPB(o[0]=__builtin_amdgcn_mfma_f32_32x32x16_bf16(PAF(2),VFR(2),o[0],0,0,0), C1,0); \
    KRD(GL,3); GAPB(o[1]=__builtin_amdgcn_mfma_f32_32x32x16_bf16(PAF(2),VFR(6),o[1],0,0,0), C1,4); \
    GAPB(o[0]=__builtin_amdgcn_mfma_f32_32x32x16_bf16(PAF(3),VFR(3),o[0],0,0,0), C1,8); \
    GAPB(o[1]=__builtin_amdgcn_mfma_f32_32x32x16_bf16(PAF(3),VFR(7),o[1],0,0,0), C1,12); \
    }while(0)
  int t=1;
  #undef CMASK
  #define CMASK(P0,P1,t) do{}while(0)
  for(;t+5<NT;t+=2){
    STEP(pB0,pB1,pA0,pA1,t,true,true,true);     WAIT_BAR(2); RESC(); ROT();
    STEP(pA0,pA1,pB0,pB1,t+1,true,true,true);   WAIT_BAR(2); RESC(); ROT();
  }
  #undef CMASK
  #define CMASK(P0,P1,t) do{int jb_=(t)-(NT-4); if(jb_>=0)cmask(P0,P1,jb_,qrel,hi);}while(0)
  #define ENDW(tt) do{ if((tt)+3<NT){WAIT_BAR(2);} else if((tt)+2<NT){WAIT_BAR(1);} else {WAIT_BAR(0);} }while(0)
  for(;t+1<NT;t+=2){
    STEP(pB0,pB1,pA0,pA1,t,(t+3<NT),(t+1<NT),(t+1<NT));       ENDW(t);   RESC(); ROT();
    STEP(pA0,pA1,pB0,pB1,t+1,(t+4<NT),(t+2<NT),(t+2<NT));     ENDW(t+1); RESC(); ROT();
  }
  STEP(pB0,pB1,pA0,pA1,NT-1,false,false,false); RESC();
  { float sacc=pB0[0]+pB0[1]; _Pragma("unroll") for(int r=2;r<16;++r)sacc+=pB0[r]; _Pragma("unroll") for(int r=0;r<16;++r)sacc+=pB1[r]; l_reg+=sacc;
    pw0=(u32x4){PKW(pB0,0),PKW(pB0,2),PKW(pB0,4),PKW(pB0,6)};pw1=(u32x4){PKW(pB0,8),PKW(pB0,10),PKW(pB0,12),PKW(pB0,14)};pw2=(u32x4){PKW(pB1,0),PKW(pB1,2),PKW(pB1,4),PKW(pB1,6)};pw3=(u32x4){PKW(pB1,8),PKW(pB1,10),PKW(pB1,12),PKW(pB1,14)};
    SBAR(); pv(o,vb0+sl_cur,PAF(0),PAF(1),PAF(2),PAF(3)); }
  #undef PKW
  #undef PAF
  #undef VFR
  #undef PIN
  #undef MX3
  #undef GAPA
  #undef GAPB
  #undef EX
  #undef VRD
  #undef KRD
  #undef STEP
  #undef ENDW
  {auto rr=__builtin_amdgcn_permlane32_swap(__float_as_uint(l_reg),__float_as_uint(l_reg),false,false);l_reg=__uint_as_float(rr[0])+__uint_as_float(rr[1]);}
  if(hi==0)wsf[32+r32]=l_reg;asm volatile("s_waitcnt lgkmcnt(0)":::"memory");
  float rli[16];
  #pragma unroll
  for(int r=0;r<16;++r)rli[r]=__builtin_amdgcn_rcpf(wsf[32+crow(r,hi)]);
  bf16*Ow=(bf16*)(Tb+(size_t)qb*TILE_BYTES+T_Y)+(long)(wid*QBLK)*QP+h*D+ocol;
  float*ssw=ssa+(rowbase+q0+wid*QBLK)*8+h;
  { bf16*stg=(bf16*)(shm+LDS_OST)+wid*2048;
    #pragma unroll
    for(int r=0;r<16;++r){const int orow=crow(r,hi);
      #pragma unroll
      for(int d0=0;d0<2;++d0)stg[orow*64+d0*32+r32]=__float2bfloat16(o[d0][r]*rli[r]);}
    asm volatile("s_waitcnt lgkmcnt(0)":::"memory");
    #pragma unroll
    for(int i=0;i<4;++i){const int row=i*8+(lane>>3),ch=lane&7; const u32x4 v=*(const u32x4*)(stg+row*64+ch*8); *(u32x4*)(Ow+(long)row*QP+ch*8)=v;
      float q=0.f;
      #pragma unroll
      for(int e=0;e<4;++e){const float lo=__uint_as_float(v[e]<<16),hi2=__uint_as_float(v[e]&0xffff0000u); q+=lo*lo+hi2*hi2;}
      q+=swz_xor<1>(q);q+=swz_xor<2>(q);q+=swz_xor<4>(q);
      if(ch==0)ssw[row*8]=q;} }
  asm volatile("s_waitcnt lgkmcnt(0)\n\ts_barrier":::"memory");
  #undef DMA_K
  #undef DMA_V
  #undef KVOFF
  #undef CMASK
  #undef ADDB
  #undef START
  #undef RESC
  #undef ROT
}
#undef SBAR
#undef WAIT_BAR

constexpr int CONV_W=31, CONV_C=512, CONV_TOK=32, CONV_ROWS=CONV_TOK+CONV_W-1, CONV_LDS_W=0, CONV_LDS_U=CONV_W*CONV_C*4;
__device__ __forceinline__ float wsum64(float v){ return wave_sum64(v); }
__device__ __forceinline__ void conv_stage_w(const float*cw,char*shm,const int tid){
  ATT_LAS u32x4*LW=(ATT_LAS u32x4*)(shm+CONV_LDS_W); const u32x4*src=(const u32x4*)cw;
  u32x4 v[8];
  #pragma unroll
  for(int i=0;i<8;++i){const int idx=tid+i*512; v[i]=(idx<CONV_W*CONV_C/4)?src[idx]:(u32x4){0u,0u,0u,0u};}
  #pragma unroll
  for(int i=0;i<8;++i){const int idx=tid+i*512; if(idx<CONV_W*CONV_C/4)LW[idx]=v[i];}
  __syncthreads();
}
__device__ __forceinline__ void conv_unit(int unit,const unsigned char*R1,const float*cbias,const float*lng,const float*lnb,char*shm,const int tid){
  const int lane=tid&63,wid=tid>>6;
  const int b=unit>>6,t0=(unit&63)*CONV_TOK;
  const unsigned char*Tb=R1+(size_t)(8*b)*TILE_BYTES;
  ATT_LAS u32x4*L=(ATT_LAS u32x4*)(shm+CONV_LDS_U);
  const ATT_LAS f32x4_t*LW=(const ATT_LAS f32x4_t*)(shm+CONV_LDS_W);
  { u32x4 v[8];
    #pragma unroll
    for(int i=0;i<8;++i){const int idx=tid+i*512,row=idx>>6,ch=idx&63,t=t0-(CONV_W-1)+row;
      v[i]=(u32x4){0u,0u,0u,0u};
      if(idx<CONV_ROWS*64&&t>=0)v[i]=*(const u32x4*)((const bf16*)(Tb+(size_t)(t>>8)*TILE_BYTES+T_U)+(size_t)(t&255)*CONV_C+ch*8);}
    #pragma unroll
    for(int i=0;i<8;++i){const int idx=tid+i*512; if(idx<CONV_ROWS*64)L[idx]=v[i];} }
  __syncthreads();
  float acc[4][8];
  { const f32x4_t b0=*(const f32x4_t*)(cbias+8*lane),b1=*(const f32x4_t*)(cbias+8*lane+4);
    #pragma unroll
    for(int tt=0;tt<4;++tt){acc[tt][0]=b0[0];acc[tt][1]=b0[1];acc[tt][2]=b0[2];acc[tt][3]=b0[3];acc[tt][4]=b1[0];acc[tt][5]=b1[1];acc[tt][6]=b1[2];acc[tt][7]=b1[3];} }
  #pragma unroll 4
  for(int j=0;j<CONV_W;++j){
    const f32x4_t w0=LW[j*128+2*lane],w1=LW[j*128+2*lane+1];
    #pragma unroll
    for(int tt=0;tt<4;++tt){
      const u32x4 u=L[(wid*4+tt+j)*64+lane];
      acc[tt][0]+=w0[0]*__uint_as_float(u[0]<<16); acc[tt][1]+=w0[1]*__uint_as_float(u[0]&0xffff0000u);
      acc[tt][2]+=w0[2]*__uint_as_float(u[1]<<16); acc[tt][3]+=w0[3]*__uint_as_float(u[1]&0xffff0000u);
      acc[tt][4]+=w1[0]*__uint_as_float(u[2]<<16); acc[tt][5]+=w1[1]*__uint_as_float(u[2]&0xffff0000u);
      acc[tt][6]+=w1[2]*__uint_as_float(u[3]<<16); acc[tt][7]+=w1[3]*__uint_as_float(u[3]&0xffff0000u);
    }
  }
  const f32x4_t g0=*(const f32x4_t*)(lng+8*lane),g1=*(const f32x4_t*)(lng+8*lane+4),e0=*(const f32x4_t*)(lnb+8*lane),e1=*(const f32x4_t*)(lnb+8*lane+4);
  const float gg[8]={g0[0],g0[1],g0[2],g0[3],g1[0],g1[1],g1[2],g1[3]},bb[8]={e0[0],e0[1],e0[2],e0[3],e1[0],e1[1],e1[2],e1[3]};
  float mu[4],rstd[4],r2[4];
  #pragma unroll
  for(int tt=0;tt<4;++tt){ float s=0.f;
    #pragma unroll
    for(int e=0;e<8;++e)s+=acc[tt][e];
    mu[tt]=s; }
  #pragma unroll
  for(int tt=0;tt<4;++tt)mu[tt]=wsum64(mu[tt])*(1.0f/CONV_C);
  #pragma unroll
  for(int tt=0;tt<4;++tt){ float q=0.f;
    #pragma unroll
    for(int e=0;e<8;++e){acc[tt][e]-=mu[tt];q+=acc[tt][e]*acc[tt][e];}
    rstd[tt]=q; }
  #pragma unroll
  for(int tt=0;tt<4;++tt)rstd[tt]=__builtin_amdgcn_rsqf(wsum64(rstd[tt])*(1.0f/CONV_C)+1e-6f);
  #pragma unroll
  for(int tt=0;tt<4;++tt){ float q2=0.f;
    #pragma unroll
    for(int e=0;e<8;++e){float y=acc[tt][e]*rstd[tt]*gg[e]+bb[e]; y=y*__builtin_amdgcn_rcpf(1.0f+__builtin_amdgcn_exp2f(-y*1.4426950408889634f)); acc[tt][e]=y;q2+=y*y;}
    r2[tt]=q2; }
  #pragma unroll
  for(int tt=0;tt<4;++tt)r2[tt]=__builtin_amdgcn_rsqf(wsum64(r2[tt])*(1.0f/CONV_C)+1e-6f);
  #pragma unroll
  for(int tt=0;tt<4;++tt){
    u32x4 w; const float r=r2[tt];
    w[0]=cvtpk_s(acc[tt][0]*r,acc[tt][1]*r);w[1]=cvtpk_s(acc[tt][2]*r,acc[tt][3]*r);w[2]=cvtpk_s(acc[tt][4]*r,acc[tt][5]*r);w[3]=cvtpk_s(acc[tt][6]*r,acc[tt][7]*r);
    { const int t=t0+wid*4+tt; *(u32x4*)((bf16*)(Tb+(size_t)(t>>8)*TILE_BYTES+T_Y)+(size_t)(t&255)*QP+CONV_C+8*lane)=w; }
  }
  __syncthreads();
}
}
constexpr int NWAVES = 8;
constexpr int M = 16384, DM = 1024, DFF = 2816, SEQ = 2048, NBATCH = 8, NMEMROWS = 2048, NLAYER = 2;
constexpr size_t MiB = 1u << 20;
constexpr size_t WS_CTL = 0, CTL_ZERO_BYTES = 256 * 1024;
constexpr size_t WS_W = 2 * MiB;
constexpr size_t W_LAYER = 97 * MiB / 2;
constexpr size_t WO_1A = 0, WO_1B = 11 * MiB, WO_IN = WO_1B + 11 * MiB / 2, WO_OUT = WO_IN + 11 * MiB / 2, WO_XQ = WO_OUT + 2 * MiB, WO_XKV = WO_XQ + 2 * MiB, WO_XO = WO_XKV + 4 * MiB,
                 WO_2A = WO_XO + 2 * MiB, WO_2B = WO_2A + 11 * MiB;
static_assert(WO_2B + 11 * MiB / 2 == W_LAYER, "weight map");
constexpr size_t WS_XB = 100 * MiB;
constexpr size_t WS_MKV = 132 * MiB;
constexpr size_t WS_MEMB = 148 * MiB;
constexpr size_t WS_R1 = 152 * MiB;
constexpr size_t DOUT_WQK = 0, DOUT_WVO = 2 * MiB, DOUT_BATCH = 8 * MiB;
constexpr size_t WS_SSP = 99 * MiB;
constexpr size_t WS_DUMMY = 248 * MiB, WS_SSA = 249 * MiB;
constexpr size_t WS_END = 250 * MiB;
constexpr int CW_BAR = 4096;
constexpr int CW_QUAD = 16384;
constexpr size_t CTL_SSM = 256 * 1024;
constexpr int RING_OFF = 0, RING_BYTES = 131072;
constexpr int EPI_SCR_OFF = RING_BYTES;
constexpr int LDSCTL_OFF = RING_BYTES + 8192, MISC_OFF = LDSCTL_OFF + 320;
constexpr int LDS_BYTES = 147456;
static_assert(MISC_OFF + 128 <= LDS_BYTES, "LDS map");

#define GAS __attribute__((address_space(1)))
#define LAS __attribute__((address_space(3)))
typedef unsigned short bf16;
typedef unsigned v4u __attribute__((ext_vector_type(4)));
typedef float f32x4 __attribute__((ext_vector_type(4)));
typedef GAS unsigned gu32;
#define RLX_AGENT __ATOMIC_RELAXED, __HIP_MEMORY_SCOPE_AGENT
#define LDS_WAIT() asm volatile("s_waitcnt lgkmcnt(0)" ::: "memory")
__device__ __forceinline__ unsigned f2bf(float f) { unsigned u = __builtin_bit_cast(unsigned, f); return (u + 0x7fffu + ((u >> 16) & 1u)) >> 16; }
__device__ __forceinline__ unsigned pk2(float lo, float hi) { return f2bf(lo) | (f2bf(hi) << 16); }

#define XB_TMO      128
#define XB_XCNT(j)  (256  + 64 * (j))
#define XB_XSUB(j)  (1280 + 64 * (j))
#define XB_XGEN(j)  (2304 + 64 * (j))
#define XB_TOP      3328
#define XB_TOPGEN   3392
#define XCD_BAR_WORDS 3456
#define XB_SPIN_CAP (1u << 18)
__device__ __forceinline__ unsigned xb_ld(unsigned* p)              { return __hip_atomic_load(p, __ATOMIC_RELAXED, __HIP_MEMORY_SCOPE_AGENT); }
__device__ __forceinline__ unsigned xb_add(unsigned* p, unsigned v) { return __hip_atomic_fetch_add(p, v, __ATOMIC_RELAXED, __HIP_MEMORY_SCOPE_AGENT); }
__device__ __forceinline__ unsigned xb_xcc_id() { return (unsigned)__builtin_amdgcn_s_getreg((3 << 11) | 20) & 0xFu; }
#define XB_SPIN(cond, bar) do { unsigned _sp = 0; while (cond) { __builtin_amdgcn_s_sleep(1); \
    if ((++_sp & 255u) == 0u) { if (xb_ld(&(bar)[XB_TMO])) break; if (_sp > XB_SPIN_CAP) { atomicAdd(&(bar)[XB_TMO], 1u); break; } } } } while (0)
struct XcdBarrier { unsigned* bar; unsigned x; volatile LAS unsigned* st; };
__device__ __forceinline__ XcdBarrier xcd_barrier_post(unsigned* bar, volatile LAS unsigned* st) {
    XcdBarrier b; b.bar = bar; b.x = xb_xcc_id(); b.st = st;
    if (threadIdx.x == 0) { const unsigned rank = xb_add(&bar[XB_XCNT(b.x)], 1u); st[2] = b.x; st[3] = rank; }
    return b;
}
__device__ __forceinline__ void xcd_barrier_complete(unsigned* bar, unsigned x, unsigned& nloc, unsigned& nx) {
    const unsigned G = gridDim.x * gridDim.y * gridDim.z;
    unsigned sum, cnt, mine, sp = 0u;
    for (;;) {
        sum = 0u; cnt = 0u; mine = 0u;
#pragma unroll
        for (unsigned j = 0; j < 16; ++j) { const unsigned c = xb_ld(&bar[XB_XCNT(j)]); sum += c; cnt += (c > 0u) ? 1u : 0u; mine = (j == x) ? c : mine; }
        if (sum == G) break;
        __builtin_amdgcn_s_sleep(1);
        if ((++sp & 255u) == 0u) { if (xb_ld(&bar[XB_TMO])) break; if (sp > XB_SPIN_CAP) { atomicAdd(&bar[XB_TMO], 1u); break; } }
    }
    nloc = mine > 0u ? mine : 1u; nx = cnt > 0u ? cnt : 1u;
}
__device__ __forceinline__ void xcd_barrier(const XcdBarrier& b) {
    asm volatile("s_waitcnt vmcnt(0)" ::: "memory");
    __syncthreads();
    if (threadIdx.x == 0) {
        unsigned* bar = b.bar;
        __builtin_amdgcn_s_waitcnt(0);
        unsigned nloc = b.st[0], nx = b.st[1];
        if (nloc == 0u) { xcd_barrier_complete(bar, b.x, nloc, nx); b.st[0] = nloc; b.st[1] = nx; }
        const unsigned old = xb_add(&bar[XB_XSUB(b.x)], 1u);
        const unsigned gen = old / nloc;
        if (old + 1u == (gen + 1u) * nloc) {
            __builtin_amdgcn_fence(__ATOMIC_RELEASE, "agent");
            asm volatile("s_waitcnt vmcnt(0)" ::: "memory");
            const unsigned og = xb_add(&bar[XB_TOP], 1u);
            const unsigned tg = og / nx;
            if (og + 1u == (tg + 1u) * nx) xb_add(&bar[XB_TOPGEN], 1u);
            else XB_SPIN(xb_ld(&bar[XB_TOPGEN]) == tg, bar);
            __builtin_amdgcn_fence(__ATOMIC_ACQUIRE, "agent");
            xb_add(&bar[XB_XGEN(b.x)], 1u);
            asm volatile("s_waitcnt vmcnt(0)" ::: "memory");
        } else {
            XB_SPIN(xb_ld(&bar[XB_XGEN(b.x)]) == gen, bar);
            __builtin_amdgcn_fence(__ATOMIC_ACQUIRE, "agent");
            asm volatile("s_waitcnt vmcnt(0)" ::: "memory");
        }
    }
    __syncthreads();
}

__device__ __forceinline__ void xcd_local_barrier(unsigned* bar, unsigned x) {
    asm volatile("s_waitcnt vmcnt(0)" ::: "memory");
    __syncthreads();
    if (threadIdx.x == 0) {
        __builtin_amdgcn_s_waitcnt(0);
        const unsigned old = xb_add(&bar[XB_XSUB(x)], 1u), gen = old / 32u;
        if (old + 1u == (gen + 1u) * 32u) xb_add(&bar[XB_XGEN(x)], 1u);
        else XB_SPIN(xb_ld(&bar[XB_XGEN(x)]) == gen, bar);
        __builtin_amdgcn_fence(__ATOMIC_ACQUIRE, "agent");
        asm volatile("s_waitcnt vmcnt(0)" ::: "memory");
    }
    __syncthreads();
}
__device__ __forceinline__ void quad_barrier(unsigned* bar, unsigned* qw) {
    asm volatile("s_waitcnt vmcnt(0)" ::: "memory");
    __syncthreads();
    if (threadIdx.x == 0) {
        __builtin_amdgcn_s_waitcnt(0);
        const unsigned old = xb_add(&qw[0], 1u), gen = old / 4u;
        if (old + 1u == (gen + 1u) * 4u) xb_add(&qw[64], 1u);
        else XB_SPIN(xb_ld(&qw[64]) == gen, bar);
        __builtin_amdgcn_fence(__ATOMIC_ACQUIRE, "agent");
        asm volatile("s_waitcnt vmcnt(0)" ::: "memory");
    }
    __syncthreads();
}

__device__ __forceinline__ float wave_sum(float v) { return wave_sum64(v); }
__device__ __forceinline__ void tr_item(const float* W, int ldw, int col0, int nvalid, int k0, const float* gain, int gsplit, const float* gain2, bf16* WT, int ldt, int drow0, LAS float* scr, int lane) {
#pragma unroll 8
    for (int i = 0; i < 32; ++i) { const int kk = 2 * i + (lane >> 5), n = lane & 31, k = k0 + kk;
        float v = (n < nvalid) ? W[(size_t)k * ldw + col0 + n] : 0.f;
        if (gain) v *= (k < gsplit ? gain[k] : gain2[k - gsplit]);
        scr[kk * 33 + n] = v; }
    LDS_WAIT(); asm volatile("" ::: "memory");
    const int c = lane & 7;
#pragma unroll
    for (int j = 0; j < 4; ++j) { const int n = (lane >> 3) + 8 * j; const LAS float* s = scr + (8 * c) * 33 + n;
        v4u o; o.x = pk2(s[0 * 33], s[1 * 33]); o.y = pk2(s[2 * 33], s[3 * 33]); o.z = pk2(s[4 * 33], s[5 * 33]); o.w = pk2(s[6 * 33], s[7 * 33]);
        *(GAS v4u*)(WT + (size_t)(drow0 + n) * ldt + k0 + 8 * c) = o; }
    LDS_WAIT(); asm volatile("" ::: "memory");
}
__device__ __forceinline__ void tr_item64(const float* W, int ldw, int col0, int nvalid, int k0, const float* gain, int gsplit, const float* gain2, bf16* WT, int ldt, int drow0, int lane) {
    float v[64];
    const float* src = W + (size_t)k0 * ldw + col0 + lane; const bool ok = lane < nvalid;
#pragma unroll
    for (int j = 0; j < 64; ++j) v[j] = ok ? __builtin_nontemporal_load(src + (size_t)j * ldw) : 0.f;
    if (gain) {
#pragma unroll
        for (int j = 0; j < 64; ++j) { const int k = k0 + j; v[j] *= (k < gsplit ? gain[k] : gain2[k - gsplit]); }
    }
    bf16* dst = WT + (size_t)(drow0 + lane) * ldt + k0;
#pragma unroll
    for (int c = 0; c < 8; ++c) { v4u o; o.x = pk2(v[8 * c], v[8 * c + 1]); o.y = pk2(v[8 * c + 2], v[8 * c + 3]); o.z = pk2(v[8 * c + 4], v[8 * c + 5]); o.w = pk2(v[8 * c + 6], v[8 * c + 7]);
        *(GAS v4u*)(dst + 8 * c) = o; }
}
__device__ __forceinline__ void row_to_bf16(const float* xrow, bf16* orow, float* ssp, int lane) {
    const GAS f32x4* xr = (const GAS f32x4*)xrow + lane;
    f32x4 v[4]; float s = 0.f;
#pragma unroll
    for (int j = 0; j < 4; ++j) { v[j] = xr[64 * j]; s += (v[j].x * v[j].x + v[j].y * v[j].y) + (v[j].z * v[j].z + v[j].w * v[j].w); }
    s = wave_sum(s);
    GAS unsigned long long* o8 = (GAS unsigned long long*)orow + lane;
#pragma unroll
    for (int j = 0; j < 4; ++j) o8[64 * j] = (unsigned long long)pk2(v[j].x, v[j].y) | ((unsigned long long)pk2(v[j].z, v[j].w) << 32);
    if (lane == 0) *ssp = s;
}

struct Args { const float* in[26]; float* out; unsigned char* ws; };

enum { PH_PRO = 0, PH_L0 = 1, PH_PER_LAYER = 9, PH_FINAL = PH_L0 + 2 * PH_PER_LAYER, PH_COUNT = PH_FINAL + 1 };

#define WSP() ({ unsigned char* w_ = args.ws; asm volatile("" : "+s"(w_)); w_; })
#define INP(i) ({ int i_ = __builtin_amdgcn_readfirstlane(i); asm volatile("" : "+s"(i_)); args.in[i_]; })
#define XPTR() ({ float* x_ = args.out; asm volatile("" : "+s"(x_)); x_; })
#define TID() ({ int w_ = wid_s; asm volatile("" : "+s"(w_)); int t_ = (w_ << 6) | (int)__builtin_amdgcn_mbcnt_hi(~0u, __builtin_amdgcn_mbcnt_lo(~0u, 0u)); asm volatile("" : "+v"(t_)); t_; })

constexpr size_t T1K = (size_t)256 * 1024 * 2, TFF = (size_t)256 * 2816 * 2, TLB = pg8::TILE_BYTES;
using G_1024 = pg8::Gemm<1024, 1024, 1024>; using G_down = pg8::Gemm<2816, 2816, 2816>; using G_qk = pg8::Gemm<2048, 1024, 256>; using G_vo = pg8::Gemm<1024, 2048, 256>;
using S_up = pg8::SchedT<0, 64, 22, T1K, T1K>; using S_mkv = pg8::SchedT<4, 8, 8, T1K, T1K>; using S_down = pg8::SchedT<0, 64, 4, TLB, TFF>; using S_win = pg8::SchedT<0, 64, 11, T1K, T1K>;
using S_wout = pg8::SchedT<0, 64, 4, TLB, T1K>; using S_xs = pg8::SchedT<1, 64, 4, T1K, T1K, DOUT_BATCH>; using S_xpv = pg8::SchedT<1, 64, 4, TLB, T1K, DOUT_BATCH>;
using S_qk = pg8::SchedT<2, 128, 1, 0, 0>; using S_vo = pg8::SchedT<3, 128, 1, 0, 0>;

#ifndef PROBE_MASK
#define PROBE_MASK 0
#endif
#ifndef PROBE_REPS
#define PROBE_REPS 1
#endif
#ifndef PROBE_BARS
#define PROBE_BARS 0
#endif
#ifndef PROBE_NOATT
#define PROBE_NOATT 0
#endif
#ifndef PROBE_NOCONV
#define PROBE_NOCONV 0
#endif
#ifndef FORCE_GLOBAL
#define FORCE_GLOBAL 0
#endif
#define NREP(k) (((PROBE_MASK >> (k)) & 1) ? (PROBE_REPS + 1) : 1)
#define REP_LOOP(k) _Pragma("unroll 1") for (int rep_ = 0; rep_ < NREP(k); ++rep_)
#define SHADOW(k) (NREP(k) > 1 && rep_ + 1 < NREP(k))
#define REP_SEAM(k) do { if (SHADOW(k)) GRIDBAR(); } while (0)

#define WSP() ({ unsigned char* w_ = args.ws; asm volatile("" : "+s"(w_)); w_; })
#define INP(i) ({ int i_ = __builtin_amdgcn_readfirstlane(i); asm volatile("" : "+s"(i_)); args.in[i_]; })
#define XPTR() ({ float* x_ = args.out; asm volatile("" : "+s"(x_)); x_; })
#define TID() ({ int w_ = wid_s; asm volatile("" : "+s"(w_)); int t_ = (w_ << 6) | (int)__builtin_amdgcn_mbcnt_hi(~0u, __builtin_amdgcn_mbcnt_lo(~0u, 0u)); asm volatile("" : "+v"(t_)); t_; })
#define MISCW(k) (*({ unsigned o_ = MISC_OFF + 4 * (k); asm volatile("" : "+s"(o_)); (volatile LAS unsigned*)(ldsp + o_); }))
#define BXP() ((int)__builtin_amdgcn_readfirstlane((int)MISCW(13)))
#define BARW() ((unsigned*)(WSP() + WS_CTL) + CW_BAR)
#define GRIDBAR() do { XcdBarrier bar_; bar_.bar = BARW(); bar_.x = xb_xcc_id(); bar_.st = &MISCW(8); xcd_barrier(bar_); } while (0)
#define XCDBAR() do { if (MISCW(12)) xcd_local_barrier(BARW(), MISCW(10)); else GRIDBAR(); } while (0)
#define QUADBAR() do { if (MISCW(12)) { unsigned* bw_ = BARW(); quad_barrier(bw_, bw_ - CW_BAR + CW_QUAD + 128 * (MISCW(10) * 8 + (MISCW(11) & 7))); } else GRIDBAR(); } while (0)

__global__ void __launch_bounds__(NWAVES * 64, 2) mega_fwd(Args args) {
    extern __shared__ __attribute__((aligned(16))) unsigned char lds[];
    LAS unsigned char* ldsp = (LAS unsigned char*)lds;
    volatile LAS unsigned* MISC = (volatile LAS unsigned*)(ldsp + MISC_OFF);
    constexpr int G = 256; const int bx = blockIdx.x;
    const int wid_s = __builtin_amdgcn_readfirstlane(threadIdx.x >> 6);
    for (int u = threadIdx.x; u < (LDS_BYTES - LDSCTL_OFF) / 4; u += NWAVES * 64) ((LAS unsigned*)(ldsp + LDSCTL_OFF))[u] = 0u;
    __syncthreads();
    (void)xcd_barrier_post((unsigned*)(args.ws + WS_CTL) + CW_BAR, MISC + 8);
    constexpr float QSCALE = 0.125f * 1.4426950408889634f, XSCALE = 0.0625f * 1.4426950408889634f;

    REP_LOOP(9) {
        unsigned char* ws = WSP(); const int tid = TID();
        const int lane = tid & 63, wave = __builtin_amdgcn_readfirstlane(tid >> 6);
        const int gw = bx * NWAVES + wave, NGW = G * NWAVES;
        constexpr int I_GU = 2 * 16 * 44, I_DN = 44 * 16, I_IN = 16 * 41, I_SQ = 16 * 16, I_KV = 16 * 32, I_WQ = 256;
        constexpr int L_ITEMS = 2 * (I_GU + I_DN) + I_IN + I_SQ + I_KV + I_SQ + I_WQ, W_ITEMS = NLAYER * L_ITEMS, X_ITEMS = M / 4, MEM_ITEMS = NMEMROWS / 4;
#pragma unroll 1
        for (int it = gw; it < W_ITEMS + X_ITEMS + MEM_ITEMS; it += NGW) {
            if (it < W_ITEMS) {
                const int l = it / L_ITEMS; int r = it % L_ITEMS;
                unsigned char* wl = ws + WS_W + (size_t)l * W_LAYER;
                if (r < 2 * (I_GU + I_DN)) {
                    const int f = r / (I_GU + I_DN); r %= (I_GU + I_DN);
                    if (r < I_GU) { const int which = r / (16 * 44), q = r % (16 * 44), kb = q / 44, nb = q % 44, j0 = nb * 64;
                        const float* w = INP(which ? (f ? 23 : 4) : (f ? 22 : 3)) + (size_t)l * DM * DFF; const float* gn = INP(f ? 21 : 2) + l * DM;
                        tr_item64(w, DFF, j0, 64, kb * 64, gn, 1 << 30, gn, (bf16*)(wl + (f ? WO_2A : WO_1A)), DM, 256 * (j0 / 128) + which * 128 + (j0 % 128), lane); }
                    else { r -= I_GU; const int kb = r / 16, nb = r % 16; const float* w = INP(f ? 24 : 5) + (size_t)l * DFF * DM;
                        tr_item64(w, DM, nb * 64, 64, kb * 64, nullptr, 0, w, (bf16*)(wl + (f ? WO_2B : WO_1B)), DFF, nb * 64, lane); }
                    continue;
                }
                r -= 2 * (I_GU + I_DN);
                if (r < I_IN) {
                    const int kb = r / 41, nb = r % 41; int col0, nvalid = 64, drow0;
                    if (nb < 24) { col0 = nb * 64; drow0 = col0; }
                    else if (nb == 24) { col0 = 1536; nvalid = 8; drow0 = 2560; }
                    else if (nb < 33) { const int ch = (nb - 25) * 64; col0 = 1544 + ch; drow0 = 1536 + 256 * (ch / 128) + (ch % 128); }
                    else { const int ch = (nb - 33) * 64; col0 = 2056 + ch; drow0 = 1536 + 256 * (ch / 128) + 128 + (ch % 128); }
                    const float* w = INP(7) + (size_t)l * DM * 2568; const float* gn = INP(6) + l * DM;
                    tr_item64(w, 2568, col0, nvalid, kb * 64, gn, 1 << 30, gn, (bf16*)(wl + WO_IN), DM, drow0, lane); continue; }
                r -= I_IN;
                if (r < I_SQ) { const int kb = r / 16, nb = r % 16; const float* w = INP(15) + (size_t)l * DM * DM;
                    tr_item64(w, DM, nb * 64, 64, kb * 64, INP(13) + l * 512, 512, INP(14) + l * 512, (bf16*)(wl + WO_OUT), DM, nb * 64, lane); continue; }
                r -= I_SQ;
                if (r < I_KV) { const int kb = r / 32, nb = r % 32; const float* w = INP(19) + (size_t)l * DM * 2048; const float* gn = INP(17) + l * DM;
                    tr_item64(w, 2048, nb * 64, 64, kb * 64, gn, 1 << 30, gn, (bf16*)(wl + WO_XKV), DM, nb * 64, lane); continue; }
                r -= I_KV;
                if (r < I_SQ) { const int kb = r / 16, nb = r % 16; const float* w = INP(20) + (size_t)l * DM * DM;
                    tr_item64(w, DM, nb * 64, 64, kb * 64, nullptr, 0, w, (bf16*)(wl + WO_XO), DM, nb * 64, lane); continue; }
                r -= I_SQ;
                { const float* w = INP(18) + (size_t)l * DM * DM; const float* gn = INP(16) + l * DM; bf16* WQ = (bf16*)(wl + WO_XQ);
                  f32x4 v[4][4];
#pragma unroll
                  for (int q = 0; q < 4; ++q)
#pragma unroll
                      for (int j = 0; j < 4; ++j) v[q][j] = __builtin_nontemporal_load((const GAS f32x4*)(w + (size_t)(4 * r + q) * DM) + lane + 64 * j);
#pragma unroll
                  for (int q = 0; q < 4; ++q) { const float g = gn[4 * r + q] * XSCALE; GAS unsigned long long* o8 = (GAS unsigned long long*)(WQ + (size_t)(4 * r + q) * DM) + lane;
#pragma unroll
                      for (int j = 0; j < 4; ++j) { const f32x4 t = v[q][j] * g; o8[64 * j] = (unsigned long long)pk2(t.x, t.y) | ((unsigned long long)pk2(t.z, t.w) << 32); } } }
            } else {
                int r = it - W_ITEMS; const bool ismem = r >= X_ITEMS; if (ismem) r -= X_ITEMS;
                const float* src = INP(ismem ? 1 : 0) + (size_t)(4 * r) * DM; bf16* dst = (bf16*)(ws + (ismem ? WS_MEMB : WS_XB)) + (size_t)(4 * r) * DM; float* ssp = ismem ? (float*)(ws + CTL_SSM) + 4 * r : (float*)(ws + WS_SSP) + (size_t)(4 * r) * 16;
                f32x4 v[4][4]; float s[4];
#pragma unroll
                for (int q = 0; q < 4; ++q)
#pragma unroll
                    for (int j = 0; j < 4; ++j) v[q][j] = __builtin_nontemporal_load((const GAS f32x4*)(src + (size_t)q * DM) + lane + 64 * j);
#pragma unroll
                for (int q = 0; q < 4; ++q) { s[q] = 0.f;
#pragma unroll
                    for (int j = 0; j < 4; ++j) s[q] += (v[q][j].x * v[q][j].x + v[q][j].y * v[q][j].y) + (v[q][j].z * v[q][j].z + v[q][j].w * v[q][j].w); }
#pragma unroll
                for (int q = 0; q < 4; ++q) { s[q] = wave_sum64(s[q]); GAS unsigned long long* o8 = (GAS unsigned long long*)(dst + (size_t)q * DM) + lane;
#pragma unroll
                    for (int j = 0; j < 4; ++j) o8[64 * j] = (unsigned long long)pk2(v[q][j].x, v[q][j].y) | ((unsigned long long)pk2(v[q][j].z, v[q][j].w) << 32);
                    if (ismem) { if (lane == 0) ssp[q] = s[q]; } else if (lane < 16) ssp[q * 16 + lane] = (lane == 0) ? s[q] : 0.f; }
            }
        }
        REP_SEAM(9);
    }
    GRIDBAR();
    if (threadIdx.x == 0) {
        unsigned* bw = BARW(); bool ok = !FORCE_GLOBAL;
        for (int j = 0; j < 16; ++j) ok = ok && (xb_ld(&bw[XB_XCNT(j)]) == (j < 8 ? 32u : 0u));
        MISCW(12) = ok ? 1u : 0u; MISCW(13) = ok ? (MISCW(11) * 8u + MISCW(10)) : (unsigned)bx;
    }
    __syncthreads();

#pragma unroll 1
    for (int l = 0; l < NLAYER; ++l) {
#pragma unroll 1
        for (int f = 0; f < 2; ++f) {
            REP_LOOP(0) {
                unsigned char* ws = WSP(); unsigned char* wl = ws + WS_W + (size_t)l * W_LAYER; const int bxp = BXP();
                G_1024 g; S_up S; S.init(bxp, ws + WS_XB, wl + (f ? WO_2A : WO_1A));
                pg8::EpiSwiGLU E{(bf16*)(ws + WS_R1), (float*)(ws + WS_SSP)};
                pg8::gemm_phase<pg8::EpiSwiGLU, decltype(S), decltype(g)>(ldsp + RING_OFF, g, S, E, TID());
                if (l == 0 && f == 0) {
#pragma unroll 1
                    for (int l2 = 0; l2 < NLAYER; ++l2) {
                        unsigned char* ws2 = WSP();
                        S_mkv S2; S2.init(bxp - 128 - 64 * l2, ws2 + WS_MEMB, ws2 + WS_W + (size_t)l2 * W_LAYER + WO_XKV);
                        pg8::EpiRowScale E2{(bf16*)(ws2 + WS_MKV) + (size_t)l2 * 2048 * 2048, (float*)(ws2 + CTL_SSM), 1.0f};
                        pg8::gemm_phase<pg8::EpiRowScale, decltype(S2), decltype(g)>(ldsp + RING_OFF, g, S2, E2, TID());
                    }
                }
                REP_SEAM(0);
            }
            QUADBAR();
            REP_LOOP(1) {
                unsigned char* ws = WSP(); unsigned char* wl = ws + WS_W + (size_t)l * W_LAYER;
                G_down g; S_down S; S.init(BXP(), ws + WS_R1, wl + (f ? WO_2B : WO_1B));
                pg8::EpiResid<0> E{(l == 0 && f == 0) ? INP(0) : (const float*)nullptr, nullptr, (bf16*)(ws + WS_XB), SHADOW(1) ? (float*)(ws + WS_DUMMY) : (float*)(ws + WS_SSP), nullptr, SHADOW(1) ? 0.f : 0.5f};
                E.shadow_skip = SHADOW(1);
                pg8::gemm_phase<pg8::EpiResid<0>, decltype(S), decltype(g)>(ldsp + RING_OFF, g, S, E, TID());
                REP_SEAM(1);
            }
            if (f == 1) break;
            QUADBAR();
            REP_LOOP(2) {
                unsigned char* ws = WSP(); unsigned char* wl = ws + WS_W + (size_t)l * W_LAYER;
                G_1024 g; S_win S; S.init(BXP(), ws + WS_XB, wl + WO_IN);
                pg8::EpiWin E{ws + WS_R1, (float*)(ws + WS_SSP), INP(8) + l * 8, QSCALE};
                pg8::gemm_phase<pg8::EpiWin, decltype(S), decltype(g)>(ldsp + RING_OFF, g, S, E, TID());
                REP_SEAM(2);
            }
            XCDBAR();
            REP_LOOP(3) {
                unsigned char* ws = WSP(); unsigned char* R1 = ws + WS_R1; const int bxp = BXP();
                char* shm = (char*)lds + RING_OFF;
                const int vcu = (bxp & 7) * 32 + (bxp >> 3);
                const int bh = vcu >> 2, s4 = vcu & 3;
                float* ssa = SHADOW(3) ? (float*)(ws + WS_DUMMY) : (float*)(ws + WS_SSA);
                if (!(SHADOW(3) && PROBE_NOATT)) {
                attn_body::scan_bias(R1, bh >> 3, bh & 7, shm, TID());
#pragma unroll 1
                for (int iu = 0; iu < 2; ++iu) attn_body::attn_unit<60>(bh >> 3, bh & 7, iu ? 7 - s4 : s4, R1, SHADOW(3) ? 512 : 0, ssa, shm, TID());
                __syncthreads();
                }
                if (!(SHADOW(3) && PROBE_NOCONV)) {
                    attn_body::conv_stage_w(INP(9) + (size_t)l * 31 * 512, shm, TID());
#pragma unroll 1
                    for (int iu = 0; iu < 2; ++iu) attn_body::conv_unit(2 * vcu + iu, R1, INP(10) + l * 512, INP(11) + l * 512, INP(12) + l * 512, shm, TID());
                }
                { unsigned char* ws2 = WSP(); unsigned char* wl = ws2 + WS_W + (size_t)l * W_LAYER;
                  G_qk g; S_qk S; S.init(bxp, (bf16*)(ws2 + WS_MKV) + (size_t)l * 2048 * 2048, wl + WO_XQ);
                  pg8::EpiAux E{(bf16*)((unsigned char*)XPTR() + DOUT_WQK), 1.0f};
                  pg8::gemm_phase<pg8::EpiAux, decltype(S), decltype(g)>(ldsp + RING_OFF, g, S, E, TID()); }
                { unsigned char* ws2 = WSP(); unsigned char* wl = ws2 + WS_W + (size_t)l * W_LAYER;
                  G_vo g; S_vo S; S.init(bxp - 128, wl + WO_XO, (bf16*)(ws2 + WS_MKV) + (size_t)l * 2048 * 2048);
                  pg8::EpiAux E{(bf16*)((unsigned char*)XPTR() + DOUT_WVO), 1.0f};
                  pg8::gemm_phase<pg8::EpiAux, decltype(S), decltype(g)>(ldsp + RING_OFF, g, S, E, TID()); }
                REP_SEAM(3);
            }
            XCDBAR();
            REP_LOOP(4) {
                unsigned char* ws = WSP(); unsigned char* wl = ws + WS_W + (size_t)l * W_LAYER;
                G_1024 g; S_wout S; S.init(BXP(), ws + WS_R1 + pg8::T_Y, wl + WO_OUT);
                pg8::EpiResid<8> E{nullptr, nullptr, (bf16*)(ws + WS_XB), SHADOW(4) ? (float*)(ws + WS_DUMMY) : (float*)(ws + WS_SSP), (float*)(ws + WS_SSA), SHADOW(4) ? 0.f : 1.0f};
                pg8::gemm_phase<pg8::EpiResid<8>, decltype(S), decltype(g)>(ldsp + RING_OFF, g, S, E, TID());
                REP_SEAM(4);
            }
            QUADBAR();
            REP_LOOP(5) {
                unsigned char* ws = WSP();
                G_1024 g; S_xs S; S.init(BXP(), ws + WS_XB, (unsigned char*)XPTR() + DOUT_WQK);
                pg8::EpiSoftmax E{ws + WS_R1, (float*)(ws + WS_SSP), (LAS float*)(ldsp + EPI_SCR_OFF)};
                E.shadow_skip = SHADOW(5);
                pg8::gemm_phase<pg8::EpiSoftmax, decltype(S), decltype(g)>(ldsp + RING_OFF, g, S, E, TID());
                REP_SEAM(5);
            }
            QUADBAR();
            REP_LOOP(6) {
                unsigned char* ws = WSP();
                G_1024 g; S_xpv S; S.init(BXP(), ws + WS_R1 + pg8::T_Y, (unsigned char*)XPTR() + DOUT_WVO);
                pg8::EpiResid<0> E{nullptr, nullptr, (bf16*)(ws + WS_XB), SHADOW(6) ? (float*)(ws + WS_DUMMY) : (float*)(ws + WS_SSP), nullptr, SHADOW(6) ? 0.f : 1.0f};
                E.shadow_skip = SHADOW(6);
                pg8::gemm_phase<pg8::EpiResid<0>, decltype(S), decltype(g)>(ldsp + RING_OFF, g, S, E, TID());
                REP_SEAM(6);
            }
            QUADBAR();
        }
        if (l + 1 < NLAYER) QUADBAR();
    }
    XCDBAR();
    for (int eb_ = 0; eb_ < PROBE_BARS; ++eb_) GRIDBAR();
    {
        unsigned char* ws = WSP(); float* X = XPTR(); const int tid = TID(); const int bxp = BXP();
        const int lane = tid & 63, wave = __builtin_amdgcn_readfirstlane(tid >> 6);
        const int row0 = (8 * (bxp & 7) + ((bxp >> 3) & 7)) * 256 + (bxp >> 6) * 64 + wave * 8;
        const float* ssf = (float*)(ws + WS_SSP); const float* gn = INP(25); const bf16* XB = (const bf16*)(ws + WS_XB);
        f32x4 gv[4];
#pragma unroll
        for (int j = 0; j < 4; ++j) gv[j] = *((const GAS f32x4*)gn + lane + 64 * j);
#pragma unroll 2
        for (int r = 0; r < 8; ++r) { const int m = row0 + r; const float rs = pg8::rs_row(ssf, m);
            const GAS unsigned long long* xr = (const GAS unsigned long long*)(XB + (size_t)m * DM) + lane; GAS f32x4* orow = (GAS f32x4*)(X + (size_t)m * DM) + lane;
#pragma unroll
            for (int j = 0; j < 4; ++j) { const unsigned long long w = xr[64 * j]; const unsigned lo = (unsigned)w, hi = (unsigned)(w >> 32);
                f32x4 v = (f32x4){__uint_as_float(lo << 16), __uint_as_float(lo & 0xffff0000u), __uint_as_float(hi << 16), __uint_as_float(hi & 0xffff0000u)};
                __builtin_nontemporal_store(v * rs * gv[j], &orow[64 * j]); } }
    }
}

static int g_grid = 0;
static bool mega_setup() {
    if (g_grid) return g_grid > 0;
    int dev = 0, cus = 0, per_cu = 0;
    if (hipGetDevice(&dev) != hipSuccess || hipDeviceGetAttribute(&cus, hipDeviceAttributeMultiprocessorCount, dev) != hipSuccess) { g_grid = -1; return false; }
    if (hipFuncSetAttribute((const void*)mega_fwd, hipFuncAttributeMaxDynamicSharedMemorySize, LDS_BYTES) != hipSuccess) { fprintf(stderr, "hipFuncSetAttribute failed\n"); g_grid = -1; return false; }
    if (hipOccupancyMaxActiveBlocksPerMultiprocessor(&per_cu, (const void*)mega_fwd, NWAVES * 64, LDS_BYTES) != hipSuccess || per_cu < 1) { fprintf(stderr, "occupancy query: %d blocks per CU\n", per_cu); (void)hipGetLastError(); g_grid = -1; return false; }
    g_grid = cus;
    if (g_grid != 256) { fprintf(stderr, "kernel_launch: %d CUs; the phase program is laid out for exactly 256: nothing launched\n", g_grid); g_grid = -1; return false; }
    return true;
}
static void mega_launch(void* const* d_in, void* d_out, void* d_ws, hipStream_t stream) {
    Args a{};
    for (int i = 0; i < 26; ++i) a.in[i] = (const float*)d_in[i];
    a.out = (float*)d_out; a.ws = (unsigned char*)d_ws;
    hipLaunchKernelGGL(mega_fwd, dim3(g_grid), dim3(NWAVES * 64), LDS_BYTES, stream, a);
}
extern "C" void kernel_launch(void* const* d_in, const int* in_sizes, int n_in, void* d_out, int out_size, void* d_ws, size_t ws_size, hipStream_t stream) {
    if (!mega_setup()) return;
    if (ws_size < WS_END) { fprintf(stderr, "kernel_launch: workspace too small (%zu < %zu)\n", ws_size, (size_t)WS_END); return; }
    (void)hipMemsetAsync((char*)d_ws + WS_CTL, 0, CTL_ZERO_BYTES, stream);
    mega_launch(d_in, d_out, d_ws, stream);
}
```

```cpp
#include <hip/hip_runtime.h>
#include <cstdio>
#include <cstdint>
template <int X> __device__ __forceinline__ float swz_xor(float v) { return __int_as_float(__builtin_amdgcn_ds_swizzle(__float_as_int(v), (X << 10) | 0x1f)); }
__device__ __forceinline__ float sum_x32(float v) { auto rr = __builtin_amdgcn_permlane32_swap(__float_as_uint(v), __float_as_uint(v), false, false); return __uint_as_float(rr[0]) + __uint_as_float(rr[1]); }
__device__ __forceinline__ float max_x32(float v) { auto rr = __builtin_amdgcn_permlane32_swap(__float_as_uint(v), __float_as_uint(v), false, false); return fmaxf(__uint_as_float(rr[0]), __uint_as_float(rr[1])); }
__device__ __forceinline__ float wave_max64(float v) { v = fmaxf(v, swz_xor<1>(v)); v = fmaxf(v, swz_xor<2>(v)); v = fmaxf(v, swz_xor<4>(v)); v = fmaxf(v, swz_xor<8>(v)); v = fmaxf(v, swz_xor<16>(v)); return max_x32(v); }
__device__ __forceinline__ float wave_sum64(float v) { v += swz_xor<1>(v); v += swz_xor<2>(v); v += swz_xor<4>(v); v += swz_xor<8>(v); v += swz_xor<16>(v); return sum_x32(v); }
namespace pg8 {
#define PG8_LAS __attribute__((address_space(3)))
typedef unsigned short bf16_t;
typedef short bf16x8 __attribute__((ext_vector_type(8)));
typedef float f32x4 __attribute__((ext_vector_type(4)));
typedef float f32x2 __attribute__((ext_vector_type(2)));
typedef unsigned u32x4 __attribute__((ext_vector_type(4)));
typedef int i32x4 __attribute__((ext_vector_type(4)));
constexpr int BM = 256, BK = 64, HALF = 128, HTB = HALF * BK * 2  , STAGE_BYTES = 8 * HTB, NXCD = 8, WGM = 8;

__host__ __device__ __forceinline__ int lds_byte(int r, int c) { const int st = (r >> 4) * 2 + (c >> 5), rr = r & 15, cc = c & 31, ob = rr * 64 + cc * 2; return st * 1024 + (ob ^ (((ob >> 9) & 1) << 5)); }
__host__ __device__ __forceinline__ void stage_rc(int b, int& R, int& C) { const int st = b / 1024, sb = b % 1024, swz = sb ^ (((sb >> 9) & 1) << 5); R = (st >> 1) * 16 + swz / 64; C = (st & 1) * 32 + (swz % 64) / 2; }
__host__ __device__ __forceinline__ int perm32(int rho) { const int n = rho >> 4, i = rho & 15; return 8 * (i >> 2) + 4 * n + (i & 3); }

struct Unit { int pm, pn; const char* a; const char* b; int aux; };
template <int LDA, int LDB, int K_, bool I8_ = false> struct Gemm { static constexpr int lda = LDA, ldb = LDB, K = K_; static constexpr bool I8 = I8_; };

__device__ __forceinline__ unsigned cvt_pk_bf16(float lo, float hi) { unsigned r; asm volatile("v_cvt_pk_bf16_f32 %0, %1, %2" : "=v"(r) : "v"(lo), "v"(hi)); return r; }


template <class Epi, class Sched, class Gemm, bool ALIGN_EPI = true, bool SP2 = true, bool PRE_B = false>
__device__ __forceinline__ void gemm_phase(PG8_LAS unsigned char* lds, const Gemm g, const Sched& S, const Epi& E, const int tid) {
    const int wid = __builtin_amdgcn_readfirstlane(tid >> 6), lane = tid & 63, wr = wid >> 2, wc = wid & 3, fr = lane & 15, fq = lane >> 4;
    constexpr int K = Gemm::K, nt = K / BK;
    unsigned voffA[2], voffB[2];
#pragma unroll
    for (int i = 0; i < 2; ++i) { int R, C; stage_rc(tid * 16 + i * 8192, R, C); const int Rb = Epi::PERM ? ((R & ~31) + perm32(R & 31)) : R;
        voffA[i] = (unsigned)(R * Gemm::lda + C) * 2u; voffB[i] = (unsigned)(Rb * Gemm::ldb + C) * 2u; }
    constexpr size_t kstep = (size_t)(BK * 2);
    constexpr size_t hstepA = (size_t)HALF * Gemm::lda * 2, hstepB = (size_t)HALF * Gemm::ldb * 2;
    const unsigned ldsw = (unsigned)wid * 1024u;
    const int aoff = lds_byte(wr * 64 + fr, fq * 8), boff = lds_byte(wc * 32 + fr, fq * 8);
#define PG8_SA(b, h) (((b) * 2 + (h)) * HTB)
#define PG8_SB(b, h) ((4 + (b) * 2 + (h)) * HTB)
#define PG8_STAGE(bufoff, gbase, voff) do { _Pragma("unroll") for (int _i = 0; _i < 2; ++_i) { unsigned vo_ = (voff)[_i]; asm volatile("" : "+v"(vo_));     \
        __builtin_amdgcn_global_load_lds((const unsigned*)((const char*)(gbase) + vo_), (PG8_LAS unsigned*)(lds + (bufoff) + ldsw + _i * 8192), 16, 0, 0); } } while (0)
#define PG8_LDA(dst, b, h) do { _Pragma("unroll") for (int m = 0; m < 4; ++m) _Pragma("unroll") for (int k = 0; k < 2; ++k) dst[m][k] = *(const PG8_LAS bf16x8*)(lds + PG8_SA(b, h) + aoff + m * 2048 + k * 1024); } while (0)
#define PG8_LDB(dst, b, h) do { _Pragma("unroll") for (int n = 0; n < 2; ++n) _Pragma("unroll") for (int k = 0; k < 2; ++k) dst[n][k] = *(const PG8_LAS bf16x8*)(lds + PG8_SB(b, h) + boff + n * 2048 + k * 1024); } while (0)
#define PG8_MMA(ai, bj, At, Bt) do { __builtin_amdgcn_s_setprio(1); _Pragma("unroll") for (int m = 0; m < 4; ++m) _Pragma("unroll") for (int n = 0; n < 2; ++n) _Pragma("unroll") for (int k = 0; k < 2; ++k) { \
        if constexpr (Gemm::I8) acc[ai][bj][m][n] = __builtin_bit_cast(f32x4, __builtin_amdgcn_mfma_i32_16x16x64_i8(__builtin_bit_cast(i32x4, Bt[n][k]), __builtin_bit_cast(i32x4, At[m][k]), __builtin_bit_cast(i32x4, acc[ai][bj][m][n]), 0, 0, 0)); \
        else acc[ai][bj][m][n] = __builtin_amdgcn_mfma_f32_16x16x32_bf16(Bt[n][k], At[m][k], acc[ai][bj][m][n], 0, 0, 0); } __builtin_amdgcn_s_setprio(0); } while (0)
#define PG8_WAIT_V(n) asm volatile("s_waitcnt vmcnt(" #n ")" ::: "memory")
#define PG8_WAIT_L(n) asm volatile("s_waitcnt lgkmcnt(" #n ")" ::: "memory")
#define PG8_BAR __builtin_amdgcn_s_barrier()
#define PG8_SCHED __builtin_amdgcn_sched_barrier(0)
    Unit cur, nxt; int ui = 0;
    if (!S.next(0, cur)) return;
    f32x4 acc[2][2][4][2];
#pragma unroll
    for (int a = 0; a < 2; ++a)
#pragma unroll
        for (int b = 0; b < 2; ++b)
#pragma unroll
            for (int m = 0; m < 4; ++m)
#pragma unroll
                for (int n = 0; n < 2; ++n) acc[a][b][m][n] = (f32x4){0.f, 0.f, 0.f, 0.f};
    bf16x8 At[4][2], B0[2][2], B1[2][2];
    const char* cA = cur.a; const char* cB = cur.b;
    typename Epi::State est; E.init_state(est, cur, wr, fr);
    if constexpr (SP2 && PRE_B) {
        PG8_STAGE(PG8_SA(0, 0), cA, voffA); PG8_STAGE(PG8_SA(0, 1), cA + hstepA, voffA);
        if (wr == 1) PG8_BAR;
        PG8_WAIT_V(2); PG8_BAR;
        PG8_STAGE(PG8_SA(1, 0), cA + kstep, voffA);
        PG8_WAIT_V(2); PG8_BAR;
    } else if constexpr (SP2) {
        PG8_STAGE(PG8_SB(0, 0), cB, voffB); PG8_STAGE(PG8_SB(0, 1), cB + hstepB, voffB); PG8_STAGE(PG8_SA(0, 0), cA, voffA); PG8_STAGE(PG8_SA(0, 1), cA + hstepA, voffA);
        if (wr == 1) PG8_BAR;
        PG8_WAIT_V(2); PG8_BAR;
        PG8_STAGE(PG8_SB(1, 0), cB + kstep, voffB); PG8_STAGE(PG8_SA(1, 0), cA + kstep, voffA); PG8_STAGE(PG8_SB(1, 1), cB + hstepB + kstep, voffB);
        PG8_WAIT_V(6); PG8_BAR;
    } else {
        PG8_STAGE(PG8_SB(0, 0), cB, voffB); PG8_STAGE(PG8_SA(0, 0), cA, voffA); PG8_STAGE(PG8_SB(0, 1), cB + hstepB, voffB); PG8_STAGE(PG8_SA(0, 1), cA + hstepA, voffA);
        if (wr == 1) PG8_BAR;
        PG8_WAIT_V(4); PG8_BAR;
        PG8_STAGE(PG8_SB(1, 0), cB + kstep, voffB); PG8_STAGE(PG8_SA(1, 0), cA + kstep, voffA); PG8_STAGE(PG8_SB(1, 1), cB + hstepB + kstep, voffB);
        PG8_WAIT_V(6); PG8_BAR;
    }
    for (;;) {
        const bool has_next = S.next(ui + 1, nxt);
        const char* nA = has_next ? nxt.a : cA; const char* nB = has_next ? nxt.b : cB;
#pragma unroll 1
        for (int t = 0; t < nt; t += 2) {
            const bool last = (t == nt - 2);
            const char* a1 = cA + (size_t)(t + 1) * kstep;
            const char* a2 = last ? nA : cA + (size_t)(t + 2) * kstep; const char* b2 = last ? nB : cB + (size_t)(t + 2) * kstep;
            const char* a3 = a2 + kstep; const char* b3 = b2 + kstep;
            if constexpr (Epi::MIDK > 0) { if (t == Epi::MIDK) E.midk(acc, est, cur, wr, wc, fr, fq); }
            if constexpr (SP2) {
            PG8_LDB(B0, 0, 0); PG8_LDB(B1, 0, 1); PG8_SCHED; PG8_LDA(At, 0, 0); PG8_STAGE(PG8_SA(1, 1), a1 + hstepA, voffA);
            PG8_WAIT_V(8); PG8_WAIT_L(0); PG8_BAR; PG8_MMA(0, 0, At, B0); PG8_MMA(0, 1, At, B1); PG8_BAR; PG8_SCHED;
            PG8_LDA(At, 0, 1); PG8_STAGE(PG8_SB(0, 0), b2, voffB); PG8_STAGE(PG8_SB(0, 1), b2 + hstepB, voffB); PG8_STAGE(PG8_SA(0, 0), a2, voffA);
            PG8_WAIT_V(8); PG8_WAIT_L(0); PG8_BAR; PG8_MMA(1, 0, At, B0); PG8_MMA(1, 1, At, B1); PG8_BAR; PG8_SCHED;
            PG8_LDB(B0, 1, 0); PG8_LDB(B1, 1, 1); PG8_SCHED; PG8_LDA(At, 1, 0); PG8_STAGE(PG8_SA(0, 1), a2 + hstepA, voffA);
            PG8_WAIT_V(8); PG8_WAIT_L(0); PG8_BAR; PG8_MMA(0, 0, At, B0); PG8_MMA(0, 1, At, B1); PG8_BAR; PG8_SCHED;
            PG8_LDA(At, 1, 1); PG8_STAGE(PG8_SB(1, 0), b3, voffB); PG8_STAGE(PG8_SB(1, 1), b3 + hstepB, voffB); PG8_STAGE(PG8_SA(1, 0), a3, voffA);
            PG8_WAIT_V(8); PG8_WAIT_L(0); PG8_BAR; PG8_MMA(1, 0, At, B0); PG8_MMA(1, 1, At, B1); PG8_BAR; PG8_SCHED;
            } else {
            PG8_LDB(B0, 0, 0); PG8_SCHED; PG8_LDA(At, 0, 0); PG8_STAGE(PG8_SA(1, 1), a1 + hstepA, voffA);
            PG8_WAIT_L(8); PG8_BAR; PG8_WAIT_L(0); PG8_MMA(0, 0, At, B0); PG8_BAR; PG8_SCHED;
            PG8_LDB(B1, 0, 1); PG8_STAGE(PG8_SB(0, 0), b2, voffB);
            PG8_BAR; PG8_WAIT_L(0); PG8_MMA(0, 1, At, B1); PG8_BAR;
            PG8_LDA(At, 0, 1); PG8_STAGE(PG8_SA(0, 0), a2, voffA);
            PG8_BAR; PG8_WAIT_L(0); PG8_MMA(1, 0, At, B0); PG8_BAR; PG8_SCHED;
            PG8_STAGE(PG8_SB(0, 1), b2 + hstepB, voffB);
            PG8_WAIT_V(6); PG8_BAR; PG8_MMA(1, 1, At, B1); PG8_BAR;
            PG8_LDB(B0, 1, 0); PG8_SCHED; PG8_LDA(At, 1, 0); PG8_STAGE(PG8_SA(0, 1), a2 + hstepA, voffA);
            PG8_WAIT_L(8); PG8_BAR; PG8_WAIT_L(0); PG8_MMA(0, 0, At, B0); PG8_BAR; PG8_SCHED;
            PG8_LDB(B1, 1, 1); PG8_STAGE(PG8_SB(1, 0), b3, voffB);
            PG8_BAR; PG8_WAIT_L(0); PG8_MMA(0, 1, At, B1); PG8_BAR;
            PG8_LDA(At, 1, 1); PG8_STAGE(PG8_SA(1, 0), a3, voffA);
            PG8_BAR; PG8_WAIT_L(0); PG8_MMA(1, 0, At, B0); PG8_BAR; PG8_SCHED;
            PG8_STAGE(PG8_SB(1, 1), b3 + hstepB, voffB);
            PG8_WAIT_V(6); PG8_BAR; PG8_MMA(1, 1, At, B1); PG8_BAR;
            }
        }
        if constexpr (ALIGN_EPI) { if (wr == 0) PG8_BAR; }
        { int fr_ = fr, fq_ = fq; asm volatile("" : "+v"(fr_), "+v"(fq_));
#if defined(PROBE_NOEPI) && PROBE_NOEPI
        if (!E.shadow_skip) E(acc, est, cur, wr, wc, fr_, fq_);
#else
        E(acc, est, cur, wr, wc, fr_, fq_);
#endif
        }
        if (!has_next) break;
#pragma unroll
        for (int a = 0; a < 2; ++a)
#pragma unroll
            for (int b = 0; b < 2; ++b)
#pragma unroll
                for (int m = 0; m < 4; ++m)
#pragma unroll
                    for (int n = 0; n < 2; ++n) acc[a][b][m][n] = (f32x4){0.f, 0.f, 0.f, 0.f};
        if (nxt.pm != cur.pm) E.init_state(est, nxt, wr, fr);
        cur = nxt; cA = nA; cB = nB; ++ui;
        if constexpr (ALIGN_EPI) { if (wr == 1) PG8_BAR; }
    }
    PG8_WAIT_V(0);
    if constexpr (!ALIGN_EPI) { if (wr == 0) PG8_BAR; }
    PG8_BAR;
#undef PG8_SA
#undef PG8_SB
#undef PG8_STAGE
#undef PG8_LDA
#undef PG8_LDB
#undef PG8_MMA
#undef PG8_WAIT_V
#undef PG8_WAIT_L
#undef PG8_BAR
#undef PG8_SCHED
}
template <class Gemm, bool PERM>
__device__ __forceinline__ void prestage_B(PG8_LAS unsigned char* lds, const char* cB, const int tid) {
    const int wid = __builtin_amdgcn_readfirstlane(tid >> 6);
    const unsigned ldsw = (unsigned)wid * 1024u;
    constexpr size_t kstep = (size_t)(BK * 2), hstepB = (size_t)HALF * Gemm::ldb * 2;
#pragma unroll
    for (int i = 0; i < 2; ++i) { int R, C; stage_rc(tid * 16 + i * 8192, R, C); const int Rb = PERM ? ((R & ~31) + perm32(R & 31)) : R;
        unsigned vo = (unsigned)(Rb * Gemm::ldb + C) * 2u; asm volatile("" : "+v"(vo));
#pragma unroll
        for (int b = 0; b < 2; ++b)
#pragma unroll
            for (int h = 0; h < 2; ++h)
                __builtin_amdgcn_global_load_lds((const unsigned*)(cB + (size_t)b * kstep + (size_t)h * hstepB + vo), (PG8_LAS unsigned*)(lds + (4 + b * 2 + h) * HTB + ldsw + i * 8192), 16, 0, 0); }
}
}
namespace pg8 {
constexpr float LOG2E = 1.4426950408889634f;
constexpr float RMS_EPS = 1e-6f;
constexpr size_t TILE_BYTES = 1536 * 1024, T_Y = 0, T_K = 512 * 1024, T_V = 768 * 1024, T_U = 1024 * 1024, T_LOGF = 1280 * 1024;

#define EPI_STATE_DECL struct State {}; __device__ __forceinline__ void init_state(State&, const Unit&, int, int) const {}
template <int kind, int nM, int nN, size_t sA, size_t sB, size_t batchB = 0>
struct SchedT {
    static constexpr int nwg = nM * nN, G = 256;
    int c; const char* A; const char* B;
    __device__ __forceinline__ void init(int c_, const void* A_, const void* B_) { c = c_; A = (const char*)A_; B = (const char*)B_; }
    __device__ __forceinline__ bool next(int i, Unit& u) const {
        const int L = i * G + c; if ((unsigned)L >= (unsigned)nwg) return false;
        if constexpr (kind <= 1) {
            int wgid = L; { constexpr int q = nwg / NXCD, r = nwg % NXCD; const int xcd = wgid % NXCD, off = wgid / NXCD; wgid = (xcd < r ? xcd * (q + 1) : r * (q + 1) + (xcd - r) * q) + off; }
            constexpr int nig = WGM * nN; const int gid = wgid / nig, fm = gid * WGM, gsz = (nM - fm) < WGM ? (nM - fm) : WGM;
            u.pm = fm + ((wgid % nig) % gsz); u.pn = (wgid % nig) / gsz;
            u.a = A + (size_t)u.pm * sA; u.b = B + (size_t)u.pn * sB + (kind == 1 ? (size_t)(u.pm >> 3) * batchB : (size_t)0); u.aux = 0;
        } else if constexpr (kind == 2) {
            const int b_ = L & 7, h = (L >> 5) & 3, t4 = (L >> 3) & 3;
            u.pm = b_ * 4 + h; u.pn = t4;
            u.a = A + ((size_t)b_ * 256 * 2048 + (size_t)h * 256) * 2; u.b = B + ((size_t)t4 * 256 * 1024 + (size_t)h * 256) * 2;
            u.aux = b_ * 4194304 + (h * 256) * 1024 + t4 * 256;
        } else if constexpr (kind == 3) {
            const int b_ = L & 7, h = (L >> 5) & 3, t4 = (L >> 3) & 3;
            u.pm = t4; u.pn = b_ * 4 + h;
            u.a = A + ((size_t)t4 * 256 * 1024 + (size_t)h * 256) * 2; u.b = B + ((size_t)b_ * 256 * 2048 + 1024 + (size_t)h * 256) * 2;
            u.aux = b_ * 4194304 + (t4 * 256) * 1024 + h * 256;
        } else {
            u.pm = L & 7; u.pn = L >> 3; u.a = A + (size_t)u.pm * sA; u.b = B + (size_t)u.pn * sB; u.aux = 0;
        }
        return true;
    }
};

__device__ __forceinline__ void store8(bf16_t* p, const f32x4 v0, const f32x4 v1) {
    u32x4 w; w.x = cvt_pk_bf16(v0[0], v0[1]); w.y = cvt_pk_bf16(v0[2], v0[3]); w.z = cvt_pk_bf16(v1[0], v1[1]); w.w = cvt_pk_bf16(v1[2], v1[3]); *(u32x4*)p = w;
}
__device__ __forceinline__ float ss_sum16(const float* ssp, int row) {
    const f32x4* p = (const f32x4*)(ssp + (size_t)row * 16); const f32x4 a = p[0], b = p[1], c = p[2], d = p[3];
    return (((a[0] + a[1]) + (a[2] + a[3])) + ((b[0] + b[1]) + (b[2] + b[3]))) + (((c[0] + c[1]) + (c[2] + c[3])) + ((d[0] + d[1]) + (d[2] + d[3])));
}
__device__ __forceinline__ float rs_row(const float* ssp, int row) { return __builtin_amdgcn_rsqf(ss_sum16(ssp, row) * (1.0f / 1024.0f) + RMS_EPS); }
__device__ __forceinline__ void store8nt(bf16_t* p, const f32x4 v0, const f32x4 v1) {
    u32x4 w; w.x = cvt_pk_bf16(v0[0], v0[1]); w.y = cvt_pk_bf16(v0[2], v0[3]); w.z = cvt_pk_bf16(v1[0], v1[1]); w.w = cvt_pk_bf16(v1[2], v1[3]); __builtin_nontemporal_store(w, (u32x4*)p);
}
__device__ __forceinline__ float sigmoidf_fast(float z) { return __builtin_amdgcn_rcpf(1.0f + __builtin_amdgcn_exp2f(-z * LOG2E)); }
__device__ __forceinline__ f32x4 sig4(f32x4 z) { f32x4 r; r[0] = sigmoidf_fast(z[0]); r[1] = sigmoidf_fast(z[1]); r[2] = sigmoidf_fast(z[2]); r[3] = sigmoidf_fast(z[3]); return r; }

struct EpiSwiGLUQ {
    static constexpr bool PERM = true; static constexpr int MIDK = 0;
    bf16_t* H; const float* rsc; const float* wsc; static constexpr int ldh = 2816;
    bool shadow_skip = false;
    struct State { float rs[2][4]; };
    __device__ __forceinline__ void init_state(State& st, const Unit& u, int wr, int fr) const {
#pragma unroll
        for (int ai = 0; ai < 2; ++ai)
#pragma unroll
            for (int m = 0; m < 4; ++m) st.rs[ai][m] = rsc[u.pm * BM + wr * 64 + fr + ai * HALF + m * 16];
    }
    __device__ __forceinline__ void midk(f32x4 (&)[2][2][4][2], const State&, const Unit&, int, int, int, int) const {}
    __device__ __forceinline__ void operator()(f32x4 (&acc)[2][2][4][2], const State& est, const Unit& u, int wr, int wc, int fr, int fq) const {
        const int rl0 = wr * 64 + fr, col0 = u.pn * HALF + wc * 32 + 8 * fq;
        bf16_t* Ht = (bf16_t*)((unsigned char*)H + (size_t)u.pm * TILE_BYTES);
        const float sg = wsc[u.pn * 8 + wc], su = wsc[u.pn * 8 + 4 + wc];
#pragma unroll
        for (int ai = 0; ai < 2; ++ai) {
#pragma unroll
            for (int m = 0; m < 4; ++m) {
                const int rl = rl0 + ai * HALF + m * 16;
                const float rg = est.rs[ai][m] * sg, ru = est.rs[ai][m] * su;
                const f32x4 g0 = __builtin_convertvector(__builtin_bit_cast(i32x4, acc[ai][0][m][0]), f32x4) * rg, g1 = __builtin_convertvector(__builtin_bit_cast(i32x4, acc[ai][0][m][1]), f32x4) * rg;
                const f32x4 u0 = __builtin_convertvector(__builtin_bit_cast(i32x4, acc[ai][1][m][0]), f32x4) * ru, u1 = __builtin_convertvector(__builtin_bit_cast(i32x4, acc[ai][1][m][1]), f32x4) * ru;
                store8(Ht + (size_t)rl * ldh + col0, g0 * sig4(g0) * u0, g1 * sig4(g1) * u1);
            }
        }
    }
};

template <int MIDK_>
struct EpiResid {
    static constexpr bool PERM = true; static constexpr int MIDK = MIDK_;
    const float* xin; float* xout; bf16_t* xb; float* ssn; const float* ssa; float alpha;
    bool shadow_skip = false;
    struct State { float rsa[MIDK_ > 0 ? 2 : 1][MIDK_ > 0 ? 4 : 1]; };
    __device__ __forceinline__ void init_state(State& st, const Unit& u, int wr, int fr) const {
        if constexpr (MIDK_ > 0) {
#pragma unroll
            for (int ai = 0; ai < 2; ++ai)
#pragma unroll
                for (int m = 0; m < 4; ++m) {
                    const f32x4* pa = (const f32x4*)(ssa + (size_t)(u.pm * BM + wr * 64 + fr + ai * HALF + m * 16) * 8); const f32x4 sa = pa[0], sb = pa[1];
                    st.rsa[ai][m] = __builtin_amdgcn_rsqf((((sa[0] + sa[1]) + (sa[2] + sa[3])) + ((sb[0] + sb[1]) + (sb[2] + sb[3]))) * (1.0f / 512.0f) + RMS_EPS);
                }
        }
    }
    __device__ __forceinline__ void midk(f32x4 (&acc)[2][2][4][2], const State& st, const Unit& u, int wr, int wc, int fr, int fq) const {
        if constexpr (MIDK_ > 0) {
#pragma unroll
            for (int ai = 0; ai < 2; ++ai)
#pragma unroll
                for (int m = 0; m < 4; ++m)
#pragma unroll
                    for (int bj = 0; bj < 2; ++bj)
#pragma unroll
                        for (int n = 0; n < 2; ++n) acc[ai][bj][m][n] *= st.rsa[ai][m];
        }
    }
    __device__ __forceinline__ void operator()(f32x4 (&acc)[2][2][4][2], const State& est, const Unit& u, int wr, int wc, int fr, int fq) const {
        const int row0 = u.pm * BM + wr * 64 + fr, col0 = u.pn * BM + wc * 32 + 8 * fq;
        if (xin) {
#pragma unroll
            for (int ai = 0; ai < 2; ++ai) {
                f32x4 r[4][2][2];
#pragma unroll
                for (int m = 0; m < 4; ++m)
#pragma unroll
                    for (int bj = 0; bj < 2; ++bj) { const size_t off = (size_t)(row0 + ai * HALF + m * 16) * 1024 + col0 + bj * HALF;
                        r[m][bj][0] = __builtin_nontemporal_load((const f32x4*)(xin + off)); r[m][bj][1] = __builtin_nontemporal_load((const f32x4*)(xin + off + 4)); }
#pragma unroll
                for (int m = 0; m < 4; ++m) {
                    const int row = row0 + ai * HALF + m * 16; float q = 0.f;
#pragma unroll
                    for (int bj = 0; bj < 2; ++bj) { const size_t off = (size_t)row * 1024 + col0 + bj * HALF;
                        const f32x4 v0 = r[m][bj][0] + acc[ai][bj][m][0] * alpha, v1 = r[m][bj][1] + acc[ai][bj][m][1] * alpha;
                        store8(xb + off, v0, v1);
                        q += (v0[0] * v0[0] + v0[1] * v0[1]) + (v0[2] * v0[2] + v0[3] * v0[3]) + (v1[0] * v1[0] + v1[1] * v1[1]) + (v1[2] * v1[2] + v1[3] * v1[3]); }
                    q += swz_xor<16>(q); q = sum_x32(q);
                    if (fq == 0) ssn[(size_t)row * 16 + u.pn * 4 + wc] = q;
                }
            }
            return;
        }
        u32x4 w[2][4][2];
#pragma unroll
        for (int ai = 0; ai < 2; ++ai)
#pragma unroll
            for (int m = 0; m < 4; ++m)
#pragma unroll
                for (int bj = 0; bj < 2; ++bj) w[ai][m][bj] = *(const u32x4*)(xb + (size_t)(row0 + ai * HALF + m * 16) * 1024 + col0 + bj * HALF);
#pragma unroll
        for (int ai = 0; ai < 2; ++ai)
#pragma unroll
            for (int m = 0; m < 4; ++m) {
                const int row = row0 + ai * HALF + m * 16; float q = 0.f;
#pragma unroll
                for (int bj = 0; bj < 2; ++bj) {
                    const size_t off = (size_t)row * 1024 + col0 + bj * HALF; const u32x4 ww = w[ai][m][bj];
                    const f32x4 r0 = (f32x4){__uint_as_float(ww.x << 16), __uint_as_float(ww.x & 0xffff0000u), __uint_as_float(ww.y << 16), __uint_as_float(ww.y & 0xffff0000u)};
                    const f32x4 r1 = (f32x4){__uint_as_float(ww.z << 16), __uint_as_float(ww.z & 0xffff0000u), __uint_as_float(ww.w << 16), __uint_as_float(ww.w & 0xffff0000u)};
                    const f32x4 v0 = r0 + acc[ai][bj][m][0] * alpha, v1 = r1 + acc[ai][bj][m][1] * alpha;
                    store8(xb + off, v0, v1);
                    q += (v0[0] * v0[0] + v0[1] * v0[1]) + (v0[2] * v0[2] + v0[3] * v0[3]) + (v1[0] * v1[0] + v1[1] * v1[1]) + (v1[2] * v1[2] + v1[3] * v1[3]);
                }
                q += swz_xor<16>(q); q = sum_x32(q);
                if (fq == 0) ssn[(size_t)row * 16 + u.pn * 4 + wc] = q;
            }
    }
};

__device__ __forceinline__ unsigned pk4q(float a, float b, float c, float d) {
    const int ia = (int)__builtin_rintf(a), ib = (int)__builtin_rintf(b), ic = (int)__builtin_rintf(c), id = (int)__builtin_rintf(d);
    return ((unsigned)ia & 255u) | (((unsigned)ib & 255u) << 8) | (((unsigned)ic & 255u) << 16) | ((unsigned)id << 24);
}
struct EpiResidQ {
    static constexpr bool PERM = true; static constexpr int MIDK = 0;
    bf16_t* xb; float* ssn; float* amx; unsigned char* xq; float* rsc; float alpha; unsigned* cnt; unsigned* tmo;
    bool shadow_skip = false;
    EPI_STATE_DECL
    __device__ __forceinline__ void midk(f32x4 (&)[2][2][4][2], const State&, const Unit&, int, int, int, int) const {}
    __device__ __forceinline__ void operator()(f32x4 (&acc)[2][2][4][2], const State&, const Unit& u, int wr, int wc, int fr, int fq) const {
        const int row0 = u.pm * BM + wr * 64 + fr, col0 = u.pn * BM + wc * 32 + 8 * fq;
#pragma unroll
        for (int ai = 0; ai < 2; ++ai) {
            u32x4 w[4][2];
#pragma unroll
            for (int m = 0; m < 4; ++m)
#pragma unroll
                for (int bj = 0; bj < 2; ++bj) w[m][bj] = *(const u32x4*)(xb + (size_t)(row0 + ai * HALF + m * 16) * 1024 + col0 + bj * HALF);
#pragma unroll
            for (int m = 0; m < 4; ++m) {
                const int row = row0 + ai * HALF + m * 16; float q = 0.f, a = 0.f;
#pragma unroll
                for (int bj = 0; bj < 2; ++bj) {
                    const u32x4 ww = w[m][bj];
                    const f32x4 r0 = (f32x4){__uint_as_float(ww.x << 16), __uint_as_float(ww.x & 0xffff0000u), __uint_as_float(ww.y << 16), __uint_as_float(ww.y & 0xffff0000u)};
                    const f32x4 r1 = (f32x4){__uint_as_float(ww.z << 16), __uint_as_float(ww.z & 0xffff0000u), __uint_as_float(ww.w << 16), __uint_as_float(ww.w & 0xffff0000u)};
                    const f32x4 v0 = r0 + acc[ai][bj][m][0] * alpha, v1 = r1 + acc[ai][bj][m][1] * alpha;
                    acc[ai][bj][m][0] = v0; acc[ai][bj][m][1] = v1;
                    store8(xb + (size_t)row * 1024 + col0 + bj * HALF, v0, v1);
                    q += (v0[0] * v0[0] + v0[1] * v0[1]) + (v0[2] * v0[2] + v0[3] * v0[3]) + (v1[0] * v1[0] + v1[1] * v1[1]) + (v1[2] * v1[2] + v1[3] * v1[3]);
                    a = fmaxf(fmaxf(fmaxf(a, fmaxf(__builtin_fabsf(v0[0]), __builtin_fabsf(v0[1]))), fmaxf(__builtin_fabsf(v0[2]), __builtin_fabsf(v0[3]))),
                              fmaxf(fmaxf(__builtin_fabsf(v1[0]), __builtin_fabsf(v1[1])), fmaxf(__builtin_fabsf(v1[2]), __builtin_fabsf(v1[3]))));
                }
                q += swz_xor<16>(q); q = sum_x32(q);
                a = fmaxf(a, swz_xor<16>(a)); a = max_x32(a);
                if (fq == 0) { ssn[(size_t)row * 16 + u.pn * 4 + wc] = q; amx[(size_t)row * 16 + u.pn * 4 + wc] = a; }
            }
        }
        asm volatile("s_waitcnt vmcnt(0)" ::: "memory");
        __builtin_amdgcn_s_barrier(); asm volatile("" ::: "memory");
        if (wr == 0 && wc == 0 && fr == 0 && fq == 0) {
            __builtin_amdgcn_s_waitcnt(0);
            const unsigned old = __hip_atomic_fetch_add(cnt, 1u, __ATOMIC_RELAXED, __HIP_MEMORY_SCOPE_AGENT), target = (old / 4u + 1u) * 4u;
            __builtin_amdgcn_fence(__ATOMIC_ACQUIRE, "agent");
            if (old + 1u != target) { unsigned sp = 0;
                while ((int)(__hip_atomic_load(cnt, __ATOMIC_RELAXED, __HIP_MEMORY_SCOPE_AGENT) - target) < 0) { __builtin_amdgcn_s_sleep(1);
                    if ((++sp & 255u) == 0u) { if (__hip_atomic_load(tmo, __ATOMIC_RELAXED, __HIP_MEMORY_SCOPE_AGENT)) break; if (sp > (1u << 18)) { atomicAdd(tmo, 1u); break; } } } }
            asm volatile("s_waitcnt vmcnt(0)" ::: "memory");
        }
        asm volatile("s_waitcnt lgkmcnt(0)" ::: "memory"); __builtin_amdgcn_s_barrier(); asm volatile("" ::: "memory");
        const bool wr_rsc = (u.pn == 0 && wc == 0);
#pragma unroll
        for (int ai = 0; ai < 2; ++ai) {
            f32x4 av[4], sv[4];
#pragma unroll
            for (int m = 0; m < 4; ++m) { const int row = row0 + ai * HALF + m * 16; av[m] = ((const f32x4*)(amx + (size_t)row * 16))[fq]; }
            if (wr_rsc) {
#pragma unroll
                for (int m = 0; m < 4; ++m) { const int row = row0 + ai * HALF + m * 16; sv[m] = ((const f32x4*)(ssn + (size_t)row * 16))[fq]; }
            }
#pragma unroll
            for (int m = 0; m < 4; ++m) {
                const int row = row0 + ai * HALF + m * 16;
                float am = fmaxf(fmaxf(av[m][0], av[m][1]), fmaxf(av[m][2], av[m][3])); am = fmaxf(am, swz_xor<16>(am)); am = max_x32(am);
                const float inv = am > 0.f ? 127.0f / am : 0.f;
#pragma unroll
                for (int bj = 0; bj < 2; ++bj) { const f32x4 v0 = acc[ai][bj][m][0] * inv, v1 = acc[ai][bj][m][1] * inv;
                    unsigned long long o = (unsigned long long)pk4q(v0[0], v0[1], v0[2], v0[3]) | ((unsigned long long)pk4q(v1[0], v1[1], v1[2], v1[3]) << 32);
                    *(unsigned long long*)(xq + (size_t)row * 1024 + col0 + bj * HALF) = o; }
                if (wr_rsc) { float ss = (sv[m][0] + sv[m][1]) + (sv[m][2] + sv[m][3]); ss += swz_xor<16>(ss); ss = sum_x32(ss);
                    if (fq == 0) rsc[row] = am * (1.0f / 127.0f) * __builtin_amdgcn_rsqf(ss * (1.0f / 1024.0f) + RMS_EPS); }
            }
        }
    }
};

struct EpiFinal {
    static constexpr bool PERM = true; static constexpr int MIDK = 0;
    bf16_t* xb; float* ssn; float alpha; float* out; const float* gain; unsigned* cnt; unsigned* tmo;
    bool shadow_skip = false;
    EPI_STATE_DECL
    __device__ __forceinline__ void midk(f32x4 (&)[2][2][4][2], const State&, const Unit&, int, int, int, int) const {}
    __device__ __forceinline__ void operator()(f32x4 (&acc)[2][2][4][2], const State&, const Unit& u, int wr, int wc, int fr, int fq) const {
        const int row0 = u.pm * BM + wr * 64 + fr, col0 = u.pn * BM + wc * 32 + 8 * fq;
#pragma unroll
        for (int ai = 0; ai < 2; ++ai) {
            u32x4 w[4][2];
#pragma unroll
            for (int m = 0; m < 4; ++m)
#pragma unroll
                for (int bj = 0; bj < 2; ++bj) w[m][bj] = *(const u32x4*)(xb + (size_t)(row0 + ai * HALF + m * 16) * 1024 + col0 + bj * HALF);
#pragma unroll
            for (int m = 0; m < 4; ++m) {
                const int row = row0 + ai * HALF + m * 16; float q = 0.f;
#pragma unroll
                for (int bj = 0; bj < 2; ++bj) {
                    const u32x4 ww = w[m][bj];
                    const f32x4 r0 = (f32x4){__uint_as_float(ww.x << 16), __uint_as_float(ww.x & 0xffff0000u), __uint_as_float(ww.y << 16), __uint_as_float(ww.y & 0xffff0000u)};
                    const f32x4 r1 = (f32x4){__uint_as_float(ww.z << 16), __uint_as_float(ww.z & 0xffff0000u), __uint_as_float(ww.w << 16), __uint_as_float(ww.w & 0xffff0000u)};
                    const f32x4 v0 = r0 + acc[ai][bj][m][0] * alpha, v1 = r1 + acc[ai][bj][m][1] * alpha;
                    acc[ai][bj][m][0] = v0; acc[ai][bj][m][1] = v1;
                    q += (v0[0] * v0[0] + v0[1] * v0[1]) + (v0[2] * v0[2] + v0[3] * v0[3]) + (v1[0] * v1[0] + v1[1] * v1[1]) + (v1[2] * v1[2] + v1[3] * v1[3]);
                }
                q += swz_xor<16>(q); q = sum_x32(q);
                if (fq == 0) ssn[(size_t)row * 16 + u.pn * 4 + wc] = q;
            }
        }
        asm volatile("s_waitcnt vmcnt(0)" ::: "memory");
        __builtin_amdgcn_s_barrier(); asm volatile("" ::: "memory");
        if (wr == 0 && wc == 0 && fr == 0 && fq == 0) {
            __builtin_amdgcn_s_waitcnt(0);
            const unsigned old = __hip_atomic_fetch_add(cnt, 1u, __ATOMIC_RELAXED, __HIP_MEMORY_SCOPE_AGENT), target = (old / 4u + 1u) * 4u;
            __builtin_amdgcn_fence(__ATOMIC_ACQUIRE, "agent");
            if (old + 1u != target) { unsigned sp = 0;
                while ((int)(__hip_atomic_load(cnt, __ATOMIC_RELAXED, __HIP_MEMORY_SCOPE_AGENT) - target) < 0) { __builtin_amdgcn_s_sleep(1);
                    if ((++sp & 255u) == 0u) { if (__hip_atomic_load(tmo, __ATOMIC_RELAXED, __HIP_MEMORY_SCOPE_AGENT)) break; if (sp > (1u << 18)) { atomicAdd(tmo, 1u); break; } } } }
            asm volatile("s_waitcnt vmcnt(0)" ::: "memory");
        }
        asm volatile("s_waitcnt lgkmcnt(0)" ::: "memory"); __builtin_amdgcn_s_barrier(); asm volatile("" ::: "memory");
        f32x4 gv[2][2];
#pragma unroll
        for (int bj = 0; bj < 2; ++bj) { gv[bj][0] = *(const f32x4*)(gain + col0 + bj * HALF); gv[bj][1] = *(const f32x4*)(gain + col0 + bj * HALF + 4); }
#pragma unroll
        for (int ai = 0; ai < 2; ++ai) {
            float rsv[4];
#pragma unroll
            for (int m = 0; m < 4; ++m) rsv[m] = rs_row(ssn, row0 + ai * HALF + m * 16);
#pragma unroll
            for (int m = 0; m < 4; ++m) {
                const size_t rowoff = (size_t)(row0 + ai * HALF + m * 16) * 1024 + col0;
#pragma unroll
                for (int bj = 0; bj < 2; ++bj) {
                    __builtin_nontemporal_store(acc[ai][bj][m][0] * rsv[m] * gv[bj][0], (f32x4*)(out + rowoff + bj * HALF));
                    __builtin_nontemporal_store(acc[ai][bj][m][1] * rsv[m] * gv[bj][1], (f32x4*)(out + rowoff + bj * HALF + 4));
                }
            }
        }
    }
};

struct EpiWin {
    static constexpr bool PERM = true; static constexpr int MIDK = 0;
    unsigned char* R1; const float* ss; const float* bfp; float qscale;
    bool shadow_skip = false;
    struct State { float rs[2][4]; };
    __device__ __forceinline__ void init_state(State& st, const Unit& u, int wr, int fr) const {
#pragma unroll
        for (int ai = 0; ai < 2; ++ai)
#pragma unroll
            for (int m = 0; m < 4; ++m) st.rs[ai][m] = rs_row(ss, u.pm * BM + wr * 64 + fr + ai * HALF + m * 16);
    }
    __device__ __forceinline__ void midk(f32x4 (&)[2][2][4][2], const State&, const Unit&, int, int, int, int) const {}
    __device__ __forceinline__ void operator()(f32x4 (&acc)[2][2][4][2], const State& est, const Unit& u, int wr, int wc, int fr, int fq) const {
        const int rl0 = wr * 64 + fr, cw = wc * 32 + 8 * fq; const int pn = u.pn;
        unsigned char* T = R1 + (size_t)u.pm * TILE_BYTES;
        float bfv[8];
#pragma unroll
        for (int h = 0; h < 8; ++h) bfv[h] = (pn >= 10) ? bfp[h] : 0.f;
#pragma unroll
        for (int ai = 0; ai < 2; ++ai) {
#pragma unroll
            for (int m = 0; m < 4; ++m) {
                const int rl = rl0 + ai * HALF + m * 16;
                const float rs = est.rs[ai][m];
                if (pn < 6) {
                    bf16_t* base; int ld; float sc = rs;
                    if (pn < 2) { base = (bf16_t*)(T + T_Y) + pn * BM; ld = 1024; sc = rs * qscale; } else if (pn < 4) { base = (bf16_t*)(T + T_K) + (pn - 2) * BM; ld = 512; } else { base = (bf16_t*)(T + T_V) + (pn - 4) * BM; ld = 512; }
#pragma unroll
                    for (int bj = 0; bj < 2; ++bj) store8(base + (size_t)rl * ld + bj * HALF + cw, acc[ai][bj][m][0] * sc, acc[ai][bj][m][1] * sc);
                } else if (pn < 10) {
                    const f32x4 a0 = acc[ai][0][m][0] * rs, a1 = acc[ai][0][m][1] * rs, g0 = acc[ai][1][m][0] * rs, g1 = acc[ai][1][m][1] * rs;
                    store8((bf16_t*)(T + T_U) + (size_t)rl * 512 + (pn - 6) * HALF + cw, a0 * sig4(g0), a1 * sig4(g1));
                } else {
                    if (wc == 0 && fq == 0) {
                        float* LF = (float*)(T + T_LOGF);
#pragma unroll
                        for (int n = 0; n < 2; ++n)
#pragma unroll
                            for (int e = 0; e < 4; ++e) {
                                const int h = 4 * n + e; const float z = acc[ai][0][m][n][e] * rs + bfv[h];
                                LF[h * 256 + rl] = fminf(z, 0.f) - __builtin_amdgcn_logf(1.0f + __builtin_amdgcn_exp2f(-fabsf(z) * LOG2E)) * 0.6931471805599453f;
                            }
                    }
                }
            }
        }
    }
};

struct EpiRowScaleQ {
    static constexpr bool PERM = true; static constexpr int MIDK = 0;
    bf16_t* O; const float* rsc; const float* wsc; static constexpr int ldc = 2048;
    bool shadow_skip = false;
    struct State { float rs[2][4]; };
    __device__ __forceinline__ void init_state(State& st, const Unit& u, int wr, int fr) const {
#pragma unroll
        for (int ai = 0; ai < 2; ++ai)
#pragma unroll
            for (int m = 0; m < 4; ++m) st.rs[ai][m] = rsc[u.pm * BM + wr * 64 + fr + ai * HALF + m * 16];
    }
    __device__ __forceinline__ void midk(f32x4 (&)[2][2][4][2], const State&, const Unit&, int, int, int, int) const {}
    __device__ __forceinline__ void operator()(f32x4 (&acc)[2][2][4][2], const State& est, const Unit& u, int wr, int wc, int fr, int fq) const {
        const int row0 = u.pm * BM + wr * 64 + fr, col0 = u.pn * BM + wc * 32 + 8 * fq;
        const float s0 = wsc[u.pn * 8 + wc], s1 = wsc[u.pn * 8 + 4 + wc];
#pragma unroll
        for (int ai = 0; ai < 2; ++ai)
#pragma unroll
            for (int m = 0; m < 4; ++m) {
                const int row = row0 + ai * HALF + m * 16;
#pragma unroll
                for (int bj = 0; bj < 2; ++bj) { const float rs = est.rs[ai][m] * (bj ? s1 : s0);
                    store8(O + (size_t)row * ldc + col0 + bj * HALF, __builtin_convertvector(__builtin_bit_cast(i32x4, acc[ai][bj][m][0]), f32x4) * rs, __builtin_convertvector(__builtin_bit_cast(i32x4, acc[ai][bj][m][1]), f32x4) * rs); }
            }
    }
};

struct EpiAux {
    static constexpr bool PERM = true; static constexpr int MIDK = 0;
    bf16_t* O; float scale; static constexpr int ldc = 1024;
    bool shadow_skip = false;
    EPI_STATE_DECL
    __device__ __forceinline__ void midk(f32x4 (&)[2][2][4][2], const State&, const Unit&, int, int, int, int) const {}
    __device__ __forceinline__ void operator()(f32x4 (&acc)[2][2][4][2], const State& est, const Unit& u, int wr, int wc, int fr, int fq) const {
        bf16_t* base = O + u.aux + (size_t)(wr * 64 + fr) * ldc + wc * 32 + 8 * fq;
#pragma unroll
        for (int ai = 0; ai < 2; ++ai)
#pragma unroll
            for (int m = 0; m < 4; ++m)
#pragma unroll
                for (int bj = 0; bj < 2; ++bj) store8(base + (size_t)(ai * HALF + m * 16) * ldc + bj * HALF, acc[ai][bj][m][0] * scale, acc[ai][bj][m][1] * scale);
    }
};

struct EpiSoftmax {
    static constexpr bool PERM = true; static constexpr int MIDK = 0;
    unsigned char* R1; const float* ss; PG8_LAS float* scr;
    bool shadow_skip = false;
    EPI_STATE_DECL
    __device__ __forceinline__ void midk(f32x4 (&)[2][2][4][2], const State&, const Unit&, int, int, int, int) const {}
    __device__ __forceinline__ void operator()(f32x4 (&acc)[2][2][4][2], const State& est, const Unit& u, int wr, int wc, int fr, int fq) const {
        const int col0 = u.pn * BM + wc * 32 + 8 * fq;
        PG8_LAS float* TM = scr; PG8_LAS float* TS = scr + 1024;
        const float* ssr = ss + (size_t)(u.pm * BM + wr * 64 + fr) * 16;
#pragma unroll
        for (int ai = 0; ai < 2; ++ai)
#pragma unroll
            for (int m = 0; m < 4; ++m) {
                const int rl = ai * HALF + wr * 64 + m * 16 + fr;
                const float rs = rs_row(ssr, ai * HALF + m * 16);
                float v = -3.0e38f;
#pragma unroll
                for (int bj = 0; bj < 2; ++bj)
#pragma unroll
                    for (int n = 0; n < 2; ++n) { const f32x4 x = acc[ai][bj][m][n] * rs; acc[ai][bj][m][n] = x; v = fmaxf(v, fmaxf(fmaxf(x[0], x[1]), fmaxf(x[2], x[3]))); }
                v = fmaxf(v, swz_xor<16>(v)); v = max_x32(v);
                if (fq == 0) TM[rl * 4 + wc] = v;
            }
        asm volatile("s_waitcnt lgkmcnt(0)" ::: "memory"); __builtin_amdgcn_s_barrier(); asm volatile("" ::: "memory");
#pragma unroll
        for (int ai = 0; ai < 2; ++ai)
#pragma unroll
            for (int m = 0; m < 4; ++m) {
                const int rl = ai * HALF + wr * 64 + m * 16 + fr;
                const f32x4 t = *(const PG8_LAS f32x4*)(TM + rl * 4);
                const float mrow = fmaxf(fmaxf(t[0], t[1]), fmaxf(t[2], t[3]));
                float s = 0.f;
#pragma unroll
                for (int bj = 0; bj < 2; ++bj)
#pragma unroll
                    for (int n = 0; n < 2; ++n) { f32x4 x = acc[ai][bj][m][n] - mrow;
                        x[0] = __builtin_amdgcn_exp2f(x[0]); x[1] = __builtin_amdgcn_exp2f(x[1]); x[2] = __builtin_amdgcn_exp2f(x[2]); x[3] = __builtin_amdgcn_exp2f(x[3]);
                        acc[ai][bj][m][n] = x; s += (x[0] + x[1]) + (x[2] + x[3]); }
                s += swz_xor<16>(s); s = sum_x32(s);
                if (fq == 0) TS[rl * 4 + wc] = s;
            }
        asm volatile("s_waitcnt lgkmcnt(0)" ::: "memory"); __builtin_amdgcn_s_barrier(); asm volatile("" ::: "memory");
        bf16_t* xp = (bf16_t*)(R1 + (size_t)u.pm * TILE_BYTES + T_Y) + (size_t)(wr * 64 + fr) * 1024 + col0;
#pragma unroll
        for (int ai = 0; ai < 2; ++ai)
#pragma unroll
            for (int m = 0; m < 4; ++m) {
                const int rl = ai * HALF + wr * 64 + m * 16 + fr;
                const f32x4 t = *(const PG8_LAS f32x4*)(TS + rl * 4);
                const float inv = __builtin_amdgcn_rcpf((t[0] + t[1]) + (t[2] + t[3]));
#pragma unroll
                for (int bj = 0; bj < 2; ++bj) store8(xp + (size_t)(ai * HALF + m * 16) * 1024 + bj * HALF, acc[ai][bj][m][0] * inv, acc[ai][bj][m][1] * inv);
            }
    }
};
}
#include <hip/hip_bf16.h>
namespace attn_body {
using bf16=__hip_bfloat16;
using bf16x8=__attribute__((ext_vector_type(8)))short;
using s16x4=__attribute__((ext_vector_type(4)))short;
using f32x16=__attribute__((ext_vector_type(16)))float;
using f32x4_t=__attribute__((ext_vector_type(4)))float;
using u32x4=__attribute__((ext_vector_type(4)))unsigned;
#define ATT_LAS __attribute__((address_space(3)))
constexpr int BATCH=8,NHEAD=8,SEQ=2048,D=64,QP=1024,KP=512;
constexpr size_t TILE_BYTES=1536*1024,T_Y=0,T_K=512*1024,T_V=768*1024,T_U=1024*1024,T_LOGF=1280*1024;
constexpr int NW=8,QBLK=32,QB=QBLK*NW,KVBLK=64,NQB=SEQ/QB;
__device__ __forceinline__ int crow(int r,int hi){return (r&3)+8*(r>>2)+4*hi;}
#define SBAR() __builtin_amdgcn_sched_barrier(0)
__device__ __forceinline__ void cmask(f32x16&p0,f32x16&p1,int jb,int qrel,int hi){
  const float NEG=-INFINITY; int kb=64*jb+4*hi;
  #pragma unroll
  for(int r=0;r<16;++r){int kv=kb+(r&3)+8*(r>>2); if(kv>qrel)p0[r]=NEG; if(kv+32>qrel)p1[r]=NEG;}
}
constexpr int NSLOT=3, SLOTB=8192;
constexpr int LDS_K=0, LDS_V=NSLOT*SLOTB, LDS_WS=2*NSLOT*SLOTB, LDS_OST=LDS_WS+NW*64*4, LDS_CB=LDS_OST+NW*4096  , LDS_WT=LDS_CB+SEQ*4, LDS_BYTES=LDS_WT+64;
__device__ __forceinline__ void glds16(const void*gsrc,unsigned lds_dst){unsigned keep;
  asm volatile("s_mov_b32 %0, m0\n\ts_mov_b32 m0, %2\n\ts_nop 0\n\tglobal_load_lds_dwordx4 %1, off\n\ts_mov_b32 m0, %0":"=&s"(keep):"v"(gsrc),"s"(lds_dst):"memory");}
__device__ __forceinline__ float max3f(float a,float b,float c){float r;asm("v_max3_f32 %0, %1, %2, %3":"=v"(r):"v"(a),"v"(b),"v"(c));return r;}
__device__ __forceinline__ float max2f(float a,float b){float r;asm("v_max_f32_e32 %0, %1, %2":"=v"(r):"v"(a),"v"(b));return r;}
__device__ __forceinline__ float fadd_s(float a,float b){float r;asm("v_add_f32_e32 %0, %1, %2":"=v"(r):"v"(a),"v"(b));return r;}
__device__ __forceinline__ float fsub_s(float a,float b){float r;asm("v_sub_f32_e32 %0, %1, %2":"=v"(r):"v"(a),"v"(b));return r;}
typedef float f32x2_t __attribute__((ext_vector_type(2))); typedef __bf16 bf16x2_t __attribute__((ext_vector_type(2)));
__device__ __forceinline__ unsigned cvtpk_s(float lo,float hi){f32x2_t v={lo,hi};bf16x2_t b=__builtin_convertvector(v,bf16x2_t);return __builtin_bit_cast(unsigned,b);}
#define WAIT_BAR(N) asm volatile("s_waitcnt vmcnt(" #N ") lgkmcnt(0)\n\ts_barrier":::"memory")

__device__ __forceinline__ void qkt(f32x16&p0,f32x16&p1,const char*Kslot,const bf16x8*qr,const f32x16&negm,int r32,int hi){
  const char*kb=Kslot+hi*1024+r32*16;
  #pragma unroll
  for(int d0=0;d0<4;++d0){
    const bf16x8 b0=*reinterpret_cast<const bf16x8*>(kb+d0*2048);
    const bf16x8 b1=*reinterpret_cast<const bf16x8*>(kb+d0*2048+512);
    if(d0==0){p0=__builtin_amdgcn_mfma_f32_32x32x16_bf16(b0,qr[0],negm,0,0,0);p1=__builtin_amdgcn_mfma_f32_32x32x16_bf16(b1,qr[0],negm,0,0,0);}
    else{p0=__builtin_amdgcn_mfma_f32_32x32x16_bf16(b0,qr[d0],p0,0,0,0);p1=__builtin_amdgcn_mfma_f32_32x32x16_bf16(b1,qr[d0],p1,0,0,0);}}
}
typedef ATT_LAS const char* lds_cptr;
typedef short v4i16_t __attribute__((ext_vector_type(4)));
__device__ __forceinline__ void kload8(bf16x8*kf,lds_cptr kp){
  kf[0]=*(const ATT_LAS bf16x8*)(kp);      kf[1]=*(const ATT_LAS bf16x8*)(kp+512);
  kf[2]=*(const ATT_LAS bf16x8*)(kp+2048); kf[3]=*(const ATT_LAS bf16x8*)(kp+2560);
  kf[4]=*(const ATT_LAS bf16x8*)(kp+4096); kf[5]=*(const ATT_LAS bf16x8*)(kp+4608);
  kf[6]=*(const ATT_LAS bf16x8*)(kp+6144); kf[7]=*(const ATT_LAS bf16x8*)(kp+6656);
}
__device__ __forceinline__ void kload2(bf16x8*kf,lds_cptr kp,int j){ kf[2*j]=*(const ATT_LAS bf16x8*)(kp+j*2048); kf[2*j+1]=*(const ATT_LAS bf16x8*)(kp+j*2048+512); }
__device__ __forceinline__ s16x4 vtr(lds_cptr p){ return __builtin_bit_cast(s16x4,__builtin_amdgcn_ds_read_tr16_b64_v4i16((ATT_LAS v4i16_t*)p)); }
__device__ __forceinline__ float rowmax(const f32x16&p0,const f32x16&p1){
  float a=max3f(p0[0],p0[1],p1[0]),b=max3f(p0[2],p0[3],p1[1]);a=max3f(a,p1[2],p1[3]);
  #pragma unroll
  for(int r=4;r<16;r+=4){a=max3f(a,p0[r],p0[r+1]);b=max3f(b,p0[r+2],p0[r+3]);a=max3f(a,p1[r],p1[r+1]);b=max3f(b,p1[r+2],p1[r+3]);}
  const float m=max2f(a,b);
  auto rr=__builtin_amdgcn_permlane32_swap(__float_as_uint(m),__float_as_uint(m),false,false);
  return max2f(__uint_as_float(rr[0]),__uint_as_float(rr[1]));
}
__device__ __forceinline__ void pv(f32x16*o,int vb,bf16x8 pa0,bf16x8 pa1,bf16x8 pa2,bf16x8 pa3){
  #pragma unroll
  for(int d0=0;d0<2;++d0){s16x4 lo[4],hi[4];
    #pragma unroll
    for(int ks=0;ks<4;++ks){
      asm volatile("ds_read_b64_tr_b16 %0,%1 offset:%c2":"=&v"(lo[ks]):"v"(vb),"i"(d0*4096+ks*1024):"memory");
      asm volatile("ds_read_b64_tr_b16 %0,%1 offset:%c2":"=&v"(hi[ks]):"v"(vb),"i"(d0*4096+ks*1024+512):"memory");}
    asm volatile("s_waitcnt lgkmcnt(0)":::"memory");SBAR();
    #define PK(k) (bf16x8){lo[k][0],lo[k][1],lo[k][2],lo[k][3],hi[k][0],hi[k][1],hi[k][2],hi[k][3]}
    o[d0]=__builtin_amdgcn_mfma_f32_32x32x16_bf16(pa0,PK(0),o[d0],0,0,0);
    o[d0]=__builtin_amdgcn_mfma_f32_32x32x16_bf16(pa1,PK(1),o[d0],0,0,0);
    o[d0]=__builtin_amdgcn_mfma_f32_32x32x16_bf16(pa2,PK(2),o[d0],0,0,0);
    o[d0]=__builtin_amdgcn_mfma_f32_32x32x16_bf16(pa3,PK(3),o[d0],0,0,0);
    #undef PK
  }
}
__device__ __forceinline__ void scan_bias(const unsigned char*R1,int b,int h,char*shm,const int tid){
  const int lane=tid&63,wid=tid>>6;
  ATT_LAS float*cb=(ATT_LAS float*)(shm+LDS_CB); ATT_LAS float*wt=(ATT_LAS float*)(shm+LDS_WT);
  const f32x4_t v=*(const f32x4_t*)((const float*)(R1+(size_t)(8*b+wid)*TILE_BYTES+T_LOGF)+h*256+4*lane);
  const float s0=v[0],s1=s0+v[1],s2=s1+v[2],s3=s2+v[3];
  float incl=s3;
  #pragma unroll
  for(int o=1;o<64;o<<=1){const float n=__int_as_float(__builtin_amdgcn_ds_bpermute((lane-o)<<2,__float_as_int(incl))); if(lane>=o)incl+=n;}
  if(lane==63)wt[wid]=incl;
  asm volatile("s_waitcnt lgkmcnt(0)\n\ts_barrier":::"memory");
  float woff=0.f;
  #pragma unroll
  for(int w=0;w<8;++w){const float x=wt[w]; if(w<wid)woff+=x;}
  const float ex=woff+incl-s3; const float L2E=-1.4426950408889634f;
  f32x4_t o4; o4[0]=(ex+s0)*L2E;o4[1]=(ex+s1)*L2E;o4[2]=(ex+s2)*L2E;o4[3]=(ex+s3)*L2E;
  *(ATT_LAS f32x4_t*)(cb+4*tid)=o4;
  asm volatile("s_waitcnt lgkmcnt(0)\n\ts_barrier":::"memory");
}
template<int THRL> __device__ __forceinline__ void attn_unit(int b,int h,int qb,const unsigned char*R1,int ocol  ,float*ssa  ,char*shm,const int tid){
  const int lane=tid&63,r32=lane&31,hi=lane>>5; const int wid=__builtin_amdgcn_readfirstlane(tid>>6);
  const long rowbase=(long)b*SEQ; const int q0=qb*QB;
  const unsigned char*Tb=R1+(size_t)(8*b)*TILE_BYTES;
  const bf16*Qw=(const bf16*)(Tb+(size_t)qb*TILE_BYTES+T_Y)+(long)(wid*QBLK)*QP+h*D;
  const unsigned lds0=(unsigned)(uintptr_t)shm;
  float*wsf=(float*)(shm+LDS_WS)+wid*64;
  const ATT_LAS float*cbh=(const ATT_LAS float*)(shm+LDS_CB)+4*hi;
  const bf16*ksrc=(const bf16*)(Tb+T_K)+h*D+(long)lane*KP+wid*8;
  const bf16*vsrc=(const bf16*)(Tb+T_V)+h*D+(long)(16*(wid&3)+(lane>>2))*KP+(wid>>2)*32+(lane&3)*8;
  const unsigned kdst=lds0+LDS_K+wid*1024, vdst=lds0+LDS_V+wid*1024;
  #define KVOFF(t) ((size_t)((t)>>2)*(TILE_BYTES/2)+(size_t)((t)&3)*KVBLK*KP)
  #define DMA_K(t,slot) glds16(ksrc+KVOFF(t),(unsigned)__builtin_amdgcn_readfirstlane(kdst+(slot)))
  #define DMA_V(t,slot) glds16(vsrc+KVOFF(t),(unsigned)__builtin_amdgcn_readfirstlane(vdst+(slot)))
  const int vb0=(int)(lds0+LDS_V)+((lane>>4)&1)*32+(lane&3)*8+(4*hi+((lane&15)>>2))*64;
  const char*Kbase=shm+LDS_K; bf16x8 kf[8];
  const lds_cptr shm3=(lds_cptr)shm; const lds_cptr kp0=shm3+LDS_K+hi*1024+r32*16; const lds_cptr vp0=shm3+LDS_V+((lane>>4)&1)*32+(lane&3)*8+(4*hi+((lane&15)>>2))*64;
  const int NT=(q0+QB)/KVBLK;
  DMA_K(0,0);DMA_V(0,0);DMA_K(1,SLOTB);
  bf16x8 qr[4];
  #pragma unroll
  for(int d0=0;d0<4;++d0)qr[d0]=*reinterpret_cast<const bf16x8*>(&Qw[(long)r32*QP+d0*16+hi*8]);
  float mhat=0.f,l_reg=0.f;f32x16 o[2];o[0]=f32x16{};o[1]=f32x16{};f32x16 negm=f32x16{};asm volatile("":"+v"(negm));
  const int qrel=wid*QBLK+r32;
  #define CMASK(P0,P1,t) do{int jb_=(t)-(NT-4); if(jb_>=0)cmask(P0,P1,jb_,qrel,hi);}while(0)
  #define ADDB(P0,P1,t) do{ const ATT_LAS float*cbt_=cbh+64*(t); \
    _Pragma("unroll") for(int j_=0;j_<4;++j_){ const f32x4_t b0_=*(const ATT_LAS f32x4_t*)(cbt_+8*j_), b1_=*(const ATT_LAS f32x4_t*)(cbt_+32+8*j_); \
      _Pragma("unroll") for(int i_=0;i_<4;++i_){P0[4*j_+i_]+=b0_[i_];P1[4*j_+i_]+=b1_[i_];} } }while(0)
  bool resc=false;
  #define START(P0,P1) do{ const float rm=rowmax(P0,P1); resc=false; \
    { const float dl=rm; mhat=fadd_s(mhat,dl); \
      _Pragma("unroll") for(int r=0;r<16;++r){P0[r]=fsub_s(P0[r],dl);P1[r]=fsub_s(P1[r],dl);} \
      _Pragma("unroll") for(int r=0;r<16;++r)negm[r]=-mhat; asm volatile("":"+v"(negm)); } \
    _Pragma("unroll") for(int r=0;r<16;++r)P0[r]=__builtin_amdgcn_exp2f(P0[r]); }while(0)
  #define RESC() do{ if(resc){ asm volatile("s_waitcnt lgkmcnt(0)":::"memory"); \
      _Pragma("unroll") for(int d_=0;d_<2;++d_) _Pragma("unroll") for(int r=0;r<16;++r)o[d_][r]*=wsf[crow(r,hi)]; } }while(0)
  f32x16 pA0,pA1,pB0,pB1;
  int sl_prev=0,sl_cur=0,sl_next=SLOTB;
  #define ROT() do{sl_prev=sl_cur;sl_cur=sl_next;sl_next=(sl_next==(NSLOT-1)*SLOTB)?0:sl_next+SLOTB;}while(0)
  DMA_K(2,2*SLOTB);
  WAIT_BAR(3);
  qkt(pA0,pA1,Kbase,qr,negm,r32,hi);asm volatile("s_nop 15\n\ts_nop 7":"+v"(pA0),"+v"(pA1));ADDB(pA0,pA1,0);asm volatile("s_nop 3":"+v"(pA0),"+v"(pA1));CMASK(pA0,pA1,0);
  START(pA0,pA1);
  _Pragma("unroll") for(int r=0;r<16;++r)pA1[r]=__builtin_amdgcn_exp2f(pA1[r]);
  WAIT_BAR(0);
  DMA_K(3,0);DMA_V(1,SLOTB);
  ROT();
  kload8(kf,kp0+sl_cur);
  WAIT_BAR(2);
  s16x4 vlo[8],vhi[8]; u32x4 pw0,pw1,pw2,pw3;
  #define PKW(P,B) cvtpk_s(P[B],P[B+1])
  #define PAF(k) __builtin_bit_cast(bf16x8,pw##k)
  #define VFR(i) (bf16x8){vlo[i][0],vlo[i][1],vlo[i][2],vlo[i][3],vhi[i][0],vhi[i][1],vhi[i][2],vhi[i][3]}
  #define PIN(x) asm volatile("":"+v"(x))
  #define MX3(a,b,c) __builtin_fmaxf(__builtin_fmaxf((a),(b)),(c))
  #define GAPA(MF,A0,A1,A2,A3,W0,W1,PW) do{ MF; sacc+=A0; sacc+=A1; sacc+=A2; sacc+=A3; PIN(sacc); W0; W1; PIN(PW); SBAR(); }while(0)
  #define EX(v) __builtin_amdgcn_exp2f(v)
  #define GAPB(MF,X,B) do{ MF; X[B]=EX(X[B]); X[B+1]=EX(X[B+1]); X[B+2]=EX(X[B+2]); X[B+3]=EX(X[B+3]); PIN(X); SBAR(); }while(0)
  #define VRD(i) do{ vlo[i]=vtr(vp_+(((i)>>2)*4096+((i)&3)*1024)); vhi[i]=vtr(vp_+(((i)>>2)*4096+((i)&3)*1024+512)); }while(0)
  #define KRD(G,j) do{ if(G){ kload2(kf,kp0+sl_next,j); SBAR(); } }while(0)
  #define STEP(C0,C1,P0,P1,t,GK,GV,GL) do{ SBAR(); \
    const lds_cptr vp_=vp0+sl_prev; \
    VRD(0); SBAR(); float sacc=(P0[0]+P0[1]); \
    GAPA(C0=__builtin_amdgcn_mfma_f32_32x32x16_bf16(kf[0],qr[0],negm,0,0,0), P0[2],P0[3],P0[4],P0[5],     pw0[0]=PKW(P0,0), pw0[1]=PKW(P0,2), pw0); \
    VRD(4); SBAR(); GAPA(C1=__builtin_amdgcn_mfma_f32_32x32x16_bf16(kf[1],qr[0],negm,0,0,0), P0[6],P0[7],P0[8],P0[9],     pw0[2]=PKW(P0,4), pw0[3]=PKW(P0,6), pw0); \
    VRD(1); SBAR(); GAPA(C0=__builtin_amdgcn_mfma_f32_32x32x16_bf16(kf[2],qr[1],C0,0,0,0),   P0[10],P0[11],P0[12],P0[13], pw1[0]=PKW(P0,8), pw1[1]=PKW(P0,10), pw1); \
    VRD(5); SBAR(); GAPA(C1=__builtin_amdgcn_mfma_f32_32x32x16_bf16(kf[3],qr[1],C1,0,0,0),   P0[14],P0[15],P1[0],P1[1],   pw1[2]=PKW(P0,12),pw1[3]=PKW(P0,14), pw1); \
    VRD(2); SBAR(); GAPA(C0=__builtin_amdgcn_mfma_f32_32x32x16_bf16(kf[4],qr[2],C0,0,0,0),   P1[2],P1[3],P1[4],P1[5],     pw2[0]=PKW(P1,0), pw2[1]=PKW(P1,2), pw2); \
    VRD(6); SBAR(); GAPA(C1=__builtin_amdgcn_mfma_f32_32x32x16_bf16(kf[5],qr[2],C1,0,0,0),   P1[6],P1[7],P1[8],P1[9],     pw2[2]=PKW(P1,4), pw2[3]=PKW(P1,6), pw2); \
    VRD(3); SBAR(); GAPA(C0=__builtin_amdgcn_mfma_f32_32x32x16_bf16(kf[6],qr[3],C0,0,0,0),   P1[10],P1[11],P1[12],P1[13], pw3[0]=PKW(P1,8), pw3[1]=PKW(P1,10), pw3); \
    VRD(7); SBAR(); GAPA(C1=__builtin_amdgcn_mfma_f32_32x32x16_bf16(kf[7],qr[3],C1,0,0,0),   P1[14],P1[15],0.f,0.f,       pw3[2]=PKW(P1,12),pw3[3]=PKW(P1,14), pw3); \
    l_reg+=sacc; \
    if(GK){DMA_K((t)+3,sl_cur);} if(GV){DMA_V((t)+1,sl_next);} \
    ADDB(C0,C1,t); \
    CMASK(C0,C1,t); \
    { float a=MX3(C0[0],C0[1],C1[0]),b=MX3(C0[2],C0[3],C1[1]); a=MX3(a,C1[2],C1[3]); \
      _Pragma("unroll") for(int r=4;r<16;r+=4){a=MX3(a,C0[r],C0[r+1]);b=MX3(b,C0[r+2],C0[r+3]);a=MX3(a,C1[r],C1[r+1]);b=MX3(b,C1[r+2],C1[r+3]);} \
      float rm=__builtin_fmaxf(a,b); { auto rr=__builtin_amdgcn_permlane32_swap(__float_as_uint(rm),__float_as_uint(rm),false,false); rm=__builtin_fmaxf(__uint_as_float(rr[0]),__uint_as_float(rr[1])); } \
      resc=false; \
      if(__builtin_expect(__any(rm>(float)THRL),0)){ const float dl=__builtin_fmaxf(rm,0.f); mhat+=dl; \
        _Pragma("unroll") for(int r=0;r<16;++r){C0[r]-=dl;C1[r]-=dl;} \
        _Pragma("unroll") for(int r=0;r<16;++r)negm[r]=-mhat; asm volatile("":"+v"(negm)); \
        const float f=__builtin_amdgcn_exp2f(-dl); l_reg*=f; if(hi==0)wsf[r32]=f; resc=true; } } \
    SBAR(); \
    GAPB(o[0]=__builtin_amdgcn_mfma_f32_32x32x16_bf16(PAF(0),VFR(0),o[0],0,0,0), C0,0); \
    GAPB(o[1]=__builtin_amdgcn_mfma_f32_32x32x16_bf16(PAF(0),VFR(4),o[1],0,0,0), C0,4); \
    KRD(GL,0); GAPB(o[0]=__builtin_amdgcn_mfma_f32_32x32x16_bf16(PAF(1),VFR(1),o[0],0,0,0), C0,8); \
    KRD(GL,1); GAPB(o[1]=__builtin_amdgcn_mfma_f32_32x32x16_bf16(PAF(1),VFR(5),o[1],0,0,0), C0,12); \
    KRD(GL,2); GAPB(o[0]=__builtin_amdgcn_mfma_f32_32x32x16_bf16(PAF(2),VFR(2),o[0],0,0,0), C1,0); \
    KRD(GL,3); GAPB(o[1]=__builtin_amdgcn_mfma_f32_32x32x16_bf16(PAF(2),VFR(6),o[1],0,0,0), C1,4); \
    GAPB(o[0]=__builtin_amdgcn_mfma_f32_32x32x16_bf16(PAF(3),VFR(3),o[0],0,0,0), C1,8); \
    GAPB(o[1]=__builtin_amdgcn_mfma_f32_32x32x16_bf16(PAF(3),VFR(7),o[1],0,0,0), C1,12); \
    }while(0)
  int t=1;
  #undef CMASK
  #define CMASK(P0,P1,t) do{}while(0)
  for(;t+5<NT;t+=2){
    STEP(pB0,pB1,pA0,pA1,t,true,true,true);     WAIT_BAR(2); RESC(); ROT();
    STEP(pA0,pA1,pB0,pB1,t+1,true,true,true);   WAIT_BAR(2); RESC(); ROT();
  }
  #undef CMASK
  #define CMASK(P0,P1,t) do{int jb_=(t)-(NT-4); if(jb_>=0)cmask(P0,P1,jb_,qrel,hi);}while(0)
  #define ENDW(tt) do{ if((tt)+3<NT){WAIT_BAR(2);} else if((tt)+2<NT){WAIT_BAR(1);} else {WAIT_BAR(0);} }while(0)
  for(;t+1<NT;t+=2){
    STEP(pB0,pB1,pA0,pA1,t,(t+3<NT),(t+1<NT),(t+1<NT));       ENDW(t);   RESC(); ROT();
    STEP(pA0,pA1,pB0,pB1,t+1,(t+4<NT),(t+2<NT),(t+2<NT));     ENDW(t+1); RESC(); ROT();
  }
  STEP(pB0,pB1,pA0,pA1,NT-1,false,false,false); RESC();
  { float sacc=pB0[0]+pB0[1]; _Pragma("unroll") for(int r=2;r<16;++r)sacc+=pB0[r]; _Pragma("unroll") for(int r=0;r<16;++r)sacc+=pB1[r]; l_reg+=sacc;
    pw0=(u32x4){PKW(pB0,0),PKW(pB0,2),PKW(pB0,4),PKW(pB0,6)};pw1=(u32x4){PKW(pB0,8),PKW(pB0,10),PKW(pB0,12),PKW(pB0,14)};pw2=(u32x4){PKW(pB1,0),PKW(pB1,2),PKW(pB1,4),PKW(pB1,6)};pw3=(u32x4){PKW(pB1,8),PKW(pB1,10),PKW(pB1,12),PKW(pB1,14)};
    SBAR(); pv(o,vb0+sl_cur,PAF(0),PAF(1),PAF(2),PAF(3)); }
  #undef PKW
  #undef PAF
  #undef VFR
  #undef PIN
  #undef MX3
  #undef GAPA
  #undef GAPB
  #undef EX
  #undef VRD
  #undef KRD
  #undef STEP
  #undef ENDW
  {auto rr=__builtin_amdgcn_permlane32_swap(__float_as_uint(l_reg),__float_as_uint(l_reg),false,false);l_reg=__uint_as_float(rr[0])+__uint_as_float(rr[1]);}
  if(hi==0)wsf[32+r32]=l_reg;asm volatile("s_waitcnt lgkmcnt(0)":::"memory");
  float rli[16];
  #pragma unroll
  for(int r=0;r<16;++r)rli[r]=__builtin_amdgcn_rcpf(wsf[32+crow(r,hi)]);
  bf16*Ow=(bf16*)(Tb+(size_t)qb*TILE_BYTES+T_Y)+(long)(wid*QBLK)*QP+h*D+ocol;
  float*ssw=ssa+(rowbase+q0+wid*QBLK)*8+h;
  { bf16*stg=(bf16*)(shm+LDS_OST)+wid*2048;
    #pragma unroll
    for(int r=0;r<16;++r){const int orow=crow(r,hi);
      #pragma unroll
      for(int d0=0;d0<2;++d0)stg[orow*64+d0*32+r32]=__float2bfloat16(o[d0][r]*rli[r]);}
    asm volatile("s_waitcnt lgkmcnt(0)":::"memory");
    #pragma unroll
    for(int i=0;i<4;++i){const int row=i*8+(lane>>3),ch=lane&7; const u32x4 v=*(const u32x4*)(stg+row*64+ch*8); *(u32x4*)(Ow+(long)row*QP+ch*8)=v;
      float q=0.f;
      #pragma unroll
      for(int e=0;e<4;++e){const float lo=__uint_as_float(v[e]<<16),hi2=__uint_as_float(v[e]&0xffff0000u); q+=lo*lo+hi2*hi2;}
      q+=swz_xor<1>(q);q+=swz_xor<2>(q);q+=swz_xor<4>(q);
      if(ch==0)ssw[row*8]=q;} }
  asm volatile("s_waitcnt lgkmcnt(0)\n\ts_barrier":::"memory");
  #undef DMA_K
  #undef DMA_V
  #undef KVOFF
  #undef CMASK
  #undef ADDB
  #undef START
  #undef RESC
  #undef ROT
}
#undef SBAR
#undef WAIT_BAR

constexpr int CONV_W=31, CONV_C=512, CONV_TOK=32, CONV_ROWS=CONV_TOK+CONV_W-1, CONV_LDS_W=0, CONV_LDS_U=CONV_W*CONV_C*4;
__device__ __forceinline__ float wsum64(float v){ return wave_sum64(v); }
__device__ __forceinline__ void conv_stage_w(const float*cw,char*shm,const int tid){
  ATT_LAS u32x4*LW=(ATT_LAS u32x4*)(shm+CONV_LDS_W); const u32x4*src=(const u32x4*)cw;
  u32x4 v[8];
  #pragma unroll
  for(int i=0;i<8;++i){const int idx=tid+i*512; v[i]=(idx<CONV_W*CONV_C/4)?src[idx]:(u32x4){0u,0u,0u,0u};}
  #pragma unroll
  for(int i=0;i<8;++i){const int idx=tid+i*512; if(idx<CONV_W*CONV_C/4)LW[idx]=v[i];}
  __syncthreads();
}
__device__ __forceinline__ void conv_unit(int unit,const unsigned char*R1,const float*cbias,const float*lng,const float*lnb,char*shm,const int tid){
  const int lane=tid&63,wid=tid>>6;
  const int b=unit>>6,t0=(unit&63)*CONV_TOK;
  const unsigned char*Tb=R1+(size_t)(8*b)*TILE_BYTES;
  ATT_LAS u32x4*L=(ATT_LAS u32x4*)(shm+CONV_LDS_U);
  const ATT_LAS f32x4_t*LW=(const ATT_LAS f32x4_t*)(shm+CONV_LDS_W);
  { u32x4 v[8];
    #pragma unroll
    for(int i=0;i<8;++i){const int idx=tid+i*512,row=idx>>6,ch=idx&63,t=t0-(CONV_W-1)+row;
      v[i]=(u32x4){0u,0u,0u,0u};
      if(idx<CONV_ROWS*64&&t>=0)v[i]=*(const u32x4*)((const bf16*)(Tb+(size_t)(t>>8)*TILE_BYTES+T_U)+(size_t)(t&255)*CONV_C+ch*8);}
    #pragma unroll
    for(int i=0;i<8;++i){const int idx=tid+i*512; if(idx<CONV_ROWS*64)L[idx]=v[i];} }
  __syncthreads();
  float acc[4][8];
  { const f32x4_t b0=*(const f32x4_t*)(cbias+8*lane),b1=*(const f32x4_t*)(cbias+8*lane+4);
    #pragma unroll
    for(int tt=0;tt<4;++tt){acc[tt][0]=b0[0];acc[tt][1]=b0[1];acc[tt][2]=b0[2];acc[tt][3]=b0[3];acc[tt][4]=b1[0];acc[tt][5]=b1[1];acc[tt][6]=b1[2];acc[tt][7]=b1[3];} }
  #pragma unroll 4
  for(int j=0;j<CONV_W;++j){
    const f32x4_t w0=LW[j*128+2*lane],w1=LW[j*128+2*lane+1];
    #pragma unroll
    for(int tt=0;tt<4;++tt){
      const u32x4 u=L[(wid*4+tt+j)*64+lane];
      acc[tt][0]+=w0[0]*__uint_as_float(u[0]<<16); acc[tt][1]+=w0[1]*__uint_as_float(u[0]&0xffff0000u);
      acc[tt][2]+=w0[2]*__uint_as_float(u[1]<<16); acc[tt][3]+=w0[3]*__uint_as_float(u[1]&0xffff0000u);
      acc[tt][4]+=w1[0]*__uint_as_float(u[2]<<16); acc[tt][5]+=w1[1]*__uint_as_float(u[2]&0xffff0000u);
      acc[tt][6]+=w1[2]*__uint_as_float(u[3]<<16); acc[tt][7]+=w1[3]*__uint_as_float(u[3]&0xffff0000u);
    }
  }
  const f32x4_t g0=*(const f32x4_t*)(lng+8*lane),g1=*(const f32x4_t*)(lng+8*lane+4),e0=*(const f32x4_t*)(lnb+8*lane),e1=*(const f32x4_t*)(lnb+8*lane+4);
  const float gg[8]={g0[0],g0[1],g0[2],g0[3],g1[0],g1[1],g1[2],g1[3]},bb[8]={e0[0],e0[1],e0[2],e0[3],e1[0],e1[1],e1[2],e1[3]};
  float mu[4],rstd[4],r2[4];
  #pragma unroll
  for(int tt=0;tt<4;++tt){ float s=0.f;
    #pragma unroll
    for(int e=0;e<8;++e)s+=acc[tt][e];
    mu[tt]=s; }
  #pragma unroll
  for(int tt=0;tt<4;++tt)mu[tt]=wsum64(mu[tt])*(1.0f/CONV_C);
  #pragma unroll
  for(int tt=0;tt<4;++tt){ float q=0.f;
    #pragma unroll
    for(int e=0;e<8;++e){acc[tt][e]-=mu[tt];q+=acc[tt][e]*acc[tt][e];}
    rstd[tt]=q; }
  #pragma unroll
  for(int tt=0;tt<4;++tt)rstd[tt]=__builtin_amdgcn_rsqf(wsum64(rstd[tt])*(1.0f/CONV_C)+1e-6f);
  #pragma unroll
  for(int tt=0;tt<4;++tt){ float q2=0.f;
    #pragma unroll
    for(int e=0;e<8;++e){float y=acc[tt][e]*rstd[tt]*gg[e]+bb[e]; y=y*__builtin_amdgcn_rcpf(1.0f+__builtin_amdgcn_exp2f(-y*1.4426950408889634f)); acc[tt][e]=y;q2+=y*y;}
    r2[tt]=q2; }
  #pragma unroll
  for(int tt=0;tt<4;++tt)r2[tt]=__builtin_amdgcn_rsqf(wsum64(r2[tt])*(1.0f/CONV_C)+1e-6f);
  #pragma unroll
  for(int tt=0;tt<4;++tt){
    u32x4 w; const float r=r2[tt];
    w[0]=cvtpk_s(acc[tt][0]*r,acc[tt][1]*r);w[1]=cvtpk_s(acc[tt][2]*r,acc[tt][3]*r);w[2]=cvtpk_s(acc[tt][4]*r,acc[tt][5]*r);w[3]=cvtpk_s(acc[tt][6]*r,acc[tt][7]*r);
    { const int t=t0+wid*4+tt; *(u32x4*)((bf16*)(Tb+(size_t)(t>>8)*TILE_BYTES+T_Y)+(size_t)(t&255)*QP+CONV_C+8*lane)=w; }
  }
  __syncthreads();
}
}
constexpr int NWAVES = 8;
constexpr int M = 16384, DM = 1024, DFF = 2816, SEQ = 2048, NBATCH = 8, NMEMROWS = 2048, NLAYER = 2;
constexpr size_t MiB = 1u << 20;
constexpr size_t WS_CTL = 0, CTL_ZERO_BYTES = 256 * 1024;
constexpr size_t WS_W = 2 * MiB;
constexpr size_t W_LAYER = 75 * MiB / 2;
constexpr size_t WO_1A = 0, WO_1B = 11 * MiB / 2, WO_IN = WO_1B + 11 * MiB / 2, WO_OUT = WO_IN + 11 * MiB / 2, WO_XQ = WO_OUT + 2 * MiB, WO_XKV = WO_XQ + 2 * MiB, WO_XO = WO_XKV + 4 * MiB,
                 WO_2A = WO_XO + 2 * MiB, WO_2B = WO_2A + 11 * MiB / 2;
static_assert(WO_2B + 11 * MiB / 2 == W_LAYER, "weight map");
constexpr size_t WS_XQ8 = 80 * MiB;
constexpr size_t WS_RSC = 96 * MiB;
constexpr size_t WS_WSC = 97 * MiB;
constexpr size_t WS_XB = 100 * MiB;
constexpr size_t WS_MKV = 132 * MiB;
constexpr size_t WS_MEMQ = 148 * MiB;
constexpr size_t WS_R1 = 152 * MiB;
constexpr size_t DOUT_WQK = 0, DOUT_WVO = 2 * MiB, DOUT_LAYER = 4 * MiB, DOUT_BATCH = 8 * MiB;
constexpr size_t WS_SSP = 99 * MiB;
constexpr size_t WS_DUMMY = 248 * MiB, WS_SSA = 249 * MiB;
constexpr size_t WS_AMX = 250 * MiB;
constexpr size_t WS_END = 251 * MiB;
constexpr int CW_BAR = 4096;
constexpr int CW_L1RDY = 8192;
constexpr int CW_XSIG = 12288;
constexpr int CW_F2RDY = 8192 + 64;
constexpr int CW_QUAD = 16384, CW_XLOC = CW_QUAD + 64 * 128;
constexpr size_t CTL_SSM = 256 * 1024;
constexpr int RING_OFF = 0, RING_BYTES = 131072;
constexpr int EPI_SCR_OFF = RING_BYTES;
constexpr int LDSCTL_OFF = RING_BYTES + 8192, MISC_OFF = LDSCTL_OFF + 320;
constexpr int LDS_BYTES = 147456;
static_assert(MISC_OFF + 128 <= LDS_BYTES, "LDS map");

#define GAS __attribute__((address_space(1)))
#define LAS __attribute__((address_space(3)))
typedef unsigned short bf16;
typedef unsigned v4u __attribute__((ext_vector_type(4)));
typedef float f32x4 __attribute__((ext_vector_type(4)));
typedef GAS unsigned gu32;
#define RLX_AGENT __ATOMIC_RELAXED, __HIP_MEMORY_SCOPE_AGENT
#define LDS_WAIT() asm volatile("s_waitcnt lgkmcnt(0)" ::: "memory")
__device__ __forceinline__ unsigned f2bf(float f) { unsigned u = __builtin_bit_cast(unsigned, f); return (u + 0x7fffu + ((u >> 16) & 1u)) >> 16; }
__device__ __forceinline__ unsigned pk2(float lo, float hi) { return f2bf(lo) | (f2bf(hi) << 16); }

#define XB_TMO      128
#define XB_XCNT(j)  (256  + 64 * (j))
#define XB_XSUB(j)  (1280 + 64 * (j))
#define XB_XGEN(j)  (2304 + 64 * (j))
#define XB_TOP      3328
#define XB_TOPGEN   3392
#define XCD_BAR_WORDS 3456
#define XB_SPIN_CAP (1u << 18)
__device__ __forceinline__ unsigned xb_ld(unsigned* p)              { return __hip_atomic_load(p, __ATOMIC_RELAXED, __HIP_MEMORY_SCOPE_AGENT); }
__device__ __forceinline__ unsigned xb_add(unsigned* p, unsigned v) { return __hip_atomic_fetch_add(p, v, __ATOMIC_RELAXED, __HIP_MEMORY_SCOPE_AGENT); }
__device__ __forceinline__ unsigned xb_xcc_id() { return (unsigned)__builtin_amdgcn_s_getreg((3 << 11) | 20) & 0xFu; }
#define XB_SPIN(cond, bar) do { unsigned _sp = 0; while (cond) { __builtin_amdgcn_s_sleep(1); \
    if ((++_sp & 255u) == 0u) { if (xb_ld(&(bar)[XB_TMO])) break; if (_sp > XB_SPIN_CAP) { atomicAdd(&(bar)[XB_TMO], 1u); break; } } } } while (0)
struct XcdBarrier { unsigned* bar; unsigned x; volatile LAS unsigned* st; };
__device__ __forceinline__ XcdBarrier xcd_barrier_post(unsigned* bar, volatile LAS unsigned* st) {
    XcdBarrier b; b.bar = bar; b.x = xb_xcc_id(); b.st = st;
    if (threadIdx.x == 0) { const unsigned rank = xb_add(&bar[XB_XCNT(b.x)], 1u); st[2] = b.x; st[3] = rank; }
    return b;
}
__device__ __forceinline__ void xcd_barrier_complete(unsigned* bar, unsigned x, unsigned& nloc, unsigned& nx) {
    const unsigned G = gridDim.x * gridDim.y * gridDim.z;
    unsigned sum, cnt, mine, sp = 0u;
    for (;;) {
        sum = 0u; cnt = 0u; mine = 0u;
#pragma unroll
        for (unsigned j = 0; j < 16; ++j) { const unsigned c = xb_ld(&bar[XB_XCNT(j)]); sum += c; cnt += (c > 0u) ? 1u : 0u; mine = (j == x) ? c : mine; }
        if (sum == G) break;
        __builtin_amdgcn_s_sleep(1);
        if ((++sp & 255u) == 0u) { if (xb_ld(&bar[XB_TMO])) break; if (sp > XB_SPIN_CAP) { atomicAdd(&bar[XB_TMO], 1u); break; } }
    }
    nloc = mine > 0u ? mine : 1u; nx = cnt > 0u ? cnt : 1u;
}
__device__ __forceinline__ void xcd_barrier(const XcdBarrier& b, const bool t0  ) {
    asm volatile("s_waitcnt vmcnt(0)" ::: "memory");
    __syncthreads();
    if (t0) {
        unsigned* bar = b.bar;
        __builtin_amdgcn_s_waitcnt(0);
        unsigned nloc = b.st[0], nx = b.st[1];
        if (nloc == 0u) { xcd_barrier_complete(bar, b.x, nloc, nx); b.st[0] = nloc; b.st[1] = nx; }
        const unsigned old = xb_add(&bar[XB_XSUB(b.x)], 1u);
        const unsigned gen = old / nloc;
        if (old + 1u == (gen + 1u) * nloc) {
            __builtin_amdgcn_fence(__ATOMIC_RELEASE, "agent");
            asm volatile("s_waitcnt vmcnt(0)" ::: "memory");
            const unsigned og = xb_add(&bar[XB_TOP], 1u);
            const unsigned tg = og / nx;
            if (og + 1u == (tg + 1u) * nx) xb_add(&bar[XB_TOPGEN], 1u);
            else XB_SPIN(xb_ld(&bar[XB_TOPGEN]) == tg, bar);
            __builtin_amdgcn_fence(__ATOMIC_ACQUIRE, "agent");
            xb_add(&bar[XB_XGEN(b.x)], 1u);
            asm volatile("s_waitcnt vmcnt(0)" ::: "memory");
        } else {
            XB_SPIN(xb_ld(&bar[XB_XGEN(b.x)]) == gen, bar);
            __builtin_amdgcn_fence(__ATOMIC_ACQUIRE, "agent");
            asm volatile("s_waitcnt vmcnt(0)" ::: "memory");
        }
    }
    __syncthreads();
}

template <class F>
__device__ __forceinline__ void xcd_local_barrier(unsigned* bar, unsigned* cw  , const bool t0, F hook  ) {
    asm volatile("s_waitcnt vmcnt(0)" ::: "memory");
    __syncthreads();
    unsigned old = 0u, target = 0u;
    if (t0) {
        __builtin_amdgcn_s_waitcnt(0);
        old = xb_add(cw, 1u); target = (old / 32u + 1u) * 32u;
        __builtin_amdgcn_fence(__ATOMIC_ACQUIRE, "agent");
    }
    hook();
    if (t0) {
        if (old + 1u != target) XB_SPIN((int)(xb_ld(cw) - target) < 0, bar);
        asm volatile("s_waitcnt vmcnt(0)" ::: "memory");
    }
    __syncthreads();
}
template <class F>
__device__ __forceinline__ void quad_barrier(unsigned* bar, unsigned* qw, const bool t0, F hook) {
    asm volatile("s_waitcnt vmcnt(0)" ::: "memory");
    __syncthreads();
    unsigned old = 0u, target = 0u;
    if (t0) {
        __builtin_amdgcn_s_waitcnt(0);
        old = xb_add(qw, 1u); target = (old / 4u + 1u) * 4u;
        __builtin_amdgcn_fence(__ATOMIC_ACQUIRE, "agent");
    }
    hook();
    if (t0) {
        if (old + 1u != target) XB_SPIN((int)(xb_ld(qw) - target) < 0, bar);
        asm volatile("s_waitcnt vmcnt(0)" ::: "memory");
    }
    __syncthreads();
}

__device__ __forceinline__ float wave_sum(float v) { return wave_sum64(v); }
__device__ __forceinline__ void tr_item(const float* W, int ldw, int col0, int nvalid, int k0, const float* gain, int gsplit, const float* gain2, bf16* WT, int ldt, int drow0, LAS float* scr, int lane) {
#pragma unroll 8
    for (int i = 0; i < 32; ++i) { const int kk = 2 * i + (lane >> 5), n = lane & 31, k = k0 + kk;
        float v = (n < nvalid) ? W[(size_t)k * ldw + col0 + n] : 0.f;
        if (gain) v *= (k < gsplit ? gain[k] : gain2[k - gsplit]);
        scr[kk * 33 + n] = v; }
    LDS_WAIT(); asm volatile("" ::: "memory");
    const int c = lane & 7;
#pragma unroll
    for (int j = 0; j < 4; ++j) { const int n = (lane >> 3) + 8 * j; const LAS float* s = scr + (8 * c) * 33 + n;
        v4u o; o.x = pk2(s[0 * 33], s[1 * 33]); o.y = pk2(s[2 * 33], s[3 * 33]); o.z = pk2(s[4 * 33], s[5 * 33]); o.w = pk2(s[6 * 33], s[7 * 33]);
        *(GAS v4u*)(WT + (size_t)(drow0 + n) * ldt + k0 + 8 * c) = o; }
    LDS_WAIT(); asm volatile("" ::: "memory");
}
__device__ __forceinline__ void tr_item64(const float* W, int ldw, int col0, int nvalid, int k0, const float* gain, int gsplit, const float* gain2, bf16* WT, int ldt, int drow0, int lane, LAS v4u* scr  , const bool wt = false  ) {
    float v[64];
    const float* src = W + (size_t)k0 * ldw + col0 + lane; const bool ok = lane < nvalid;
#pragma unroll
    for (int j = 0; j < 64; ++j) v[j] = ok ? __builtin_nontemporal_load(src + (size_t)j * ldw) : 0.f;
    if (gain) {
#pragma unroll
        for (int j = 0; j < 64; ++j) { const int k = k0 + j; v[j] *= (k < gsplit ? gain[k] : gain2[k - gsplit]); }
    }
#pragma unroll
    for (int p = 0; p < 8; ++p) { v4u o; o.x = pk2(v[8 * p], v[8 * p + 1]); o.y = pk2(v[8 * p + 2], v[8 * p + 3]); o.z = pk2(v[8 * p + 4], v[8 * p + 5]); o.w = pk2(v[8 * p + 6], v[8 * p + 7]);
        scr[lane * 8 + (p ^ (lane & 7))] = o; }
    LDS_WAIT(); asm volatile("" ::: "memory");
#pragma unroll
    for (int c = 0; c < 8; ++c) { const int n = 8 * c + (lane >> 3), p = (lane & 7) ^ (n & 7);
        const v4u o = scr[c * 64 + lane];
        if (wt) __builtin_amdgcn_raw_buffer_store_b128(o, __builtin_amdgcn_make_buffer_rsrc(WT, 0, 0x7fffffff, 0x00020000), (int)(((size_t)(drow0 + n) * ldt + k0 + 8 * p) * 2), 0,   16);
        else *(GAS v4u*)(WT + (size_t)(drow0 + n) * ldt + k0 + 8 * p) = o; }
    LDS_WAIT(); asm volatile("" ::: "memory");
}
__device__ __forceinline__ void row_to_bf16(const float* xrow, bf16* orow, float* ssp, int lane) {
    const GAS f32x4* xr = (const GAS f32x4*)xrow + lane;
    f32x4 v[4]; float s = 0.f;
#pragma unroll
    for (int j = 0; j < 4; ++j) { v[j] = xr[64 * j]; s += (v[j].x * v[j].x + v[j].y * v[j].y) + (v[j].z * v[j].z + v[j].w * v[j].w); }
    s = wave_sum(s);
    GAS unsigned long long* o8 = (GAS unsigned long long*)orow + lane;
#pragma unroll
    for (int j = 0; j < 4; ++j) o8[64 * j] = (unsigned long long)pk2(v[j].x, v[j].y) | ((unsigned long long)pk2(v[j].z, v[j].w) << 32);
    if (lane == 0) *ssp = s;
}

__device__ __forceinline__ unsigned pk4_i8(float a, float b, float c, float d) {
    const int ia = (int)__builtin_rintf(a), ib = (int)__builtin_rintf(b), ic = (int)__builtin_rintf(c), id = (int)__builtin_rintf(d);
    return ((unsigned)ia & 255u) | (((unsigned)ib & 255u) << 8) | (((unsigned)ic & 255u) << 16) | ((unsigned)id << 24);
}
__device__ __forceinline__ void q8_item(const float* W, int ldw, int col0, const float* gain, signed char* WT8, int drow0, float* wsc, LAS unsigned char* scr, int tid, const bool wt = false) {
    const int c4 = (tid & 7) * 4, kq = tid >> 3;
    f32x4 v[4][4]; float am = 0.f;
#pragma unroll
    for (int i = 0; i < 4; ++i)
#pragma unroll
        for (int e = 0; e < 4; ++e) v[i][e] = __builtin_nontemporal_load((const GAS f32x4*)(W + (size_t)(256 * i + 4 * kq + e) * ldw + col0 + c4));
#pragma unroll
    for (int i = 0; i < 4; ++i) { const f32x4 g4 = *(const GAS f32x4*)(gain + 256 * i + 4 * kq);
#pragma unroll
        for (int e = 0; e < 4; ++e) { v[i][e] *= g4[e];
            am = fmaxf(fmaxf(am, fmaxf(__builtin_fabsf(v[i][e].x), __builtin_fabsf(v[i][e].y))), fmaxf(__builtin_fabsf(v[i][e].z), __builtin_fabsf(v[i][e].w))); } }
    am = wave_max64(am);
    LAS float* red = (LAS float*)(scr + 32 * 1040);
    if ((tid & 63) == 0) red[tid >> 6] = am;
    __syncthreads();
    am = fmaxf(fmaxf(fmaxf(red[0], red[1]), fmaxf(red[2], red[3])), fmaxf(fmaxf(red[4], red[5]), fmaxf(red[6], red[7])));
    const float inv = am > 0.f ? 127.0f / am : 0.f;
#pragma unroll
    for (int i = 0; i < 4; ++i)
#pragma unroll
        for (int j = 0; j < 4; ++j) *(LAS unsigned*)(scr + (c4 + j) * 1040 + 256 * i + 4 * kq) = pk4_i8(v[i][0][j] * inv, v[i][1][j] * inv, v[i][2][j] * inv, v[i][3][j] * inv);
    __syncthreads();
    const int c = tid >> 4, kc = tid & 15;
#pragma unroll
    for (int j = 0; j < 4; ++j) { const v4u o = *(const LAS v4u*)(scr + c * 1040 + 16 * kc + 256 * j);
        if (wt) __builtin_amdgcn_raw_buffer_store_b128(o, __builtin_amdgcn_make_buffer_rsrc(WT8, 0, 0x7fffffff, 0x00020000), (drow0 + c) * 1024 + 16 * kc + 256 * j, 0, 16);
        else *(GAS v4u*)(WT8 + (size_t)(drow0 + c) * 1024 + 16 * kc + 256 * j) = o; }
    if (tid == 0) { const float sc = am > 0.f ? am * (1.0f / 127.0f) : 1.0f; if (wt) __hip_atomic_store((GAS unsigned*)wsc, __float_as_uint(sc), RLX_AGENT); else *wsc = sc; }
    __syncthreads();
}
__device__ __forceinline__ void quant_rows8(const bf16* XB, const float* ssp, signed char* XQ, float* rsc, int row0, int lane) {
    unsigned long long w[8][4]; float ss[8];
#pragma unroll
    for (int r = 0; r < 8; ++r) { const GAS unsigned long long* xr = (const GAS unsigned long long*)(XB + (size_t)(row0 + r) * DM) + lane;
#pragma unroll
        for (int j = 0; j < 4; ++j) w[r][j] = xr[64 * j]; }
#pragma unroll
    for (int r = 0; r < 8; ++r) ss[r] = pg8::ss_sum16(ssp, row0 + r);
#pragma unroll
    for (int r = 0; r < 8; ++r) { const int m = row0 + r; GAS unsigned* q4 = (GAS unsigned*)(XQ + (size_t)m * DM) + lane;
        f32x4 v[4]; float am = 0.f;
#pragma unroll
        for (int j = 0; j < 4; ++j) { const unsigned lo = (unsigned)w[r][j], hi = (unsigned)(w[r][j] >> 32);
            v[j] = (f32x4){__uint_as_float(lo << 16), __uint_as_float(lo & 0xffff0000u), __uint_as_float(hi << 16), __uint_as_float(hi & 0xffff0000u)};
            am = fmaxf(fmaxf(am, fmaxf(__builtin_fabsf(v[j].x), __builtin_fabsf(v[j].y))), fmaxf(__builtin_fabsf(v[j].z), __builtin_fabsf(v[j].w))); }
        am = wave_max64(am);
        const float inv = am > 0.f ? 127.0f / am : 0.f;
#pragma unroll
        for (int j = 0; j < 4; ++j) q4[64 * j] = pk4_i8(v[j].x * inv, v[j].y * inv, v[j].z * inv, v[j].w * inv);
        if (lane == 0) rsc[m] = am * (1.0f / 127.0f) * __builtin_amdgcn_rsqf(ss[r] * (1.0f / 1024.0f) + pg8::RMS_EPS); }
}

struct Args { const float* in[26]; float* out; unsigned char* ws; };

enum { PH_PRO = 0, PH_L0 = 1, PH_PER_LAYER = 9, PH_FINAL = PH_L0 + 2 * PH_PER_LAYER, PH_COUNT = PH_FINAL + 1 };

#define WSP() ({ unsigned long long w_ = (unsigned long long)args.ws; asm volatile("" : "+s"(w_)); (unsigned char*)(GAS unsigned char*)w_; })
#define INP(i) ({ int i_ = __builtin_amdgcn_readfirstlane(i); asm volatile("" : "+s"(i_)); (const float*)(const GAS float*)(unsigned long long)args.in[i_]; })
#define XPTR() ({ unsigned long long x_ = (unsigned long long)args.out; asm volatile("" : "+s"(x_)); (float*)(GAS float*)x_; })
#define TID() ({ int w_ = wid_s; unsigned m_ = ~0u; asm volatile("" : "+s"(w_), "+s"(m_)); int t_ = (w_ << 6) | (int)__builtin_amdgcn_mbcnt_hi(m_, __builtin_amdgcn_mbcnt_lo(m_, 0u)); asm volatile("" : "+v"(t_)); t_; })

constexpr size_t T1K = (size_t)256 * 1024 * 2, TFF = (size_t)256 * 2816 * 2, TLB = pg8::TILE_BYTES;
using G_1024 = pg8::Gemm<1024, 1024, 1024>; using G_up8 = pg8::Gemm<512, 512, 512, true>; using G_down = pg8::Gemm<2816, 2816, 2816>; using G_qk = pg8::Gemm<2048, 1024, 256>; using G_vo = pg8::Gemm<1024, 2048, 256>;
using S_up = pg8::SchedT<0, 64, 22, T1K / 2, T1K / 2>; using S_mkv = pg8::SchedT<4, 8, 8, T1K / 2, T1K / 2>; using S_down = pg8::SchedT<0, 64, 4, TLB, TFF>; using S_win = pg8::SchedT<0, 64, 11, T1K, T1K>;
using S_wout = pg8::SchedT<0, 64, 4, TLB, T1K>; using S_xs = pg8::SchedT<1, 64, 4, T1K, T1K, DOUT_BATCH>; using S_xpv = pg8::SchedT<1, 64, 4, TLB, T1K, DOUT_BATCH>;
using S_qk = pg8::SchedT<2, 128, 1, 0, 0>; using S_vo = pg8::SchedT<3, 128, 1, 0, 0>;

#ifndef PROBE_MASK
#define PROBE_MASK 0
#endif
#ifndef PROBE_REPS
#define PROBE_REPS 1
#endif
#ifndef PROBE_BARS
#define PROBE_BARS 0
#endif
#ifndef PROBE_NOATT
#define PROBE_NOATT 0
#endif
#ifndef PROBE_NOCONV
#define PROBE_NOCONV 0
#endif
#ifndef FORCE_GLOBAL
#define FORCE_GLOBAL 0
#endif
#define NREP(k) (((PROBE_MASK >> (k)) & 1) ? (PROBE_REPS + 1) : 1)
#define REP_LOOP(k) _Pragma("unroll 1") for (int rep_ = 0; rep_ < NREP(k); ++rep_)
#define SHADOW(k) (NREP(k) > 1 && rep_ + 1 < NREP(k))
#define REP_SEAM(k) do { if (SHADOW(k)) GRIDBAR(); } while (0)

#define WSP() ({ unsigned long long w_ = (unsigned long long)args.ws; asm volatile("" : "+s"(w_)); (unsigned char*)(GAS unsigned char*)w_; })
#define INP(i) ({ int i_ = __builtin_amdgcn_readfirstlane(i); asm volatile("" : "+s"(i_)); (const float*)(const GAS float*)(unsigned long long)args.in[i_]; })
#define XPTR() ({ unsigned long long x_ = (unsigned long long)args.out; asm volatile("" : "+s"(x_)); (float*)(GAS float*)x_; })
#define TID() ({ int w_ = wid_s; unsigned m_ = ~0u; asm volatile("" : "+s"(w_), "+s"(m_)); int t_ = (w_ << 6) | (int)__builtin_amdgcn_mbcnt_hi(m_, __builtin_amdgcn_mbcnt_lo(m_, 0u)); asm volatile("" : "+v"(t_)); t_; })
#define MISCW(k) (*({ unsigned o_ = MISC_OFF + 4 * (k); asm volatile("" : "+s"(o_)); (volatile LAS unsigned*)(ldsp + o_); }))
#define BXP() ((int)__builtin_amdgcn_readfirstlane((int)MISCW(13)))
#define BARW() ((unsigned*)(WSP() + WS_CTL) + CW_BAR)
#define GRIDBAR() do { XcdBarrier bar_; bar_.bar = BARW(); bar_.x = xb_xcc_id(); bar_.st = &MISCW(8); xcd_barrier(bar_, TID() == 0); } while (0)
#define XCDBAR_H(hook) do { if (MISCW(12)) { unsigned* bw_ = BARW(); xcd_local_barrier(bw_, bw_ - CW_BAR + CW_XLOC + 64 * MISCW(10), TID() == 0, hook); } else { hook(); GRIDBAR(); } } while (0)
#define QUADBAR_H(hook) do { if (MISCW(12)) { unsigned* bw_ = BARW(); quad_barrier(bw_, bw_ - CW_BAR + CW_QUAD + 128 * (MISCW(10) * 8 + (MISCW(11) & 7)), TID() == 0, hook); } else { hook(); GRIDBAR(); } } while (0)
#define XCDBAR() XCDBAR_H([]{})
#define QUADBAR() QUADBAR_H([]{})

#define RDY_SIGNAL3(cw_x, n_x, cw_a, cw_b) do { asm volatile("s_waitcnt vmcnt(0)" ::: "memory"); __syncthreads(); if (TID() == 0) { unsigned* bw_ = BARW(); \
        xb_add(bw_ - CW_BAR + (cw_a), 1u); if ((cw_b) >= 0) xb_add(bw_ - CW_BAR + (cw_b), 1u); } } while (0)
#define RDY_WAIT(cw, n) do { if (TID() == 0) { unsigned* bw_ = BARW(); XB_SPIN(xb_ld(bw_ - CW_BAR + (cw)) < (unsigned)(n), bw_); if (!MISCW(12)) { __builtin_amdgcn_fence(__ATOMIC_ACQUIRE, "agent"); asm volatile("s_waitcnt vmcnt(0)" ::: "memory"); } } __syncthreads(); } while (0)
#define L1_WAIT() RDY_WAIT(CW_L1RDY, 128)

__device__ __forceinline__ void stagger_wait(unsigned ticks) {
    const unsigned long long t0 = __builtin_amdgcn_s_memrealtime();
    while (__builtin_amdgcn_s_memrealtime() - t0 < (unsigned long long)ticks) __builtin_amdgcn_s_sleep(8);
}
#ifndef STAGGER_UP
#define STAGGER_UP 0
#endif
#ifndef STAGGER_WIN
#define STAGGER_WIN 0
#endif

__global__ void __launch_bounds__(NWAVES * 64, 2) mega_fwd(Args args) {
    extern __shared__ __attribute__((aligned(16))) unsigned char lds[];
    LAS unsigned char* ldsp = (LAS unsigned char*)lds;
    volatile LAS unsigned* MISC = (volatile LAS unsigned*)(ldsp + MISC_OFF);
    constexpr int G = 256; const int bx = blockIdx.x;
    const int wid_s = __builtin_amdgcn_readfirstlane(threadIdx.x >> 6);
    for (int u = threadIdx.x; u < (LDS_BYTES - LDSCTL_OFF) / 4; u += NWAVES * 64) ((LAS unsigned*)(ldsp + LDSCTL_OFF))[u] = 0u;
    __syncthreads();
    (void)xcd_barrier_post((unsigned*)(args.ws + WS_CTL) + CW_BAR, MISC + 8);
    constexpr float QSCALE = 0.125f * 1.4426950408889634f, XSCALE = 0.0625f * 1.4426950408889634f;

    constexpr int I_DN = 44 * 16, I_IN = 16 * 41, I_SQ = 16 * 16, I_KV = 16 * 32, I_WQ = 256;
    constexpr int L_ITEMS = 2 * I_DN + I_IN + I_SQ + I_KV + I_SQ + I_WQ, KV0 = 2 * I_DN + I_IN + I_SQ  , Q_ITEMS = 352;
#define W_ITEM(l_, r_, lane, scr) do { const int l = (l_); int r = (r_); \
        unsigned char* ws = WSP(); \
                unsigned char* wl = ws + WS_W + (size_t)l * W_LAYER; \
                if (r < 2 * I_DN) { \
                    const int f = r / I_DN; r %= I_DN; \
                    { const int kb = r / 16, nb = r % 16; const float* w = INP(f ? 24 : 5) + (size_t)l * DFF * DM; \
                        tr_item64(w, DM, nb * 64, 64, kb * 64, nullptr, 0, w, (bf16*)(wl + (f ? WO_2B : WO_1B)), DFF, nb * 64, lane, scr, true); } \
                    break; \
                } \
                r -= 2 * I_DN; \
                if (r < I_IN) { \
                    const int kb = r / 41, nb = r % 41; int col0, nvalid = 64, drow0; \
                    if (nb < 24) { col0 = nb * 64; drow0 = col0; } \
                    else if (nb == 24) { col0 = 1536; nvalid = 8; drow0 = 2560; } \
                    else if (nb < 33) { const int ch = (nb - 25) * 64; col0 = 1544 + ch; drow0 = 1536 + 256 * (ch / 128) + (ch % 128); } \
                    else { const int ch = (nb - 33) * 64; col0 = 2056 + ch; drow0 = 1536 + 256 * (ch / 128) + 128 + (ch % 128); } \
                    const float* w = INP(7) + (size_t)l * DM * 2568; const float* gn = INP(6) + l * DM; \
                    tr_item64(w, 2568, col0, nvalid, kb * 64, gn, 1 << 30, gn, (bf16*)(wl + WO_IN), DM, drow0, lane, scr, true); break; } \
                r -= I_IN; \
                if (r < I_SQ) { const int kb = r / 16, nb = r % 16; const float* w = INP(15) + (size_t)l * DM * DM; \
                    tr_item64(w, DM, nb * 64, 64, kb * 64, INP(13) + l * 512, 512, INP(14) + l * 512, (bf16*)(wl + WO_OUT), DM, nb * 64, lane, scr, true); break; } \
                r -= I_SQ; \
                if (r < I_KV) { const int kb = r / 32, nb = r % 32; const float* w = INP(19) + (size_t)l * DM * 2048; const float* gn = INP(17) + l * DM; \
                    tr_item64(w, 2048, nb * 64, 64, kb * 64, gn, 1 << 30, gn, (bf16*)(wl + WO_XKV), DM, nb * 64, lane, scr, true); break; } \
                r -= I_KV; \
                if (r < I_SQ) { const int kb = r / 16, nb = r % 16; const float* w = INP(20) + (size_t)l * DM * DM; \
                    tr_item64(w, DM, nb * 64, 64, kb * 64, nullptr, 0, w, (bf16*)(wl + WO_XO), DM, nb * 64, lane, scr, true); break; } \
                r -= I_SQ; \
                { const float* w = INP(18) + (size_t)l * DM * DM; const float* gn = INP(16) + l * DM; bf16* WQ = (bf16*)(wl + WO_XQ); \
                  f32x4 v[4][4]; \
_Pragma("unroll") \
                  for (int q = 0; q < 4; ++q) \
_Pragma("unroll") \
                      for (int j = 0; j < 4; ++j) v[q][j] = __builtin_nontemporal_load((const GAS f32x4*)(w + (size_t)(4 * r + q) * DM) + lane + 64 * j); \
_Pragma("unroll") \
                  for (int q = 0; q < 4; ++q) { const float g = gn[4 * r + q] * XSCALE; GAS unsigned long long* o8 = (GAS unsigned long long*)(WQ + (size_t)(4 * r + q) * DM) + lane; \
_Pragma("unroll") \
                      for (int j = 0; j < 4; ++j) { const f32x4 t = v[q][j] * g; const unsigned long long ow = (unsigned long long)pk2(t.x, t.y) | ((unsigned long long)pk2(t.z, t.w) << 32); __hip_atomic_store(o8 + 64 * j, ow, RLX_AGENT); } } } \
    } while (0)
#define Q_ITEM(l_, r_, tid, wt_) do { const int l = (l_), r = (r_); const int f = r / 176, which = (r % 176) / 88, j0 = (r % 88) * 32, drow0 = 256 * (j0 / 128) + which * 128 + (j0 % 128); \
        unsigned char* ws_ = WSP(); \
        q8_item(INP(which ? (f ? 23 : 4) : (f ? 22 : 3)) + (size_t)l * DM * DFF, DFF, j0, INP(f ? 21 : 2) + l * DM, (signed char*)(ws_ + WS_W + (size_t)l * W_LAYER + (f ? WO_2A : WO_1A)), drow0, \
                (float*)(ws_ + WS_WSC) + (l * 2 + f) * 176 + drow0 / 32, ldsp + RING_OFF, tid, wt_); } while (0)
#define QKV_ITEM(l_, nb_, tid) do { const int l = (l_), nb = (nb_); unsigned char* ws_ = WSP(); \
        q8_item(INP(19) + (size_t)l * DM * 2048, 2048, nb * 32, INP(17) + l * DM, (signed char*)(ws_ + WS_W + (size_t)l * W_LAYER + WO_XKV), nb * 32, (float*)(ws_ + WS_WSC) + 1024 + l * 64 + nb, ldsp + RING_OFF, tid, true); } while (0)

    REP_LOOP(9) {
        unsigned char* ws = WSP(); const int tid = TID();
        const int lane = tid & 63, wave = __builtin_amdgcn_readfirstlane(tid >> 6);
        const int gw = bx * NWAVES + wave, NGW = G * NWAVES;
        LAS v4u* scr = (LAS v4u*)(ldsp + RING_OFF + wave * 8192);
#pragma unroll 1
        for (int it = G - 1 - bx; it < 352 + 128; it += G) { if (it < 176) Q_ITEM(0, it, tid, true); else if (it < 352) Q_ITEM(1, it - 176, tid, true); else QKV_ITEM((it - 352) >> 6, (it - 352) & 63, tid); }
        constexpr int W_ITEMS = L_ITEMS - I_KV, X_ITEMS = M / 4, MEM_ITEMS = NMEMROWS / 4;
#pragma unroll 1
        for (int it = gw; it < W_ITEMS + X_ITEMS + MEM_ITEMS; it += NGW) {
            if (it < W_ITEMS) {
                W_ITEM(0, it < KV0 ? it : it + I_KV, lane, scr);
            } else {
                int r = it - W_ITEMS; const bool ismem = r >= X_ITEMS; if (ismem) r -= X_ITEMS;
                const float* src = INP(ismem ? 1 : 0) + (size_t)(4 * r) * DM; unsigned char* dq = ws + (ismem ? WS_MEMQ : WS_XQ8) + (size_t)(4 * r) * DM; float* rsc = (ismem ? (float*)(ws + CTL_SSM) : (float*)(ws + WS_RSC)) + 4 * r;
                f32x4 v[4][4]; float s[4], mx[4];
#pragma unroll
                for (int q = 0; q < 4; ++q)
#pragma unroll
                    for (int j = 0; j < 4; ++j) v[q][j] = __builtin_nontemporal_load((const GAS f32x4*)(src + (size_t)q * DM) + lane + 64 * j);
#pragma unroll
                for (int q = 0; q < 4; ++q) { s[q] = 0.f; mx[q] = 0.f;
#pragma unroll
                    for (int j = 0; j < 4; ++j) { s[q] += (v[q][j].x * v[q][j].x + v[q][j].y * v[q][j].y) + (v[q][j].z * v[q][j].z + v[q][j].w * v[q][j].w);
                        mx[q] = fmaxf(fmaxf(mx[q], fmaxf(__builtin_fabsf(v[q][j].x), __builtin_fabsf(v[q][j].y))), fmaxf(__builtin_fabsf(v[q][j].z), __builtin_fabsf(v[q][j].w))); } }
#pragma unroll
                for (int q = 0; q < 4; ++q) { s[q] = wave_sum64(s[q]);
                    const float am = wave_max64(mx[q]), inv = am > 0.f ? 127.0f / am : 0.f;
                    GAS unsigned* q4 = (GAS unsigned*)(dq + (size_t)q * DM) + lane;
#pragma unroll
                    for (int j = 0; j < 4; ++j) __hip_atomic_store(q4 + 64 * j, pk4_i8(v[q][j].x * inv, v[q][j].y * inv, v[q][j].z * inv, v[q][j].w * inv), RLX_AGENT);
                    if (lane == 0) __hip_atomic_store((GAS unsigned*)(rsc + q), __float_as_uint(am * (1.0f / 127.0f) * __builtin_amdgcn_rsqf(s[q] * (1.0f / 1024.0f) + pg8::RMS_EPS)), RLX_AGENT); }
            }
        }
        REP_SEAM(9);
    }
    GRIDBAR();
    if (TID() == 0) {
        unsigned* bw = BARW(); bool ok = !FORCE_GLOBAL;
        for (int j = 0; j < 16; ++j) ok = ok && (xb_ld(&bw[XB_XCNT(j)]) == (j < 8 ? 32u : 0u));
        MISCW(12) = ok ? 1u : 0u; MISCW(13) = ok ? (MISCW(11) * 8u + MISCW(10)) : (unsigned)bx;
    }
    __syncthreads();

#pragma unroll 1
    for (int l = 0; l < NLAYER; ++l) {
#pragma unroll 1
        for (int f = 0; f < 2; ++f) {
            if (l == 1 && f == 0) L1_WAIT();
            if (f == 1) RDY_WAIT(CW_F2RDY + 64 * l, 64);
            if (l + f > 0 && !MISCW(12)) {
                unsigned char* ws = WSP(); const int tid = TID(); const int bxp = BXP();
                quant_rows8((const bf16*)(ws + WS_XB), (const float*)(ws + WS_SSP), (signed char*)(ws + WS_XQ8), (float*)(ws + WS_RSC),
                            (8 * (bxp & 7) + ((bxp >> 3) & 7)) * 256 + (bxp >> 6) * 64 + __builtin_amdgcn_readfirstlane(tid >> 6) * 8, tid & 63);
            }
            {
                unsigned char* ws = WSP(); unsigned char* wl = ws + WS_W + (size_t)l * W_LAYER; const int bxp = BXP();
                {
                G_up8 g8; S_up S; S.init(bxp, ws + WS_XQ8, wl + (f ? WO_2A : WO_1A));
                pg8::Unit u0; S.next(0, u0);
                auto hook = [=] { pg8::prestage_B<G_up8, true>(ldsp + RING_OFF, u0.b, TID()); };
                if (l + f > 0) QUADBAR_H(hook); else hook();
                if (STAGGER_UP && bxp >= 128 && f == 1 && l == 1) stagger_wait(STAGGER_UP);
                pg8::EpiSwiGLUQ E{(bf16*)(ws + WS_R1), (const float*)(ws + WS_RSC), (const float*)(ws + WS_WSC) + (l * 2 + f) * 176};
                pg8::gemm_phase<pg8::EpiSwiGLUQ, decltype(S), decltype(g8), true, true, true>(ldsp + RING_OFF, g8, S, E, TID());
                }
                if (l == 0 && f == 1 && bxp >= 128) {
                    const int tid = TID(); const int lane = tid & 63, wave = __builtin_amdgcn_readfirstlane(tid >> 6);
                    LAS v4u* scr = (LAS v4u*)(ldsp + RING_OFF + wave * 8192);
#pragma unroll 1
                    for (int it = (bxp - 128) * NWAVES + wave; it < L_ITEMS - I_KV; it += 128 * NWAVES) W_ITEM(1, it < KV0 ? it : it + I_KV, lane, scr);
                    RDY_SIGNAL3(CW_XSIG + 1024, 16, CW_L1RDY, -1);
                }
                G_1024 g;
                if (l == 0 && f == 0) {
#pragma unroll 1
                    for (int l2 = 0; l2 < NLAYER; ++l2) {
                        unsigned char* ws2 = WSP();
                        G_up8 g8; S_mkv S2; S2.init(bxp - 128 - 64 * l2, ws2 + WS_MEMQ, ws2 + WS_W + (size_t)l2 * W_LAYER + WO_XKV);
                        pg8::EpiRowScaleQ E2{(bf16*)(ws2 + WS_MKV) + (size_t)l2 * 2048 * 2048, (const float*)(ws2 + CTL_SSM), (const float*)(ws2 + WS_WSC) + 1024 + l2 * 64};
                        pg8::gemm_phase<pg8::EpiRowScaleQ, decltype(S2), decltype(g8)>(ldsp + RING_OFF, g8, S2, E2, TID());
                    }
                }
                if (l == 1 && f == 0) {
                    { unsigned char* ws2 = WSP(); unsigned char* wl2 = ws2 + WS_W + (size_t)W_LAYER;
                      G_qk g2; S_qk S2; S2.init(bxp - 128, (bf16*)(ws2 + WS_MKV) + (size_t)2048 * 2048, wl2 + WO_XQ);
                      pg8::EpiAux E2{(bf16*)((unsigned char*)XPTR() + DOUT_LAYER + DOUT_WQK), 1.0f};
                      pg8::gemm_phase<pg8::EpiAux, decltype(S2), decltype(g2)>(ldsp + RING_OFF, g2, S2, E2, TID()); }
                    { unsigned char* ws2 = WSP(); unsigned char* wl2 = ws2 + WS_W + (size_t)W_LAYER;
                      G_vo g2; S_vo S2; S2.init(bxp - 128, wl2 + WO_XO, (bf16*)(ws2 + WS_MKV) + (size_t)2048 * 2048);
                      pg8::EpiAux E2{(bf16*)((unsigned char*)XPTR() + DOUT_LAYER + DOUT_WVO), 1.0f};
                      pg8::gemm_phase<pg8::EpiAux, decltype(S2), decltype(g2)>(ldsp + RING_OFF, g2, S2, E2, TID()); }
                }
            }
            const bool last_phase = (l == NLAYER - 1 && f == 1);
            {
                unsigned char* ws = WSP(); unsigned char* wl = ws + WS_W + (size_t)l * W_LAYER;
                G_down g; S_down S; S.init(BXP(), ws + WS_R1, wl + (f ? WO_2B : WO_1B));
                pg8::Unit u0; S.next(0, u0);
                auto hook = [=] { pg8::prestage_B<G_down, true>(ldsp + RING_OFF, u0.b, TID()); };
                if (last_phase) XCDBAR_H(hook); else QUADBAR_H(hook);
                if (last_phase && MISCW(12)) {
                    unsigned* bw = BARW();
                    pg8::EpiFinal E{(bf16*)(ws + WS_XB), (float*)(ws + WS_SSP), 0.5f, XPTR(), INP(25), bw - CW_BAR + CW_QUAD + 128 * (MISCW(10) * 8 + (MISCW(11) & 7)), bw + XB_TMO};
                    pg8::gemm_phase<pg8::EpiFinal, decltype(S), decltype(g), true, true, true>(ldsp + RING_OFF, g, S, E, TID());
                    return;
                }
                if (l == 0 && f == 1 && MISCW(12)) {
                    unsigned* bw = BARW();
                    pg8::EpiResidQ E{(bf16*)(ws + WS_XB), (float*)(ws + WS_SSP), (float*)(ws + WS_AMX), ws + WS_XQ8, (float*)(ws + WS_RSC), 0.5f, bw - CW_BAR + CW_QUAD + 128 * (MISCW(10) * 8 + (MISCW(11) & 7)), bw + XB_TMO};
                    pg8::gemm_phase<pg8::EpiResidQ, decltype(S), decltype(g), true, true, true>(ldsp + RING_OFF, g, S, E, TID());
                } else {
                pg8::EpiResid<0> E{(l == 0 && f == 0) ? INP(0) : (const float*)nullptr, nullptr, (bf16*)(ws + WS_XB), (float*)(ws + WS_SSP), nullptr, 0.5f};
                pg8::gemm_phase<pg8::EpiResid<0>, decltype(S), decltype(g), true, true, true>(ldsp + RING_OFF, g, S, E, TID());
                }
            }
            if (f == 1) break;
            {
                unsigned char* ws = WSP(); unsigned char* wl = ws + WS_W + (size_t)l * W_LAYER;
                const int bxp = BXP();
                G_1024 g; S_win S; S.init(bxp, ws + WS_XB, wl + WO_IN);
                pg8::Unit u0; S.next(0, u0);
                auto hook = [=] { pg8::prestage_B<G_1024, true>(ldsp + RING_OFF, u0.b, TID()); };
                QUADBAR_H(hook);
                if (STAGGER_WIN && bxp >= 192 && l == 1) stagger_wait(STAGGER_WIN);
                pg8::EpiWin E{ws + WS_R1, (float*)(ws + WS_SSP), INP(8) + l * 8, QSCALE};
                pg8::gemm_phase<pg8::EpiWin, decltype(S), decltype(g), true, true, true>(ldsp + RING_OFF, g, S, E, TID());
                if (bxp >= 192) {
                    const int tid = TID();
                    if (l == 0) {
#pragma unroll 1
                        for (int it = bxp - 192; it < 176; it += 64) Q_ITEM(0, 176 + it, tid, true);
                        RDY_SIGNAL3(CW_XSIG, 8, CW_F2RDY, -1);
                    } else {
#pragma unroll 1
                        for (int it = bxp - 192; it < 176; it += 64) Q_ITEM(1, 176 + it, tid, true);
                        RDY_SIGNAL3(CW_XSIG + 2048, 8, CW_F2RDY + 64, -1);
                    }
                }
            }
            XCDBAR();
            REP_LOOP(3) {
                unsigned char* ws = WSP(); unsigned char* R1 = ws + WS_R1; const int bxp = BXP();
                char* shm = (char*)lds + RING_OFF;
                const int vcu = (bxp & 7) * 32 + (bxp >> 3);
                const int bh = vcu >> 2, s4 = vcu & 3;
                float* ssa = SHADOW(3) ? (float*)(ws + WS_DUMMY) : (float*)(ws + WS_SSA);
                if (!(SHADOW(3) && PROBE_NOATT)) {
                attn_body::scan_bias(R1, bh >> 3, bh & 7, shm, TID());
#pragma unroll 1
                for (int iu = 0; iu < 2; ++iu) attn_body::attn_unit<60>(bh >> 3, bh & 7, iu ? 7 - s4 : s4, R1, SHADOW(3) ? 512 : 0, ssa, shm, TID());
                __syncthreads();
                }
                if (!(SHADOW(3) && PROBE_NOCONV)) {
                    attn_body::conv_stage_w(INP(9) + (size_t)l * 31 * 512, shm, TID());
#pragma unroll 1
                    for (int iu = 0; iu < 2; ++iu) attn_body::conv_unit(2 * vcu + iu, R1, INP(10) + l * 512, INP(11) + l * 512, INP(12) + l * 512, shm, TID());
                }
                if (l == 0) {
                { unsigned char* ws2 = WSP(); unsigned char* wl = ws2 + WS_W + (size_t)l * W_LAYER;
                  G_qk g; S_qk S; S.init(bxp, (bf16*)(ws2 + WS_MKV) + (size_t)l * 2048 * 2048, wl + WO_XQ);
                  pg8::EpiAux E{(bf16*)((unsigned char*)XPTR() + DOUT_WQK), 1.0f};
                  pg8::gemm_phase<pg8::EpiAux, decltype(S), decltype(g)>(ldsp + RING_OFF, g, S, E, TID()); }
                { unsigned char* ws2 = WSP(); unsigned char* wl = ws2 + WS_W + (size_t)l * W_LAYER;
                  G_vo g; S_vo S; S.init(bxp - 128, wl + WO_XO, (bf16*)(ws2 + WS_MKV) + (size_t)l * 2048 * 2048);
                  pg8::EpiAux E{(bf16*)((unsigned char*)XPTR() + DOUT_WVO), 1.0f};
                  pg8::gemm_phase<pg8::EpiAux, decltype(S), decltype(g)>(ldsp + RING_OFF, g, S, E, TID()); }
                }
                REP_SEAM(3);
            }
            {
                unsigned char* ws = WSP(); unsigned char* wl = ws + WS_W + (size_t)l * W_LAYER;
                G_1024 g; S_wout S; S.init(BXP(), ws + WS_R1 + pg8::T_Y, wl + WO_OUT);
                pg8::Unit u0; S.next(0, u0);
                auto hook = [=] { pg8::prestage_B<G_1024, true>(ldsp + RING_OFF, u0.b, TID()); };
                XCDBAR_H(hook);
                pg8::EpiResid<8> E{nullptr, nullptr, (bf16*)(ws + WS_XB), (float*)(ws + WS_SSP), (float*)(ws + WS_SSA), 1.0f};
                pg8::gemm_phase<pg8::EpiResid<8>, decltype(S), decltype(g), true, true, true>(ldsp + RING_OFF, g, S, E, TID());
            }
            {
                unsigned char* ws = WSP();
                G_1024 g; S_xs S; S.init(BXP(), ws + WS_XB, (unsigned char*)XPTR() + (size_t)l * DOUT_LAYER + DOUT_WQK);
                pg8::Unit u0; S.next(0, u0);
                auto hook = [=] { pg8::prestage_B<G_1024, true>(ldsp + RING_OFF, u0.b, TID()); };
                QUADBAR_H(hook);
                pg8::EpiSoftmax E{ws + WS_R1, (float*)(ws + WS_SSP), (LAS float*)(ldsp + EPI_SCR_OFF)};
                pg8::gemm_phase<pg8::EpiSoftmax, decltype(S), decltype(g), true, true, true>(ldsp + RING_OFF, g, S, E, TID());
            }
            {
                unsigned char* ws = WSP();
                G_1024 g; S_xpv S; S.init(BXP(), ws + WS_R1 + pg8::T_Y, (unsigned char*)XPTR() + (size_t)l * DOUT_LAYER + DOUT_WVO);
                pg8::Unit u0; S.next(0, u0);
                auto hook = [=] { pg8::prestage_B<G_1024, true>(ldsp + RING_OFF, u0.b, TID()); };
                QUADBAR_H(hook);
                if (MISCW(12)) {
                    unsigned* bw = BARW();
                    pg8::EpiResidQ E{(bf16*)(ws + WS_XB), (float*)(ws + WS_SSP), (float*)(ws + WS_AMX), ws + WS_XQ8, (float*)(ws + WS_RSC), 1.0f, bw - CW_BAR + CW_QUAD + 128 * (MISCW(10) * 8 + (MISCW(11) & 7)), bw + XB_TMO};
                    pg8::gemm_phase<pg8::EpiResidQ, decltype(S), decltype(g), true, true, true>(ldsp + RING_OFF, g, S, E, TID());
                } else {
                pg8::EpiResid<0> E{nullptr, nullptr, (bf16*)(ws + WS_XB), (float*)(ws + WS_SSP), nullptr, 1.0f};
                pg8::gemm_phase<pg8::EpiResid<0>, decltype(S), decltype(g), true, true, true>(ldsp + RING_OFF, g, S, E, TID());
                }
            }
            if (!MISCW(12)) QUADBAR();
        }
        if (l + 1 < NLAYER && !MISCW(12)) QUADBAR();
    }
    XCDBAR();
    for (int eb_ = 0; eb_ < PROBE_BARS; ++eb_) GRIDBAR();
#if defined(PROBE_QBARS)
    for (int eb_ = 0; eb_ < PROBE_QBARS; ++eb_) QUADBAR();
#endif
    {
        unsigned char* ws = WSP(); float* X = XPTR(); const int tid = TID(); const int bxp = BXP();
        const int lane = tid & 63, wave = __builtin_amdgcn_readfirstlane(tid >> 6);
        const int row0 = (8 * (bxp & 7) + ((bxp >> 3) & 7)) * 256 + (bxp >> 6) * 64 + wave * 8;
        const float* ssf = (float*)(ws + WS_SSP); const float* gn = INP(25); const bf16* XB = (const bf16*)(ws + WS_XB);
        f32x4 gv[4];
#pragma unroll
        for (int j = 0; j < 4; ++j) gv[j] = *((const GAS f32x4*)gn + lane + 64 * j);
#pragma unroll 2
        for (int r = 0; r < 8; ++r) { const int m = row0 + r; const float rs = pg8::rs_row(ssf, m);
            const GAS unsigned long long* xr = (const GAS unsigned long long*)(XB + (size_t)m * DM) + lane; GAS f32x4* orow = (GAS f32x4*)(X + (size_t)m * DM) + lane;
#pragma unroll
            for (int j = 0; j < 4; ++j) { const unsigned long long w = xr[64 * j]; const unsigned lo = (unsigned)w, hi = (unsigned)(w >> 32);
                f32x4 v = (f32x4){__uint_as_float(lo << 16), __uint_as_float(lo & 0xffff0000u), __uint_as_float(hi << 16), __uint_as_float(hi & 0xffff0000u)};
                __builtin_nontemporal_store(v * rs * gv[j], &orow[64 * j]); } }
    }
}

static int g_grid = 0;
static bool mega_setup() {
    if (g_grid) return g_grid > 0;
    int dev = 0, cus = 0, per_cu = 0;
    if (hipGetDevice(&dev) != hipSuccess || hipDeviceGetAttribute(&cus, hipDeviceAttributeMultiprocessorCount, dev) != hipSuccess) { g_grid = -1; return false; }
    if (hipFuncSetAttribute((const void*)mega_fwd, hipFuncAttributeMaxDynamicSharedMemorySize, LDS_BYTES) != hipSuccess) { fprintf(stderr, "hipFuncSetAttribute failed\n"); g_grid = -1; return false; }
    if (hipOccupancyMaxActiveBlocksPerMultiprocessor(&per_cu, (const void*)mega_fwd, NWAVES * 64, LDS_BYTES) != hipSuccess || per_cu < 1) { fprintf(stderr, "occupancy query: %d blocks per CU\n", per_cu); (void)hipGetLastError(); g_grid = -1; return false; }
    g_grid = cus;
    if (g_grid != 256) { fprintf(stderr, "kernel_launch: %d CUs; the phase program is laid out for exactly 256: nothing launched\n", g_grid); g_grid = -1; return false; }
    return true;
}
static void mega_launch(void* const* d_in, void* d_out, void* d_ws, hipStream_t stream) {
    Args a{};
    for (int i = 0; i < 26; ++i) a.in[i] = (const float*)d_in[i];
    a.out = (float*)d_out; a.ws = (unsigned char*)d_ws;
    hipLaunchKernelGGL(mega_fwd, dim3(g_grid), dim3(NWAVES * 64), LDS_BYTES, stream, a);
}
extern "C" void kernel_launch(void* const* d_in, const int* in_sizes, int n_in, void* d_out, int out_size, void* d_ws, size_t ws_size, hipStream_t stream) {
    if (!mega_setup()) return;
    if (ws_size < WS_END) { fprintf(stderr, "kernel_launch: workspace too small (%zu < %zu)\n", ws_size, (size_t)WS_END); return; }
    (void)hipMemsetAsync((char*)d_ws + WS_CTL, 0, CTL_ZERO_BYTES, stream);
    mega_launch(d_in, d_out, d_ws, stream);
}
```
